# Optimizing an MI355X kernel written in HIP

```python
import math
import jax
import jax.numpy as jnp
from jax import lax
import numpy as np

D_MODEL = 1024
BATCH = 4
SEQ = 8192
DEPTH = 4

GRID_W = 64
CTX_LEN = 256
HEAD_DIM = 64
ROPE_THETA = 10000.0
NORM_EPS = 1e-6
Q_BLOCK = 128
D_FF = 4 * D_MODEL
N_MOD = 6
MIX_HALF = D_MODEL // 2

GLA_HEADS = 4
GLA_DV = MIX_HALF // GLA_HEADS
GLA_DK = GLA_DV // 2
GLA_RANK = 16
GLA_NORMALIZER = 16.0
GLA_CHUNK = 64
GLA_QK = GLA_HEADS * GLA_DK
GLA_V = GLA_HEADS * GLA_DV

GQA_HEADS = MIX_HALF // HEAD_DIM
GQA_KV_HEADS = 2

HY_CH = MIX_HALF
HY_ORDER = 2
HY_SHORT = 3
HY_BANDS = 16
HY_EMB = 2 * HY_BANDS + 1
HY_FFN = 64
HY_TARGET = 1e-2
HY_FAST_PCT = 0.3
HY_SLOW_PCT = 1.5
HY_COLS = (HY_ORDER + 1) * HY_CH

DIFF_HEADS = MIX_HALF // (2 * HEAD_DIM)
DIFF_QK = DIFF_HEADS * 2 * HEAD_DIM
DIFF_V = DIFF_HEADS * 2 * HEAD_DIM

EVEN_COLS = 2 * GLA_QK + 2 * GLA_V + 2 * GLA_RANK + (GQA_HEADS + 2 * GQA_KV_HEADS) * HEAD_DIM
EVEN_MIX = GLA_V + GQA_HEADS * HEAD_DIM
ODD_COLS = HY_COLS + 2 * DIFF_QK + DIFF_V
ODD_MIX = HY_CH + DIFF_V

kernel_name = "hybrid_gla_gqa_hyena_diffattn_dit"


def rmsnorm(x, g):
    xf = x.astype(jnp.float32)
    y = xf * lax.rsqrt(jnp.mean(xf * xf, axis=-1, keepdims=True) + NORM_EPS)
    return (y * g.astype(jnp.float32)).astype(x.dtype)


def modulate(h, shift, scale):
    return h * (1 + scale) + shift


def split_cols(t, sizes):
    return jnp.split(t, np.cumsum(sizes)[:-1].tolist(), axis=-1)


def sq_relu_mlp(h, w1, w2):
    return jnp.square(jax.nn.relu(h @ w1)) @ w2


def axial_rope_tables(rows):
    r = jnp.broadcast_to(jnp.arange(rows, dtype=jnp.float32)[:, None], (rows, GRID_W)).reshape(-1)
    col = jnp.broadcast_to(jnp.arange(GRID_W, dtype=jnp.float32)[None, :], (rows, GRID_W)).reshape(-1)
    n_pairs = HEAD_DIM // 4
    inv = ROPE_THETA ** (-jnp.arange(n_pairs, dtype=jnp.float32) / n_pairs)
    ang = jnp.concatenate([r[:, None] * inv, col[:, None] * inv], axis=-1)
    return jnp.cos(ang), jnp.sin(ang)


def apply_rope(t, cos, sin):
    L = t.shape[1]
    bshape = (L,) + (1,) * (t.ndim - 3) + (HEAD_DIM // 2,)
    cs, sn = cos.reshape(bshape), sin.reshape(bshape)
    tp = t.astype(jnp.float32).reshape(t.shape[:-1] + (HEAD_DIM // 2, 2))
    x1, x2 = tp[..., 0], tp[..., 1]
    out = jnp.stack([x1 * cs - x2 * sn, x1 * sn + x2 * cs], axis=-1)
    return out.reshape(t.shape).astype(t.dtype)


def gla_chunked(q, k, v, la, s0):
    B, L, H, dk = q.shape
    dv = v.shape[-1]
    n = L // GLA_CHUNK

    def blocks(t):
        return t.astype(jnp.float32).reshape(B, n, GLA_CHUNK, H, t.shape[-1]).transpose(1, 0, 3, 2, 4)

    q, k, v, la = blocks(q), blocks(k), blocks(v), blocks(la)
    b = jnp.cumsum(la, axis=3)
    b_end = b[:, :, :, -1:]
    q_in = q * jnp.exp(b)
    k_in = k * jnp.exp(-b)
    k_end = k * jnp.exp(b_end - b)
    mask = jnp.tril(jnp.ones((GLA_CHUNK, GLA_CHUNK), dtype=bool))
    a = jnp.where(mask, jnp.einsum('nbhid,nbhjd->nbhij', q_in, k_in), 0.0)
    o_intra = jnp.einsum('nbhij,nbhjv->nbhiv', a, v)

    def step(s, inp):
        q_c, k_c, v_c, dec = inp
        o_c = jnp.einsum('bhid,bhdv->bhiv', q_c, s)
        s = s * dec[..., None] + jnp.einsum('bhjd,bhjv->bhdv', k_c, v_c)
        return s, o_c

    s_fin, o_inter = lax.scan(step, s0, (q_in, k_end, v, jnp.exp(b_end[:, :, :, 0])))
    o = (o_intra + o_inter).transpose(1, 0, 3, 2, 4).reshape(B, L, H, dv)
    return o, s_fin


def gla_final_state(k, v, la, s0):
    b = jnp.cumsum(la, axis=1)
    tot = b[:, -1]
    kw = k.astype(jnp.float32) * jnp.exp(tot[:, None] - b)
    return s0 * jnp.exp(tot)[..., None] + jnp.einsum('blhd,blhv->bhdv', kw, v.astype(jnp.float32))


def gla_mixer(p, pc, w_lr, b_lr, gain, ctx_out):
    def prep(q, k, v, g, lr):
        B, L, _ = q.shape
        gk = jnp.einsum('blzr,zrk->blzk', lr.reshape(B, L, 2, GLA_RANK), w_lr) + b_lr
        la = (jax.nn.log_sigmoid(gk.astype(jnp.float32)) / GLA_NORMALIZER).reshape(B, L, 2, GLA_HEADS, GLA_DK)
        return (q.reshape(B, L, GLA_HEADS, GLA_DK) * GLA_DK ** -0.5,
                k.reshape(B, L, GLA_HEADS, GLA_DK),
                v.reshape(B, L, GLA_HEADS, GLA_DV),
                g.reshape(B, L, GLA_HEADS, GLA_DV),
                la)

    q, k, v, g, la = prep(*p)
    qc, kc, vc, gc, lac = prep(*pc)
    s0 = jnp.zeros((q.shape[0], GLA_HEADS, GLA_DK, GLA_DV), jnp.float32)
    o, oc = 0.0, 0.0
    for d in range(2):
        rev = (lambda t: t[:, ::-1]) if d == 1 else (lambda t: t)
        if ctx_out:
            oc_d, s_ctx = gla_chunked(rev(qc), rev(kc), rev(vc), rev(lac[:, :, d]), s0)
            oc = oc + rev(oc_d)
        else:
            s_ctx = gla_final_state(rev(kc), rev(vc), rev(lac[:, :, d]), s0)
        o_d, _ = gla_chunked(rev(q), rev(k), rev(v), rev(la[:, :, d]), s_ctx)
        o = o + rev(o_d)

    def out(o, g):
        B, L = o.shape[:2]
        return (rmsnorm(o.astype(g.dtype), gain) * jax.nn.silu(g)).reshape(B, L, GLA_V)

    return out(o, g), (out(oc, gc) if ctx_out else None)


def gqa_attend(q, keys, vals):
    B, L, hq, hd = q.shape
    hkv = keys.shape[2]
    qb = q.reshape(B, L // Q_BLOCK, Q_BLOCK, hkv, hq // hkv, hd).transpose(1, 0, 2, 3, 4, 5)

    def one(qblk):
        s = jnp.einsum('bqkgd,bskd->bkgqs', qblk, keys).astype(jnp.float32) * hd ** -0.5
        pr = jax.nn.softmax(s, axis=-1).astype(vals.dtype)
        return jnp.einsum('bkgqs,bskd->bqkgd', pr, vals)

    o = lax.map(one, qb)
    return o.transpose(1, 0, 2, 3, 4, 5).reshape(B, L, hq * hd)


def gqa_mixer(p, pc, qk_g, cos, sin, ctx_out):
    def heads(q, k, v):
        B, L, _ = q.shape
        q = rmsnorm(q.reshape(B, L, GQA_HEADS, HEAD_DIM), qk_g[0])
        k = rmsnorm(k.reshape(B, L, GQA_KV_HEADS, HEAD_DIM), qk_g[1])
        return q, k, v.reshape(B, L, GQA_KV_HEADS, HEAD_DIM)

    q, k, v = heads(*p)
    qc, kc, vc = heads(*pc)
    q, k = apply_rope(q, cos, sin), apply_rope(k, cos, sin)
    y = gqa_attend(q, jnp.concatenate([kc, k], axis=1), jnp.concatenate([vc, v], axis=1))
    yc = gqa_attend(qc, kc, vc) if ctx_out else None
    return y, yc


def even_mixer(h, hc, w_in, w_lr, b_lr, gla_g, qk_g, w_out, cos, sin, ctx_out):
    sizes = (GLA_QK, GLA_QK, GLA_V, GLA_V, 2 * GLA_RANK,
             GQA_HEADS * HEAD_DIM, GQA_KV_HEADS * HEAD_DIM, GQA_KV_HEADS * HEAD_DIM)
    p = split_cols(h @ w_in, sizes)
    pc = split_cols(hc @ w_in, sizes)
    y_a, yc_a = gla_mixer(p[:5], pc[:5], w_lr, b_lr, gla_g, ctx_out)
    y_b, yc_b = gqa_mixer(p[5:], pc[5:], qk_g, cos, sin, ctx_out)
    y = jnp.concatenate([y_a, y_b], axis=-1) @ w_out
    yc = (jnp.concatenate([yc_a, yc_b], axis=-1) @ w_out) if ctx_out else None
    return y, yc


def short_conv3(u, w, b):
    up = jnp.pad(u, ((0, 0), (1, 1), (0, 0)))
    return up[:, :-2] * w[0] + up[:, 1:-1] * w[1] + up[:, 2:] * w[2] + b


def hyena_filters(L, w1, b1, w2, b2, w3):
    pos = jnp.arange(L, dtype=jnp.float32)
    t = pos / max(L - 1, 1)
    w = 2 * math.pi * pos / L
    bands = jnp.linspace(1e-4, HY_BANDS - 1, HY_BANDS, dtype=jnp.float32)
    z = jnp.concatenate([t[:, None], jnp.cos(w[:, None] * bands), -jnp.sin(w[:, None] * bands)], axis=-1)
    z = z.astype(w1.dtype)
    hid = jnp.sin(z @ w1 + b1)
    hid = jnp.sin(hid @ w2 + b2)
    h = (hid @ w3).astype(jnp.float32).reshape(L, HY_ORDER, 2, HY_CH)
    deltas = jnp.abs(jnp.linspace(math.log(HY_TARGET) / HY_FAST_PCT, math.log(HY_TARGET) / HY_SLOW_PCT,
                                  HY_CH, dtype=jnp.float32))
    return h * jnp.exp(-t[:, None] * deltas)[:, None, None, :]


def bidir_fft_conv(u, h_fwd, h_bwd):
    L, C = h_fwd.shape
    k = jnp.concatenate([h_fwd, jnp.zeros((1, C), h_fwd.dtype), h_bwd[1:][::-1]], axis=0)
    uf = jnp.fft.rfft(u.astype(jnp.float32), n=2 * L, axis=1)
    kf = jnp.fft.rfft(k, n=2 * L, axis=0)
    y = jnp.fft.irfft(uf * kf[None], n=2 * L, axis=1)[:, :L]
    return y.astype(u.dtype)


def hyena_mixer(u, uc, conv_w, conv_b, f_w1, f_b1, f_w2, f_b2, f_w3, hy_bias, ctx_out):
    def run(u):
        L = u.shape[1]
        v, x1, x2 = jnp.split(short_conv3(u, conv_w, conv_b), HY_ORDER + 1, axis=-1)
        h = hyena_filters(L, f_w1, f_b1, f_w2, f_b2, f_w3)
        z = v
        for o, gate in enumerate((x1, x2)):
            z = gate * (bidir_fft_conv(z, h[:, o, 0], h[:, o, 1]) + z * hy_bias[o])
        return z

    return run(u), (run(uc) if ctx_out else None)


def diff_attend(q, keys, vals, lam):
    B, L, H, _, hd = q.shape
    qb = q.reshape(B, L // Q_BLOCK, Q_BLOCK, H, 2, hd).transpose(1, 0, 2, 3, 4, 5)

    def one(qblk):
        s = jnp.einsum('bqhcd,bshcd->bhcqs', qblk, keys).astype(jnp.float32) * hd ** -0.5
        pr = jax.nn.softmax(s, axis=-1)
        a = (pr[:, :, 0] - lam * pr[:, :, 1]).astype(vals.dtype)
        return jnp.einsum('bhqs,bshv->bqhv', a, vals)

    o = lax.map(one, qb)
    return o.transpose(1, 0, 2, 3, 4).reshape(B, L, H, vals.shape[-1])


def diff_mixer(p, pc, lam_p, gain, layer_idx, cos, sin, ctx_out):
    lam_init = 0.8 - 0.6 * math.exp(-0.3 * layer_idx)
    lp = lam_p.astype(jnp.float32)
    lam = jnp.exp(jnp.sum(lp[0] * lp[1])) - jnp.exp(jnp.sum(lp[2] * lp[3])) + lam_init

    def heads(q, k, v):
        B, L, _ = q.shape
        return (q.reshape(B, L, DIFF_HEADS, 2, HEAD_DIM), k.reshape(B, L, DIFF_HEADS, 2, HEAD_DIM),
                v.reshape(B, L, DIFF_HEADS, 2 * HEAD_DIM))

    q, k, v = heads(*p)
    qc, kc, vc = heads(*pc)
    q, k = apply_rope(q, cos, sin), apply_rope(k, cos, sin)

    def out(o):
        B, L = o.shape[:2]
        return (rmsnorm(o, gain) * (1 - lam_init)).reshape(B, L, DIFF_V)

    y = out(diff_attend(q, jnp.concatenate([kc, k], axis=1), jnp.concatenate([vc, v], axis=1), lam))
    yc = out(diff_attend(qc, kc, vc, lam)) if ctx_out else None
    return y, yc


def odd_mixer(h, hc, w_in, conv_w, conv_b, f_w1, f_b1, f_w2, f_b2, f_w3, hy_bias, lam_p, diff_g, w_out,
              cos, sin, layer_idx, ctx_out):
    sizes = (HY_COLS, DIFF_QK, DIFF_QK, DIFF_V)
    p = split_cols(h @ w_in, sizes)
    pc = split_cols(hc @ w_in, sizes)
    y_c, yc_c = hyena_mixer(p[0], pc[0], conv_w, conv_b, f_w1, f_b1, f_w2, f_b2, f_w3, hy_bias, ctx_out)
    y_d, yc_d = diff_mixer(p[1:], pc[1:], lam_p, diff_g, layer_idx, cos, sin, ctx_out)
    y = jnp.concatenate([y_c, y_d], axis=-1) @ w_out
    yc = (jnp.concatenate([yc_c, yc_d], axis=-1) @ w_out) if ctx_out else None
    return y, yc


def setup_inputs(seed: int = 0) -> dict:
    key = jax.random.key(seed)
    ks = jax.random.split(key, 28)
    ne, no = (DEPTH + 1) // 2, DEPTH // 2
    f32 = jnp.float32

    def nrm(k, shape, fan_in, scale=1.0):
        return jax.random.normal(k, shape, f32) * (scale * fan_in ** -0.5)

    def gain(k, shape):
        return 1.0 + 0.05 * jax.random.normal(k, shape, f32)

    def small(k, shape, s):
        return s * jax.random.normal(k, shape, f32)

    return {
        "x": jax.random.normal(ks[0], (BATCH, SEQ, D_MODEL), f32),
        "c": jax.random.normal(ks[1], (BATCH, D_MODEL), f32),
        "ctx": jax.random.normal(ks[2], (BATCH, CTX_LEN, D_MODEL), f32),
        "c_ctx": jax.random.normal(ks[3], (D_MODEL,), f32),
        "w_ada": nrm(ks[4], (DEPTH, D_MODEL, N_MOD * D_MODEL), D_MODEL),
        "b_ada": small(ks[5], (DEPTH, N_MOD * D_MODEL), 0.02),
        "norm_g": gain(ks[6], (DEPTH, 4, D_MODEL)),
        "w_mlp_in": nrm(ks[7], (DEPTH, D_MODEL, D_FF), D_MODEL),
        "w_mlp_out": nrm(ks[8], (DEPTH, D_FF, D_MODEL), D_FF),
        "ev_w_in": nrm(ks[9], (ne, D_MODEL, EVEN_COLS), D_MODEL),
        "ev_w_lr": nrm(ks[10], (ne, 2, GLA_RANK, GLA_QK), GLA_RANK),
        "ev_b_lr": small(ks[11], (ne, 2, GLA_QK), 0.1),
        "ev_gla_g": gain(ks[12], (ne, GLA_DV)),
        "ev_qk_g": gain(ks[13], (ne, 2, HEAD_DIM)),
        "ev_w_out": nrm(ks[14], (ne, EVEN_MIX, D_MODEL), EVEN_MIX),
        "od_w_in": nrm(ks[15], (no, D_MODEL, ODD_COLS), D_MODEL),
        "od_conv_w": nrm(ks[16], (no, HY_SHORT, HY_COLS), HY_SHORT),
        "od_conv_b": small(ks[17], (no, HY_COLS), 0.02),
        "od_f_w1": nrm(ks[18], (no, HY_EMB, HY_FFN), HY_EMB),
        "od_f_b1": small(ks[19], (no, HY_FFN), 0.1),
        "od_f_w2": nrm(ks[20], (no, HY_FFN, HY_FFN), HY_FFN),
        "od_f_b2": small(ks[21], (no, HY_FFN), 0.1),
        "od_f_w3": nrm(ks[22], (no, HY_FFN, HY_ORDER * 2 * HY_CH), HY_FFN, 0.05),
        "od_hy_bias": small(ks[23], (no, HY_ORDER, HY_CH), 0.5),
        "od_lam": small(ks[24], (no, 4, HEAD_DIM), 0.1),
        "od_diff_g": gain(ks[25], (no, 2 * HEAD_DIM)),
        "od_w_out": nrm(ks[26], (no, ODD_MIX, D_MODEL), ODD_MIX),
    }


def reference(x, c, ctx, c_ctx, w_ada, b_ada, norm_g, w_mlp_in, w_mlp_out,
              ev_w_in, ev_w_lr, ev_b_lr, ev_gla_g, ev_qk_g, ev_w_out,
              od_w_in, od_conv_w, od_conv_b, od_f_w1, od_f_b1, od_f_w2, od_f_b2, od_f_w3,
              od_hy_bias, od_lam, od_diff_g, od_w_out):
    ROWS = x.shape[1] // GRID_W
    cos, sin = axial_rope_tables(ROWS)
    sc = jax.nn.silu(c)
    scc = jax.nn.silu(c_ctx)
    for i in range(DEPTH):
        last = i == DEPTH - 1
        j = i // 2
        g = norm_g[i]
        m = [t[:, None, :] for t in jnp.split(sc @ w_ada[i] + b_ada[i], N_MOD, axis=-1)]
        mc = jnp.split(scc @ w_ada[i] + b_ada[i], N_MOD, axis=-1)
        h = modulate(rmsnorm(x, g[0]), m[0], m[1])
        hc = modulate(rmsnorm(ctx, g[0]), mc[0], mc[1])
        if i % 2 == 0:
            y, yc = even_mixer(h, hc, ev_w_in[j], ev_w_lr[j], ev_b_lr[j], ev_gla_g[j], ev_qk_g[j], ev_w_out[j],
                               cos, sin, not last)
        else:
            y, yc = odd_mixer(h, hc, od_w_in[j], od_conv_w[j], od_conv_b[j], od_f_w1[j], od_f_b1[j], od_f_w2[j],
                              od_f_b2[j], od_f_w3[j], od_hy_bias[j], od_lam[j], od_diff_g[j], od_w_out[j],
                              cos, sin, i, not last)
        x = x + m[2] * rmsnorm(y, g[1])
        x = x + m[5] * rmsnorm(sq_relu_mlp(modulate(rmsnorm(x, g[2]), m[3], m[4]), w_mlp_in[i], w_mlp_out[i]), g[3])
        if not last:
            ctx = ctx + mc[2] * rmsnorm(yc, g[1])
            ctx = ctx + mc[5] * rmsnorm(
                sq_relu_mlp(modulate(rmsnorm(ctx, g[2]), mc[3], mc[4]), w_mlp_in[i], w_mlp_out[i]), g[3])
    return x
```

```cpp
#include <hip/hip_runtime.h>
#include <cstdio>
#include <cstdint>

namespace pg8 {
#define PG8_LAS __attribute__((address_space(3)))
typedef unsigned short bf16_t;
typedef short bf16x8 __attribute__((ext_vector_type(8)));
typedef float f32x4 __attribute__((ext_vector_type(4)));
typedef unsigned u32x4 __attribute__((ext_vector_type(4)));
constexpr int BM = 256, BK = 64, HALF = 128, HTB = HALF * BK * 2  , STAGE_BYTES = 8 * HTB, NXCD = 8, WGM = 8;

__host__ __device__ __forceinline__ int lds_byte(int r, int c) { const int st = (r >> 4) * 2 + (c >> 5), rr = r & 15, cc = c & 31, ob = rr * 64 + cc * 2; return st * 1024 + (ob ^ (((ob >> 9) & 1) << 5)); }
__host__ __device__ __forceinline__ void stage_rc(int b, int& R, int& C) { const int st = b / 1024, sb = b % 1024, swz = sb ^ (((sb >> 9) & 1) << 5); R = (st >> 1) * 16 + swz / 64; C = (st & 1) * 32 + (swz % 64) / 2; }
__host__ __device__ __forceinline__ int perm32(int rho) { const int n = rho >> 4, i = rho & 15; return 8 * (i >> 2) + 4 * n + (i & 3); }

struct Unit { int pm, pn; };
struct Gemm { const bf16_t* A; const bf16_t* Bt; int M, N, K; };

struct StaticOrder {
    int nM, nN, nwg, G, c;
    __host__ __device__ void init(int M, int N, int G_, int c_) { nM = M / BM; nN = N / BM; nwg = nM * nN; G = G_; c = c_; }
    __host__ __device__ bool next(int i, Unit& u) const {
        const long L = (long)i * G + c; if (L >= nwg) return false;
        int wgid = (int)L; { const int q = nwg / NXCD, r = nwg % NXCD, xcd = wgid % NXCD, off = wgid / NXCD; wgid = (xcd < r ? xcd * (q + 1) : r * (q + 1) + (xcd - r) * q) + off; }
        const int nig = WGM * nN, gid = wgid / nig, fm = gid * WGM, gsz = (nM - fm) < WGM ? (nM - fm) : WGM;
        u.pm = fm + ((wgid % nig) % gsz); u.pn = (wgid % nig) / gsz; return true;
    }
    __device__ __forceinline__ void a_ready(const Unit&) const {}
    __device__ __forceinline__ void done(const Unit&) const {}
};


__device__ __forceinline__ unsigned cvt_pk_bf16(float lo, float hi) { unsigned r; asm volatile("v_cvt_pk_bf16_f32 %0, %1, %2" : "=v"(r) : "v"(lo), "v"(hi)); return r; }
template <int ACT  > struct EpiBf16 {
    static constexpr bool PERM = true, AFTER_DRAIN = false;
    bf16_t* O; int ldc;
    __device__ __forceinline__ void operator()(const f32x4 (&acc)[2][2][4][2], const Unit& u, int wr, int wc, int fr, int fq) const {
        const int row0 = u.pm * BM + wr * 64 + fr; const int col0 = u.pn * BM + wc * 32 + 8 * fq;
#pragma unroll
        for (int ai = 0; ai < 2; ++ai)
#pragma unroll
            for (int m = 0; m < 4; ++m) { bf16_t* rowp = O + (size_t)(row0 + ai * HALF + m * 16) * ldc + col0;
#pragma unroll
                for (int bj = 0; bj < 2; ++bj) { f32x4 v0 = acc[ai][bj][m][0], v1 = acc[ai][bj][m][1];
                    if (ACT == 2) {
#pragma unroll
                        for (int e = 0; e < 4; ++e) { const float a0 = fmaxf(v0[e], 0.f), a1 = fmaxf(v1[e], 0.f); v0[e] = a0 * a0; v1[e] = a1 * a1; } }
                    u32x4 w; w.x = cvt_pk_bf16(v0[0], v0[1]); w.y = cvt_pk_bf16(v0[2], v0[3]); w.z = cvt_pk_bf16(v1[0], v1[1]); w.w = cvt_pk_bf16(v1[2], v1[3]);
                    *(u32x4*)(rowp + bj * HALF) = w; } }
    }
};

template <class Epi, class Sched, bool ALIGN_EPI = false, bool SP2 = false>
__device__ __forceinline__ void gemm_phase(PG8_LAS unsigned char* lds, const Gemm g, const Sched& S, const Epi& E) {
    int tid_ = threadIdx.x; asm volatile("" : "+v"(tid_));
    const int tid = tid_, wid = __builtin_amdgcn_readfirstlane(tid >> 6), lane = tid & 63, wr = wid >> 2, wc = wid & 3, fr = lane & 15, fq = lane >> 4;
    const int K = g.K, nt = K / BK;
    unsigned voffA[2], voffB[2];
#pragma unroll
    for (int i = 0; i < 2; ++i) { int R, C; stage_rc(tid * 16 + i * 8192, R, C); const int Rb = Epi::PERM ? ((R & ~31) + perm32(R & 31)) : R;
        voffA[i] = (unsigned)(R * K + C) * 2u; voffB[i] = (unsigned)(Rb * K + C) * 2u; }
    const size_t kstep = (size_t)(BK * 2);
    const size_t hstep = (size_t)HALF * K * 2;
    const size_t tstep = 2 * hstep;
    const unsigned ldsw = (unsigned)wid * 1024u;
    const int aoff = lds_byte(wr * 64 + fr, fq * 8), boff = lds_byte(wc * 32 + fr, fq * 8);
#define PG8_SA(b, h) (((b) * 2 + (h)) * HTB)
#define PG8_SB(b, h) ((4 + (b) * 2 + (h)) * HTB)
#define PG8_STAGE(bufoff, gbase, voff) do { _Pragma("unroll") for (int _i = 0; _i < 2; ++_i) \
        __builtin_amdgcn_global_load_lds((const unsigned*)((const char*)(gbase) + (voff)[_i]), (PG8_LAS unsigned*)(lds + (bufoff) + ldsw + _i * 8192), 16, 0, 0); } while (0)
#define PG8_LDA(dst, b, h) do { _Pragma("unroll") for (int m = 0; m < 4; ++m) _Pragma("unroll") for (int k = 0; k < 2; ++k) dst[m][k] = *(const PG8_LAS bf16x8*)(lds + PG8_SA(b, h) + aoff + m * 2048 + k * 1024); } while (0)
#define PG8_LDB(dst, b, h) do { _Pragma("unroll") for (int n = 0; n < 2; ++n) _Pragma("unroll") for (int k = 0; k < 2; ++k) dst[n][k] = *(const PG8_LAS bf16x8*)(lds + PG8_SB(b, h) + boff + n * 2048 + k * 1024); } while (0)
#define PG8_MMA(ai, bj, At, Bt) do { __builtin_amdgcn_s_setprio(1); _Pragma("unroll") for (int m = 0; m < 4; ++m) _Pragma("unroll") for (int n = 0; n < 2; ++n) _Pragma("unroll") for (int k = 0; k < 2; ++k) \
        acc[ai][bj][m][n] = __builtin_amdgcn_mfma_f32_16x16x32_bf16(Bt[n][k], At[m][k], acc[ai][bj][m][n], 0, 0, 0); __builtin_amdgcn_s_setprio(0); } while (0)
#define PG8_WAIT_V(n) asm volatile("s_waitcnt vmcnt(" #n ")" ::: "memory")
#define PG8_WAIT_L(n) asm volatile("s_waitcnt lgkmcnt(" #n ")" ::: "memory")
#define PG8_BAR __builtin_amdgcn_s_barrier()
#define PG8_SCHED __builtin_amdgcn_sched_barrier(0)
    Unit cur, nxt; int ui = 0;
    if (!S.next(0, cur)) return;
    f32x4 acc[2][2][4][2];
#pragma unroll
    for (int a = 0; a < 2; ++a)
#pragma unroll
        for (int b = 0; b < 2; ++b)
#pragma unroll
            for (int m = 0; m < 4; ++m)
#pragma unroll
                for (int n = 0; n < 2; ++n) acc[a][b][m][n] = (f32x4){0.f, 0.f, 0.f, 0.f};
    bf16x8 At[4][2], B0[2][2], B1[2][2];
    const char* cA = (const char*)g.A + (size_t)cur.pm * tstep; const char* cB = (const char*)g.Bt + (size_t)cur.pn * tstep;
    S.a_ready(cur);
    if constexpr (SP2) {
        PG8_STAGE(PG8_SB(0, 0), cB, voffB); PG8_STAGE(PG8_SB(0, 1), cB + hstep, voffB); PG8_STAGE(PG8_SA(0, 0), cA, voffA); PG8_STAGE(PG8_SA(0, 1), cA + hstep, voffA);
        if (wr == 1) PG8_BAR;
        PG8_WAIT_V(2); PG8_BAR;
        PG8_STAGE(PG8_SB(1, 0), cB + kstep, voffB); PG8_STAGE(PG8_SA(1, 0), cA + kstep, voffA); PG8_STAGE(PG8_SB(1, 1), cB + hstep + kstep, voffB);
        PG8_WAIT_V(6); PG8_BAR;
    } else {
        PG8_STAGE(PG8_SB(0, 0), cB, voffB); PG8_STAGE(PG8_SA(0, 0), cA, voffA); PG8_STAGE(PG8_SB(0, 1), cB + hstep, voffB); PG8_STAGE(PG8_SA(0, 1), cA + hstep, voffA);
        if (wr == 1) PG8_BAR;
        PG8_WAIT_V(4); PG8_BAR;
        PG8_STAGE(PG8_SB(1, 0), cB + kstep, voffB); PG8_STAGE(PG8_SA(1, 0), cA + kstep, voffA); PG8_STAGE(PG8_SB(1, 1), cB + hstep + kstep, voffB);
        PG8_WAIT_V(6); PG8_BAR;
    }
    for (;;) {
        const bool has_next = S.next(ui + 1, nxt);
        const char* nA = has_next ? (const char*)g.A + (size_t)nxt.pm * tstep : cA; const char* nB = has_next ? (const char*)g.Bt + (size_t)nxt.pn * tstep : cB;
        for (int t = 0; t < nt; t += 2) {
            const bool last = (t == nt - 2);
            const char* a1 = cA + (size_t)(t + 1) * kstep;
            const char* a2 = last ? nA : cA + (size_t)(t + 2) * kstep; const char* b2 = last ? nB : cB + (size_t)(t + 2) * kstep;
            const char* a3 = a2 + kstep; const char* b3 = b2 + kstep;
            if (last && has_next) S.a_ready(nxt);
            if constexpr (SP2) {
            PG8_LDB(B0, 0, 0); PG8_LDB(B1, 0, 1); PG8_SCHED; PG8_LDA(At, 0, 0); PG8_STAGE(PG8_SA(1, 1), a1 + hstep, voffA);
            PG8_WAIT_V(8); PG8_WAIT_L(0); PG8_BAR; PG8_MMA(0, 0, At, B0); PG8_MMA(0, 1, At, B1); PG8_BAR; PG8_SCHED;
            PG8_LDA(At, 0, 1); PG8_STAGE(PG8_SB(0, 0), b2, voffB); PG8_STAGE(PG8_SB(0, 1), b2 + hstep, voffB); PG8_STAGE(PG8_SA(0, 0), a2, voffA);
            PG8_WAIT_V(8); PG8_WAIT_L(0); PG8_BAR; PG8_MMA(1, 0, At, B0); PG8_MMA(1, 1, At, B1); PG8_BAR; PG8_SCHED;
            PG8_LDB(B0, 1, 0); PG8_LDB(B1, 1, 1); PG8_SCHED; PG8_LDA(At, 1, 0); PG8_STAGE(PG8_SA(0, 1), a2 + hstep, voffA);
            PG8_WAIT_V(8); PG8_WAIT_L(0); PG8_BAR; PG8_MMA(0, 0, At, B0); PG8_MMA(0, 1, At, B1); PG8_BAR; PG8_SCHED;
            PG8_LDA(At, 1, 1); PG8_STAGE(PG8_SB(1, 0), b3, voffB); PG8_STAGE(PG8_SB(1, 1), b3 + hstep, voffB); PG8_STAGE(PG8_SA(1, 0), a3, voffA);
            PG8_WAIT_V(8); PG8_WAIT_L(0); PG8_BAR; PG8_MMA(1, 0, At, B0); PG8_MMA(1, 1, At, B1); PG8_BAR; PG8_SCHED;
            } else {
            PG8_LDB(B0, 0, 0); PG8_SCHED; PG8_LDA(At, 0, 0); PG8_STAGE(PG8_SA(1, 1), a1 + hstep, voffA);
            PG8_WAIT_L(8); PG8_BAR; PG8_WAIT_L(0); PG8_MMA(0, 0, At, B0); PG8_BAR; PG8_SCHED;
            PG8_LDB(B1, 0, 1); PG8_STAGE(PG8_SB(0, 0), b2, voffB);
            PG8_BAR; PG8_WAIT_L(0); PG8_MMA(0, 1, At, B1); PG8_BAR;
            PG8_LDA(At, 0, 1); PG8_STAGE(PG8_SA(0, 0), a2, voffA);
            PG8_BAR; PG8_WAIT_L(0); PG8_MMA(1, 0, At, B0); PG8_BAR; PG8_SCHED;
            PG8_STAGE(PG8_SB(0, 1), b2 + hstep, voffB);
            PG8_WAIT_V(6); PG8_BAR; PG8_MMA(1, 1, At, B1); PG8_BAR;
            PG8_LDB(B0, 1, 0); PG8_SCHED; PG8_LDA(At, 1, 0); PG8_STAGE(PG8_SA(0, 1), a2 + hstep, voffA);
            PG8_WAIT_L(8); PG8_BAR; PG8_WAIT_L(0); PG8_MMA(0, 0, At, B0); PG8_BAR; PG8_SCHED;
            PG8_LDB(B1, 1, 1); PG8_STAGE(PG8_SB(1, 0), b3, voffB);
            PG8_BAR; PG8_WAIT_L(0); PG8_MMA(0, 1, At, B1); PG8_BAR;
            PG8_LDA(At, 1, 1); PG8_STAGE(PG8_SA(1, 0), a3, voffA);
            PG8_BAR; PG8_WAIT_L(0); PG8_MMA(1, 0, At, B0); PG8_BAR; PG8_SCHED;
            PG8_STAGE(PG8_SB(1, 1), b3 + hstep, voffB);
            PG8_WAIT_V(6); PG8_BAR; PG8_MMA(1, 1, At, B1); PG8_BAR;
            }
        }
        if constexpr (ALIGN_EPI) { if (wr == 0) PG8_BAR; }
        if constexpr (!Epi::AFTER_DRAIN) { E(acc, cur, wr, wc, fr, fq); S.done(cur); }
        if (!has_next) break;
#pragma unroll
        for (int a = 0; a < 2; ++a)
#pragma unroll
            for (int b = 0; b < 2; ++b)
#pragma unroll
                for (int m = 0; m < 4; ++m)
#pragma unroll
                    for (int n = 0; n < 2; ++n) acc[a][b][m][n] = (f32x4){0.f, 0.f, 0.f, 0.f};
        cur = nxt; cA = nA; cB = nB; ++ui;
        if constexpr (ALIGN_EPI) { if (wr == 1) PG8_BAR; }
    }
    PG8_WAIT_V(0);
    if constexpr (!ALIGN_EPI) { if (wr == 0) PG8_BAR; }
    PG8_BAR;
    if constexpr (Epi::AFTER_DRAIN) { E.fused(acc, cur, wr, wc, fr, fq, lds, wid, lane); S.done(cur); }
#undef PG8_SA
#undef PG8_SB
#undef PG8_STAGE
#undef PG8_LDA
#undef PG8_LDB
#undef PG8_MMA
#undef PG8_WAIT_V
#undef PG8_WAIT_L
#undef PG8_BAR
#undef PG8_SCHED
}
}

#define GAS __attribute__((address_space(1)))
#define LAS __attribute__((address_space(3)))
typedef unsigned short bf16;
typedef unsigned v4u __attribute__((ext_vector_type(4)));
typedef float f32x4 __attribute__((ext_vector_type(4)));
typedef short bf16x8 __attribute__((ext_vector_type(8)));
typedef GAS unsigned gu32;
typedef GAS unsigned long long gu64;
#define RLX_AGENT __ATOMIC_RELAXED, __HIP_MEMORY_SCOPE_AGENT
#define LDS_WAIT() asm volatile("s_waitcnt lgkmcnt(0)" ::: "memory")
#define VM_WAIT() asm volatile("s_waitcnt vmcnt(0)" ::: "memory")
__device__ __forceinline__ unsigned long long rt() { return __builtin_amdgcn_s_memrealtime(); }
__device__ __forceinline__ unsigned f2bf(float f) { unsigned u = __builtin_bit_cast(unsigned, f); return (u + 0x7fffu + ((u >> 16) & 1u)) >> 16; }
__device__ __forceinline__ unsigned pk2(float lo, float hi) { return f2bf(lo) | (f2bf(hi) << 16); }

#define XB_TMO      128
#define XB_XCNT(j)  (256  + 64 * (j))
#define XB_XSUB(j)  (1280 + 64 * (j))
#define XB_XGEN(j)  (2304 + 64 * (j))
#define XB_TOP      3328
#define XB_TOPGEN   3392
#define XCD_BAR_WORDS 3456
#define XB_SPIN_CAP (1u << 18)

__device__ __forceinline__ unsigned xb_ld(unsigned* p)              { return __hip_atomic_load(p, __ATOMIC_RELAXED, __HIP_MEMORY_SCOPE_AGENT); }
__device__ __forceinline__ unsigned xb_add(unsigned* p, unsigned v) { return __hip_atomic_fetch_add(p, v, __ATOMIC_RELAXED, __HIP_MEMORY_SCOPE_AGENT); }
__device__ __forceinline__ unsigned xb_xcc_id() { return (unsigned)__builtin_amdgcn_s_getreg((3 << 11) | 20) & 0xFu; }
#define XB_SPIN(cond, bar) do { unsigned _sp = 0; while (cond) { __builtin_amdgcn_s_sleep(1); \
    if ((++_sp & 255u) == 0u) { if (xb_ld(&(bar)[XB_TMO])) break; if (_sp > XB_SPIN_CAP) { atomicAdd(&(bar)[XB_TMO], 1u); break; } } } } while (0)

struct XcdBarrier {
    unsigned* bar; unsigned x;
    volatile LAS unsigned* st;
};

__device__ __forceinline__ XcdBarrier xcd_barrier_post(unsigned* bar, volatile LAS unsigned* st) {
    XcdBarrier b; b.bar = bar; b.x = xb_xcc_id(); b.st = st;
    if (threadIdx.x == 0) (void)xb_add(&bar[XB_XCNT(b.x)], 1u);
    return b;
}
__device__ __forceinline__ void xcd_barrier_complete(unsigned* bar, unsigned x, unsigned& nloc, unsigned& nx) {
    const unsigned G = gridDim.x * gridDim.y * gridDim.z;
    unsigned sum, cnt, mine, sp = 0u;
    for (;;) {
        sum = 0u; cnt = 0u; mine = 0u;
#pragma unroll
        for (unsigned j = 0; j < 16; ++j) { const unsigned c = xb_ld(&bar[XB_XCNT(j)]); sum += c; cnt += (c > 0u) ? 1u : 0u; mine = (j == x) ? c : mine; }
        if (sum == G) break;
        __builtin_amdgcn_s_sleep(1);
        if ((++sp & 255u) == 0u) { if (xb_ld(&bar[XB_TMO])) break; if (sp > XB_SPIN_CAP) { atomicAdd(&bar[XB_TMO], 1u); break; } }
    }
    nloc = mine > 0u ? mine : 1u; nx = cnt > 0u ? cnt : 1u;
}

__device__ __forceinline__ void xcd_barrier(const XcdBarrier& b) {
    asm volatile("s_waitcnt vmcnt(0)" ::: "memory");
    __syncthreads();
    if (threadIdx.x == 0) {
        unsigned* bar = b.bar;
        __builtin_amdgcn_s_waitcnt(0);
        unsigned nloc = b.st[0], nx = b.st[1];
        if (nloc == 0u) { xcd_barrier_complete(bar, b.x, nloc, nx); b.st[0] = nloc; b.st[1] = nx; }
        const unsigned old = xb_add(&bar[XB_XSUB(b.x)], 1u);
        const unsigned gen = old / nloc;
        if (old + 1u == (gen + 1u) * nloc) {
            __builtin_amdgcn_fence(__ATOMIC_RELEASE, "agent");
            asm volatile("s_waitcnt vmcnt(0)" ::: "memory");
            const unsigned og = xb_add(&bar[XB_TOP], 1u);
            const unsigned tg = og / nx;
            if (og + 1u == (tg + 1u) * nx) xb_add(&bar[XB_TOPGEN], 1u);
            else XB_SPIN(xb_ld(&bar[XB_TOPGEN]) == tg, bar);
            __builtin_amdgcn_fence(__ATOMIC_ACQUIRE, "agent");
            xb_add(&bar[XB_XGEN(b.x)], 1u);
            asm volatile("s_waitcnt vmcnt(0)" ::: "memory");
        } else {
            XB_SPIN(xb_ld(&bar[XB_XGEN(b.x)]) == gen, bar);
            __builtin_amdgcn_fence(__ATOMIC_ACQUIRE, "agent");
            asm volatile("s_waitcnt vmcnt(0)" ::: "memory");
        }
    }
    __syncthreads();
}

constexpr int NB = 4, SEQ = 8192, CTXL = 256, PB = SEQ + CTXL, R = NB * PB, D = 1024, DFF = 4096, DEPTH = 4;
constexpr int NP_EV = 2560, NP_OD = 3072;
constexpr float EPS = 1e-6f;
constexpr float C2 = 0.125f * 1.4426950408889634f;
constexpr int EQ = 0, EK = 256, EVV = 512, EG = 1024, EGQ = 1536, EGK = 2048, EGV = 2176, ELR = 2304;
constexpr int ODQ = 1536, ODK = 2048, ODV = 2560;
constexpr int NWAVES = 8, NTHR = 512;
constexpr int LDS_BYTES = 163840, LDS_MISC = 163840 - 256;

constexpr size_t MiB = 1u << 20;
constexpr size_t WS_CTL = 0, CTL_ZERO_BYTES = 1 * MiB;
constexpr size_t WS_MOD = 1 * MiB;
constexpr size_t WS_TAB = 2 * MiB;
constexpr size_t WS_HID = 3 * MiB;
constexpr size_t WS_XC = 8 * MiB;
constexpr size_t WS_W = 12 * MiB, W_LAYER = 24 * MiB, W_IN = 0, W_OUT = 6 * MiB, W_1 = 8 * MiB, W_2 = 16 * MiB;
constexpr size_t WS_A1 = 108 * MiB;
constexpr size_t WS_Y = 174 * MiB;
constexpr size_t WS_PH = 240 * MiB;
constexpr size_t WS_OGLA = WS_PH + 165 * MiB;
constexpr size_t WS_HF = WS_PH + 198 * MiB;
constexpr size_t WS_END = 504 * MiB;
constexpr int CW_BAR = 4096;

struct Args { const float* in[27]; float* out; unsigned char* ws; int ph_lo, ph_hi; };
enum { I_X = 0, I_C, I_CTX, I_CCTX, I_WADA, I_BADA, I_NORMG, I_W1, I_W2, I_EVWIN, I_EVWLR, I_EVBLR, I_EVGLAG, I_EVQKG, I_EVWOUT,
       I_ODWIN, I_ODCONVW, I_ODCONVB, I_FW1, I_FB1, I_FW2, I_FB2, I_FW3, I_HYBIAS, I_LAM, I_DIFFG, I_ODWOUT };

typedef const __attribute__((address_space(4))) Args* KA;
__device__ __forceinline__ KA ka_launder(KA a) { asm volatile("" : "+s"(a)); return a; }
__device__ __forceinline__ int otid() { int t = threadIdx.x; asm volatile("" : "+v"(t)); return t; }
__device__ __forceinline__ float bf2f(bf16 v) { return __builtin_bit_cast(float, (unsigned)v << 16); }
__device__ __forceinline__ float wave_sum(float v) {
#pragma unroll
    for (int o = 1; o < 64; o <<= 1) v += __shfl_xor(v, o);
    return v;
}
__device__ __forceinline__ float rl(float v, int k) { return __builtin_bit_cast(float, __builtin_amdgcn_readlane(__builtin_bit_cast(int, v), k)); }
__device__ __forceinline__ float siluf(float v) { return v / (1.f + __expf(-v)); }
__device__ __forceinline__ float lam_init_of(int layer) { return 0.8f - 0.6f * expf(-0.3f * (float)layer); }
__device__ __forceinline__ float* xrow_ptr(KA a, int r) {
    const int b = r / PB, p = r - b * PB;
    return p < CTXL ? (float*)(a->ws + WS_XC) + (size_t)(b * CTXL + p) * D : a->out + (size_t)(b * SEQ + (p - CTXL)) * D;
}
__device__ __forceinline__ const float* xin_ptr(KA a, int r) {
    const int b = r / PB, p = r - b * PB;
    return p < CTXL ? a->in[I_CTX] + (size_t)(b * CTXL + p) * D : a->in[I_X] + (size_t)(b * SEQ + (p - CTXL)) * D;
}
__device__ __forceinline__ int row_cls(int r) { const int b = r / PB, p = r - b * PB; return p < CTXL ? 4 : b; }

__device__ __forceinline__ void transpose_item(const float* W, int K, int N, int src_n0, bf16* WT, int dst_n0, int k0, LAS float* scr, int lane) {
    if (src_n0 < 0) {
#pragma unroll
        for (int j = 0; j < 4; ++j) { const int n = (lane >> 3) + 8 * j; *(GAS v4u*)(WT + (size_t)(dst_n0 + n) * K + k0 + 8 * (lane & 7)) = (v4u){0u, 0u, 0u, 0u}; }
        return;
    }
#pragma unroll 8
    for (int i = 0; i < 32; ++i) { const int kk = 2 * i + (lane >> 5); scr[kk * 33 + (lane & 31)] = W[(size_t)(k0 + kk) * N + src_n0 + (lane & 31)]; }
    LDS_WAIT(); asm volatile("" ::: "memory");
    const int c = lane & 7;
#pragma unroll
    for (int j = 0; j < 4; ++j) { const int n = (lane >> 3) + 8 * j; const LAS float* s = scr + (8 * c) * 33 + n;
        v4u o; o.x = pk2(s[0 * 33], s[1 * 33]); o.y = pk2(s[2 * 33], s[3 * 33]); o.z = pk2(s[4 * 33], s[5 * 33]); o.w = pk2(s[6 * 33], s[7 * 33]);
        *(GAS v4u*)(WT + (size_t)(dst_n0 + n) * K + k0 + 8 * c) = o; }
    LDS_WAIT(); asm volatile("" ::: "memory");
}
__device__ __forceinline__ int ev_src_col(int j) {
    if (j < 1536) return j; if (j < 2304) return j + 32; if (j < 2336) return j - 768; return -1;
}
__device__ __forceinline__ void p0a_prologue(KA a, LAS unsigned char* lds) {
    const int tid = otid(), lane = tid & 63, wave = __builtin_amdgcn_readfirstlane(tid >> 6);
    const int gw = blockIdx.x * NWAVES + wave, NGW = gridDim.x * NWAVES;
    LAS float* sc = (LAS float*)lds;
    LAS float* red = (LAS float*)(lds + 20480);
    for (int i = tid; i < 5 * 1024; i += NTHR) { const int cls = i >> 10, k = i & 1023; const float v = cls < 4 ? a->in[I_C][cls * 1024 + k] : a->in[I_CCTX][k]; sc[i] = v / (1.f + expf(-v)); }
    __syncthreads();
    float* MOD = (float*)(a->ws + WS_MOD);
    for (int item = blockIdx.x; item < 4 * 48; item += gridDim.x) {
        const int l = item / 48, nb = item % 48;
        const float* W = a->in[I_WADA] + (size_t)l * 1024 * 6144 + nb * 128 + lane * 2;
        float acc[5][2];
#pragma unroll
        for (int c = 0; c < 5; ++c) { acc[c][0] = 0.f; acc[c][1] = 0.f; }
#pragma unroll 4
        for (int kk = 0; kk < 128; ++kk) { const int k = wave * 128 + kk; const float2 w = *(const float2*)(W + (size_t)k * 6144);
#pragma unroll
            for (int c = 0; c < 5; ++c) { const float s = sc[c * 1024 + k]; acc[c][0] += s * w.x; acc[c][1] += s * w.y; } }
#pragma unroll
        for (int c = 0; c < 5; ++c) { red[(wave * 5 + c) * 128 + lane * 2] = acc[c][0]; red[(wave * 5 + c) * 128 + lane * 2 + 1] = acc[c][1]; }
        __syncthreads();
        for (int o = tid; o < 640; o += NTHR) { const int c = o >> 7, cc = o & 127; float s = a->in[I_BADA][l * 6144 + nb * 128 + cc];
#pragma unroll
            for (int w = 0; w < 8; ++w) s += red[(w * 5 + c) * 128 + cc];
            MOD[(size_t)(l * 5 + c) * 6144 + nb * 128 + cc] = s; }
        __syncthreads();
    }
    {
        LAS float* scr = (LAS float*)(lds + 49152 + wave * 8448);
        constexpr int IT_EV = 16 * 80, IT_OD = 16 * 96, IT_O = 16 * 32, IT_1 = 16 * 128, IT_2 = 64 * 32;
        constexpr int PER_EV = IT_EV + IT_O + IT_1 + IT_2, PER_OD = IT_OD + IT_O + IT_1 + IT_2, PER_PAIR = PER_EV + PER_OD;
        for (int it = gw; it < 2 * PER_PAIR; it += NGW) {
            const int pr = it / PER_PAIR; int r = it % PER_PAIR; const int odd = r >= PER_EV; if (odd) r -= PER_EV;
            const int l = 2 * pr + odd; unsigned char* wl = a->ws + WS_W + (size_t)l * W_LAYER;
            const int it_in = odd ? IT_OD : IT_EV;
            if (r < it_in) { const int nblk = odd ? 96 : 80, kb = r / nblk, nb = r % nblk;
                if (odd) transpose_item(a->in[I_ODWIN] + (size_t)pr * 1024 * 3072, 1024, 3072, nb * 32, (bf16*)(wl + W_IN), nb * 32, kb * 64, scr, lane);
                else     transpose_item(a->in[I_EVWIN] + (size_t)pr * 1024 * 2336, 1024, 2336, ev_src_col(nb * 32), (bf16*)(wl + W_IN), nb * 32, kb * 64, scr, lane);
                continue; }
            r -= it_in;
            if (r < IT_O) { const int kb = r / 32, nb = r % 32; transpose_item((odd ? a->in[I_ODWOUT] : a->in[I_EVWOUT]) + (size_t)pr * 1024 * 1024, 1024, 1024, nb * 32, (bf16*)(wl + W_OUT), nb * 32, kb * 64, scr, lane); continue; }
            r -= IT_O;
            if (r < IT_1) { const int kb = r / 128, nb = r % 128; transpose_item(a->in[I_W1] + (size_t)l * 1024 * 4096, 1024, 4096, nb * 32, (bf16*)(wl + W_1), nb * 32, kb * 64, scr, lane); continue; }
            r -= IT_1;
            { const int kb = r / 32, nb = r % 32; transpose_item(a->in[I_W2] + (size_t)l * 4096 * 1024, 4096, 1024, nb * 32, (bf16*)(wl + W_2), nb * 32, kb * 64, scr, lane); }
        }
    }
    {
        float* tab = (float*)(a->ws + WS_TAB);
        const int gt = blockIdx.x * NTHR + tid;
        if (gt < 3072) { const int pos = gt < 2048 ? gt / 16 : (gt - 2048) / 16, i = gt & 15;
            const float inv = powf(10000.f, -(float)i / 16.f), ang = (float)pos * inv;
            tab[gt * 2] = cosf(ang); tab[gt * 2 + 1] = sinf(ang); }
        if (gw == NGW - 1) {
#pragma unroll
            for (int j = 0; j < 2; ++j) { const float* lp = a->in[I_LAM] + j * 256;
                const float s1 = wave_sum(lp[lane] * lp[64 + lane]), s2 = wave_sum(lp[128 + lane] * lp[192 + lane]);
                if (lane == 0) tab[8192 + j] = expf(s1) - expf(s2) + lam_init_of(2 * j + 1); }
        }
    }
    for (int it = gw; it < 2 * PB; it += NGW) {
        const int j = it / PB, q = it % PB; const bool isctx = q >= SEQ; const int pos = isctx ? q - SEQ : q, L = isctx ? CTXL : SEQ;
        const float t = (float)pos / (float)(L - 1), w = 2.f * 3.14159265358979323846f * (float)pos / (float)L;
        float z = 0.f;
        if (lane == 0) z = t;
        else if (lane <= 16) { const float band = 1e-4f + (float)(lane - 1) * ((15.f - 1e-4f) / 15.f); z = cosf(w * band); }
        else if (lane <= 32) { const float band = 1e-4f + (float)(lane - 17) * ((15.f - 1e-4f) / 15.f); z = -sinf(w * band); }
        const float* w1 = a->in[I_FW1] + j * 33 * 64; const float* w2 = a->in[I_FW2] + j * 64 * 64;
        float h1 = a->in[I_FB1][j * 64 + lane];
#pragma unroll
        for (int e = 0; e < 33; ++e) h1 += __shfl(z, e) * w1[e * 64 + lane];
        h1 = sinf(h1);
        float h2 = a->in[I_FB2][j * 64 + lane];
#pragma unroll
        for (int e = 0; e < 64; ++e) h2 += __shfl(h1, e) * w2[e * 64 + lane];
        h2 = sinf(h2);
        float* HID = (float*)(a->ws + WS_HID) + (isctx ? (size_t)(2 * SEQ + j * CTXL + pos) * 64 : (size_t)(j * SEQ + pos) * 64);
        HID[lane] = h2;
    }
}

struct Row16 { f32x4 v[4]; };
__device__ __forceinline__ Row16 ld_row_f32(const float* p, int lane) { Row16 r; const GAS f32x4* q = (const GAS f32x4*)p + lane;
#pragma unroll
    for (int j = 0; j < 4; ++j) r.v[j] = q[64 * j];
    return r; }
__device__ __forceinline__ Row16 ld_row_bf16(const bf16* p, int lane) { Row16 r; const GAS unsigned long long* q = (const GAS unsigned long long*)p + lane;
#pragma unroll
    for (int j = 0; j < 4; ++j) { const unsigned long long w = q[64 * j]; r.v[j] = (f32x4){bf2f((bf16)(w & 0xffff)), bf2f((bf16)((w >> 16) & 0xffff)), bf2f((bf16)((w >> 32) & 0xffff)), bf2f((bf16)(w >> 48))}; }
    return r; }
__device__ __forceinline__ void st_row_f32(float* p, const Row16& r, int lane) { GAS f32x4* q = (GAS f32x4*)p + lane;
#pragma unroll
    for (int j = 0; j < 4; ++j) q[64 * j] = r.v[j]; }
__device__ __forceinline__ void st_row_bf16(bf16* p, const Row16& r, int lane) { GAS unsigned long long* q = (GAS unsigned long long*)p + lane;
#pragma unroll
    for (int j = 0; j < 4; ++j) q[64 * j] = (unsigned long long)pk2(r.v[j].x, r.v[j].y) | ((unsigned long long)pk2(r.v[j].z, r.v[j].w) << 32); }
__device__ __forceinline__ float row_sumsq(const Row16& r) { float s = 0.f;
#pragma unroll
    for (int j = 0; j < 4; ++j) s += (r.v[j].x * r.v[j].x + r.v[j].y * r.v[j].y) + (r.v[j].z * r.v[j].z + r.v[j].w * r.v[j].w);
    return wave_sum(s); }
__device__ __forceinline__ void norm_mod_store(const Row16& x, const float* g, const float* shift, const float* scale, bf16* dst, int lane) {
    const float rstd = 1.f / sqrtf(row_sumsq(x) * (1.f / D) + EPS);
    const Row16 G = ld_row_f32(g, lane), SH = ld_row_f32(shift, lane), SC = ld_row_f32(scale, lane); Row16 o;
#pragma unroll
    for (int j = 0; j < 4; ++j) o.v[j] = (x.v[j] * rstd) * G.v[j] * (SC.v[j] + 1.f) + SH.v[j];
    st_row_bf16(dst, o, lane);
}
__device__ __forceinline__ void p0b_first_norm(KA a) {
    const int tid_o = otid(), lane = tid_o & 63, wave = tid_o >> 6, gw = blockIdx.x * NWAVES + wave, NGW = gridDim.x * NWAVES;
    const float* MOD = (const float*)(a->ws + WS_MOD); bf16* A1 = (bf16*)(a->ws + WS_A1);
    for (int r = gw; r < R; r += NGW) {
        const Row16 x = ld_row_f32(xin_ptr(a, r), lane); const float* m = MOD + (size_t)(0 * 5 + row_cls(r)) * 6144;
        norm_mod_store(x, a->in[I_NORMG] + 0, m + 0, m + 1024, A1 + (size_t)r * D, lane);
    }
}
__device__ __forceinline__ void rowwise_post(KA a, int layer, int which) {
    const int tid_o = otid(), lane = tid_o & 63, wave = tid_o >> 6, gw = blockIdx.x * NWAVES + wave, NGW = gridDim.x * NWAVES;
    const float* MOD = (const float*)(a->ws + WS_MOD); bf16* A1 = (bf16*)(a->ws + WS_A1); const bf16* Y = (const bf16*)(a->ws + WS_Y);
    const float* ng = a->in[I_NORMG] + (size_t)layer * 4 * D;
    const bool lastp = (layer == DEPTH - 1) && which == 1;
    for (int r = gw; r < R; r += NGW) {
        const int cls = row_cls(r);
        if (lastp && cls == 4) continue;
        const float* m = MOD + (size_t)(layer * 5 + cls) * 6144;
        const Row16 y = ld_row_bf16(Y + (size_t)r * D, lane);
        const float rstd = 1.f / sqrtf(row_sumsq(y) * (1.f / D) + EPS);
        const float* xsrc = (layer == 0 && which == 0) ? xin_ptr(a, r) : (const float*)xrow_ptr(a, r);
        Row16 x = ld_row_f32(xsrc, lane);
        const Row16 G = ld_row_f32(ng + (which ? 3 : 1) * D, lane), GT = ld_row_f32(m + (which ? 5 : 2) * 1024, lane);
#pragma unroll
        for (int j = 0; j < 4; ++j) x.v[j] = x.v[j] + GT.v[j] * ((y.v[j] * rstd) * G.v[j]);
        st_row_f32(xrow_ptr(a, r), x, lane);
        if (lastp) continue;
        if (which == 0) norm_mod_store(x, ng + 2 * D, m + 3 * 1024, m + 4 * 1024, A1 + (size_t)r * D, lane);
        else { const float* m2 = MOD + (size_t)((layer + 1) * 5 + cls) * 6144; norm_mod_store(x, ng + 4 * D, m2 + 0, m2 + 1024, A1 + (size_t)r * D, lane); }
    }
}

__device__ __forceinline__ void rope_cs(KA a, int p, int lane, float& cs, float& sn) {
    const float* tab = (const float*)(a->ws + WS_TAB); const int t = p - CTXL, rr = t >> 6, cc = t & 63, i = lane >> 1;
    const float* e = i < 16 ? tab + (rr * 16 + i) * 2 : tab + 4096 + (cc * 16 + (i - 16)) * 2;
    cs = e[0]; sn = e[1];
}
__device__ __forceinline__ void prep_even(KA a, int j) {
    const int tid_o = otid(), lane = tid_o & 63, wave = tid_o >> 6, gw = blockIdx.x * NWAVES + wave, NGW = gridDim.x * NWAVES;
    bf16* P = (bf16*)(a->ws + WS_PH); const float* qkg = a->in[I_EVQKG] + j * 128;
    const float gq = qkg[lane], gk = qkg[64 + lane];
    for (int r = gw; r < R; r += NGW) {
        const int b = r / PB, p = r - b * PB; const bool latent = p >= CTXL;
        float cs = 1.f, sn = 0.f; if (latent) rope_cs(a, p, lane, cs, sn);
        bf16* prow = P + (size_t)r * NP_EV;
#pragma unroll
        for (int hh = 0; hh < 10; ++hh) {
            const int col = hh < 8 ? EGQ + hh * 64 : EGK + (hh - 8) * 64;
            const float x = bf2f(prow[col + lane]); const float ss = wave_sum(x * x);
            float y = x * (1.f / sqrtf(ss * (1.f / 64.f) + EPS)) * (hh < 8 ? gq : gk);
            const float pt = __shfl_xor(y, 1);
            if (latent) y = (lane & 1) ? (pt * sn + y * cs) : (y * cs - pt * sn);
            if (hh < 8) y *= C2;
            prow[col + lane] = (bf16)f2bf(y);
        }
    }
}
__device__ __forceinline__ void prep_odd_rope(KA a) {
    const int tid_o = otid(), lane = tid_o & 63, wave = tid_o >> 6, gw = blockIdx.x * NWAVES + wave, NGW = gridDim.x * NWAVES;
    bf16* P = (bf16*)(a->ws + WS_PH);
    for (int r = gw; r < R; r += NGW) {
        const int b = r / PB, p = r - b * PB; const bool latent = p >= CTXL;
        float cs = 1.f, sn = 0.f; if (latent) rope_cs(a, p, lane, cs, sn);
        bf16* prow = P + (size_t)r * NP_OD;
#pragma unroll
        for (int hh = 0; hh < 16; ++hh) {
            const int col = ODQ + hh * 64;
            float y = bf2f(prow[col + lane]);
            const float pt = __shfl_xor(y, 1);
            if (latent) y = (lane & 1) ? (pt * sn + y * cs) : (y * cs - pt * sn);
            if (hh < 8) y *= C2;
            if (latent || hh < 8) prow[col + lane] = (bf16)f2bf(y);
        }
    }
}

struct VHead { const bf16* base; int np; int qcol, kcol, vcol; bf16* obase; int opitch, ocol; };
__device__ __forceinline__ void naive_attn_item(const VHead& h, int b, int qb, LAS unsigned char* lds) {
    const int tid = otid();
    LAS float* Kt = (LAS float*)lds; LAS float* Vt = Kt + 32 * 64;
    const bool isctx = qb == 16; const int p = isctx ? tid : CTXL + qb * 512 + tid; const bool valid = !isctx || tid < CTXL; const int NK = isctx ? CTXL : PB;
    const size_t rowb = (size_t)b * PB;
    float q[64], o[64]; float m = -1e30f, l = 0.f;
    if (valid) { const bf16* qp = h.base + (rowb + p) * h.np + h.qcol;
#pragma unroll
        for (int d = 0; d < 64; ++d) { q[d] = bf2f(qp[d]); o[d] = 0.f; } }
    else {
#pragma unroll
        for (int d = 0; d < 64; ++d) { q[d] = 0.f; o[d] = 0.f; } }
    for (int k0 = 0; k0 < NK; k0 += 32) {
        __syncthreads();
        { const int kr = tid >> 4, d0 = (tid & 15) * 4; const bf16* kp = h.base + (rowb + k0 + kr) * h.np;
            const unsigned long long kw = *(const unsigned long long*)(kp + h.kcol + d0), vw = *(const unsigned long long*)(kp + h.vcol + d0);
#pragma unroll
            for (int e = 0; e < 4; ++e) { Kt[kr * 64 + d0 + e] = bf2f((bf16)((kw >> (16 * e)) & 0xffff)); Vt[kr * 64 + d0 + e] = bf2f((bf16)((vw >> (16 * e)) & 0xffff)); } }
        __syncthreads();
        if (valid) {
#pragma unroll 1
            for (int jk = 0; jk < 32; ++jk) {
                float s = 0.f;
#pragma unroll
                for (int d = 0; d < 64; d += 4) { const f32x4 kv = *(const LAS f32x4*)(Kt + jk * 64 + d); s += q[d] * kv.x + q[d + 1] * kv.y + q[d + 2] * kv.z + q[d + 3] * kv.w; }
                if (s > m) { const float f = exp2f(m - s); l *= f;
#pragma unroll
                    for (int d = 0; d < 64; ++d) o[d] *= f;
                    m = s; }
                const float pe = exp2f(s - m); l += pe;
#pragma unroll
                for (int d = 0; d < 64; d += 4) { const f32x4 vv = *(const LAS f32x4*)(Vt + jk * 64 + d); o[d] += pe * vv.x; o[d + 1] += pe * vv.y; o[d + 2] += pe * vv.z; o[d + 3] += pe * vv.w; }
            }
        }
    }
    if (valid) { const float il = 1.f / l; bf16* op = h.obase + (rowb + p) * h.opitch + h.ocol;
#pragma unroll
        for (int d = 0; d < 64; d += 2) *(unsigned*)(op + d) = pk2(o[d] * il, o[d + 1] * il); }
}
__device__ __forceinline__ void naive_attn_phase(KA a, bool odd, LAS unsigned char* lds) {
    const int nvh = odd ? 16 : 8;
    for (int item = blockIdx.x; item < nvh * 68; item += gridDim.x) {
        const int vh = item / 68, rem = item % 68, b = rem / 17, qb = rem % 17;
        VHead h;
        if (!odd) { h.base = (const bf16*)(a->ws + WS_PH); h.np = NP_EV; h.qcol = EGQ + vh * 64; h.kcol = EGK + (vh >> 2) * 64; h.vcol = EGV + (vh >> 2) * 64;
            h.obase = (bf16*)(a->ws + WS_A1); h.opitch = D; h.ocol = 512 + vh * 64; }
        else { const int hd = vh >> 2, c = (vh >> 1) & 1, vhf = vh & 1; h.base = (const bf16*)(a->ws + WS_PH); h.np = NP_OD; h.qcol = ODQ + hd * 128 + c * 64; h.kcol = ODK + hd * 128 + c * 64; h.vcol = ODV + hd * 128 + vhf * 64;
            h.obase = (bf16*)(a->ws + WS_Y); h.opitch = D; h.ocol = hd * 256 + c * 128 + vhf * 64; }
        naive_attn_item(h, b, qb, lds);
    }
}

__device__ __forceinline__ float log_sigmoid(float x) { return fminf(x, 0.f) - log1pf(expf(-fabsf(x))); }
__device__ __forceinline__ void naive_gla_phase(KA a, int j) {
    const int tid_o = otid(), lane = tid_o & 63, wave = tid_o >> 6, gw = blockIdx.x * NWAVES + wave;
    if (gw >= 32) return;
    const int b = gw >> 3, hd = (gw >> 1) & 3, dvh = gw & 1;
    const bf16* P = (const bf16*)(a->ws + WS_PH); float* OG = (float*)(a->ws + WS_OGLA);
    for (int dir = 0; dir < 2; ++dir) {
        float S[64];
#pragma unroll
        for (int k = 0; k < 64; ++k) S[k] = 0.f;
        float wl[16];
#pragma unroll
        for (int r = 0; r < 16; ++r) wl[r] = a->in[I_EVWLR][((size_t)(j * 2 + dir) * 16 + r) * 256 + hd * 64 + lane];
        const float bl = a->in[I_EVBLR][(j * 2 + dir) * 256 + hd * 64 + lane];
        auto rowof = [&](int step) -> size_t { const int p = dir == 0 ? step : (step < CTXL ? CTXL - 1 - step : PB - 1 - (step - CTXL)); return (size_t)b * PB + p; };
        size_t row = rowof(0);
        const bf16* pr = P + row * NP_EV;
        float qv = bf2f(pr[EQ + hd * 64 + lane]) * 0.125f, kv = bf2f(pr[EK + hd * 64 + lane]), lrv = bf2f(pr[ELR + dir * 16 + (lane & 15)]), vv = bf2f(pr[EVV + hd * 128 + dvh * 64 + lane]);
#pragma unroll 1
        for (int step = 0; step < PB; ++step) {
            const size_t nrow = rowof(step + 1 < PB ? step + 1 : step); const bf16* npr = P + nrow * NP_EV;
            const float nqv = bf2f(npr[EQ + hd * 64 + lane]) * 0.125f, nkv = bf2f(npr[EK + hd * 64 + lane]), nlrv = bf2f(npr[ELR + dir * 16 + (lane & 15)]), nvv = bf2f(npr[EVV + hd * 128 + dvh * 64 + lane]);
            float gk = bl;
#pragma unroll
            for (int r = 0; r < 16; ++r) gk += __shfl(lrv, r) * wl[r];
            const float av = expf(log_sigmoid(gk) * (1.f / 16.f));
            float o = 0.f;
#pragma unroll
            for (int k = 0; k < 64; ++k) { const float aa = rl(av, k), kk = rl(kv, k), qq = rl(qv, k); S[k] = aa * S[k] + kk * vv; o += qq * S[k]; }
            float* op = OG + row * 512 + hd * 128 + dvh * 64 + lane;
            if (dir == 0) *op = o; else *op += o;
            row = nrow; qv = nqv; kv = nkv; lrv = nlrv; vv = nvv;
        }
    }
}
__device__ __forceinline__ void gla_out_phase(KA a, int j) {
    const int tid_o = otid(), lane = tid_o & 63, wave = tid_o >> 6, gw = blockIdx.x * NWAVES + wave, NGW = gridDim.x * NWAVES;
    const bf16* P = (const bf16*)(a->ws + WS_PH); const float* OG = (const float*)(a->ws + WS_OGLA); bf16* MIX = (bf16*)(a->ws + WS_A1);
    const float g0 = a->in[I_EVGLAG][j * 128 + lane], g1 = a->in[I_EVGLAG][j * 128 + 64 + lane];
    for (int r = gw; r < R; r += NGW) {
#pragma unroll
        for (int hd = 0; hd < 4; ++hd) {
            const float o0 = OG[(size_t)r * 512 + hd * 128 + lane], o1 = OG[(size_t)r * 512 + hd * 128 + 64 + lane];
            const float rstd = 1.f / sqrtf(wave_sum(o0 * o0 + o1 * o1) * (1.f / 128.f) + EPS);
            const float ga = bf2f(P[(size_t)r * NP_EV + EG + hd * 128 + lane]), gb = bf2f(P[(size_t)r * NP_EV + EG + hd * 128 + 64 + lane]);
            MIX[(size_t)r * D + hd * 128 + lane] = (bf16)f2bf(o0 * rstd * g0 * siluf(ga));
            MIX[(size_t)r * D + hd * 128 + 64 + lane] = (bf16)f2bf(o1 * rstd * g1 * siluf(gb));
        }
    }
}
__device__ __forceinline__ void diff_out_phase(KA a, int j, int layer) {
    const int tid_o = otid(), lane = tid_o & 63, wave = tid_o >> 6, gw = blockIdx.x * NWAVES + wave, NGW = gridDim.x * NWAVES;
    const bf16* O01 = (const bf16*)(a->ws + WS_Y); bf16* MIX = (bf16*)(a->ws + WS_A1);
    const float lam = ((const float*)(a->ws + WS_TAB))[8192 + j], post = 1.f - lam_init_of(layer);
    const float g0 = a->in[I_DIFFG][j * 128 + lane], g1 = a->in[I_DIFFG][j * 128 + 64 + lane];
    for (int r = gw; r < R; r += NGW) {
#pragma unroll
        for (int hd = 0; hd < 4; ++hd) {
            const bf16* o = O01 + (size_t)r * D + hd * 256;
            const float o0 = bf2f(o[lane]) - lam * bf2f(o[128 + lane]), o1 = bf2f(o[64 + lane]) - lam * bf2f(o[192 + lane]);
            const float rstd = 1.f / sqrtf(wave_sum(o0 * o0 + o1 * o1) * (1.f / 128.f) + EPS);
            MIX[(size_t)r * D + 512 + hd * 128 + lane] = (bf16)f2bf(o0 * rstd * g0 * post);
            MIX[(size_t)r * D + 512 + hd * 128 + 64 + lane] = (bf16)f2bf(o1 * rstd * g1 * post);
        }
    }
}

__device__ __forceinline__ void hyena_filter_phase(KA a, int j) {
    const int tid = otid();
    const float* w3 = a->in[I_FW3] + (size_t)j * 64 * 2048;
    const float da = logf(1e-2f) / 0.3f, db = logf(1e-2f) / 1.5f;
    for (int item = blockIdx.x; item < 2048 * 17; item += gridDim.x) {
        const int col = item / 17, tb = item % 17; const bool isctx = tb == 16; const int L = isctx ? CTXL : SEQ; const int t = isctx ? tid : tb * 512 + tid;
        if (isctx && tid >= CTXL) continue;
        const float* hid = (const float*)(a->ws + WS_HID) + (isctx ? (size_t)(2 * SEQ + j * CTXL + t) * 64 : (size_t)(j * SEQ + t) * 64);
        float acc = 0.f;
#pragma unroll
        for (int e = 0; e < 64; e += 4) { const f32x4 hv = *(const f32x4*)(hid + e);
            acc += hv.x * w3[(e + 0) * 2048 + col] + hv.y * w3[(e + 1) * 2048 + col] + hv.z * w3[(e + 2) * 2048 + col] + hv.w * w3[(e + 3) * 2048 + col]; }
        const int c = col & 511; const float delta = fabsf(da + (float)c * ((db - da) / 511.f));
        const float tt = (float)t / (float)(L - 1);
        float* HF = (float*)(a->ws + WS_HF) + (isctx ? (size_t)2048 * SEQ + (size_t)col * CTXL : (size_t)col * SEQ);
        HF[t] = acc * expf(-tt * delta);
    }
}
__device__ __forceinline__ float short_conv(const bf16* P, const float* cw, const float* cb, size_t rowbase, int L, int t, int ch) {
    const float u0 = t > 0 ? bf2f(P[(rowbase + t - 1) * NP_OD + ch]) : 0.f, u1 = bf2f(P[(rowbase + t) * NP_OD + ch]), u2 = t + 1 < L ? bf2f(P[(rowbase + t + 1) * NP_OD + ch]) : 0.f;
    return u0 * cw[ch] + u1 * cw[1536 + ch] + u2 * cw[3072 + ch] + cb[ch];
}
__device__ __forceinline__ void naive_hyena_phase(KA a, int j, LAS unsigned char* lds) {
    const int tid = otid();
    const bf16* P = (const bf16*)(a->ws + WS_PH); bf16* MIX = (bf16*)(a->ws + WS_A1);
    const float* cw = a->in[I_ODCONVW] + (size_t)j * 3 * 1536; const float* cb = a->in[I_ODCONVB] + j * 1536; const float* hb = a->in[I_HYBIAS] + j * 1024;
    for (int item = blockIdx.x; item < 4096; item += gridDim.x) {
        const bool isctx = item >= 2048; const int it = item & 2047, b = it >> 9, c = it & 511; const int L = isctx ? CTXL : SEQ;
        const size_t rowbase = (size_t)b * PB + (isctx ? 0 : CTXL);
        const float* HF = (const float*)(a->ws + WS_HF) + (isctx ? (size_t)2048 * SEQ : 0);
        LAS float* harr = (LAS float*)lds; LAS float* ubuf = harr + 2 * L; LAS float* zbuf = ubuf + L;
        __syncthreads();
        for (int t = tid; t < L; t += NTHR) { ubuf[t] = short_conv(P, cw, cb, rowbase, L, t, c); zbuf[t] = short_conv(P, cw, cb, rowbase, L, t, 512 + c); }
        for (int o = 0; o < 2; ++o) {
            const float* hf = HF + (size_t)(o * 1024 + c) * L; const float* hbk = HF + (size_t)(o * 1024 + 512 + c) * L;
            for (int k = tid; k < 2 * L; k += NTHR) { const int d = k - L; harr[k] = d >= 0 ? hf[d] : (d > -L ? hbk[-d] : 0.f); }
            __syncthreads();
            const LAS float* in = o == 0 ? ubuf : zbuf;
            LAS float* gt = o == 0 ? zbuf : ubuf;
            const int t0 = tid * 16;
            float y[16];
#pragma unroll
            for (int i = 0; i < 16; ++i) y[i] = 0.f;
            if (t0 < L) {
#pragma unroll 1
                for (int S = 0; S < L; S += 16) {
                    float W[32], U[16];
                    const LAS float* wp = harr + (t0 - S + L - 16);
#pragma unroll
                    for (int i = 0; i < 32; i += 4) { const f32x4 v = *(const LAS f32x4*)(wp + i); W[i] = v.x; W[i + 1] = v.y; W[i + 2] = v.z; W[i + 3] = v.w; }
#pragma unroll
                    for (int i = 0; i < 16; i += 4) { const f32x4 v = *(const LAS f32x4*)(in + S + i); U[i] = v.x; U[i + 1] = v.y; U[i + 2] = v.z; U[i + 3] = v.w; }
#pragma unroll
                    for (int s = 0; s < 16; ++s)
#pragma unroll
                        for (int i = 0; i < 16; ++i) y[i] += W[16 + i - s] * U[s];
                }
            }
            asm volatile("" ::: "memory");
            const float bias = hb[o * 512 + c];
            if (o == 0) {
                __syncthreads();
                if (t0 < L) {
#pragma unroll
                    for (int i = 0; i < 16; ++i) { const int t = t0 + i; y[i] = gt[t] * (y[i] + in[t] * bias); }
#pragma unroll
                    for (int i = 0; i < 16; ++i) zbuf[t0 + i] = y[i];
                }
                __syncthreads();
                for (int t = tid; t < L; t += NTHR) ubuf[t] = short_conv(P, cw, cb, rowbase, L, t, 1024 + c);
                __syncthreads();
            } else {
                if (t0 < L) {
#pragma unroll
                    for (int i = 0; i < 16; ++i) { const int t = t0 + i; MIX[(rowbase + t) * D + c] = (bf16)f2bf(gt[t] * (y[i] + in[t] * bias)); }
                }
                __syncthreads();
            }
        }
    }
}

__global__ void __launch_bounds__(NTHR, 2) fwd_kernel(Args a_unused) {
    extern __shared__ __attribute__((aligned(16))) unsigned char lds_raw[];
    LAS unsigned char* lds = (LAS unsigned char*)lds_raw;
    volatile LAS unsigned* MISC = (volatile LAS unsigned*)(lds + LDS_MISC);
    const KA a0 = (KA)__builtin_amdgcn_kernarg_segment_ptr();
    if (threadIdx.x < 64) MISC[threadIdx.x] = 0u;
    __syncthreads();
    const int lo = a0->ph_lo, hi = a0->ph_hi;
    XcdBarrier bar; bar.bar = (unsigned*)(a0->ws + WS_CTL) + CW_BAR; bar.x = 0; bar.st = MISC + 8;
    if (hi - lo > 1) bar = xcd_barrier_post((unsigned*)(a0->ws + WS_CTL) + CW_BAR, MISC + 8);
#define IN(k) (lo <= (k) && (k) < hi)
#define SEAM(k) do { if (IN((k) + 1)) xcd_barrier(bar); } while (0)
    if (IN(0)) { p0a_prologue(ka_launder(a0), lds); SEAM(0); }
    if (IN(1)) { p0b_first_norm(ka_launder(a0)); SEAM(1); }
#pragma unroll 1
    for (int layer = 0; layer < DEPTH; ++layer) {
        const int pb = 2 + 9 * layer, j = layer >> 1; const bool odd = layer & 1;
        const int NP = odd ? NP_OD : NP_EV;
        if (IN(pb + 0)) {
            const KA a = ka_launder(a0); unsigned char* ws = a->ws; const unsigned char* wl = ws + WS_W + (size_t)layer * W_LAYER;
            pg8::Gemm g{(const bf16*)(ws + WS_A1), (const bf16*)(wl + W_IN), R, NP, D}; pg8::StaticOrder S; S.init(R, NP, (int)gridDim.x, (int)blockIdx.x);
            pg8::EpiBf16<0> E{(bf16*)(ws + WS_PH), NP};
            pg8::gemm_phase<pg8::EpiBf16<0>, pg8::StaticOrder, true, true>(lds, g, S, E);
            SEAM(pb + 0);
        }
        if (IN(pb + 1)) {
            if (odd) { prep_odd_rope(ka_launder(a0)); hyena_filter_phase(ka_launder(a0), j); } else prep_even(ka_launder(a0), j);
            SEAM(pb + 1);
        }
        if (IN(pb + 2)) {
            if (odd) { naive_hyena_phase(ka_launder(a0), j, lds); __syncthreads(); naive_attn_phase(ka_launder(a0), true, lds); }
            else { naive_gla_phase(ka_launder(a0), j); __syncthreads(); naive_attn_phase(ka_launder(a0), false, lds); }
            SEAM(pb + 2);
        }
        if (IN(pb + 3)) {
            if (odd) diff_out_phase(ka_launder(a0), j, layer); else gla_out_phase(ka_launder(a0), j);
            SEAM(pb + 3);
        }
        if (IN(pb + 4)) {
            const KA a = ka_launder(a0); unsigned char* ws = a->ws; const unsigned char* wl = ws + WS_W + (size_t)layer * W_LAYER;
            pg8::Gemm g{(const bf16*)(ws + WS_A1), (const bf16*)(wl + W_OUT), R, D, D}; pg8::StaticOrder S; S.init(R, D, (int)gridDim.x, (int)blockIdx.x);
            pg8::EpiBf16<0> E{(bf16*)(ws + WS_Y), D};
            pg8::gemm_phase<pg8::EpiBf16<0>, pg8::StaticOrder, true, true>(lds, g, S, E);
            SEAM(pb + 4);
        }
        if (IN(pb + 5)) { rowwise_post(ka_launder(a0), layer, 0); SEAM(pb + 5); }
        if (IN(pb + 6)) {
            const KA a = ka_launder(a0); unsigned char* ws = a->ws; const unsigned char* wl = ws + WS_W + (size_t)layer * W_LAYER;
            pg8::Gemm g{(const bf16*)(ws + WS_A1), (const bf16*)(wl + W_1), R, DFF, D}; pg8::StaticOrder S; S.init(R, DFF, (int)gridDim.x, (int)blockIdx.x);
            pg8::EpiBf16<2> E{(bf16*)(ws + WS_PH), DFF};
            pg8::gemm_phase<pg8::EpiBf16<2>, pg8::StaticOrder, true, true>(lds, g, S, E);
            SEAM(pb + 6);
        }
        if (IN(pb + 7)) {
            const KA a = ka_launder(a0); unsigned char* ws = a->ws; const unsigned char* wl = ws + WS_W + (size_t)layer * W_LAYER;
            pg8::Gemm g{(const bf16*)(ws + WS_PH), (const bf16*)(wl + W_2), R, D, DFF}; pg8::StaticOrder S; S.init(R, D, (int)gridDim.x, (int)blockIdx.x);
            pg8::EpiBf16<0> E{(bf16*)(ws + WS_Y), D};
            pg8::gemm_phase<pg8::EpiBf16<0>, pg8::StaticOrder, true, true>(lds, g, S, E);
            SEAM(pb + 7);
        }
        if (IN(pb + 8)) { rowwise_post(ka_launder(a0), layer, 1); SEAM(pb + 8); }
    }
#undef IN
#undef SEAM
}

constexpr int N_PHASES = 2 + 9 * DEPTH;
#ifndef MK_ONE_LAUNCH
#define MK_ONE_LAUNCH 0
#endif
extern "C" void kernel_launch(void* const* d_in, const int* in_sizes, int n_in, void* d_out, int out_size, void* d_ws, size_t ws_size, hipStream_t stream) {
    static int grid = 0;
    if (grid == 0) {
        if (n_in != 27 || in_sizes[0] != NB * SEQ * D || out_size != NB * SEQ * D || ws_size < WS_END) { fprintf(stderr, "kernel_launch: unexpected shapes (n_in %d, in0 %d, out %d, ws %zu)\n", n_in, n_in > 0 ? in_sizes[0] : -1, out_size, ws_size); grid = -1; return; }
        int dev = 0, cus = 0;
        if (hipGetDevice(&dev) != hipSuccess || hipDeviceGetAttribute(&cus, hipDeviceAttributeMultiprocessorCount, dev) != hipSuccess) { grid = -1; return; }
        if (hipFuncSetAttribute((const void*)fwd_kernel, hipFuncAttributeMaxDynamicSharedMemorySize, LDS_BYTES) != hipSuccess) { fprintf(stderr, "kernel_launch: hipFuncSetAttribute failed\n"); grid = -1; return; }
        (void)hipGetLastError();
        grid = cus;
    }
    if (grid < 0) return;
    if (hipMemsetAsync((char*)d_ws + WS_CTL, 0, CTL_ZERO_BYTES, stream) != hipSuccess) return;
    Args a{};
    for (int i = 0; i < 27; ++i) a.in[i] = (const float*)d_in[i];
    a.out = (float*)d_out; a.ws = (unsigned char*)d_ws;
#if MK_ONE_LAUNCH
    a.ph_lo = 0; a.ph_hi = N_PHASES;
    hipLaunchKernelGGL(fwd_kernel, dim3(grid), dim3(NTHR), LDS_BYTES, stream, a);
#else
    for (int k = 0; k < N_PHASES; ++k) { a.ph_lo = k; a.ph_hi = k + 1; hipLaunchKernelGGL(fwd_kernel, dim3(grid), dim3(NTHR), LDS_BYTES, stream, a); }
#endif
}
```

```cpp
#include <hip/hip_runtime.h>
#include <cstdio>
#include <cstdint>
#include <hip/hip_bf16.h>
#include <cmath>

namespace pg8 {
#define PG8_LAS __attribute__((address_space(3)))
typedef unsigned short bf16_t;
typedef short bf16x8 __attribute__((ext_vector_type(8)));
typedef float f32x4 __attribute__((ext_vector_type(4)));
typedef unsigned u32x4 __attribute__((ext_vector_type(4)));
constexpr int BM = 256, BK = 64, HALF = 128, HTB = HALF * BK * 2  , STAGE_BYTES = 8 * HTB, NXCD = 8, WGM = 8;

__host__ __device__ __forceinline__ int lds_byte(int r, int c) { const int st = (r >> 4) * 2 + (c >> 5), rr = r & 15, cc = c & 31, ob = rr * 64 + cc * 2; return st * 1024 + (ob ^ (((ob >> 9) & 1) << 5)); }
__host__ __device__ __forceinline__ void stage_rc(int b, int& R, int& C) { const int st = b / 1024, sb = b % 1024, swz = sb ^ (((sb >> 9) & 1) << 5); R = (st >> 1) * 16 + swz / 64; C = (st & 1) * 32 + (swz % 64) / 2; }
__host__ __device__ __forceinline__ int perm32(int rho) { const int n = rho >> 4, i = rho & 15; return 8 * (i >> 2) + 4 * n + (i & 3); }

struct Unit { int pm, pn, kind; };
struct Gemm { const bf16_t* A; const bf16_t* Bt; int M, N, K; int ld; };

struct StaticOrder {
    int nM, nN, nwg, G, c, skip;
    __host__ __device__ void init(int M, int N, int G_, int c_, int skip_ = 0) { nM = M / BM; nN = N / BM; nwg = nM * nN; G = G_; c = c_; skip = skip_; }
    __host__ __device__ bool next(int i, Unit& u) const {
        const long L = (long)i * G + c; if (L >= nwg) return false;
        int wgid = (int)L; { const int q = nwg / NXCD, r = nwg % NXCD, xcd = wgid % NXCD, off = wgid / NXCD; wgid = (xcd < r ? xcd * (q + 1) : r * (q + 1) + (xcd - r) * q) + off; }
        const int nig = WGM * nN, gid = wgid / nig, fm = gid * WGM, gsz = (nM - fm) < WGM ? (nM - fm) : WGM;
        u.pm = fm + ((wgid % nig) % gsz); u.pn = (wgid % nig) / gsz; u.kind = 0; if (skip) u.pm += (u.pm >> 5) + 1; return true;
    }
    __device__ __forceinline__ const char* abase(const Gemm& g, const Unit& u, size_t tstep) const { return (const char*)g.A + (size_t)u.pm * tstep; }
    __device__ __forceinline__ const char* bbase(const Gemm& g, const Unit& u, size_t tstep) const { return (const char*)g.Bt + (size_t)u.pn * tstep; }
    __device__ __forceinline__ void a_ready(const Unit&) const {}
    __device__ __forceinline__ void done(const Unit&) const {}
};
struct DualOrder {
    StaticOrder s0, s1; const char *A0, *B0, *A1, *B1; int G, c;
    __device__ __forceinline__ void init(const void* a0, const void* b0, int M0, int N0, const void* a1, const void* b1, int M1, int N1, int G_, int c_) {
        s0.init(M0, N0, 1, 0); s1.init(M1, N1, 1, 0); A0 = (const char*)a0; B0 = (const char*)b0; A1 = (const char*)a1; B1 = (const char*)b1; G = G_; c = c_; }
    __device__ __forceinline__ bool next(int i, Unit& u) const {
        const int L = i * G + c;
        if (L < s0.nwg) { s0.next(L, u); u.kind = 0; return true; }
        if (L - s0.nwg < s1.nwg) { s1.next(L - s0.nwg, u); u.kind = 1; return true; }
        return false; }
    __device__ __forceinline__ const char* abase(const Gemm&, const Unit& u, size_t tstep) const { return (u.kind ? A1 : A0) + (size_t)u.pm * tstep; }
    __device__ __forceinline__ const char* bbase(const Gemm&, const Unit& u, size_t tstep) const { return (u.kind ? B1 : B0) + (size_t)u.pn * tstep; }
    __device__ __forceinline__ void a_ready(const Unit&) const {}
    __device__ __forceinline__ void done(const Unit&) const {}
};
template <int NN, int NS> struct CtxSplitOrder {
    int G, c; size_t kbytes;
    __device__ __forceinline__ void init(int Kslice, int G_, int c_) { G = G_; c = c_; kbytes = (size_t)Kslice * 2; }
    __device__ __forceinline__ bool next(int i, Unit& u) const { const int L = i * G + c; if (L >= 4 * NN * NS) return false; u.kind = L % NS; u.pn = (L / NS) % NN; u.pm = L / (NS * NN); return true; }
    __device__ __forceinline__ const char* abase(const Gemm& g, const Unit& u, size_t tstep) const { return (const char*)g.A + (size_t)(33 * u.pm) * tstep + (size_t)u.kind * kbytes; }
    __device__ __forceinline__ const char* bbase(const Gemm& g, const Unit& u, size_t tstep) const { return (const char*)g.Bt + (size_t)u.pn * tstep + (size_t)u.kind * kbytes; }
    __device__ __forceinline__ void a_ready(const Unit&) const {}
    __device__ __forceinline__ void done(const Unit&) const {}
};

__device__ __forceinline__ unsigned cvt_pk_bf16(float lo, float hi) { unsigned r; asm volatile("v_cvt_pk_bf16_f32 %0, %1, %2" : "=v"(r) : "v"(lo), "v"(hi)); return r; }
template <int ACT  > struct EpiBf16 {
    static constexpr bool PERM = true, AFTER_DRAIN = false;
    bf16_t* O; int ldc; int probe_nostore = 0;
    __device__ __forceinline__ void operator()(const f32x4 (&acc)[2][2][4][2], const Unit& u, int wr, int wc, int fr, int fq) const {
        if (probe_nostore && u.pm != 0x7fffffff) { float t = 0.f;
#pragma unroll
            for (int ai = 0; ai < 2; ++ai)
#pragma unroll
                for (int m = 0; m < 4; ++m)
#pragma unroll
                    for (int bj = 0; bj < 2; ++bj) t += acc[ai][bj][m][0][0] + acc[ai][bj][m][1][3];
            if (t == 1234.5678f) O[0] = 1; return; }
        const int row0 = u.pm * BM + wr * 64 + fr; const int col0 = u.pn * BM + wc * 32 + 8 * fq;
#pragma unroll
        for (int ai = 0; ai < 2; ++ai)
#pragma unroll
            for (int m = 0; m < 4; ++m) { bf16_t* rowp = O + (size_t)(row0 + ai * HALF + m * 16) * ldc + col0;
#pragma unroll
                for (int bj = 0; bj < 2; ++bj) { f32x4 v0 = acc[ai][bj][m][0], v1 = acc[ai][bj][m][1];
                    if (ACT == 2) {
#pragma unroll
                        for (int e = 0; e < 4; ++e) { const float a0 = fmaxf(v0[e], 0.f), a1 = fmaxf(v1[e], 0.f); v0[e] = a0 * a0; v1[e] = a1 * a1; } }
                    u32x4 w; w.x = cvt_pk_bf16(v0[0], v0[1]); w.y = cvt_pk_bf16(v0[2], v0[3]); w.z = cvt_pk_bf16(v1[0], v1[1]); w.w = cvt_pk_bf16(v1[2], v1[3]);
                    *(u32x4*)(rowp + bj * HALF) = w; } }
    }
};
struct EpiDual {
    static constexpr bool PERM = true, AFTER_DRAIN = false;
    bf16_t* O0; int ldc0; bf16_t* O1; int ldc1;
    __device__ __forceinline__ void operator()(const f32x4 (&acc)[2][2][4][2], const Unit& u, int wr, int wc, int fr, int fq) const {
        const EpiBf16<0> e{u.kind ? O1 : O0, u.kind ? ldc1 : ldc0}; e(acc, u, wr, wc, fr, fq);
    }
};
struct EpiInProj {
    static constexpr bool PERM = true, AFTER_DRAIN = false;
    bf16_t* O0; int ldc0; bf16_t* O1; int ldc1; const float* tab; const float* qkg; int odd; float qscale;
    __device__ __forceinline__ void operator()(const f32x4 (&acc)[2][2][4][2], const Unit& u, int wr, int wc, int fr, int fq) const {
        if (u.kind) { const EpiBf16<0> e{O1, ldc1}; e(acc, u, wr, wc, fr, fq); return; }
        const bool perm = !odd && u.pn >= 6 && u.pn <= 8;
        int mode = 0;
        if (odd) mode = u.pn < 2 ? 1 : (u.pn < 4 ? 2 : 0); else mode = (u.pn == 6 || u.pn == 7) ? 1 : ((u.pn == 8 && wc < 2) ? 2 : 0);
        const int pp = u.pm % 33; const bool rope = mode != 0 && pp != 0; const bool norm = mode != 0 && !odd;
        const int row0 = u.pm * BM + wr * 64 + fr;
        const int colb = u.pn * BM + (perm ? 64 * wc + 8 * fq : 32 * wc + 8 * fq), bjs = perm ? 32 : HALF;
        if (mode == 0) {
#pragma unroll
            for (int ai = 0; ai < 2; ++ai)
#pragma unroll
                for (int m = 0; m < 4; ++m) { bf16_t* rowp = O0 + (size_t)(row0 + ai * HALF + m * 16) * ldc0 + colb;
#pragma unroll
                    for (int bj = 0; bj < 2; ++bj) { const f32x4 v0 = acc[ai][bj][m][0], v1 = acc[ai][bj][m][1];
                        u32x4 w; w.x = cvt_pk_bf16(v0[0], v0[1]); w.y = cvt_pk_bf16(v0[2], v0[3]); w.z = cvt_pk_bf16(v1[0], v1[1]); w.w = cvt_pk_bf16(v1[2], v1[3]);
                        *(u32x4*)(rowp + bj * bjs) = w; } }
            return;
        }
        f32x4 G[2][2];
#pragma unroll
        for (int bj = 0; bj < 2; ++bj)
#pragma unroll
            for (int n = 0; n < 2; ++n) G[bj][n] = norm ? *(const f32x4*)(qkg + (mode == 2 ? 64 : 0) + 32 * bj + 8 * fq + 4 * n) : (f32x4){1.f, 1.f, 1.f, 1.f};
        const float sc = mode == 1 ? qscale : 1.f;
        const float* trow = tab + ((4 * (pp - 1) + wr) * 16 + 4 * fq) * 2;
        const float* tcol = tab + 4096 + (fr * 16 + 4 * fq) * 2;
        const f32x4 ID = (f32x4){1.f, 0.f, 1.f, 0.f};
        f32x4 TR[2][2];
#pragma unroll
        for (int ai = 0; ai < 2; ++ai) { TR[ai][0] = rope ? *(const f32x4*)(trow + ai * 64) : ID; TR[ai][1] = rope ? *(const f32x4*)(trow + ai * 64 + 4) : ID; }
        f32x4 TCn0 = rope ? *(const f32x4*)(tcol) : ID, TCn1 = rope ? *(const f32x4*)(tcol + 4) : ID;
#pragma unroll
        for (int m = 0; m < 4; ++m) {
            const f32x4 TC0 = TCn0, TC1 = TCn1;
            if (m < 3) { TCn0 = rope ? *(const f32x4*)(tcol + (m + 1) * 512) : ID; TCn1 = rope ? *(const f32x4*)(tcol + (m + 1) * 512 + 4) : ID; }
#pragma unroll
            for (int ai = 0; ai < 2; ++ai) {
                f32x4 v[2][2];
#pragma unroll
                for (int bj = 0; bj < 2; ++bj)
#pragma unroll
                    for (int n = 0; n < 2; ++n) v[bj][n] = acc[ai][bj][m][n];
                if (norm) { float ss = 0.f;
#pragma unroll
                    for (int bj = 0; bj < 2; ++bj)
#pragma unroll
                        for (int n = 0; n < 2; ++n) ss += (v[bj][n][0] * v[bj][n][0] + v[bj][n][1] * v[bj][n][1]) + (v[bj][n][2] * v[bj][n][2] + v[bj][n][3] * v[bj][n][3]);
                    { const unsigned u_ = __builtin_bit_cast(unsigned, ss); auto a_ = __builtin_amdgcn_permlane16_swap(u_, u_, false, false); ss = __builtin_bit_cast(float, (unsigned)a_[0]) + __builtin_bit_cast(float, (unsigned)a_[1]);
                      const unsigned w_ = __builtin_bit_cast(unsigned, ss); auto b_ = __builtin_amdgcn_permlane32_swap(w_, w_, false, false); ss = __builtin_bit_cast(float, (unsigned)b_[0]) + __builtin_bit_cast(float, (unsigned)b_[1]); }
                    const float rstd = 1.0f / sqrtf(ss * (1.f / 64.f) + 1e-6f);
#pragma unroll
                    for (int bj = 0; bj < 2; ++bj)
#pragma unroll
                        for (int n = 0; n < 2; ++n) v[bj][n] = (v[bj][n] * rstd) * G[bj][n]; }
                bf16_t* rowp = O0 + (size_t)(row0 + ai * HALF + m * 16) * ldc0 + colb;
#pragma unroll
                for (int bj = 0; bj < 2; ++bj) {
                    if (rope) {
                        const bool colang = odd ? (wc & 1) : (bj == 1);
                        const f32x4 T0 = colang ? TC0 : TR[ai][0], T1 = colang ? TC1 : TR[ai][1];
                        const f32x4 a0 = v[bj][0], a1 = v[bj][1];
                        v[bj][0] = (f32x4){a0[0] * T0[0] - a0[1] * T0[1], a0[0] * T0[1] + a0[1] * T0[0], a0[2] * T0[2] - a0[3] * T0[3], a0[2] * T0[3] + a0[3] * T0[2]};
                        v[bj][1] = (f32x4){a1[0] * T1[0] - a1[1] * T1[1], a1[0] * T1[1] + a1[1] * T1[0], a1[2] * T1[2] - a1[3] * T1[3], a1[2] * T1[3] + a1[3] * T1[2]};
                    }
                    const f32x4 x0 = v[bj][0] * sc, x1 = v[bj][1] * sc;
                    u32x4 w; w.x = cvt_pk_bf16(x0[0], x0[1]); w.y = cvt_pk_bf16(x0[2], x0[3]); w.z = cvt_pk_bf16(x1[0], x1[1]); w.w = cvt_pk_bf16(x1[2], x1[3]);
                    *(u32x4*)(rowp + bj * bjs) = w;
                }
            }
        }
    }
};
struct EpiSlab {
    static constexpr bool PERM = true, AFTER_DRAIN = false;
    bf16_t* O; int ldc; size_t slab;
    __device__ __forceinline__ void operator()(const f32x4 (&acc)[2][2][4][2], const Unit& u, int wr, int wc, int fr, int fq) const {
        const EpiBf16<0> e{O + (size_t)u.kind * slab, ldc}; e(acc, u, wr, wc, fr, fq);
    }
};

template <class Epi, class Sched, bool ALIGN_EPI = false, bool SP2 = false>
__device__ __forceinline__ void gemm_phase(PG8_LAS unsigned char* lds, const Gemm g, const Sched& S, const Epi& E, const int tid_in) {
    int tid_ = tid_in; asm volatile("" : "+v"(tid_));
    const int tid = tid_, wid = __builtin_amdgcn_readfirstlane(tid >> 6), lane = tid & 63, wr = wid >> 2, wc = wid & 3, fr = lane & 15, fq = lane >> 4;
    const int K = g.ld ? g.ld : g.K, nt = g.K / BK;
    unsigned voffA[2], voffB[2];
#pragma unroll
    for (int i = 0; i < 2; ++i) { int R, C; stage_rc(tid * 16 + i * 8192, R, C); const int Rb = Epi::PERM ? ((R & ~31) + perm32(R & 31)) : R;
        voffA[i] = (unsigned)(R * K + C) * 2u; voffB[i] = (unsigned)(Rb * K + C) * 2u; }
    const size_t kstep = (size_t)(BK * 2);
    const size_t hstep = (size_t)HALF * K * 2;
    const size_t tstep = 2 * hstep;
    const unsigned ldsw = (unsigned)wid * 1024u;
    const int aoff = lds_byte(wr * 64 + fr, fq * 8), boff = lds_byte(wc * 32 + fr, fq * 8);
#define PG8_SA(b, h) (((b) * 2 + (h)) * HTB)
#define PG8_SB(b, h) ((4 + (b) * 2 + (h)) * HTB)
#define PG8_STAGE(bufoff, gbase, voff) do { _Pragma("unroll") for (int _i = 0; _i < 2; ++_i) \
        __builtin_amdgcn_global_load_lds((const unsigned*)((const char*)(gbase) + (voff)[_i]), (PG8_LAS unsigned*)(lds + (bufoff) + ldsw + _i * 8192), 16, 0, 0); } while (0)
#define PG8_LDA(dst, b, h) do { _Pragma("unroll") for (int m = 0; m < 4; ++m) _Pragma("unroll") for (int k = 0; k < 2; ++k) dst[m][k] = *(const PG8_LAS bf16x8*)(lds + PG8_SA(b, h) + aoff + m * 2048 + k * 1024); } while (0)
#define PG8_LDB(dst, b, h) do { _Pragma("unroll") for (int n = 0; n < 2; ++n) _Pragma("unroll") for (int k = 0; k < 2; ++k) dst[n][k] = *(const PG8_LAS bf16x8*)(lds + PG8_SB(b, h) + boff + n * 2048 + k * 1024); } while (0)
#define PG8_MMA(ai, bj, At, Bt) do { __builtin_amdgcn_s_setprio(1); _Pragma("unroll") for (int m = 0; m < 4; ++m) _Pragma("unroll") for (int n = 0; n < 2; ++n) _Pragma("unroll") for (int k = 0; k < 2; ++k) \
        acc[ai][bj][m][n] = __builtin_amdgcn_mfma_f32_16x16x32_bf16(Bt[n][k], At[m][k], acc[ai][bj][m][n], 0, 0, 0); __builtin_amdgcn_s_setprio(0); } while (0)
#define PG8_WAIT_V(n) asm volatile("s_waitcnt vmcnt(" #n ")" ::: "memory")
#define PG8_WAIT_L(n) asm volatile("s_waitcnt lgkmcnt(" #n ")" ::: "memory")
#define PG8_BAR __builtin_amdgcn_s_barrier()
#define PG8_SCHED __builtin_amdgcn_sched_barrier(0)
    Unit cur, nxt; int ui = 0;
    if (!S.next(0, cur)) return;
    f32x4 acc[2][2][4][2];
#pragma unroll
    for (int a = 0; a < 2; ++a)
#pragma unroll
        for (int b = 0; b < 2; ++b)
#pragma unroll
            for (int m = 0; m < 4; ++m)
#pragma unroll
                for (int n = 0; n < 2; ++n) acc[a][b][m][n] = (f32x4){0.f, 0.f, 0.f, 0.f};
    bf16x8 At[4][2], B0[2][2], B1[2][2];
    const char* cA = S.abase(g, cur, tstep); const char* cB = S.bbase(g, cur, tstep);
    S.a_ready(cur);
    if constexpr (SP2) {
        PG8_STAGE(PG8_SB(0, 0), cB, voffB); PG8_STAGE(PG8_SB(0, 1), cB + hstep, voffB); PG8_STAGE(PG8_SA(0, 0), cA, voffA); PG8_STAGE(PG8_SA(0, 1), cA + hstep, voffA);
        if (wr == 1) PG8_BAR;
        PG8_WAIT_V(2); PG8_BAR;
        PG8_STAGE(PG8_SB(1, 0), cB + kstep, voffB); PG8_STAGE(PG8_SA(1, 0), cA + kstep, voffA); PG8_STAGE(PG8_SB(1, 1), cB + hstep + kstep, voffB);
        PG8_WAIT_V(6); PG8_BAR;
    } else {
        PG8_STAGE(PG8_SB(0, 0), cB, voffB); PG8_STAGE(PG8_SA(0, 0), cA, voffA); PG8_STAGE(PG8_SB(0, 1), cB + hstep, voffB); PG8_STAGE(PG8_SA(0, 1), cA + hstep, voffA);
        if (wr == 1) PG8_BAR;
        PG8_WAIT_V(4); PG8_BAR;
        PG8_STAGE(PG8_SB(1, 0), cB + kstep, voffB); PG8_STAGE(PG8_SA(1, 0), cA + kstep, voffA); PG8_STAGE(PG8_SB(1, 1), cB + hstep + kstep, voffB);
        PG8_WAIT_V(6); PG8_BAR;
    }
    for (;;) {
        const bool has_next = S.next(ui + 1, nxt);
        const char* nA = has_next ? S.abase(g, nxt, tstep) : cA; const char* nB = has_next ? S.bbase(g, nxt, tstep) : cB;
        for (int t = 0; t < nt; t += 2) {
            const bool last = (t == nt - 2);
            const char* a1 = cA + (size_t)(t + 1) * kstep;
            const char* a2 = last ? nA : cA + (size_t)(t + 2) * kstep; const char* b2 = last ? nB : cB + (size_t)(t + 2) * kstep;
            const char* a3 = a2 + kstep; const char* b3 = b2 + kstep;
            if (last && has_next) S.a_ready(nxt);
            if constexpr (SP2) {
            PG8_LDB(B0, 0, 0); PG8_LDB(B1, 0, 1); PG8_SCHED; PG8_LDA(At, 0, 0); PG8_STAGE(PG8_SA(1, 1), a1 + hstep, voffA);
            PG8_WAIT_V(8); PG8_WAIT_L(0); PG8_BAR; PG8_MMA(0, 0, At, B0); PG8_MMA(0, 1, At, B1); PG8_BAR; PG8_SCHED;
            PG8_LDA(At, 0, 1); PG8_STAGE(PG8_SB(0, 0), b2, voffB); PG8_STAGE(PG8_SB(0, 1), b2 + hstep, voffB); PG8_STAGE(PG8_SA(0, 0), a2, voffA);
            PG8_WAIT_V(8); PG8_WAIT_L(0); PG8_BAR; PG8_MMA(1, 0, At, B0); PG8_MMA(1, 1, At, B1); PG8_BAR; PG8_SCHED;
            PG8_LDB(B0, 1, 0); PG8_LDB(B1, 1, 1); PG8_SCHED; PG8_LDA(At, 1, 0); PG8_STAGE(PG8_SA(0, 1), a2 + hstep, voffA);
            PG8_WAIT_V(8); PG8_WAIT_L(0); PG8_BAR; PG8_MMA(0, 0, At, B0); PG8_MMA(0, 1, At, B1); PG8_BAR; PG8_SCHED;
            PG8_LDA(At, 1, 1); PG8_STAGE(PG8_SB(1, 0), b3, voffB); PG8_STAGE(PG8_SB(1, 1), b3 + hstep, voffB); PG8_STAGE(PG8_SA(1, 0), a3, voffA);
            PG8_WAIT_V(8); PG8_WAIT_L(0); PG8_BAR; PG8_MMA(1, 0, At, B0); PG8_MMA(1, 1, At, B1); PG8_BAR; PG8_SCHED;
            } else {
            PG8_LDB(B0, 0, 0); PG8_SCHED; PG8_LDA(At, 0, 0); PG8_STAGE(PG8_SA(1, 1), a1 + hstep, voffA);
            PG8_WAIT_L(8); PG8_BAR; PG8_WAIT_L(0); PG8_MMA(0, 0, At, B0); PG8_BAR; PG8_SCHED;
            PG8_LDB(B1, 0, 1); PG8_STAGE(PG8_SB(0, 0), b2, voffB);
            PG8_BAR; PG8_WAIT_L(0); PG8_MMA(0, 1, At, B1); PG8_BAR;
            PG8_LDA(At, 0, 1); PG8_STAGE(PG8_SA(0, 0), a2, voffA);
            PG8_BAR; PG8_WAIT_L(0); PG8_MMA(1, 0, At, B0); PG8_BAR; PG8_SCHED;
            PG8_STAGE(PG8_SB(0, 1), b2 + hstep, voffB);
            PG8_WAIT_V(6); PG8_BAR; PG8_MMA(1, 1, At, B1); PG8_BAR;
            PG8_LDB(B0, 1, 0); PG8_SCHED; PG8_LDA(At, 1, 0); PG8_STAGE(PG8_SA(0, 1), a2 + hstep, voffA);
            PG8_WAIT_L(8); PG8_BAR; PG8_WAIT_L(0); PG8_MMA(0, 0, At, B0); PG8_BAR; PG8_SCHED;
            PG8_LDB(B1, 1, 1); PG8_STAGE(PG8_SB(1, 0), b3, voffB);
            PG8_BAR; PG8_WAIT_L(0); PG8_MMA(0, 1, At, B1); PG8_BAR;
            PG8_LDA(At, 1, 1); PG8_STAGE(PG8_SA(1, 0), a3, voffA);
            PG8_BAR; PG8_WAIT_L(0); PG8_MMA(1, 0, At, B0); PG8_BAR; PG8_SCHED;
            PG8_STAGE(PG8_SB(1, 1), b3 + hstep, voffB);
            PG8_WAIT_V(6); PG8_BAR; PG8_MMA(1, 1, At, B1); PG8_BAR;
            }
        }
        if constexpr (ALIGN_EPI) { if (wr == 0) PG8_BAR; }
        if constexpr (!Epi::AFTER_DRAIN) { E(acc, cur, wr, wc, fr, fq); S.done(cur); }
        if (!has_next) break;
#pragma unroll
        for (int a = 0; a < 2; ++a)
#pragma unroll
            for (int b = 0; b < 2; ++b)
#pragma unroll
                for (int m = 0; m < 4; ++m)
#pragma unroll
                    for (int n = 0; n < 2; ++n) acc[a][b][m][n] = (f32x4){0.f, 0.f, 0.f, 0.f};
        cur = nxt; cA = nA; cB = nB; ++ui;
        if constexpr (ALIGN_EPI) { if (wr == 1) PG8_BAR; }
    }
    PG8_WAIT_V(0);
    if constexpr (!ALIGN_EPI) { if (wr == 0) PG8_BAR; }
    PG8_BAR;
    if constexpr (Epi::AFTER_DRAIN) { E.fused(acc, cur, wr, wc, fr, fq, lds, wid, lane); S.done(cur); }
#undef PG8_SA
#undef PG8_SB
#undef PG8_STAGE
#undef PG8_LDA
#undef PG8_LDB
#undef PG8_MMA
#undef PG8_WAIT_V
#undef PG8_WAIT_L
#undef PG8_BAR
#undef PG8_SCHED
}
}

#define GAS __attribute__((address_space(1)))
#define LAS __attribute__((address_space(3)))
typedef unsigned short bf16;
typedef unsigned v4u __attribute__((ext_vector_type(4)));
typedef float f32x4 __attribute__((ext_vector_type(4)));
typedef short bf16x8 __attribute__((ext_vector_type(8)));
typedef GAS unsigned gu32;
typedef GAS unsigned long long gu64;
#define RLX_AGENT __ATOMIC_RELAXED, __HIP_MEMORY_SCOPE_AGENT
#define LDS_WAIT() asm volatile("s_waitcnt lgkmcnt(0)" ::: "memory")
#define VM_WAIT() asm volatile("s_waitcnt vmcnt(0)" ::: "memory")
__device__ __forceinline__ unsigned long long rt() { return __builtin_amdgcn_s_memrealtime(); }
typedef float hw_f32x2 __attribute__((ext_vector_type(2))); typedef __bf16 hw_bf16x2 __attribute__((ext_vector_type(2)));
__device__ __forceinline__ unsigned pk2(float lo, float hi) { const hw_f32x2 v = {lo, hi}; return __builtin_bit_cast(unsigned, __builtin_convertvector(v, hw_bf16x2)); }
__device__ __forceinline__ unsigned f2bf(float f) { return pk2(f, 0.f) & 0xffffu; }

#define XB_TMO      128
#define XB_XCNT(j)  (256  + 64 * (j))
#define XB_XSUB(j)  (1280 + 64 * (j))
#define XB_XGEN(j)  (2304 + 64 * (j))
#define XB_TOP      3328
#define XB_TOPGEN   3392
#define XCD_BAR_WORDS 3456
#define XB_SPIN_CAP (1u << 21)

__device__ __forceinline__ unsigned xb_ld(unsigned* p)              { return __hip_atomic_load(p, __ATOMIC_RELAXED, __HIP_MEMORY_SCOPE_AGENT); }
__device__ __forceinline__ unsigned xb_add(unsigned* p, unsigned v) { return __hip_atomic_fetch_add(p, v, __ATOMIC_RELAXED, __HIP_MEMORY_SCOPE_AGENT); }
__device__ __forceinline__ unsigned xb_xcc_id() { return (unsigned)__builtin_amdgcn_s_getreg((3 << 11) | 20) & 0xFu; }
#define XB_SPIN(cond, bar) do { unsigned _sp = 0; while (cond) { __builtin_amdgcn_s_sleep(1); \
    if ((++_sp & 255u) == 0u) { if (xb_ld(&(bar)[XB_TMO])) break; if (_sp > XB_SPIN_CAP) { atomicAdd(&(bar)[XB_TMO], 1u); break; } } } } while (0)

struct XcdBarrier {
    unsigned* bar; unsigned x;
    volatile LAS unsigned* st;
};

__device__ __forceinline__ XcdBarrier xcd_barrier_post(unsigned* bar, volatile LAS unsigned* st) {
    XcdBarrier b; b.bar = bar; b.x = xb_xcc_id(); b.st = st;
    if (threadIdx.x == 0) (void)xb_add(&bar[XB_XCNT(b.x)], 1u);
    return b;
}
__device__ __forceinline__ void xcd_barrier_complete(unsigned* bar, unsigned x, unsigned& nloc, unsigned& nx) {
    const unsigned G = gridDim.x * gridDim.y * gridDim.z;
    unsigned sum, cnt, mine, sp = 0u;
    for (;;) {
        sum = 0u; cnt = 0u; mine = 0u;
#pragma unroll
        for (unsigned j = 0; j < 16; ++j) { const unsigned c = xb_ld(&bar[XB_XCNT(j)]); sum += c; cnt += (c > 0u) ? 1u : 0u; mine = (j == x) ? c : mine; }
        if (sum == G) break;
        __builtin_amdgcn_s_sleep(1);
        if ((++sp & 255u) == 0u) { if (xb_ld(&bar[XB_TMO])) break; if (sp > XB_SPIN_CAP) { atomicAdd(&bar[XB_TMO], 1u); break; } }
    }
    nloc = mine > 0u ? mine : 1u; nx = cnt > 0u ? cnt : 1u;
}

__device__ __forceinline__ void xcd_barrier(const XcdBarrier& b, const int wv) {
    asm volatile("s_waitcnt vmcnt(0)" ::: "memory");
    __syncthreads();
    int xb_lane; asm volatile("v_mbcnt_lo_u32_b32 %0, -1, 0\n\tv_mbcnt_hi_u32_b32 %0, -1, %0" : "=v"(xb_lane));
    if (wv == 0 && xb_lane == 0) {
        unsigned* bar = b.bar;
        __builtin_amdgcn_s_waitcnt(0);
        unsigned nloc = b.st[0], nx = b.st[1];
        if (nloc == 0u) { xcd_barrier_complete(bar, b.x, nloc, nx); b.st[0] = nloc; b.st[1] = nx; }
        const unsigned old = xb_add(&bar[XB_XSUB(b.x)], 1u);
        const unsigned gen = old / nloc;
        if (old + 1u == (gen + 1u) * nloc) {
            __builtin_amdgcn_fence(__ATOMIC_RELEASE, "agent");
            asm volatile("s_waitcnt vmcnt(0)" ::: "memory");
            const unsigned og = xb_add(&bar[XB_TOP], 1u);
            const unsigned tg = og / nx;
            if (og + 1u == (tg + 1u) * nx) xb_add(&bar[XB_TOPGEN], 1u);
            else XB_SPIN(xb_ld(&bar[XB_TOPGEN]) == tg, bar);
            __builtin_amdgcn_fence(__ATOMIC_ACQUIRE, "agent");
            xb_add(&bar[XB_XGEN(b.x)], 1u);
            asm volatile("s_waitcnt vmcnt(0)" ::: "memory");
        } else {
            XB_SPIN(xb_ld(&bar[XB_XGEN(b.x)]) == gen, bar);
            __builtin_amdgcn_fence(__ATOMIC_ACQUIRE, "agent");
            asm volatile("s_waitcnt vmcnt(0)" ::: "memory");
        }
    }
    __syncthreads();
}

#include <hip/hip_bf16.h>
#include <cmath>
namespace attn_body {
using bf16=__hip_bfloat16;
using bf16x8=__attribute__((ext_vector_type(8)))short;
using s16x4=__attribute__((ext_vector_type(4)))short;
using f32x16=__attribute__((ext_vector_type(16)))float;
using u32x4=__attribute__((ext_vector_type(4)))unsigned;
constexpr int D=64;
constexpr int NW=8,QBLK=32,QB=QBLK*NW,KVBLK=64;
constexpr int ATTN_UNIT_ROWS=QB;
__device__ __forceinline__ int crow(int r,int hi){return (r&3)+8*(r>>2)+4*hi;}
#define SBAR() __builtin_amdgcn_sched_barrier(0)
constexpr int NSLOT=3, SLOTB=8192;
constexpr int LDS_K=0, LDS_V=NSLOT*SLOTB, LDS_WS=2*NSLOT*SLOTB, LDS_OST=LDS_WS+NW*64*4, LDS_BYTES=LDS_OST+NW*4096;
constexpr float C2=0.125f*1.4426950408889634f;
__device__ __forceinline__ void glds16(const void*gsrc,unsigned lds_dst){unsigned keep;
  asm volatile("s_mov_b32 %0, m0\n\ts_mov_b32 m0, %2\n\ts_nop 0\n\tglobal_load_lds_dwordx4 %1, off\n\ts_mov_b32 m0, %0":"=&s"(keep):"v"(gsrc),"s"(lds_dst):"memory");}
__device__ __forceinline__ float max3f(float a,float b,float c){float r;asm("v_max3_f32 %0, %1, %2, %3":"=v"(r):"v"(a),"v"(b),"v"(c));return r;}
__device__ __forceinline__ float max2f(float a,float b){float r;asm("v_max_f32_e32 %0, %1, %2":"=v"(r):"v"(a),"v"(b));return r;}
__device__ __forceinline__ float fadd_s(float a,float b){float r;asm("v_add_f32_e32 %0, %1, %2":"=v"(r):"v"(a),"v"(b));return r;}
__device__ __forceinline__ float fsub_s(float a,float b){float r;asm("v_sub_f32_e32 %0, %1, %2":"=v"(r):"v"(a),"v"(b));return r;}
typedef float f32x2_t __attribute__((ext_vector_type(2))); typedef __bf16 bf16x2_t __attribute__((ext_vector_type(2)));
__device__ __forceinline__ unsigned cvtpk_s(float lo,float hi){f32x2_t v={lo,hi};bf16x2_t b=__builtin_convertvector(v,bf16x2_t);return __builtin_bit_cast(unsigned,b);}
#define WAIT_BAR(N) asm volatile("s_waitcnt vmcnt(" #N ") lgkmcnt(0)\n\ts_barrier":::"memory")

__device__ __forceinline__ void qkt(f32x16&p0,f32x16&p1,const char*Kslot,const bf16x8*qr,const f32x16&negm,int r32,int hi){
  const char*kb=Kslot+hi*1024+r32*16;
  #pragma unroll
  for(int d0=0;d0<4;++d0){
    const bf16x8 b0=*reinterpret_cast<const bf16x8*>(kb+d0*2048);
    const bf16x8 b1=*reinterpret_cast<const bf16x8*>(kb+d0*2048+512);
    if(d0==0){p0=__builtin_amdgcn_mfma_f32_32x32x16_bf16(b0,qr[0],negm,0,0,0);p1=__builtin_amdgcn_mfma_f32_32x32x16_bf16(b1,qr[0],negm,0,0,0);}
    else{p0=__builtin_amdgcn_mfma_f32_32x32x16_bf16(b0,qr[d0],p0,0,0,0);p1=__builtin_amdgcn_mfma_f32_32x32x16_bf16(b1,qr[d0],p1,0,0,0);}}
}
typedef __attribute__((address_space(3))) const char* lds_cptr;
typedef short v4i16_t __attribute__((ext_vector_type(4)));
__device__ __forceinline__ void kload8(bf16x8*kf,lds_cptr kp){
  kf[0]=*(const __attribute__((address_space(3))) bf16x8*)(kp);      kf[1]=*(const __attribute__((address_space(3))) bf16x8*)(kp+512);
  kf[2]=*(const __attribute__((address_space(3))) bf16x8*)(kp+2048); kf[3]=*(const __attribute__((address_space(3))) bf16x8*)(kp+2560);
  kf[4]=*(const __attribute__((address_space(3))) bf16x8*)(kp+4096); kf[5]=*(const __attribute__((address_space(3))) bf16x8*)(kp+4608);
  kf[6]=*(const __attribute__((address_space(3))) bf16x8*)(kp+6144); kf[7]=*(const __attribute__((address_space(3))) bf16x8*)(kp+6656);
}
__device__ __forceinline__ void kload2(bf16x8*kf,lds_cptr kp,int j){ kf[2*j]=*(const __attribute__((address_space(3))) bf16x8*)(kp+j*2048); kf[2*j+1]=*(const __attribute__((address_space(3))) bf16x8*)(kp+j*2048+512); }
__device__ __forceinline__ s16x4 vtr(lds_cptr p){ return __builtin_bit_cast(s16x4,__builtin_amdgcn_ds_read_tr16_b64_v4i16((__attribute__((address_space(3))) v4i16_t*)p)); }
__device__ __forceinline__ float rowmax(const f32x16&p0,const f32x16&p1){
  float a=max3f(p0[0],p0[1],p1[0]),b=max3f(p0[2],p0[3],p1[1]);a=max3f(a,p1[2],p1[3]);
  #pragma unroll
  for(int r=4;r<16;r+=4){a=max3f(a,p0[r],p0[r+1]);b=max3f(b,p0[r+2],p0[r+3]);a=max3f(a,p1[r],p1[r+1]);b=max3f(b,p1[r+2],p1[r+3]);}
  const float m=max2f(a,b);
  auto rr=__builtin_amdgcn_permlane32_swap(__float_as_uint(m),__float_as_uint(m),false,false);
  return max2f(__uint_as_float(rr[0]),__uint_as_float(rr[1]));
}
__device__ __forceinline__ void pv(f32x16*o,int vb,bf16x8 pa0,bf16x8 pa1,bf16x8 pa2,bf16x8 pa3){
  #pragma unroll
  for(int d0=0;d0<2;++d0){s16x4 lo[4],hi[4];
    #pragma unroll
    for(int ks=0;ks<4;++ks){
      asm volatile("ds_read_b64_tr_b16 %0,%1 offset:%c2":"=&v"(lo[ks]):"v"(vb),"i"(d0*4096+ks*1024):"memory");
      asm volatile("ds_read_b64_tr_b16 %0,%1 offset:%c2":"=&v"(hi[ks]):"v"(vb),"i"(d0*4096+ks*1024+512):"memory");}
    asm volatile("s_waitcnt lgkmcnt(0)":::"memory");SBAR();
    #define PK(k) (bf16x8){lo[k][0],lo[k][1],lo[k][2],lo[k][3],hi[k][0],hi[k][1],hi[k][2],hi[k][3]}
    o[d0]=__builtin_amdgcn_mfma_f32_32x32x16_bf16(pa0,PK(0),o[d0],0,0,0);
    o[d0]=__builtin_amdgcn_mfma_f32_32x32x16_bf16(pa1,PK(1),o[d0],0,0,0);
    o[d0]=__builtin_amdgcn_mfma_f32_32x32x16_bf16(pa2,PK(2),o[d0],0,0,0);
    o[d0]=__builtin_amdgcn_mfma_f32_32x32x16_bf16(pa3,PK(3),o[d0],0,0,0);
    #undef PK
  }
}

#ifndef ATTN_STORE16
#define ATTN_STORE16(p,v) (*(u32x4*)(p)=(v))
#endif
template<int THRL> __device__ __forceinline__ void attn_unit(const int tid_in,const bf16*Qu,int qpitch,const bf16*__restrict__ Kh,const bf16*__restrict__ Vh,int kvpitch,bf16*Ou,int opitch,const int NT,char*shm){
  int tid_=tid_in; asm volatile("":"+v"(tid_));
  const int tid=tid_,lane=tid&63,r32=lane&31,hi=lane>>5; const int wid=__builtin_amdgcn_readfirstlane(tid>>6);
  const bf16*Qw=Qu+(long)(wid*QBLK)*qpitch;
  const unsigned lds0=(unsigned)(uintptr_t)shm;
  float*wsf=(float*)(shm+LDS_WS)+wid*64;
  const bf16*ksrc=Kh+(long)lane*kvpitch+wid*8;
  const bf16*vsrc=Vh+(long)(16*(wid&3)+(lane>>2))*kvpitch+(wid>>2)*32+(lane&3)*8;
  const unsigned kdst=lds0+LDS_K+wid*1024, vdst=lds0+LDS_V+wid*1024;
  #define DMA_K(t,slot) glds16(ksrc+(long)(t)*KVBLK*kvpitch,(unsigned)__builtin_amdgcn_readfirstlane(kdst+(slot)))
  #define DMA_V(t,slot) glds16(vsrc+(long)(t)*KVBLK*kvpitch,(unsigned)__builtin_amdgcn_readfirstlane(vdst+(slot)))
  const int vb0=(int)(lds0+LDS_V)+((lane>>4)&1)*32+(lane&3)*8+(4*hi+((lane&15)>>2))*64;
  const char*Kbase=shm+LDS_K; bf16x8 kf[8];
  const lds_cptr shm3=(lds_cptr)shm; const lds_cptr kp0=shm3+LDS_K+hi*1024+r32*16; const lds_cptr vp0=shm3+LDS_V+((lane>>4)&1)*32+(lane&3)*8+(4*hi+((lane&15)>>2))*64;
  DMA_K(0,0);DMA_V(0,0);DMA_K(1,SLOTB);
  bf16x8 qr[4];
  #pragma unroll
  for(int d0=0;d0<4;++d0)qr[d0]=*reinterpret_cast<const bf16x8*>(&Qw[(long)r32*qpitch+d0*16+hi*8]);
  float mhat=0.f;f32x16 o[3];o[0]=f32x16{};o[1]=f32x16{};o[2]=f32x16{};f32x16 negm=f32x16{};asm volatile("":"+v"(negm));
  bf16x8 onesf={(short)0x3F80,(short)0x3F80,(short)0x3F80,(short)0x3F80,(short)0x3F80,(short)0x3F80,(short)0x3F80,(short)0x3F80};asm volatile("":"+v"(onesf));
  #define CMASK(P0,P1,t) do{}while(0)
  bool resc=false;
  #define START(P0,P1) do{ const float rm=rowmax(P0,P1); resc=false; \
    { const float dl=rm; mhat=fadd_s(mhat,dl); \
      _Pragma("unroll") for(int r=0;r<16;++r){P0[r]=fsub_s(P0[r],dl);P1[r]=fsub_s(P1[r],dl);} \
      _Pragma("unroll") for(int r=0;r<16;++r)negm[r]=-mhat; asm volatile("":"+v"(negm)); } \
    _Pragma("unroll") for(int r=0;r<16;++r)P0[r]=__builtin_amdgcn_exp2f(P0[r]); }while(0)
  #define RESC() do{ if(resc){ asm volatile("s_waitcnt lgkmcnt(0)":::"memory"); \
      _Pragma("unroll") for(int d_=0;d_<3;++d_) _Pragma("unroll") for(int r=0;r<16;++r)o[d_][r]*=wsf[crow(r,hi)]; } }while(0)
  f32x16 pA0,pA1,pB0,pB1;
  int sl_prev=0,sl_cur=0,sl_next=SLOTB;
  #define ROT() do{sl_prev=sl_cur;sl_cur=sl_next;sl_next=(sl_next==(NSLOT-1)*SLOTB)?0:sl_next+SLOTB;}while(0)
  DMA_K(2,2*SLOTB);
  WAIT_BAR(3);
  qkt(pA0,pA1,Kbase,qr,negm,r32,hi);asm volatile("s_nop 15\n\ts_nop 7":"+v"(pA0),"+v"(pA1));CMASK(pA0,pA1,0);
  START(pA0,pA1);
  _Pragma("unroll") for(int r=0;r<16;++r)pA1[r]=__builtin_amdgcn_exp2f(pA1[r]);
  WAIT_BAR(0);
  DMA_K(3,0);DMA_V(1,SLOTB);
  ROT();
  kload8(kf,kp0+sl_cur);
  WAIT_BAR(2);
  s16x4 vlo[8],vhi[8]; u32x4 pw0,pw1,pw2,pw3;
  #define PKW(P,B) cvtpk_s(P[B],P[B+1])
  #define PAF(k) __builtin_bit_cast(bf16x8,pw##k)
  #define VFR(i) (bf16x8){vlo[i][0],vlo[i][1],vlo[i][2],vlo[i][3],vhi[i][0],vhi[i][1],vhi[i][2],vhi[i][3]}
  #define PIN(x) asm volatile("":"+v"(x))
  #define MX3(a,b,c) __builtin_fmaxf(__builtin_fmaxf((a),(b)),(c))
  #define GAPA(MF,A0,A1,A2,A3,W0,W1,PW) do{ MF; W0; W1; PIN(PW); SBAR(); }while(0)
  #define EX(v) __builtin_amdgcn_exp2f(v)
  #define GX(MF,E0,E1,E2,X) do{ MF; E0; E1; E2; PIN(X); SBAR(); }while(0)
  #define VRD(i) do{ vlo[i]=vtr(vp_+(((i)>>2)*4096+((i)&3)*1024)); vhi[i]=vtr(vp_+(((i)>>2)*4096+((i)&3)*1024+512)); }while(0)
  #define KRD(G,j) do{ if(G){ kload2(kf,kp0+sl_next,j); SBAR(); } }while(0)
  #define STEP(C0,C1,P0,P1,t,GK,GV,GL) do{ SBAR(); \
    const lds_cptr vp_=vp0+sl_prev; \
    VRD(0); SBAR(); \
    GAPA(C0=__builtin_amdgcn_mfma_f32_32x32x16_bf16(kf[0],qr[0],negm,0,0,0), P0[2],P0[3],P0[4],P0[5],     pw0[0]=PKW(P0,0), pw0[1]=PKW(P0,2), pw0); \
    VRD(4); SBAR(); GAPA(C1=__builtin_amdgcn_mfma_f32_32x32x16_bf16(kf[1],qr[0],negm,0,0,0), P0[6],P0[7],P0[8],P0[9],     pw0[2]=PKW(P0,4), pw0[3]=PKW(P0,6), pw0); \
    VRD(1); SBAR(); GAPA(C0=__builtin_amdgcn_mfma_f32_32x32x16_bf16(kf[2],qr[1],C0,0,0,0),   P0[10],P0[11],P0[12],P0[13], pw1[0]=PKW(P0,8), pw1[1]=PKW(P0,10), pw1); \
    VRD(5); SBAR(); GAPA(C1=__builtin_amdgcn_mfma_f32_32x32x16_bf16(kf[3],qr[1],C1,0,0,0),   P0[14],P0[15],P1[0],P1[1],   pw1[2]=PKW(P0,12),pw1[3]=PKW(P0,14), pw1); \
    VRD(2); SBAR(); GAPA(C0=__builtin_amdgcn_mfma_f32_32x32x16_bf16(kf[4],qr[2],C0,0,0,0),   P1[2],P1[3],P1[4],P1[5],     pw2[0]=PKW(P1,0), pw2[1]=PKW(P1,2), pw2); \
    VRD(6); SBAR(); GAPA(C1=__builtin_amdgcn_mfma_f32_32x32x16_bf16(kf[5],qr[2],C1,0,0,0),   P1[6],P1[7],P1[8],P1[9],     pw2[2]=PKW(P1,4), pw2[3]=PKW(P1,6), pw2); \
    VRD(3); SBAR(); GAPA(C0=__builtin_amdgcn_mfma_f32_32x32x16_bf16(kf[6],qr[3],C0,0,0,0),   P1[10],P1[11],P1[12],P1[13], pw3[0]=PKW(P1,8), pw3[1]=PKW(P1,10), pw3); \
    VRD(7); SBAR(); GAPA(C1=__builtin_amdgcn_mfma_f32_32x32x16_bf16(kf[7],qr[3],C1,0,0,0),   P1[14],P1[15],0.f,0.f,       pw3[2]=PKW(P1,12),pw3[3]=PKW(P1,14), pw3); \
    if(GK){DMA_K((t)+3,sl_cur);} if(GV){DMA_V((t)+1,sl_next);} \
    CMASK(C0,C1,t); \
    { float a=MX3(C0[0],C0[1],C1[0]),b=MX3(C0[2],C0[3],C1[1]); a=MX3(a,C1[2],C1[3]); \
      _Pragma("unroll") for(int r=4;r<16;r+=4){a=MX3(a,C0[r],C0[r+1]);b=MX3(b,C0[r+2],C0[r+3]);a=MX3(a,C1[r],C1[r+1]);b=MX3(b,C1[r+2],C1[r+3]);} \
      float rm=__builtin_fmaxf(a,b); { auto rr=__builtin_amdgcn_permlane32_swap(__float_as_uint(rm),__float_as_uint(rm),false,false); rm=__builtin_fmaxf(__uint_as_float(rr[0]),__uint_as_float(rr[1])); } \
      resc=false; \
      if(__builtin_expect(__any(rm>(float)THRL),0)){ const float dl=__builtin_fmaxf(rm,0.f); mhat+=dl; \
        _Pragma("unroll") for(int r=0;r<16;++r){C0[r]-=dl;C1[r]-=dl;} \
        _Pragma("unroll") for(int r=0;r<16;++r)negm[r]=-mhat; asm volatile("":"+v"(negm)); \
        const float f=__builtin_amdgcn_exp2f(-dl); if(hi==0)wsf[r32]=f; resc=true; } } \
    SBAR(); \
    GX(o[0]=__builtin_amdgcn_mfma_f32_32x32x16_bf16(PAF(0),VFR(0),o[0],0,0,0), C0[0]=EX(C0[0]), C0[1]=EX(C0[1]), C0[2]=EX(C0[2]), C0); \
    GX(o[1]=__builtin_amdgcn_mfma_f32_32x32x16_bf16(PAF(0),VFR(4),o[1],0,0,0), C0[3]=EX(C0[3]), C0[4]=EX(C0[4]), C0[5]=EX(C0[5]), C0); \
    GX(o[2]=__builtin_amdgcn_mfma_f32_32x32x16_bf16(PAF(0),onesf,o[2],0,0,0),  C0[6]=EX(C0[6]), C0[7]=EX(C0[7]), (void)0, C0); \
    KRD(GL,0); GX(o[0]=__builtin_amdgcn_mfma_f32_32x32x16_bf16(PAF(1),VFR(1),o[0],0,0,0), C0[8]=EX(C0[8]), C0[9]=EX(C0[9]), C0[10]=EX(C0[10]), C0); \
    KRD(GL,1); GX(o[1]=__builtin_amdgcn_mfma_f32_32x32x16_bf16(PAF(1),VFR(5),o[1],0,0,0), C0[11]=EX(C0[11]), C0[12]=EX(C0[12]), C0[13]=EX(C0[13]), C0); \
    GX(o[2]=__builtin_amdgcn_mfma_f32_32x32x16_bf16(PAF(1),onesf,o[2],0,0,0),  C0[14]=EX(C0[14]), C0[15]=EX(C0[15]), (void)0, C0); \
    KRD(GL,2); GX(o[0]=__builtin_amdgcn_mfma_f32_32x32x16_bf16(PAF(2),VFR(2),o[0],0,0,0), C1[0]=EX(C1[0]), C1[1]=EX(C1[1]), C1[2]=EX(C1[2]), C1); \
    KRD(GL,3); GX(o[1]=__builtin_amdgcn_mfma_f32_32x32x16_bf16(PAF(2),VFR(6),o[1],0,0,0), C1[3]=EX(C1[3]), C1[4]=EX(C1[4]), C1[5]=EX(C1[5]), C1); \
    GX(o[2]=__builtin_amdgcn_mfma_f32_32x32x16_bf16(PAF(2),onesf,o[2],0,0,0),  C1[6]=EX(C1[6]), C1[7]=EX(C1[7]), (void)0, C1); \
    GX(o[0]=__builtin_amdgcn_mfma_f32_32x32x16_bf16(PAF(3),VFR(3),o[0],0,0,0), C1[8]=EX(C1[8]), C1[9]=EX(C1[9]), C1[10]=EX(C1[10]), C1); \
    GX(o[1]=__builtin_amdgcn_mfma_f32_32x32x16_bf16(PAF(3),VFR(7),o[1],0,0,0), C1[11]=EX(C1[11]), C1[12]=EX(C1[12]), C1[13]=EX(C1[13]), C1); \
    GX(o[2]=__builtin_amdgcn_mfma_f32_32x32x16_bf16(PAF(3),onesf,o[2],0,0,0),  C1[14]=EX(C1[14]), C1[15]=EX(C1[15]), (void)0, C1); \
    }while(0)
  int t=1;
  #undef CMASK
  #define CMASK(P0,P1,t) do{}while(0)
  for(;t+5<NT;t+=2){
    STEP(pB0,pB1,pA0,pA1,t,true,true,true);     WAIT_BAR(2); RESC(); ROT();
    STEP(pA0,pA1,pB0,pB1,t+1,true,true,true);   WAIT_BAR(2); RESC(); ROT();
  }
  #undef CMASK
  #define CMASK(P0,P1,t) do{}while(0)
  #define ENDW(tt) do{ if((tt)+3<NT){WAIT_BAR(2);} else if((tt)+2<NT){WAIT_BAR(1);} else {WAIT_BAR(0);} }while(0)
  for(;t+1<NT;t+=2){
    STEP(pB0,pB1,pA0,pA1,t,(t+3<NT),(t+1<NT),(t+1<NT));       ENDW(t);   RESC(); ROT();
    STEP(pA0,pA1,pB0,pB1,t+1,(t+4<NT),(t+2<NT),(t+2<NT));     ENDW(t+1); RESC(); ROT();
  }
  STEP(pB0,pB1,pA0,pA1,NT-1,false,false,false); RESC();
  {
    pw0=(u32x4){PKW(pB0,0),PKW(pB0,2),PKW(pB0,4),PKW(pB0,6)};pw1=(u32x4){PKW(pB0,8),PKW(pB0,10),PKW(pB0,12),PKW(pB0,14)};pw2=(u32x4){PKW(pB1,0),PKW(pB1,2),PKW(pB1,4),PKW(pB1,6)};pw3=(u32x4){PKW(pB1,8),PKW(pB1,10),PKW(pB1,12),PKW(pB1,14)};
    SBAR(); pv(o,vb0+sl_cur,PAF(0),PAF(1),PAF(2),PAF(3));
    o[2]=__builtin_amdgcn_mfma_f32_32x32x16_bf16(PAF(0),onesf,o[2],0,0,0); o[2]=__builtin_amdgcn_mfma_f32_32x32x16_bf16(PAF(1),onesf,o[2],0,0,0);
    o[2]=__builtin_amdgcn_mfma_f32_32x32x16_bf16(PAF(2),onesf,o[2],0,0,0); o[2]=__builtin_amdgcn_mfma_f32_32x32x16_bf16(PAF(3),onesf,o[2],0,0,0); }
  #undef PKW
  #undef PAF
  #undef VFR
  #undef PIN
  #undef MX3
  #undef GAPA
  #undef GX
  #undef EX
  #undef VRD
  #undef KRD
  #undef STEP
  #undef ENDW
  float rli[16];
  #pragma unroll
  for(int r=0;r<16;++r)rli[r]=__builtin_amdgcn_rcpf(o[2][r]);
  bf16*Ow=Ou+(long)(wid*QBLK)*opitch;
  { bf16*stg=(bf16*)(shm+LDS_OST)+wid*2048;
    #pragma unroll
    for(int r=0;r<16;++r){const int orow=crow(r,hi);
      #pragma unroll
      for(int d0=0;d0<2;++d0)stg[orow*64+d0*32+r32]=__float2bfloat16(o[d0][r]*rli[r]);}
    asm volatile("s_waitcnt lgkmcnt(0)":::"memory");
    #pragma unroll
    for(int i=0;i<4;++i){const int row=i*8+(lane>>3),ch=lane&7; const u32x4 v=*(const u32x4*)(stg+row*64+ch*8); ATTN_STORE16(Ow+(long)row*opitch+ch*8,v);} }
  asm volatile("s_waitcnt lgkmcnt(0)\n\ts_barrier":::"memory");
  #undef DMA_K
  #undef DMA_V
  #undef CMASK
  #undef START
  #undef RESC
  #undef ROT
}
__device__ __forceinline__ void pv128(f32x16*o,int vb,bf16x8 pa0,bf16x8 pa1,bf16x8 pa2,bf16x8 pa3){
  #pragma unroll
  for(int d0=0;d0<4;++d0){s16x4 lo[4],hi[4];
    #pragma unroll
    for(int ks=0;ks<4;++ks){
      asm volatile("ds_read_b64_tr_b16 %0,%1 offset:%c2":"=&v"(lo[ks]):"v"(vb),"i"(d0*4096+ks*1024):"memory");
      asm volatile("ds_read_b64_tr_b16 %0,%1 offset:%c2":"=&v"(hi[ks]):"v"(vb),"i"(d0*4096+ks*1024+512):"memory");}
    asm volatile("s_waitcnt lgkmcnt(0)":::"memory");SBAR();
    #define PK(k) (bf16x8){lo[k][0],lo[k][1],lo[k][2],lo[k][3],hi[k][0],hi[k][1],hi[k][2],hi[k][3]}
    o[d0]=__builtin_amdgcn_mfma_f32_32x32x16_bf16(pa0,PK(0),o[d0],0,0,0);
    o[d0]=__builtin_amdgcn_mfma_f32_32x32x16_bf16(pa1,PK(1),o[d0],0,0,0);
    o[d0]=__builtin_amdgcn_mfma_f32_32x32x16_bf16(pa2,PK(2),o[d0],0,0,0);
    o[d0]=__builtin_amdgcn_mfma_f32_32x32x16_bf16(pa3,PK(3),o[d0],0,0,0);
    #undef PK
  }
}
constexpr int LDS_V128=NSLOT*SLOTB, LDS_WS128=LDS_V128+NSLOT*2*SLOTB, LDS_OST128=LDS_WS128+NW*64*4, LDS_BYTES128=LDS_OST128+NW*8192;
template<int THRL> __device__ __forceinline__ void attn_unit128(const int tid_in,const bf16*Qu,int qpitch,const bf16*__restrict__ Kh,const bf16*__restrict__ Vh,int kvpitch,bf16*Ou,int opitch,const int NT,char*shm){
  int tid_=tid_in; asm volatile("":"+v"(tid_));
  const int tid=tid_,lane=tid&63,r32=lane&31,hi=lane>>5; const int wid=__builtin_amdgcn_readfirstlane(tid>>6);
  const bf16*Qw=Qu+(long)(wid*QBLK)*qpitch;
  const unsigned lds0=(unsigned)(uintptr_t)shm;
  float*wsf=(float*)(shm+LDS_WS128)+wid*64;
  const bf16*ksrc=Kh+(long)lane*kvpitch+wid*8;
  const bf16*vsrc=Vh+(long)(16*(wid&3)+(lane>>2))*kvpitch+(wid>>2)*32+(lane&3)*8;
  const unsigned kdst=lds0+LDS_K+wid*1024, vdst=lds0+LDS_V128+wid*1024;
  #define DMA_K(t,slot) glds16(ksrc+(long)(t)*KVBLK*kvpitch,(unsigned)__builtin_amdgcn_readfirstlane(kdst+(slot)))
  #define DMA_V(t,slot) do{ glds16(vsrc+(long)(t)*KVBLK*kvpitch,(unsigned)__builtin_amdgcn_readfirstlane(vdst+2*(slot))); glds16(vsrc+(long)(t)*KVBLK*kvpitch+64,(unsigned)__builtin_amdgcn_readfirstlane(vdst+8192+2*(slot))); }while(0)
  const int vb0=(int)(lds0+LDS_V128)+((lane>>4)&1)*32+(lane&3)*8+(4*hi+((lane&15)>>2))*64;
  const char*Kbase=shm+LDS_K; bf16x8 kf[8];
  const lds_cptr shm3=(lds_cptr)shm; const lds_cptr kp0=shm3+LDS_K+hi*1024+r32*16; const lds_cptr vp0=shm3+LDS_V128+((lane>>4)&1)*32+(lane&3)*8+(4*hi+((lane&15)>>2))*64;
  DMA_K(0,0);DMA_V(0,0);DMA_K(1,SLOTB);
  bf16x8 qr[4];
  #pragma unroll
  for(int d0=0;d0<4;++d0)qr[d0]=*reinterpret_cast<const bf16x8*>(&Qw[(long)r32*qpitch+d0*16+hi*8]);
  float mhat=0.f,l_reg=0.f;f32x16 o[4];o[0]=f32x16{};o[1]=f32x16{};o[2]=f32x16{};o[3]=f32x16{};f32x16 negm=f32x16{};asm volatile("":"+v"(negm));
  #define CMASK(P0,P1,t) do{}while(0)
  bool resc=false;
  #define START(P0,P1) do{ const float rm=rowmax(P0,P1); resc=false; \
    { const float dl=rm; mhat=fadd_s(mhat,dl); \
      _Pragma("unroll") for(int r=0;r<16;++r){P0[r]=fsub_s(P0[r],dl);P1[r]=fsub_s(P1[r],dl);} \
      _Pragma("unroll") for(int r=0;r<16;++r)negm[r]=-mhat; asm volatile("":"+v"(negm)); } \
    _Pragma("unroll") for(int r=0;r<16;++r)P0[r]=__builtin_amdgcn_exp2f(P0[r]); }while(0)
  #define RESC() do{ if(resc){ asm volatile("s_waitcnt lgkmcnt(0)":::"memory"); \
      _Pragma("unroll") for(int d_=0;d_<4;++d_) _Pragma("unroll") for(int r=0;r<16;++r)o[d_][r]*=wsf[crow(r,hi)]; } }while(0)
  f32x16 pA0,pA1,pB0,pB1;
  int sl_prev=0,sl_cur=0,sl_next=SLOTB;
  #define ROT() do{sl_prev=sl_cur;sl_cur=sl_next;sl_next=(sl_next==(NSLOT-1)*SLOTB)?0:sl_next+SLOTB;}while(0)
  DMA_K(2,2*SLOTB);
  WAIT_BAR(4);
  qkt(pA0,pA1,Kbase,qr,negm,r32,hi);asm volatile("s_nop 15\n\ts_nop 7":"+v"(pA0),"+v"(pA1));CMASK(pA0,pA1,0);
  START(pA0,pA1);
  _Pragma("unroll") for(int r=0;r<16;++r)pA1[r]=__builtin_amdgcn_exp2f(pA1[r]);
  WAIT_BAR(0);
  DMA_K(3,0);DMA_V(1,SLOTB);
  ROT();
  kload8(kf,kp0+sl_cur);
  WAIT_BAR(3);
  s16x4 vbl[3],vbh[3]; u32x4 pw0,pw1,pw2,pw3;
  #define PKW(P,B) cvtpk_s(P[B],P[B+1])
  #define PAF(k) __builtin_bit_cast(bf16x8,pw##k)
  #define VFB(s) (bf16x8){vbl[s][0],vbl[s][1],vbl[s][2],vbl[s][3],vbh[s][0],vbh[s][1],vbh[s][2],vbh[s][3]}
  #define PIN(x) asm volatile("":"+v"(x))
  #define MX3(a,b,c) __builtin_fmaxf(__builtin_fmaxf((a),(b)),(c))
  #define GAPA(MF,A0,A1,A2,A3,W0,W1,PW) do{ MF; sacc+=A0; sacc+=A1; sacc+=A2; sacc+=A3; PIN(sacc); W0; W1; PIN(PW); SBAR(); }while(0)
  #define EX(v) __builtin_amdgcn_exp2f(v)
  #define VRD3(s,i) do{ vbl[s]=vtr(vp_+(((i)&3)*4096+((i)>>2)*1024)); vbh[s]=vtr(vp_+(((i)&3)*4096+((i)>>2)*1024+512)); }while(0)
  #define GAPB(i,X,B) do{ o[(i)&3]=__builtin_amdgcn_mfma_f32_32x32x16_bf16(PAFI((i)>>2),VFB((i)%3),o[(i)&3],0,0,0); if((i)+2<16){VRD3(((i)+2)%3,(i)+2);} X[B]=EX(X[B]); X[B+1]=EX(X[B+1]); PIN(X); SBAR(); }while(0)
  #define PAFI(k) ((k)==0?PAF(0):(k)==1?PAF(1):(k)==2?PAF(2):PAF(3))
  #define KRD(G,j) do{ if(G){ kload2(kf,kp0+sl_next,j); SBAR(); } }while(0)
  #define STEP(C0,C1,P0,P1,t,GK,GV,GL) do{ SBAR(); \
    const lds_cptr vp_=vp0+2*sl_prev; \
    float sacc=(P0[0]+P0[1]); \
    GAPA(C0=__builtin_amdgcn_mfma_f32_32x32x16_bf16(kf[0],qr[0],negm,0,0,0), P0[2],P0[3],P0[4],P0[5],     pw0[0]=PKW(P0,0), pw0[1]=PKW(P0,2), pw0); \
    GAPA(C1=__builtin_amdgcn_mfma_f32_32x32x16_bf16(kf[1],qr[0],negm,0,0,0), P0[6],P0[7],P0[8],P0[9],     pw0[2]=PKW(P0,4), pw0[3]=PKW(P0,6), pw0); \
    GAPA(C0=__builtin_amdgcn_mfma_f32_32x32x16_bf16(kf[2],qr[1],C0,0,0,0),   P0[10],P0[11],P0[12],P0[13], pw1[0]=PKW(P0,8), pw1[1]=PKW(P0,10), pw1); \
    GAPA(C1=__builtin_amdgcn_mfma_f32_32x32x16_bf16(kf[3],qr[1],C1,0,0,0),   P0[14],P0[15],P1[0],P1[1],   pw1[2]=PKW(P0,12),pw1[3]=PKW(P0,14), pw1); \
    GAPA(C0=__builtin_amdgcn_mfma_f32_32x32x16_bf16(kf[4],qr[2],C0,0,0,0),   P1[2],P1[3],P1[4],P1[5],     pw2[0]=PKW(P1,0), pw2[1]=PKW(P1,2), pw2); \
    GAPA(C1=__builtin_amdgcn_mfma_f32_32x32x16_bf16(kf[5],qr[2],C1,0,0,0),   P1[6],P1[7],P1[8],P1[9],     pw2[2]=PKW(P1,4), pw2[3]=PKW(P1,6), pw2); \
    VRD3(0,0); SBAR(); GAPA(C0=__builtin_amdgcn_mfma_f32_32x32x16_bf16(kf[6],qr[3],C0,0,0,0),   P1[10],P1[11],P1[12],P1[13], pw3[0]=PKW(P1,8), pw3[1]=PKW(P1,10), pw3); \
    VRD3(1,1); SBAR(); GAPA(C1=__builtin_amdgcn_mfma_f32_32x32x16_bf16(kf[7],qr[3],C1,0,0,0),   P1[14],P1[15],0.f,0.f,       pw3[2]=PKW(P1,12),pw3[3]=PKW(P1,14), pw3); \
    l_reg+=sacc; \
    if(GK){DMA_K((t)+3,sl_cur);} if(GV){DMA_V((t)+1,sl_next);} \
    { float a=MX3(C0[0],C0[1],C1[0]),b=MX3(C0[2],C0[3],C1[1]); a=MX3(a,C1[2],C1[3]); \
      _Pragma("unroll") for(int r=4;r<16;r+=4){a=MX3(a,C0[r],C0[r+1]);b=MX3(b,C0[r+2],C0[r+3]);a=MX3(a,C1[r],C1[r+1]);b=MX3(b,C1[r+2],C1[r+3]);} \
      float rm=__builtin_fmaxf(a,b); { auto rr=__builtin_amdgcn_permlane32_swap(__float_as_uint(rm),__float_as_uint(rm),false,false); rm=__builtin_fmaxf(__uint_as_float(rr[0]),__uint_as_float(rr[1])); } \
      resc=false; \
      if(__builtin_expect(__any(rm>(float)THRL),0)){ const float dl=__builtin_fmaxf(rm,0.f); mhat+=dl; \
        _Pragma("unroll") for(int r=0;r<16;++r){C0[r]-=dl;C1[r]-=dl;} \
        _Pragma("unroll") for(int r=0;r<16;++r)negm[r]=-mhat; asm volatile("":"+v"(negm)); \
        const float f=__builtin_amdgcn_exp2f(-dl); l_reg*=f; if(hi==0)wsf[r32]=f; resc=true; } } \
    SBAR(); \
    GAPB(0,C0,0); GAPB(1,C0,2); GAPB(2,C0,4); GAPB(3,C0,6); \
    KRD(GL,0); GAPB(4,C0,8); GAPB(5,C0,10); KRD(GL,1); GAPB(6,C0,12); GAPB(7,C0,14); \
    KRD(GL,2); GAPB(8,C1,0); GAPB(9,C1,2); KRD(GL,3); GAPB(10,C1,4); GAPB(11,C1,6); \
    GAPB(12,C1,8); GAPB(13,C1,10); GAPB(14,C1,12); GAPB(15,C1,14); \
    }while(0)
  int t=1;
  #undef CMASK
  #define CMASK(P0,P1,t) do{}while(0)
  for(;t+5<NT;t+=2){
    STEP(pB0,pB1,pA0,pA1,t,true,true,true);     WAIT_BAR(3); RESC(); ROT();
    STEP(pA0,pA1,pB0,pB1,t+1,true,true,true);   WAIT_BAR(3); RESC(); ROT();
  }
  #undef CMASK
  #define CMASK(P0,P1,t) do{}while(0)
  #define ENDW(tt) do{ if((tt)+3<NT){WAIT_BAR(3);} else if((tt)+2<NT){WAIT_BAR(2);} else {WAIT_BAR(0);} }while(0)
  for(;t+1<NT;t+=2){
    STEP(pB0,pB1,pA0,pA1,t,(t+3<NT),(t+1<NT),(t+1<NT));       ENDW(t);   RESC(); ROT();
    STEP(pA0,pA1,pB0,pB1,t+1,(t+4<NT),(t+2<NT),(t+2<NT));     ENDW(t+1); RESC(); ROT();
  }
  STEP(pB0,pB1,pA0,pA1,NT-1,false,false,false); RESC();
  { float sacc=pB0[0]+pB0[1]; _Pragma("unroll") for(int r=2;r<16;++r)sacc+=pB0[r]; _Pragma("unroll") for(int r=0;r<16;++r)sacc+=pB1[r]; l_reg+=sacc;
    pw0=(u32x4){PKW(pB0,0),PKW(pB0,2),PKW(pB0,4),PKW(pB0,6)};pw1=(u32x4){PKW(pB0,8),PKW(pB0,10),PKW(pB0,12),PKW(pB0,14)};pw2=(u32x4){PKW(pB1,0),PKW(pB1,2),PKW(pB1,4),PKW(pB1,6)};pw3=(u32x4){PKW(pB1,8),PKW(pB1,10),PKW(pB1,12),PKW(pB1,14)};
    SBAR(); pv128(o,vb0+2*sl_cur,PAF(0),PAF(1),PAF(2),PAF(3)); }
  #undef PKW
  #undef PAF
  #undef VFB
  #undef VRD3
  #undef PAFI
  #undef PIN
  #undef MX3
  #undef GAPA
  #undef GAPB
  #undef EX
  #undef KRD
  #undef STEP
  #undef ENDW
  {auto rr=__builtin_amdgcn_permlane32_swap(__float_as_uint(l_reg),__float_as_uint(l_reg),false,false);l_reg=__uint_as_float(rr[0])+__uint_as_float(rr[1]);}
  if(hi==0)wsf[32+r32]=l_reg;asm volatile("s_waitcnt lgkmcnt(0)":::"memory");
  float rli[16];
  #pragma unroll
  for(int r=0;r<16;++r)rli[r]=__builtin_amdgcn_rcpf(wsf[32+crow(r,hi)]);
  bf16*Ow=Ou+(long)(wid*QBLK)*opitch;
  { bf16*stg=(bf16*)(shm+LDS_OST128)+wid*4096;
    #pragma unroll
    for(int r=0;r<16;++r){const int orow=crow(r,hi);
      #pragma unroll
      for(int d0=0;d0<4;++d0)stg[orow*128+d0*32+r32]=__float2bfloat16(o[d0][r]*rli[r]);}
    asm volatile("s_waitcnt lgkmcnt(0)":::"memory");
    #pragma unroll
    for(int i=0;i<8;++i){const int row=i*4+(lane>>4),ch=lane&15; const u32x4 v=*(const u32x4*)(stg+row*128+ch*8); ATTN_STORE16(Ow+(long)row*opitch+ch*8,v);} }
  asm volatile("s_waitcnt lgkmcnt(0)\n\ts_barrier":::"memory");
  #undef DMA_K
  #undef DMA_V
  #undef CMASK
  #undef START
  #undef RESC
  #undef ROT
}
constexpr int ATTN_LDS_BYTES=LDS_BYTES;
#undef SBAR
#undef WAIT_BAR
}

constexpr int NB = 4, SEQ = 8192, CTXL = 256, PB = SEQ + CTXL, R = NB * PB, D = 1024, DFF = 4096, DEPTH = 4;
constexpr int NP_EV = 2560, NP_OD = 1536;
constexpr float EPS = 1e-6f;
constexpr float C2 = 0.125f * 1.4426950408889634f;
constexpr int EQ = 0, EK = 256, EVV = 512, EG = 1024, EGQ = 1536, EGK = 2048, EGV = 2176, ELR = 2304;
constexpr int ODQ = 0, ODK = 512, ODV = 1024;
constexpr int NWAVES = 8, NTHR = 512;
constexpr int LDS_BYTES = 163840, LDS_MISC = 163840 - 256;

constexpr size_t MiB = 1u << 20;
constexpr size_t WS_CTL = 0, CTL_ZERO_BYTES = 1 * MiB;
constexpr size_t WS_MOD = 1 * MiB;
constexpr size_t WS_TAB = 2 * MiB;
constexpr size_t WS_HID = 3 * MiB;
constexpr size_t WS_XB = 36 * MiB;
constexpr size_t WS_W = 12 * MiB, W_IN = 0, W_OUT = 6 * MiB, W_1 = 8 * MiB, W_2 = 16 * MiB;
constexpr size_t WS_A1 = 108 * MiB;
constexpr size_t WS_Y = 174 * MiB;
constexpr size_t WS_PH = 240 * MiB;
constexpr size_t WS_OGLA = WS_PH + 165 * MiB;
constexpr size_t WS_HF = WS_PH + 198 * MiB;
constexpr size_t WS_SLAB = 504 * MiB;
constexpr size_t WS_END = 512 * MiB;
constexpr int CW_BAR = 4096;

struct Args { const float* in[27]; float* out; unsigned char* ws; int ph_lo, ph_hi; };
enum { I_X = 0, I_C, I_CTX, I_CCTX, I_WADA, I_BADA, I_NORMG, I_W1, I_W2, I_EVWIN, I_EVWLR, I_EVBLR, I_EVGLAG, I_EVQKG, I_EVWOUT,
       I_ODWIN, I_ODCONVW, I_ODCONVB, I_FW1, I_FB1, I_FW2, I_FB2, I_FW3, I_HYBIAS, I_LAM, I_DIFFG, I_ODWOUT };

typedef const __attribute__((address_space(4))) Args* KA;
__device__ __forceinline__ KA ka_launder(KA a) { asm volatile("" : "+s"(a)); return a; }
__device__ __forceinline__ int otid_(int wv) { int l; asm volatile("v_mbcnt_lo_u32_b32 %0, -1, 0\n\tv_mbcnt_hi_u32_b32 %0, -1, %0" : "=v"(l)); return (wv << 6) | l; }
#define otid() otid_(wv_)
__device__ __forceinline__ int obx() { int b = blockIdx.x; asm volatile("" : "+s"(b)); return b; }
__device__ __forceinline__ float bf2f(bf16 v) { return __builtin_bit_cast(float, (unsigned)v << 16); }
template <int CTRL> __device__ __forceinline__ float dpp_mov(float v) { return __builtin_bit_cast(float, __builtin_amdgcn_update_dpp(0, __builtin_bit_cast(int, v), CTRL, 0xF, 0xF, false)); }
__device__ __forceinline__ float sum16(float v) {
    v += dpp_mov<0xB1>(v);
    v += dpp_mov<0x4E>(v);
    v += dpp_mov<0x141>(v);
    v += dpp_mov<0x140>(v);
    return v;
}
__device__ __forceinline__ float sum_rows4(float v) {
    const unsigned u = __builtin_bit_cast(unsigned, v);
    auto a = __builtin_amdgcn_permlane16_swap(u, u, false, false);
    const float w = __builtin_bit_cast(float, (unsigned)a[0]) + __builtin_bit_cast(float, (unsigned)a[1]);
    const unsigned uw = __builtin_bit_cast(unsigned, w);
    auto b = __builtin_amdgcn_permlane32_swap(uw, uw, false, false);
    return __builtin_bit_cast(float, (unsigned)b[0]) + __builtin_bit_cast(float, (unsigned)b[1]);
}
__device__ __forceinline__ float wave_sum(float v) { return sum_rows4(sum16(v)); }
__device__ __forceinline__ float rl(float v, int k) { return __builtin_bit_cast(float, __builtin_amdgcn_readlane(__builtin_bit_cast(int, v), k)); }
__device__ __forceinline__ float siluf(float v) { return v / (1.f + __expf(-v)); }
__device__ __forceinline__ float lam_init_of(int layer) { return 0.8f - 0.6f * expf(-0.3f * (float)layer); }
__device__ __forceinline__ const float* xin_ptr(KA a, int r) {
    const int b = r / PB, p = r - b * PB;
    return p < CTXL ? a->in[I_CTX] + (size_t)(b * CTXL + p) * D : a->in[I_X] + (size_t)(b * SEQ + (p - CTXL)) * D;
}
__device__ __forceinline__ int row_cls(int r) { const int b = r / PB, p = r - b * PB; return p < CTXL ? 4 : b; }

__device__ __forceinline__ void transpose_item(const float* W, int K, int N, int src_n0, bf16* WT, int dst_n0, int k0, LAS float* scr, int lane) {
    if (src_n0 < 0) {
#pragma unroll
        for (int j = 0; j < 4; ++j) { const int n = (lane >> 3) + 8 * j; *(GAS v4u*)(WT + (size_t)(dst_n0 + n) * K + k0 + 8 * (lane & 7)) = (v4u){0u, 0u, 0u, 0u}; }
        return;
    }
#pragma unroll 8
    for (int i = 0; i < 32; ++i) { const int kk = 2 * i + (lane >> 5); scr[kk * 33 + (lane & 31)] = W[(size_t)(k0 + kk) * N + src_n0 + (lane & 31)]; }
    LDS_WAIT(); asm volatile("" ::: "memory");
    const int c = lane & 7;
#pragma unroll
    for (int j = 0; j < 4; ++j) { const int n = (lane >> 3) + 8 * j; const LAS float* s = scr + (8 * c) * 33 + n;
        v4u o; o.x = pk2(s[0 * 33], s[1 * 33]); o.y = pk2(s[2 * 33], s[3 * 33]); o.z = pk2(s[4 * 33], s[5 * 33]); o.w = pk2(s[6 * 33], s[7 * 33]);
        *(GAS v4u*)(WT + (size_t)(dst_n0 + n) * K + k0 + 8 * c) = o; }
    LDS_WAIT(); asm volatile("" ::: "memory");
}
__device__ __forceinline__ int ev_src_col(int j) {
    if (j < 1536) return j;
    if (j < 2304) { const int tile = j >> 8, pb = (j & 255) >> 5, bj = pb >> 2, wc = pb & 3;
        return (tile << 8) + (2 * wc + bj) * 32 + 32; }
    if (j < 2336) return j - 768; return -1;
}
__device__ __forceinline__ void convert_layer_weights(int wv_, KA a, int l, int mask, LAS unsigned char* lds) {
    const int tid = otid(), lane = tid & 63, wave = __builtin_amdgcn_readfirstlane(tid >> 6);
    const int gw = blockIdx.x * NWAVES + wave, NGW = gridDim.x * NWAVES;
    LAS float* scr = (LAS float*)(lds + 49152 + wave * 8448);
    const int odd = l & 1, pr = l >> 1; unsigned char* wl = a->ws + WS_W;
    const int n_in = (mask & 1) ? (odd ? 16 * 96 : 16 * 80) : 0, n_o = (mask & 2) ? 16 * 32 : 0, n_1 = (mask & 4) ? 16 * 128 : 0, n_2 = (mask & 8) ? 64 * 32 : 0;
    for (int it = gw; it < n_in + n_o + n_1 + n_2; it += NGW) {
        int r = it;
        if (r < n_in) { const int nblk = odd ? 96 : 80, kb = r / nblk, nb = r % nblk;
            if (odd) transpose_item(a->in[I_ODWIN] + (size_t)pr * 1024 * 3072, 1024, 3072, nb * 32, (bf16*)(wl + W_IN), nb * 32, kb * 64, scr, lane);
            else     transpose_item(a->in[I_EVWIN] + (size_t)pr * 1024 * 2336, 1024, 2336, ev_src_col(nb * 32), (bf16*)(wl + W_IN), nb * 32, kb * 64, scr, lane);
            continue; }
        r -= n_in;
        if (r < n_o) { const int kb = r / 32, nb = r % 32; transpose_item((odd ? a->in[I_ODWOUT] : a->in[I_EVWOUT]) + (size_t)pr * 1024 * 1024, 1024, 1024, nb * 32, (bf16*)(wl + W_OUT), nb * 32, kb * 64, scr, lane); continue; }
        r -= n_o;
        if (r < n_1) { const int kb = r / 128, nb = r % 128; transpose_item(a->in[I_W1] + (size_t)l * 1024 * 4096, 1024, 4096, nb * 32, (bf16*)(wl + W_1), nb * 32, kb * 64, scr, lane); continue; }
        r -= n_1;
        { const int kb = r / 32, nb = r % 32; transpose_item(a->in[I_W2] + (size_t)l * 4096 * 1024, 4096, 1024, nb * 32, (bf16*)(wl + W_2), nb * 32, kb * 64, scr, lane); }
    }
}
__device__ __forceinline__ void p0a_prologue(int wv_, KA a, LAS unsigned char* lds) {
    const int tid = otid(), lane = tid & 63, wave = __builtin_amdgcn_readfirstlane(tid >> 6);
    const int gw = blockIdx.x * NWAVES + wave, NGW = gridDim.x * NWAVES;
    LAS float* sc = (LAS float*)lds;
    LAS float* red = (LAS float*)(lds + 20480);
    for (int i = tid; i < 5 * 1024; i += NTHR) { const int cls = i >> 10, k = i & 1023; const float v = cls < 4 ? a->in[I_C][cls * 1024 + k] : a->in[I_CCTX][k]; sc[i] = v / (1.f + expf(-v)); }
    __syncthreads();
    float* MOD = (float*)(a->ws + WS_MOD);
    for (int item = blockIdx.x; item < 4 * 48; item += gridDim.x) {
        const int l = item / 48, nb = item % 48;
        const float* W = a->in[I_WADA] + (size_t)l * 1024 * 6144 + nb * 128 + lane * 2;
        float acc[5][2];
#pragma unroll
        for (int c = 0; c < 5; ++c) { acc[c][0] = 0.f; acc[c][1] = 0.f; }
#pragma unroll 4
        for (int kk = 0; kk < 128; ++kk) { const int k = wave * 128 + kk; const float2 w = *(const float2*)(W + (size_t)k * 6144);
#pragma unroll
            for (int c = 0; c < 5; ++c) { const float s = sc[c * 1024 + k]; acc[c][0] += s * w.x; acc[c][1] += s * w.y; } }
#pragma unroll
        for (int c = 0; c < 5; ++c) { red[(wave * 5 + c) * 128 + lane * 2] = acc[c][0]; red[(wave * 5 + c) * 128 + lane * 2 + 1] = acc[c][1]; }
        __syncthreads();
        for (int o = tid; o < 640; o += NTHR) { const int c = o >> 7, cc = o & 127; float s = a->in[I_BADA][l * 6144 + nb * 128 + cc];
#pragma unroll
            for (int w = 0; w < 8; ++w) s += red[(w * 5 + c) * 128 + cc];
            MOD[(size_t)(l * 5 + c) * 6144 + nb * 128 + cc] = s; }
        __syncthreads();
    }
    convert_layer_weights(wv_, a, 0, 15, lds);
    {
        float* tab = (float*)(a->ws + WS_TAB);
        const int gt = blockIdx.x * NTHR + tid;
        if (gt < 3072) { const int pos = gt < 2048 ? gt / 16 : (gt - 2048) / 16, i = gt & 15;
            const float inv = powf(10000.f, -(float)i / 16.f), ang = (float)pos * inv;
            tab[gt * 2] = cosf(ang); tab[gt * 2 + 1] = sinf(ang); }
        if (gw == NGW - 1) {
#pragma unroll
            for (int j = 0; j < 2; ++j) { const float* lp = a->in[I_LAM] + j * 256;
                const float s1 = wave_sum(lp[lane] * lp[64 + lane]), s2 = wave_sum(lp[128 + lane] * lp[192 + lane]);
                if (lane == 0) tab[8192 + j] = expf(s1) - expf(s2) + lam_init_of(2 * j + 1); }
        }
    }
    for (int it = gw; it < 2 * PB; it += NGW) {
        const int j = it / PB, q = it % PB; const bool isctx = q >= SEQ; const int pos = isctx ? q - SEQ : q, L = isctx ? CTXL : SEQ;
        const float t = (float)pos / (float)(L - 1), w = 2.f * 3.14159265358979323846f * (float)pos / (float)L;
        float z = 0.f;
        if (lane == 0) z = t;
        else if (lane <= 16) { const float band = 1e-4f + (float)(lane - 1) * ((15.f - 1e-4f) / 15.f); z = cosf(w * band); }
        else if (lane <= 32) { const float band = 1e-4f + (float)(lane - 17) * ((15.f - 1e-4f) / 15.f); z = -sinf(w * band); }
        const float* w1 = a->in[I_FW1] + j * 33 * 64; const float* w2 = a->in[I_FW2] + j * 64 * 64;
        float h1 = a->in[I_FB1][j * 64 + lane];
#pragma unroll
        for (int e = 0; e < 33; ++e) h1 += rl(z, e) * w1[e * 64 + lane];
        h1 = sinf(h1);
        float h2 = a->in[I_FB2][j * 64 + lane];
#pragma unroll
        for (int e = 0; e < 64; ++e) h2 += rl(h1, e) * w2[e * 64 + lane];
        h2 = sinf(h2);
        float* HID = (float*)(a->ws + WS_HID) + (isctx ? (size_t)(2 * SEQ + j * CTXL + pos) * 64 : (size_t)(j * SEQ + pos) * 64);
        HID[lane] = h2;
    }
}

struct Row16 { f32x4 v[4]; };
__device__ __forceinline__ Row16 ld_row_f32(const float* p, int lane) { Row16 r; const GAS f32x4* q = (const GAS f32x4*)p + lane;
#pragma unroll
    for (int j = 0; j < 4; ++j) r.v[j] = q[64 * j];
    return r; }
__device__ __forceinline__ Row16 ld_row_bf16(const bf16* p, int lane) { Row16 r; const GAS unsigned long long* q = (const GAS unsigned long long*)p + lane;
#pragma unroll
    for (int j = 0; j < 4; ++j) { const unsigned long long w = q[64 * j]; const unsigned lo = (unsigned)w, hi = (unsigned)(w >> 32);
        r.v[j] = (f32x4){__builtin_bit_cast(float, lo << 16), __builtin_bit_cast(float, lo & 0xffff0000u), __builtin_bit_cast(float, hi << 16), __builtin_bit_cast(float, hi & 0xffff0000u)}; }
    return r; }
__device__ __forceinline__ void st_row_f32(float* p, const Row16& r, int lane) { GAS f32x4* q = (GAS f32x4*)p + lane;
#pragma unroll
    for (int j = 0; j < 4; ++j) q[64 * j] = r.v[j]; }
__device__ __forceinline__ void st_row_bf16(bf16* p, const Row16& r, int lane) { GAS unsigned long long* q = (GAS unsigned long long*)p + lane;
#pragma unroll
    for (int j = 0; j < 4; ++j) q[64 * j] = (unsigned long long)pk2(r.v[j].x, r.v[j].y) | ((unsigned long long)pk2(r.v[j].z, r.v[j].w) << 32); }
__device__ __forceinline__ float row_sumsq(const Row16& r) { float s = 0.f;
#pragma unroll
    for (int j = 0; j < 4; ++j) s += (r.v[j].x * r.v[j].x + r.v[j].y * r.v[j].y) + (r.v[j].z * r.v[j].z + r.v[j].w * r.v[j].w);
    return wave_sum(s); }
__device__ __forceinline__ void norm_mod_store(const Row16& x, const float* g, const float* shift, const float* scale, bf16* dst, int lane) {
    const float rstd = 1.f / sqrtf(row_sumsq(x) * (1.f / D) + EPS);
    const Row16 G = ld_row_f32(g, lane), SH = ld_row_f32(shift, lane), SC = ld_row_f32(scale, lane); Row16 o;
#pragma unroll
    for (int j = 0; j < 4; ++j) o.v[j] = (x.v[j] * rstd) * G.v[j] * (SC.v[j] + 1.f) + SH.v[j];
    st_row_bf16(dst, o, lane);
}
__device__ __forceinline__ void p0b_first_norm(int wv_, KA a) {
    const int tid_o = otid(), lane = tid_o & 63, wave = tid_o >> 6, gw = blockIdx.x * NWAVES + wave, NGW = gridDim.x * NWAVES;
    const float* MOD = (const float*)(a->ws + WS_MOD); bf16* A1 = (bf16*)(a->ws + WS_A1);
    for (int rb = gw; rb < R; rb += 2 * NGW) {
        const int r2 = rb + NGW < R ? rb + NGW : rb;
        const Row16 xa = ld_row_f32(xin_ptr(a, rb), lane), xb = ld_row_f32(xin_ptr(a, r2), lane);
        { const float* m = MOD + (size_t)(0 * 5 + row_cls(rb)) * 6144; norm_mod_store(xa, a->in[I_NORMG] + 0, m + 0, m + 1024, A1 + (size_t)rb * D, lane); }
        if (rb + NGW < R) { const float* m = MOD + (size_t)(0 * 5 + row_cls(r2)) * 6144; norm_mod_store(xb, a->in[I_NORMG] + 0, m + 0, m + 1024, A1 + (size_t)r2 * D, lane); }
    }
}
typedef unsigned long long u64_t;
template <bool FIRST> struct RawRow { u64_t xb[FIRST ? 1 : 4]; f32x4 xf[FIRST ? 4 : 1]; u64_t y1[4], y2[4]; };
__device__ __forceinline__ Row16 cvt_raw(const u64_t (&q)[4]) { Row16 r;
#pragma unroll
    for (int j = 0; j < 4; ++j) { const unsigned lo = (unsigned)q[j], hi = (unsigned)(q[j] >> 32);
        r.v[j] = (f32x4){__builtin_bit_cast(float, lo << 16), __builtin_bit_cast(float, lo & 0xffff0000u), __builtin_bit_cast(float, hi << 16), __builtin_bit_cast(float, hi & 0xffff0000u)}; }
    return r; }
template <bool FIRST> __device__ __forceinline__ void rowwise_body(int wv_, KA a, int layer, int which, LAS unsigned char* lds) {
    const int tid = otid(), lane = tid & 63, wave = tid >> 6, gw = blockIdx.x * NWAVES + wave;
    const float* MOD = (const float*)(a->ws + WS_MOD); bf16* A1 = (bf16*)(a->ws + WS_A1); const bf16* Y = (const bf16*)(a->ws + WS_Y); const bf16* SLAB = (const bf16*)(a->ws + WS_SLAB);
    bf16* XB = (bf16*)(a->ws + WS_XB);
    const float* ng = a->in[I_NORMG] + (size_t)layer * 4 * D;
    const bool lastl = layer == DEPTH - 1, lastp = lastl && which == 1;
    constexpr int RPW = 17;
    const int rbl = blockIdx.x * (NWAVES * RPW), rbh = rbl + NWAVES * RPW - 1;
    const int clsA = row_cls(rbl < R ? rbl : R - 1), clsB = row_cls(rbh < R ? rbh : R - 1);
    LAS f32x4* vec = (LAS f32x4*)lds;
    for (int idx = tid; idx < 2 * 7 * 256; idx += NTHR) { const int c = idx / (7 * 256), v = (idx >> 8) % 7, q = idx & 255, cls = c ? clsB : clsA;
        const float* m = MOD + (size_t)(layer * 5 + cls) * 6144; const float* m2 = MOD + (size_t)((lastp || !which ? layer : layer + 1) * 5 + cls) * 6144;
        const float* src = v == 0 ? ng + 1 * D : v == 1 ? ng + 3 * D : v == 2 ? (which ? ng + 4 * D : ng + 2 * D) : v == 3 ? m + 2 * 1024 : v == 4 ? m + 5 * 1024 : v == 5 ? (which ? m2 + 0 : m + 3 * 1024) : (which ? m2 + 1024 : m + 4 * 1024);
        vec[idx] = *(const f32x4*)(src + 4 * q); }
    __syncthreads();
    const int r0 = gw * RPW, r1 = r0 + RPW < R ? r0 + RPW : R;
    if (r0 >= R) return;
    auto load_raw = [&](RawRow<FIRST>& q, int r) {
        if constexpr (FIRST) { const GAS f32x4* xp = (const GAS f32x4*)xin_ptr(a, r) + lane;
#pragma unroll
            for (int j = 0; j < 4; ++j) q.xf[j] = xp[64 * j]; }
        else { const GAS u64_t* xp = (const GAS u64_t*)(XB + (size_t)r * D) + lane;
#pragma unroll
            for (int j = 0; j < 4; ++j) q.xb[j] = xp[64 * j]; }
        const GAS u64_t* yp = (const GAS u64_t*)(Y + (size_t)r * D) + lane;
#pragma unroll
        for (int j = 0; j < 4; ++j) q.y1[j] = yp[64 * j];
        if (which) { const GAS u64_t* zp = (const GAS u64_t*)(A1 + (size_t)r * D) + lane;
#pragma unroll
            for (int j = 0; j < 4; ++j) q.y2[j] = zp[64 * j]; } };
    RawRow<FIRST> q0, q1, q2;
    load_raw(q0, r0); q1 = q0; q2 = q0;
    if (r0 + 1 < r1) load_raw(q1, r0 + 1);
    for (int r = r0; r < r1; ++r) {
        if (r + 2 < r1) load_raw(q2, r + 2);
        const int b = r / PB, p = r - b * PB, cls = p < CTXL ? 4 : b;
        if (!(lastl && cls == 4)) {
            const LAS f32x4* vt = vec + (cls == clsA ? 0 : 7 * 256) + lane;
            Row16 x;
            if constexpr (FIRST) {
#pragma unroll
                for (int jj = 0; jj < 4; ++jj) x.v[jj] = q0.xf[jj]; }
            else x = cvt_raw(q0.xb);
            const Row16 y1 = cvt_raw(q0.y1);
            const float rstd1 = 1.f / sqrtf(row_sumsq(y1) * (1.f / D) + EPS);
#pragma unroll
            for (int jj = 0; jj < 4; ++jj) x.v[jj] = x.v[jj] + vt[3 * 256 + 64 * jj] * ((y1.v[jj] * rstd1) * vt[0 * 256 + 64 * jj]);
            bool done = false;
            if (which) {
                Row16 y2;
                if (p < CTXL) { y2 = ld_row_bf16(SLAB + (size_t)(b * CTXL + p) * D, lane);
#pragma unroll
                    for (int k = 1; k < 4; ++k) { const Row16 sk = ld_row_bf16(SLAB + (size_t)k * 1024 * D + (size_t)(b * CTXL + p) * D, lane);
#pragma unroll
                        for (int jj = 0; jj < 4; ++jj) y2.v[jj] = y2.v[jj] + sk.v[jj]; } }
                else y2 = cvt_raw(q0.y2);
                const float rstd2 = 1.f / sqrtf(row_sumsq(y2) * (1.f / D) + EPS);
#pragma unroll
                for (int jj = 0; jj < 4; ++jj) x.v[jj] = x.v[jj] + vt[4 * 256 + 64 * jj] * ((y2.v[jj] * rstd2) * vt[1 * 256 + 64 * jj]);
                if (lastp) { st_row_f32(a->out + (size_t)(b * SEQ + (p - CTXL)) * D, x, lane); done = true; }
                else st_row_bf16(XB + (size_t)r * D, x, lane);
            }
            if (!done) {
                const float rs2 = 1.f / sqrtf(row_sumsq(x) * (1.f / D) + EPS); Row16 o;
#pragma unroll
                for (int jj = 0; jj < 4; ++jj) o.v[jj] = (x.v[jj] * rs2) * vt[2 * 256 + 64 * jj] * (vt[6 * 256 + 64 * jj] + 1.f) + vt[5 * 256 + 64 * jj];
                st_row_bf16(A1 + (size_t)r * D, o, lane);
            }
        }
        q0 = q1; q1 = q2;
    }
}
__device__ __forceinline__ void rowwise_post(int wv_, KA a, int layer, int which, LAS unsigned char* lds) {
    if (layer == 0) rowwise_body<true>(wv_, a, layer, which, lds); else rowwise_body<false>(wv_, a, layer, which, lds);
}

__device__ __forceinline__ void attn_phase_fast(int wv_, KA a, bool odd, char* lds_generic, bool skip_ctx_q = false) {
    const int G = gridDim.x, bx = blockIdx.x; const int vcu = (G % 8 == 0) ? (bx % 8) * (G / 8) + bx / 8 : bx;
    const int nvh = 8, nheavy = 4 * nvh * 32, ntot = nheavy + (skip_ctx_q ? 0 : 4 * nvh);
    unsigned char* ws = a->ws;
    const attn_body::bf16* P = (const attn_body::bf16*)(ws + WS_PH);
    for (int u = vcu; u < ntot; u += G) {
        int b, vh, panel;
        if (u < nheavy) { const int i = u >> 8, v = u & 255, xcd = v >> 5; b = xcd >> 1; vh = (xcd & 1) * (nvh >> 1) + i; panel = (v & 31) + 1; }
        else { const int lu = u - nheavy; b = lu / nvh; vh = lu % nvh; panel = 0; }
        const size_t row0 = (size_t)b * PB, qrow = row0 + 256 * panel; const int NT = panel == 0 ? CTXL / 64 : PB / 64;
        if (!odd) { const int kvh = vh >> 2;
            attn_body::attn_unit<8>(otid(), P + qrow * NP_EV + EGQ + vh * 64, NP_EV, P + row0 * NP_EV + EGK + kvh * 64, P + row0 * NP_EV + EGV + kvh * 64, NP_EV,
                                    (attn_body::bf16*)(ws + WS_A1) + qrow * D + 512 + vh * 64, D, NT, lds_generic); }
        else { const int hd = vh >> 1, c = vh & 1;
            attn_body::attn_unit128<8>(otid(), P + qrow * NP_OD + ODQ + hd * 128 + c * 64, NP_OD, P + row0 * NP_OD + ODK + hd * 128 + c * 64, P + row0 * NP_OD + ODV + hd * 128, NP_OD,
                                       (attn_body::bf16*)(ws + WS_Y) + qrow * D + hd * 256 + c * 128, D, NT, lds_generic); }
    }
}

constexpr size_t WS_UT = WS_Y, WS_S0T = WS_PH + 165 * MiB, WS_DEC = 504 * MiB;
constexpr int GQP = 144, GVP = 272, GIMG_OFF = 8 * (64 * GQP) + 2 * (64 * GVP) + 2048;
typedef short gbf16x8 __attribute__((ext_vector_type(8)));
typedef short gs16x4 __attribute__((ext_vector_type(4)));
typedef float gf32x4 __attribute__((ext_vector_type(4)));
__device__ __forceinline__ gs16x4 gtr(const LAS unsigned char* p) { return __builtin_bit_cast(gs16x4, __builtin_amdgcn_ds_read_tr16_b64_v4i16((LAS gs16x4*)p)); }
__device__ __forceinline__ gbf16x8 gcat(gs16x4 lo, gs16x4 hi) { return (gbf16x8){lo[0], lo[1], lo[2], lo[3], hi[0], hi[1], hi[2], hi[3]}; }
__device__ __forceinline__ float log_sigmoid_fast(float x) { return fminf(x, 0.f) - __logf(1.f + __expf(-fabsf(x))); }
__device__ __forceinline__ float rls(float v, int k) { return __builtin_bit_cast(float, __builtin_amdgcn_readlane(__builtin_bit_cast(int, v), k)); }

__device__ __forceinline__ void gla_prep_b(KA a, int j, const bf16* P, size_t row0, int head, int pdir, int role, int wave, int lane, LAS float* xch, float (&bv)[2][4][4], float (&tall)[4]) {
    const int g = lane >> 4, l15 = lane & 15; const gbf16x8 zero8 = {0, 0, 0, 0, 0, 0, 0, 0};
    gbf16x8 lrA[2];
#pragma unroll
    for (int tt = 0; tt < 2; ++tt) { lrA[tt] = zero8; if (g < 2) lrA[tt] = *(const gbf16x8*)(P + (row0 + 32 * role + 16 * tt + l15) * NP_EV + ELR + pdir * 16 + 8 * g); }
    gf32x4 gk[2][4];
#pragma unroll
    for (int dt = 0; dt < 4; ++dt) {
        unsigned hw[4] = {0u, 0u, 0u, 0u}, lw[4] = {0u, 0u, 0u, 0u};
        if (g < 2) {
#pragma unroll
            for (int e = 0; e < 8; ++e) { const float w = a->in[I_EVWLR][((size_t)(j * 2 + pdir) * 16 + 8 * g + e) * 256 + head * 64 + 16 * dt + l15];
                const unsigned h = f2bf(w), l = f2bf(w - __builtin_bit_cast(float, h << 16)); hw[e >> 1] |= h << (16 * (e & 1)); lw[e >> 1] |= l << (16 * (e & 1)); } }
        const gbf16x8 wh = __builtin_bit_cast(gbf16x8, (v4u){hw[0], hw[1], hw[2], hw[3]}), wlo = __builtin_bit_cast(gbf16x8, (v4u){lw[0], lw[1], lw[2], lw[3]});
        const float bl = a->in[I_EVBLR][(j * 2 + pdir) * 256 + head * 64 + 16 * dt + l15];
#pragma unroll
        for (int tt = 0; tt < 2; ++tt) { gf32x4 acc = (gf32x4){bl, bl, bl, bl};
            acc = __builtin_amdgcn_mfma_f32_16x16x32_bf16(lrA[tt], wh, acc, 0, 0, 0); acc = __builtin_amdgcn_mfma_f32_16x16x32_bf16(lrA[tt], wlo, acc, 0, 0, 0); gk[tt][dt] = acc; }
    }
    float tot[4];
#pragma unroll
    for (int dt = 0; dt < 4; ++dt) { float t2 = 0.f;
#pragma unroll
        for (int tt = 0; tt < 2; ++tt)
#pragma unroll
            for (int r = 0; r < 4; ++r) { const float x = gk[tt][dt][r]; const float e = __builtin_amdgcn_exp2f(-fabsf(x) * 1.4426950408889634f);
                const float la = (fminf(x, 0.f) - 0.6931471805599453f * __builtin_amdgcn_logf(1.f + e)) * (1.f / 16.f); gk[tt][dt][r] = la; t2 += la; }
        tot[dt] = sum_rows4(t2); }
    if (g == 0) {
#pragma unroll
        for (int dt = 0; dt < 4; ++dt) xch[wave * 64 + 16 * dt + l15] = tot[dt]; }
    gbf16x8 tri[2];
#pragma unroll
    for (int tt = 0; tt < 2; ++tt) { unsigned w[4] = {0u, 0u, 0u, 0u}; const int tl = 16 * tt + l15;
#pragma unroll
        for (int e = 0; e < 8; ++e) { const int tp = e < 4 ? 4 * g + e : 16 + 4 * g + (e - 4); const bool keep = pdir == 0 ? (tp <= tl) : (tp >= tl); w[e >> 1] |= keep ? (0x3F80u << (16 * (e & 1))) : 0u; }
        tri[tt] = __builtin_bit_cast(gbf16x8, (v4u){w[0], w[1], w[2], w[3]}); }
    gf32x4 bl2[2][4];
#pragma unroll
    for (int dt = 0; dt < 4; ++dt) { unsigned hw[4], lw[4];
#pragma unroll
        for (int e = 0; e < 8; e += 2) { const float x0 = gk[e >> 2][dt][e & 3], x1 = gk[e >> 2][dt][(e & 3) + 1];
            const unsigned h0 = f2bf(x0), h1 = f2bf(x1); hw[e >> 1] = h0 | (h1 << 16);
            lw[e >> 1] = f2bf(x0 - __builtin_bit_cast(float, h0 << 16)) | (f2bf(x1 - __builtin_bit_cast(float, h1 << 16)) << 16); }
        const gbf16x8 bh = __builtin_bit_cast(gbf16x8, (v4u){hw[0], hw[1], hw[2], hw[3]}), blo = __builtin_bit_cast(gbf16x8, (v4u){lw[0], lw[1], lw[2], lw[3]});
#pragma unroll
        for (int tt = 0; tt < 2; ++tt) { gf32x4 acc = (gf32x4){0.f, 0.f, 0.f, 0.f};
            acc = __builtin_amdgcn_mfma_f32_16x16x32_bf16(tri[tt], bh, acc, 0, 0, 0); acc = __builtin_amdgcn_mfma_f32_16x16x32_bf16(tri[tt], blo, acc, 0, 0, 0); bl2[tt][dt] = acc; } }
    __syncthreads();
    const bool need_other = pdir == 0 ? (role == 1) : (role == 0);
#pragma unroll
    for (int dt = 0; dt < 4; ++dt) { const float other = xch[(wave ^ 1) * 64 + 16 * dt + l15]; tall[dt] = tot[dt] + other; const float add = need_other ? other : 0.f;
#pragma unroll
        for (int tt = 0; tt < 2; ++tt)
#pragma unroll
            for (int r = 0; r < 4; ++r) bv[tt][dt][r] = bl2[tt][dt][r] + add; }
}
__device__ __forceinline__ void gla_state_phase(int wv_, KA a, int j, LAS unsigned char* lds) {
    const int tid = otid(), lane = tid & 63, wave = __builtin_amdgcn_readfirstlane(tid >> 6);
    const int hl = wave >> 2, dir = (wave >> 1) & 1, role = wave & 1, g = lane >> 4, l15 = lane & 15;
    unsigned char* ws = a->ws; const bf16* P = (const bf16*)(ws + WS_PH);
    LAS unsigned char* kimg = lds + (hl * 2 + dir) * (64 * GQP); LAS unsigned char* vimg = lds + 4 * (64 * GQP) + hl * (64 * GVP); LAS float* xch = (LAS float*)(lds + 4 * (64 * GQP) + 2 * (64 * GVP));
    for (int unit = blockIdx.x; unit < NB * 132 * 2; unit += gridDim.x) {
        const int b = unit / 264, rem = unit % 264, cidx = rem >> 1, hp = rem & 1, head = hp * 2 + hl; const size_t row0 = (size_t)b * PB + cidx * 64;
        const int chain = (b * 4 + head) * 2 + dir;
        __syncthreads();
        { v4u vv[4], kk[2];
#pragma unroll
            for (int it = 0; it < 4; ++it) { const int ch = tid + it * NTHR, hh = ch >> 10, t = (ch >> 4) & 63, c16 = ch & 15; vv[it] = *(const v4u*)(P + (row0 + t) * NP_EV + EVV + (hp * 2 + hh) * 128 + c16 * 8); }
#pragma unroll
            for (int it = 0; it < 2; ++it) { const int ch = tid + it * NTHR, hh = ch >> 9, t = (ch >> 3) & 63, c8 = ch & 7; kk[it] = *(const v4u*)(P + (row0 + t) * NP_EV + EK + (hp * 2 + hh) * 64 + c8 * 8); }
#pragma unroll
            for (int it = 0; it < 4; ++it) { const int ch = tid + it * NTHR, hh = ch >> 10, t = (ch >> 4) & 63, c16 = ch & 15; *(LAS v4u*)(lds + 4 * (64 * GQP) + hh * (64 * GVP) + t * GVP + c16 * 16) = vv[it]; }
#pragma unroll
            for (int it = 0; it < 2; ++it) { const int ch = tid + it * NTHR, hh = ch >> 9, t = (ch >> 3) & 63, c8 = ch & 7;
                *(LAS v4u*)(lds + (hh * 2) * (64 * GQP) + t * GQP + c8 * 16) = kk[it]; *(LAS v4u*)(lds + (hh * 2 + 1) * (64 * GQP) + t * GQP + c8 * 16) = kk[it]; } }
        float bv[2][4][4], tall[4];
        gla_prep_b(a, j, P, row0, head, dir, role, wave, lane, xch, bv, tall);
#pragma unroll
        for (int tt = 0; tt < 2; ++tt)
#pragma unroll
            for (int dt = 0; dt < 4; ++dt)
#pragma unroll
                for (int r = 0; r < 4; ++r) { const int t = 32 * role + 16 * tt + 4 * g + r, dk = 16 * dt + l15;
                    LAS bf16* kp = (LAS bf16*)(kimg + t * GQP + dk * 2);
                    *kp = (bf16)f2bf(bf2f(*kp) * __builtin_amdgcn_exp2f((tall[dt] - bv[tt][dt][r]) * 1.4426950408889634f)); }
        if (role == 0 && g == 0) {
#pragma unroll
            for (int dt = 0; dt < 4; ++dt) ((float*)(ws + WS_DEC))[((size_t)chain * 132 + cidx) * 64 + 16 * dt + l15] = __builtin_amdgcn_exp2f(tall[dt] * 1.4426950408889634f); }
        __syncthreads();
        gf32x4 acc[4][4];
#pragma unroll
        for (int x = 0; x < 4; ++x)
#pragma unroll
            for (int y = 0; y < 4; ++y) acc[x][y] = (gf32x4){0.f, 0.f, 0.f, 0.f};
        const int q = l15 >> 2, p4 = lane & 3;
#pragma unroll
        for (int ks = 0; ks < 2; ++ks) {
            gbf16x8 af[4], bfr[4];
#pragma unroll
            for (int x = 0; x < 4; ++x) { const LAS unsigned char* pa = kimg + (32 * ks + 8 * g + q) * GQP + (16 * x + 4 * p4) * 2; af[x] = gcat(gtr(pa), gtr(pa + 4 * GQP)); }
#pragma unroll
            for (int y = 0; y < 4; ++y) { const LAS unsigned char* pb = vimg + (32 * ks + 8 * g + q) * GVP + (64 * role + 16 * y + 4 * p4) * 2; bfr[y] = gcat(gtr(pb), gtr(pb + 4 * GVP)); }
#pragma unroll
            for (int x = 0; x < 4; ++x)
#pragma unroll
                for (int y = 0; y < 4; ++y) acc[x][y] = __builtin_amdgcn_mfma_f32_16x16x32_bf16(af[x], bfr[y], acc[x][y], 0, 0, 0);
        }
        bf16* UT = (bf16*)(ws + WS_UT) + ((size_t)chain * 132 + cidx) * 8192;
#pragma unroll
        for (int x = 0; x < 4; ++x)
#pragma unroll
            for (int y = 0; y < 4; ++y) { const int dv = 64 * role + 16 * y + l15, dk = 16 * x + 4 * g;
                *(unsigned long long*)(UT + dv * 64 + dk) = (unsigned long long)pk2(acc[x][y][0], acc[x][y][1]) | ((unsigned long long)pk2(acc[x][y][2], acc[x][y][3]) << 32); }
    }
}
__device__ __forceinline__ void gla_scan_phase(int wv_, KA a) {
    const int tid = otid(), lane = tid & 63, wave = tid >> 6;
    const int vt = (blockIdx.x + gridDim.x * wave) * 64 + lane;
    if (vt >= 32 * 1024) return;
    unsigned char* ws = a->ws;
    const int chain = vt >> 10, e = vt & 1023, dir = chain & 1;
    const bf16* UT = (const bf16*)(ws + WS_UT); bf16* S0T = (bf16*)(ws + WS_S0T); const float* DEC = (const float*)(ws + WS_DEC);
    float S[8];
#pragma unroll
    for (int i = 0; i < 8; ++i) S[i] = 0.f;
#pragma unroll 11
    for (int s = 0; s < 132; ++s) {
        const int cidx = dir == 0 ? s : (s < 4 ? 3 - s : 135 - s);
        const size_t off = ((size_t)chain * 132 + cidx) * 8192 + (size_t)e * 8;
        const v4u u = *(const v4u*)(UT + off);
        const f32x4 d0 = *(const f32x4*)(DEC + ((size_t)chain * 132 + cidx) * 64 + (e & 7) * 8), d1 = *(const f32x4*)(DEC + ((size_t)chain * 132 + cidx) * 64 + (e & 7) * 8 + 4);
        v4u o; o.x = pk2(S[0], S[1]); o.y = pk2(S[2], S[3]); o.z = pk2(S[4], S[5]); o.w = pk2(S[6], S[7]);
        *(v4u*)(S0T + off) = o;
        const unsigned uw[4] = {u.x, u.y, u.z, u.w}; const float dd[8] = {d0.x, d0.y, d0.z, d0.w, d1.x, d1.y, d1.z, d1.w};
#pragma unroll
        for (int i = 0; i < 8; ++i) { const float uv = __builtin_bit_cast(float, (i & 1) ? (uw[i >> 1] & 0xffff0000u) : (uw[i >> 1] << 16)); S[i] = S[i] * dd[i] + uv; }
    }
}
__device__ __forceinline__ void gla_output_phase(int wv_, KA a, int j, LAS unsigned char* lds, int skipmask = 0) {
    const int tid = otid(), lane = tid & 63, wave = __builtin_amdgcn_readfirstlane(tid >> 6);
    const int hl = wave >> 2, pdir = (wave >> 1) & 1, role = wave & 1, q4 = wave & 3, g = lane >> 4, l15 = lane & 15;
    unsigned char* ws = a->ws; const bf16* P = (const bf16*)(ws + WS_PH); bf16* MIX = (bf16*)(ws + WS_A1);
    LAS unsigned char* qimg0 = lds + (hl * 2) * (64 * GQP); LAS unsigned char* kimg0 = lds + (4 + hl * 2) * (64 * GQP); LAS unsigned char* vimg = lds + 8 * (64 * GQP) + hl * (64 * GVP);
    for (int unit = blockIdx.x; unit < NB * 132 * 2; unit += gridDim.x) {
        const int b = unit / 264, rem = unit % 264, cidx = rem >> 1, hp = rem & 1, head = hp * 2 + hl; const size_t row0 = (size_t)b * PB + cidx * 64;
        __syncthreads();
        gbf16x8 sfA[8][2], sfB[8][2];
        const bf16* S0f = (const bf16*)(ws + WS_S0T) + ((size_t)((b * 4 + head) * 2) * 132 + cidx) * 8192;
#pragma unroll
        for (int c = 0; c < 8; ++c)
#pragma unroll
            for (int ks = 0; ks < 2; ++ks) sfA[c][ks] = *(const gbf16x8*)(S0f + (16 * c + l15) * 64 + 32 * ks + 8 * g);
        { v4u vv[4], gg[4], qq2[2], kk[2];
#pragma unroll
            for (int it = 0; it < 4; ++it) { const int ch = tid + it * NTHR, hh = ch >> 10, t = (ch >> 4) & 63, c16 = ch & 15; const bf16* src = P + (row0 + t) * NP_EV + (hp * 2 + hh) * 128 + c16 * 8; vv[it] = *(const v4u*)(src + EVV); gg[it] = *(const v4u*)(src + EG); }
#pragma unroll
            for (int it = 0; it < 2; ++it) { const int ch = tid + it * NTHR, hh = ch >> 9, t = (ch >> 3) & 63, c8 = ch & 7; const bf16* src = P + (row0 + t) * NP_EV + (hp * 2 + hh) * 64 + c8 * 8; qq2[it] = *(const v4u*)(src + EQ); kk[it] = *(const v4u*)(src + EK); }
#pragma unroll
            for (int it = 0; it < 4; ++it) { const int ch = tid + it * NTHR, hh = ch >> 10, t = (ch >> 4) & 63, c16 = ch & 15;
                *(LAS v4u*)(lds + 8 * (64 * GQP) + hh * (64 * GVP) + t * GVP + c16 * 16) = vv[it]; *(LAS v4u*)(lds + GIMG_OFF + hh * (64 * GVP) + t * GVP + c16 * 16) = gg[it]; }
#pragma unroll
            for (int it = 0; it < 2; ++it) { const int ch = tid + it * NTHR, hh = ch >> 9, t = (ch >> 3) & 63, c8 = ch & 7;
                *(LAS v4u*)(lds + (hh * 2) * (64 * GQP) + t * GQP + c8 * 16) = qq2[it]; *(LAS v4u*)(lds + (hh * 2 + 1) * (64 * GQP) + t * GQP + c8 * 16) = qq2[it];
                *(LAS v4u*)(lds + (4 + hh * 2) * (64 * GQP) + t * GQP + c8 * 16) = kk[it]; *(LAS v4u*)(lds + (4 + hh * 2 + 1) * (64 * GQP) + t * GQP + c8 * 16) = kk[it]; } }
        {
            float bv[2][4][4], tall[4];
            gla_prep_b(a, j, P, row0, head, pdir, role, wave, lane, (LAS float*)(lds + 8 * (64 * GQP) + 2 * (64 * GVP)), bv, tall);
            LAS unsigned char* qi = qimg0 + pdir * (64 * GQP); LAS unsigned char* ki = kimg0 + pdir * (64 * GQP);
#pragma unroll
            for (int tt = 0; tt < 2; ++tt)
#pragma unroll
                for (int dt = 0; dt < 4; ++dt)
#pragma unroll
                    for (int r = 0; r < 4; ++r) { const int t = 32 * role + 16 * tt + 4 * g + r, dk = 16 * dt + l15;
                        const float e = __builtin_amdgcn_exp2f(bv[tt][dt][r] * 1.4426950408889634f);
                        LAS bf16* qp = (LAS bf16*)(qi + t * GQP + dk * 2); LAS bf16* kp = (LAS bf16*)(ki + t * GQP + dk * 2);
                        *qp = (bf16)f2bf(bf2f(*qp) * 0.125f * e);
                        *kp = (bf16)f2bf(bf2f(*kp) * __builtin_amdgcn_rcpf(e)); }
        }
        __syncthreads();
        gf32x4 o[8];
#pragma unroll
        for (int c = 0; c < 8; ++c) o[c] = (gf32x4){0.f, 0.f, 0.f, 0.f};
        const int qq = l15 >> 2, p4 = lane & 3;
#pragma unroll
        for (int c = 0; c < 8; ++c)
#pragma unroll
            for (int ks = 0; ks < 2; ++ks) sfB[c][ks] = *(const gbf16x8*)(S0f + (size_t)132 * 8192 + (16 * c + l15) * 64 + 32 * ks + 8 * g);
        if (!(skipmask & 2))
#pragma unroll
        for (int dir = 0; dir < 2; ++dir) {
            const LAS unsigned char* qimg = qimg0 + dir * (64 * GQP); const LAS unsigned char* kimg = kimg0 + dir * (64 * GQP);
            gbf16x8 qf[2];
#pragma unroll
            for (int ks = 0; ks < 2; ++ks) qf[ks] = *(const LAS gbf16x8*)(qimg + (16 * q4 + l15) * GQP + (32 * ks + 8 * g) * 2);
            gf32x4 st[4];
#pragma unroll
            for (int jt = 0; jt < 4; ++jt) { st[jt] = (gf32x4){0.f, 0.f, 0.f, 0.f};
#pragma unroll
                for (int ks = 0; ks < 2; ++ks) { const gbf16x8 kf = *(const LAS gbf16x8*)(kimg + (16 * jt + l15) * GQP + (32 * ks + 8 * g) * 2);
                    st[jt] = __builtin_amdgcn_mfma_f32_16x16x32_bf16(kf, qf[ks], st[jt], 0, 0, 0); }
                const int i = 16 * q4 + l15;
#pragma unroll
                for (int r = 0; r < 4; ++r) { const int jj = 16 * jt + 4 * g + r; const bool keep = dir == 0 ? (jj <= i) : (jj >= i); st[jt][r] = keep ? st[jt][r] : 0.f; } }
            gbf16x8 pa[2];
#pragma unroll
            for (int k2 = 0; k2 < 2; ++k2) { const unsigned w0 = pk2(st[2 * k2][0], st[2 * k2][1]), w1 = pk2(st[2 * k2][2], st[2 * k2][3]), w2 = pk2(st[2 * k2 + 1][0], st[2 * k2 + 1][1]), w3 = pk2(st[2 * k2 + 1][2], st[2 * k2 + 1][3]);
                pa[k2] = __builtin_bit_cast(gbf16x8, (v4u){w0, w1, w2, w3}); }
#pragma unroll
            for (int c = 0; c < 8; ++c) {
#pragma unroll
                for (int k2 = 0; k2 < 2; ++k2) { const LAS unsigned char* pv = vimg + (32 * k2 + 4 * g + qq) * GVP + (16 * c + 4 * p4) * 2;
                    const gbf16x8 vf = gcat(gtr(pv), gtr(pv + 16 * GVP));
                    o[c] = __builtin_amdgcn_mfma_f32_16x16x32_bf16(pa[k2], vf, o[c], 0, 0, 0); }
#pragma unroll
                for (int ks = 0; ks < 2; ++ks) o[c] = __builtin_amdgcn_mfma_f32_16x16x32_bf16(qf[ks], dir ? sfB[c][ks] : sfA[c][ks], o[c], 0, 0, 0);
            }
        }
        if (skipmask & 4) continue;
        float ss[4];
#pragma unroll
        for (int r = 0; r < 4; ++r) { float t2 = 0.f;
#pragma unroll
            for (int c = 0; c < 8; ++c) t2 += o[c][r] * o[c][r];
            t2 = sum16(t2);
            ss[r] = 1.f / sqrtf(t2 * (1.f / 128.f) + EPS); }
        LAS unsigned char* gimg = lds + GIMG_OFF + hl * (64 * GVP);
#pragma unroll
        for (int c = 0; c < 8; ++c) { const float gain = a->in[I_EVGLAG][j * 128 + 16 * c + l15];
#pragma unroll
            for (int r = 0; r < 4; ++r) { LAS bf16* gp = (LAS bf16*)(gimg + (16 * q4 + 4 * g + r) * GVP + (16 * c + l15) * 2);
                *gp = (bf16)f2bf(o[c][r] * ss[r] * gain * siluf(bf2f(*gp))); } }
        __syncthreads();
#pragma unroll
        for (int it = 0; it < 4; ++it) { const int ch = tid + it * NTHR, hh = ch >> 10, t = (ch >> 4) & 63, c16 = ch & 15;
            *(v4u*)(MIX + (row0 + t) * D + (hp * 2 + hh) * 128 + c16 * 8) = *(const LAS v4u*)(lds + GIMG_OFF + hh * (64 * GVP) + t * GVP + c16 * 16); }
    }
}

__device__ __forceinline__ void diff_out_phase(int wv_, KA a, int j, int layer) {
    const int tid_o = otid(), lane = tid_o & 63, wave = tid_o >> 6, gw = blockIdx.x * NWAVES + wave, NGW = gridDim.x * NWAVES;
    const bf16* O01 = (const bf16*)(a->ws + WS_Y); bf16* MIX = (bf16*)(a->ws + WS_A1);
    const float lam = ((const float*)(a->ws + WS_TAB))[8192 + j], post = 1.f - lam_init_of(layer);
    const int hd = lane >> 4, d8 = (lane & 15) * 8;
    float gn[8];
#pragma unroll
    for (int e = 0; e < 8; ++e) gn[e] = a->in[I_DIFFG][j * 128 + d8 + e] * post;
    for (int rb = gw; rb < R; rb += 4 * NGW) {
        v4u w0[4], w1[4];
#pragma unroll
        for (int k = 0; k < 4; ++k) { const int r = rb + k * NGW < R ? rb + k * NGW : rb; const bf16* o = O01 + (size_t)r * D + hd * 256 + d8; w0[k] = *(const v4u*)o; w1[k] = *(const v4u*)(o + 128); }
#pragma unroll
        for (int k = 0; k < 4; ++k) { const int r = rb + k * NGW;
            if (r >= R || (layer == DEPTH - 1 && row_cls(r) == 4)) continue;
            const unsigned a0[4] = {w0[k].x, w0[k].y, w0[k].z, w0[k].w}, a1[4] = {w1[k].x, w1[k].y, w1[k].z, w1[k].w};
            float v[8]; float ss = 0.f;
#pragma unroll
            for (int e = 0; e < 8; ++e) { const float x0 = __builtin_bit_cast(float, (e & 1) ? (a0[e >> 1] & 0xffff0000u) : (a0[e >> 1] << 16)), x1 = __builtin_bit_cast(float, (e & 1) ? (a1[e >> 1] & 0xffff0000u) : (a1[e >> 1] << 16));
                v[e] = x0 - lam * x1; ss += v[e] * v[e]; }
            ss = sum16(ss);
            const float rstd = 1.f / sqrtf(ss * (1.f / 128.f) + EPS);
            v4u ow; ow.x = pk2(v[0] * rstd * gn[0], v[1] * rstd * gn[1]); ow.y = pk2(v[2] * rstd * gn[2], v[3] * rstd * gn[3]); ow.z = pk2(v[4] * rstd * gn[4], v[5] * rstd * gn[5]); ow.w = pk2(v[6] * rstd * gn[6], v[7] * rstd * gn[7]);
            *(v4u*)(MIX + (size_t)r * D + 512 + hd * 128 + d8) = ow; }
    }
}

typedef float cf2 __attribute__((ext_vector_type(2)));
constexpr size_t WS_PT = WS_PH + 99 * MiB;
constexpr size_t WS_HYS = WS_A1;
constexpr float TWC[16] = {1.000000000e+00f, 9.807852804e-01f, 9.238795325e-01f, 8.314696123e-01f, 7.071067812e-01f, 5.555702330e-01f, 3.826834324e-01f, 1.950903220e-01f, 6.123233996e-17f, -1.950903220e-01f, -3.826834324e-01f, -5.555702330e-01f, -7.071067812e-01f, -8.314696123e-01f, -9.238795325e-01f, -9.807852804e-01f};
constexpr float TWS[16] = {0.000000000e+00f, 1.950903220e-01f, 3.826834324e-01f, 5.555702330e-01f, 7.071067812e-01f, 8.314696123e-01f, 9.238795325e-01f, 9.807852804e-01f, 1.000000000e+00f, 9.807852804e-01f, 9.238795325e-01f, 8.314696123e-01f, 7.071067812e-01f, 5.555702330e-01f, 3.826834324e-01f, 1.950903220e-01f};
__device__ __forceinline__ cf2 cmul(cf2 a, cf2 b) { return (cf2){a.x * b.x - a.y * b.y, a.x * b.y + a.y * b.x}; }
__device__ __forceinline__ cf2 cmulc(cf2 a, cf2 b) { return (cf2){a.x * b.x + a.y * b.y, a.y * b.x - a.x * b.y}; }
template <bool INV> __device__ __forceinline__ cf2 tw_mul(cf2 d, int ti) {
    if (ti == 0) return d;
    if (ti == 8) return INV ? (cf2){-d.y, d.x} : (cf2){d.y, -d.x};
    const float c = TWC[ti], s = TWS[ti];
    return INV ? (cf2){d.x * c - d.y * s, d.y * c + d.x * s} : (cf2){d.x * c + d.y * s, d.y * c - d.x * s};
}
template <int N, int H, bool INV> struct FftStage {
    static __device__ __forceinline__ void run(cf2 (&x)[N]) {
#pragma unroll
        for (int g = 0; g < N; g += 2 * H)
#pragma unroll
            for (int j = 0; j < H; ++j) { const cf2 a = x[g + j], b = x[g + j + H]; x[g + j] = a + b; x[g + j + H] = tw_mul<INV>(a - b, j * (16 / H)); }
        FftStage<N, H / 2, INV>::run(x);
    }
};
template <int N, bool INV> struct FftStage<N, 0, INV> { static __device__ __forceinline__ void run(cf2 (&)[N]) {} };
template <int N, bool INV> __device__ __forceinline__ void fft_reg(cf2 (&x)[N]) { FftStage<N, N / 2, INV>::run(x); }
__device__ __forceinline__ void fft32_half(cf2 (&x)[32]) {
#pragma unroll
    for (int j = 0; j < 16; ++j) x[j + 16] = tw_mul<false>(x[j], j);
    FftStage<32, 8, false>::run(x);
}
__host__ __device__ constexpr int br5(int i) { return ((i & 1) << 4) | ((i & 2) << 2) | (i & 4) | ((i & 8) >> 2) | ((i & 16) >> 4); }
__host__ __device__ constexpr int br4(int i) { return ((i & 1) << 3) | ((i & 2) << 1) | ((i & 4) >> 1) | ((i & 8) >> 3); }

#define HY_OPAQUE(w) asm volatile("" : "+v"(w.x), "+v"(w.y))
__device__ __forceinline__ void hy_p1_store(LAS cf2* buf, cf2 (&x)[32], int m, cf2 w1) {
    HY_OPAQUE(w1);
    const int base = 17 * (m >> 4) + (m & 15); cf2 pw = (cf2){1.f, 0.f};
#pragma unroll
    for (int k = 0; k < 32; ++k) { if (k) { pw = cmul(pw, w1); x[br5(k)] = cmul(x[br5(k)], pw); } buf[560 * k + base] = x[br5(k)]; }
}
__device__ __forceinline__ void hy_p2(LAS cf2* buf, int tid, cf2 w2) {
    HY_OPAQUE(w2);
    const int base = 560 * (tid >> 4) + (tid & 15); cf2 x[32];
#pragma unroll
    for (int n = 0; n < 32; ++n) x[n] = buf[base + 17 * n];
    fft_reg<32, false>(x);
    cf2 pw = (cf2){1.f, 0.f};
#pragma unroll
    for (int k = 0; k < 32; ++k) { if (k) { pw = cmul(pw, w2); x[br5(k)] = cmul(x[br5(k)], pw); } buf[base + 17 * k] = x[br5(k)]; }
}
template <int MODE> __device__ __forceinline__ void hy_p3(LAS cf2* buf, int tid, cf2* kf) {
#pragma unroll
    for (int i = 0; i < 2; ++i) {
        const int blk = tid + 512 * i, base = 560 * (blk >> 5) + 17 * (blk & 31); cf2 x[16];
#pragma unroll
        for (int n = 0; n < 16; ++n) x[n] = buf[base + n];
        fft_reg<16, false>(x);
        cf2* kp = kf + (size_t)(i * 16) * 512 + tid;
        if (MODE == 0) {
#pragma unroll
            for (int r = 0; r < 16; ++r) kp[r * 512] = x[r] * (1.f / 16384.f);
        } else {
            cf2 y[16];
#pragma unroll
            for (int r = 0; r < 16; ++r) x[r] = cmul(x[r], kp[r * 512]);
#pragma unroll
            for (int k = 0; k < 16; ++k) y[k] = x[br4(k)];
            fft_reg<16, true>(y);
#pragma unroll
            for (int r = 0; r < 16; ++r) buf[base + br4(r)] = y[r];
        }
    }
}
__device__ __forceinline__ void hy_ip2(LAS cf2* buf, int tid, cf2 w2) {
    HY_OPAQUE(w2);
    const int base = 560 * (tid >> 4) + (tid & 15); cf2 x[32]; cf2 pw = (cf2){1.f, 0.f};
#pragma unroll
    for (int k = 0; k < 32; ++k) { x[k] = buf[base + 17 * k]; if (k) { pw = cmulc(pw, w2); x[k] = cmul(x[k], pw); } }
    fft_reg<32, true>(x);
#pragma unroll
    for (int r = 0; r < 32; ++r) buf[base + 17 * br5(r)] = x[r];
}
__device__ __forceinline__ void hy_ip3(const LAS cf2* buf, cf2 (&x)[32], int m, cf2 w1) {
    HY_OPAQUE(w1);
    const int base = 17 * (m >> 4) + (m & 15); cf2 pw = (cf2){1.f, 0.f};
#pragma unroll
    for (int k = 0; k < 32; ++k) { x[k] = buf[560 * k + base]; if (k) { pw = cmulc(pw, w1); x[k] = cmul(x[k], pw); } }
    fft_reg<32, true>(x);
}
__device__ __forceinline__ float hy_sconv(const bf16* row, int L, int t, float w0, float w1, float w2, float cb) {
    float u0 = bf2f(row[t - 1]), u1 = bf2f(row[t]), u2 = bf2f(row[t + 1]); u0 = t > 0 ? u0 : 0.f; u2 = t + 1 < L ? u2 : 0.f;
    return u0 * w0 + u1 * w1 + u2 * w2 + cb;
}
__device__ __forceinline__ void hyena_fft_phase(int wv_, KA a, int j, bool do_ctx, LAS unsigned char* lds, bool dry = false, int skipmask = 0) {
    const int tid0 = otid();
    LAS cf2* buf = (LAS cf2*)lds;
    unsigned char* ws = a->ws;
    bf16* PT = (bf16*)(ws + WS_PT); const float* HF = (const float*)(ws + WS_HF);
    cf2* KF = (cf2*)(ws + WS_HYS + (size_t)blockIdx.x * 262144); float* Z1 = (float*)(ws + WS_HYS + (size_t)blockIdx.x * 262144 + 131072);
    const float* cw = a->in[I_ODCONVW] + (size_t)j * 3 * 1536; const float* cb = a->in[I_ODCONVB] + j * 1536; const float* hb = a->in[I_HYBIAS] + j * 1024;
    const float a1 = -6.283185307179586f * (float)tid0 * (1.f / 16384.f), a2 = -6.283185307179586f * (float)(tid0 & 15) * (1.f / 512.f);
    const cf2 w1 = (cf2){cosf(a1), sinf(a1)}, w2 = (cf2){cosf(a2), sinf(a2)};
    for (int c = blockIdx.x; c < 512; c += gridDim.x) {
#pragma unroll 1
        for (int o = 0; o < 2; ++o) {
            const float bias = hb[o * 512 + c];
            const int chg = 512 * (o + 1) + c;
            const float gw0 = cw[chg], gw1 = cw[1536 + chg], gw2 = cw[3072 + chg], gcb = cb[chg];
            if (!(skipmask & 1)) {
                int tid = tid0; asm volatile("" : "+v"(tid)); const int m = tid;
                const float* hf = HF + (size_t)(o * 1024 + c) * SEQ; const float* hbk = HF + (size_t)(o * 1024 + 512 + c) * SEQ;
                cf2 x[32];
#pragma unroll
                for (int n1 = 0; n1 < 32; ++n1) { float v;
                    if (n1 < 16) v = hf[512 * n1 + m]; else if (n1 == 16) v = m == 0 ? 0.f : hbk[8192 - m]; else v = hbk[16384 - 512 * n1 - m];
                    x[n1] = (cf2){v, 0.f}; }
                fft_reg<32, false>(x);
                hy_p1_store(buf, x, m, w1);
                __syncthreads(); hy_p2(buf, tid, w2); __syncthreads(); hy_p3<0>(buf, tid, KF); __syncthreads();
            }
#pragma unroll 1
            for (int pr = 0; pr < ((skipmask & 2) ? 0 : 2); ++pr) {
                int tid = tid0; asm volatile("" : "+v"(tid)); const int m = tid;
                cf2 xin[16];
                if (o == 0) { const float vw0 = cw[c], vw1 = cw[1536 + c], vw2 = cw[3072 + c], vcb = cb[c];
                    const bf16* r0 = PT + (size_t)c * R + (size_t)(2 * pr) * PB + CTXL; const bf16* r1 = r0 + PB;
#pragma unroll
                    for (int n1 = 0; n1 < 16; ++n1) xin[n1] = (cf2){hy_sconv(r0, SEQ, 512 * n1 + m, vw0, vw1, vw2, vcb), hy_sconv(r1, SEQ, 512 * n1 + m, vw0, vw1, vw2, vcb)}; }
                else {
#pragma unroll
                    for (int n1 = 0; n1 < 16; ++n1) xin[n1] = (cf2){Z1[(2 * pr) * SEQ + 512 * n1 + m], Z1[(2 * pr + 1) * SEQ + 512 * n1 + m]}; }
                cf2 x[32];
#pragma unroll
                for (int n1 = 0; n1 < 16; ++n1) x[n1] = xin[n1];
                fft32_half(x);
                hy_p1_store(buf, x, m, w1);
                __syncthreads(); hy_p2(buf, tid, w2); __syncthreads(); hy_p3<1>(buf, tid, KF); __syncthreads(); hy_ip2(buf, tid, w2); __syncthreads();
                hy_ip3(buf, x, m, w1);
                __syncthreads();
                const bf16* g0 = PT + (size_t)chg * R + (size_t)(2 * pr) * PB + CTXL; const bf16* g1 = g0 + PB;
#pragma unroll
                for (int i = 0; i < 32; ++i) { const int n1 = br5(i); if (n1 >= 16) continue; const int n = 512 * n1 + m;
                    const float z0 = hy_sconv(g0, SEQ, n, gw0, gw1, gw2, gcb) * (x[i].x + xin[n1].x * bias), z1 = hy_sconv(g1, SEQ, n, gw0, gw1, gw2, gcb) * (x[i].y + xin[n1].y * bias);
                    if (o == 0) { Z1[(2 * pr) * SEQ + n] = z0; Z1[(2 * pr + 1) * SEQ + n] = z1; }
                    else if (dry) { Z1[(2 * pr) * SEQ + n] = z0; Z1[(2 * pr + 1) * SEQ + n] = z1; }
                    else { bf16* o0 = PT + (size_t)c * R + (size_t)(2 * pr) * PB + CTXL; o0[n] = (bf16)f2bf(z0); o0[PB + n] = (bf16)f2bf(z1); } }
            }
        }
        if (do_ctx) {
            int tid = tid0; asm volatile("" : "+v"(tid));
            LAS float* uin = (LAS float*)lds;
            LAS float* hfl = uin + 3072;
            LAS float* z1c = hfl + 1024;
            const float* HFC = HF + (size_t)2048 * SEQ;
            __syncthreads();
            for (int idx = tid; idx < 3072; idx += NTHR) { const int k3 = idx >> 10, b = (idx >> 8) & 3, t = idx & 255, ch = 512 * k3 + c;
                uin[idx] = hy_sconv(PT + (size_t)ch * R + (size_t)b * PB, CTXL, t, cw[ch], cw[1536 + ch], cw[3072 + ch], cb[ch]); }
            for (int idx = tid; idx < 1024; idx += NTHR) hfl[idx] = HFC[(size_t)((idx >> 9) * 1024 + ((idx >> 8) & 1) * 512 + c) * CTXL + (idx & 255)];
            __syncthreads();
#pragma unroll 1
            for (int o = 0; o < 2; ++o) {
                const float bias = hb[o * 512 + c];
                float zz[2];
#pragma unroll
                for (int e = 0; e < 2; ++e) { const int oi = tid * 2 + e, b = oi >> 8, t = oi & 255;
                    const LAS float* in = o == 0 ? uin + b * 256 : z1c + b * 256; const LAS float* hfw = hfl + o * 512; const LAS float* hbw = hfw + 256;
                    float acc = 0.f;
                    for (int s = 0; s <= t; ++s) acc += hfw[t - s] * in[s];
                    for (int s = t + 1; s < 256; ++s) acc += hbw[s - t] * in[s];
                    zz[e] = uin[(1 + o) * 1024 + b * 256 + t] * (acc + in[t] * bias); }
                __syncthreads();
#pragma unroll
                for (int e = 0; e < 2; ++e) { const int oi = tid * 2 + e, b = oi >> 8, t = oi & 255;
                    if (o == 0 || dry) z1c[b * 256 + t] = zz[e]; else PT[(size_t)c * R + (size_t)b * PB + t] = (bf16)f2bf(zz[e]); }
                __syncthreads();
            }
        }
    }
}
__device__ __forceinline__ void hyena_transpose_phase(int wv_, KA a, LAS unsigned char* lds) {
    const int tid = otid();
    unsigned char* ws = a->ws; const bf16* PT = (const bf16*)(ws + WS_PT); bf16* MIX = (bf16*)(ws + WS_A1);
    constexpr int NT = 8 * (R / 64), TSZ = 64 * 66;
    for (int tb = blockIdx.x * 4; tb < NT; tb += gridDim.x * 4) {
        __syncthreads();
        v4u v[4];
#pragma unroll
        for (int k = 0; k < 4; ++k) { const int t = tb + k < NT ? tb + k : NT - 1; const int c0 = (t & 7) * 64, r0 = (t >> 3) * 64, cc = tid >> 3, rc = tid & 7;
            v[k] = *(const v4u*)(PT + (size_t)(c0 + cc) * R + r0 + rc * 8); }
#pragma unroll
        for (int k = 0; k < 4; ++k) { const int cc = tid >> 3, rc = tid & 7; LAS unsigned* d = (LAS unsigned*)((LAS bf16*)lds + k * TSZ + cc * 66 + rc * 8); d[0] = v[k].x; d[1] = v[k].y; d[2] = v[k].z; d[3] = v[k].w; }
        __syncthreads();
#pragma unroll
        for (int k = 0; k < 4; ++k) { if (tb + k >= NT) break; const int t = tb + k, c0 = (t & 7) * 64, r0 = (t >> 3) * 64, rr = tid >> 3, cch = tid & 7; const LAS bf16* tile = (const LAS bf16*)lds + k * TSZ; unsigned w[4];
#pragma unroll
            for (int e = 0; e < 4; ++e) w[e] = (unsigned)tile[(cch * 8 + 2 * e) * 66 + rr] | ((unsigned)tile[(cch * 8 + 2 * e + 1) * 66 + rr] << 16);
            *(v4u*)(MIX + (size_t)(r0 + rr) * D + c0 + cch * 8) = (v4u){w[0], w[1], w[2], w[3]}; }
    }
}

__device__ __forceinline__ void hyena_filter_phase(int wv_, KA a, int j) {
    typedef float f32x16_t __attribute__((ext_vector_type(16)));
    const int tid = otid(), lane = tid & 63, wave = tid >> 6, gw = blockIdx.x * NWAVES + wave, NGW = gridDim.x * NWAVES, l31 = lane & 31, h = lane >> 5;
    const float* w3 = a->in[I_FW3] + (size_t)j * 64 * 2048; unsigned char* ws = a->ws;
    const float da = logf(1e-2f) / 0.3f, db = logf(1e-2f) / 1.5f;
    for (int it = gw; it < 64 * 33; it += NGW) {
        const int ct = it & 63, tg = it >> 6; const bool isctx = tg == 32; const int L = isctx ? CTXL : SEQ;
        const float* hid = (const float*)(ws + WS_HID) + (isctx ? (size_t)(2 * SEQ + j * CTXL) * 64 : (size_t)(j * SEQ) * 64);
        float* HF = (float*)(ws + WS_HF) + (isctx ? (size_t)2048 * SEQ : 0);
        float aw[32];
#pragma unroll
        for (int sx = 0; sx < 32; ++sx) aw[sx] = w3[(size_t)(32 * h + sx) * 2048 + ct * 32 + l31];
        float dl[16];
#pragma unroll
        for (int r = 0; r < 16; ++r) { const int col = ct * 32 + (r & 3) + 8 * (r >> 2) + 4 * h; dl[r] = fabsf(da + (float)(col & 511) * ((db - da) / 511.f)); }
#pragma unroll 1
        for (int tt = 0; tt < 8; ++tt) {
            const int t0 = (isctx ? tt : 8 * tg + tt) * 32, t = t0 + l31;
            const f32x4* hr = (const f32x4*)(hid + (size_t)t * 64 + 32 * h);
            float bv[32];
#pragma unroll
            for (int q4 = 0; q4 < 8; ++q4) { const f32x4 v = hr[q4]; bv[4 * q4] = v.x; bv[4 * q4 + 1] = v.y; bv[4 * q4 + 2] = v.z; bv[4 * q4 + 3] = v.w; }
            f32x16_t acc = {};
#pragma unroll
            for (int sx = 0; sx < 32; ++sx) acc = __builtin_amdgcn_mfma_f32_32x32x2f32(aw[sx], bv[sx], acc, 0, 0, 0);
            const float tf = (float)t / (float)(L - 1);
#pragma unroll
            for (int r = 0; r < 16; ++r) { const int col = ct * 32 + (r & 3) + 8 * (r >> 2) + 4 * h; HF[(size_t)col * L + t] = acc[r] * __expf(-tf * dl[r]); }
        }
    }
}
#ifndef PROBE_REPEAT
#define PROBE_REPEAT 0
#endif
#define PRB(id, stmt) do { if (PROBE_REPEAT == (id)) { stmt; __syncthreads(); } } while (0)
__global__ void __launch_bounds__(NTHR, 2) fwd_kernel(Args a_unused) {
    extern __shared__ __attribute__((aligned(16))) unsigned char lds_raw[];
    LAS unsigned char* lds = (LAS unsigned char*)lds_raw;
    volatile LAS unsigned* MISC = (volatile LAS unsigned*)(lds + LDS_MISC);
    const KA a0 = (KA)__builtin_amdgcn_kernarg_segment_ptr();
    if (threadIdx.x < 64) MISC[threadIdx.x] = 0u;
    const int wv_ = __builtin_amdgcn_readfirstlane(threadIdx.x >> 6);
    __syncthreads();
    const int lo = a0->ph_lo, hi = a0->ph_hi;
    XcdBarrier bar; bar.bar = (unsigned*)(a0->ws + WS_CTL) + CW_BAR; bar.x = 0; bar.st = MISC + 8;
    if (hi - lo > 1) bar = xcd_barrier_post((unsigned*)(a0->ws + WS_CTL) + CW_BAR, MISC + 8);
#define IN(k) (lo <= (k) && (k) < hi)
#define SEAM(k) do { if (IN((k) + 1)) { xcd_barrier(bar, wv_); if (PROBE_REPEAT == 20) xcd_barrier(bar, wv_); } } while (0)
    if (IN(0)) { PRB(13, p0a_prologue(wv_, ka_launder(a0), lds)); p0a_prologue(wv_, ka_launder(a0), lds); SEAM(0); }
    if (IN(1)) { PRB(14, p0b_first_norm(wv_, ka_launder(a0))); p0b_first_norm(wv_, ka_launder(a0)); SEAM(1); }
#pragma unroll 1
    for (int layer = 0; layer < DEPTH; ++layer) {
        const int pb = 2 + 9 * layer, j = layer >> 1; const bool odd = layer & 1; const int last = layer == DEPTH - 1;
        if (IN(pb + 0)) {
            const KA a = ka_launder(a0); unsigned char* ws = a->ws; const unsigned char* wl = ws + WS_W;
            if (odd) { hyena_filter_phase(wv_, ka_launder(a0), j); __syncthreads(); }
            if (odd) {
                pg8::Gemm g{nullptr, nullptr, R, NP_OD, D, 0}; pg8::DualOrder S;
                S.init(ws + WS_A1, wl + W_IN + (size_t)1536 * D * 2, R, 1536, wl + W_IN, ws + WS_A1, 1536, R, (int)gridDim.x, obx());
                pg8::EpiInProj E{(bf16*)(ws + WS_PH), NP_OD, (bf16*)(ws + WS_PT), R, (const float*)(ws + WS_TAB), nullptr, 1, C2};
                PRB(1, (pg8::gemm_phase<pg8::EpiInProj, pg8::DualOrder, true, true>(lds, g, S, E, otid())));
                pg8::gemm_phase<pg8::EpiInProj, pg8::DualOrder, true, true>(lds, g, S, E, otid());
            } else {
                pg8::Gemm g{(const bf16*)(ws + WS_A1), (const bf16*)(wl + W_IN), R, NP_EV, D, 0}; pg8::StaticOrder S; S.init(R, NP_EV, (int)gridDim.x, obx());
                pg8::EpiInProj E{(bf16*)(ws + WS_PH), NP_EV, nullptr, 0, (const float*)(ws + WS_TAB), a->in[I_EVQKG] + j * 128, 0, C2};
                PRB(1, (pg8::gemm_phase<pg8::EpiInProj, pg8::StaticOrder, true, true>(lds, g, S, E, otid())));
                pg8::gemm_phase<pg8::EpiInProj, pg8::StaticOrder, true, true>(lds, g, S, E, otid());
            }
            SEAM(pb + 0);
        }
        if (IN(pb + 1)) {
            if (!odd) { PRB(2, gla_state_phase(wv_, ka_launder(a0), j, lds)); gla_state_phase(wv_, ka_launder(a0), j, lds); SEAM(pb + 1); }
        }
        if (IN(pb + 2)) {
            if (odd) { PRB(7, hyena_fft_phase(wv_, ka_launder(a0), j, layer != DEPTH - 1, lds, true)); PRB(71, hyena_fft_phase(wv_, ka_launder(a0), j, false, lds, true, 2)); PRB(72, hyena_fft_phase(wv_, ka_launder(a0), j, false, lds, true, 1)); hyena_fft_phase(wv_, ka_launder(a0), j, layer != DEPTH - 1, lds); __syncthreads(); PRB(6, attn_phase_fast(wv_, ka_launder(a0), true, (char*)lds_raw, last)); attn_phase_fast(wv_, ka_launder(a0), true, (char*)lds_raw, last); }
            else { PRB(4, gla_scan_phase(wv_, ka_launder(a0))); gla_scan_phase(wv_, ka_launder(a0)); __syncthreads(); PRB(5, attn_phase_fast(wv_, ka_launder(a0), false, (char*)lds_raw)); attn_phase_fast(wv_, ka_launder(a0), false, (char*)lds_raw); }
            SEAM(pb + 2);
        }
        if (IN(pb + 3)) {
            if (odd) { PRB(9, (diff_out_phase(wv_, ka_launder(a0), j, layer), hyena_transpose_phase(wv_, ka_launder(a0), lds))); diff_out_phase(wv_, ka_launder(a0), j, layer); hyena_transpose_phase(wv_, ka_launder(a0), lds); } else { PRB(8, gla_output_phase(wv_, ka_launder(a0), j, lds)); PRB(31, gla_output_phase(wv_, ka_launder(a0), j, lds, 1)); PRB(32, gla_output_phase(wv_, ka_launder(a0), j, lds, 2)); PRB(34, gla_output_phase(wv_, ka_launder(a0), j, lds, 4)); PRB(37, gla_output_phase(wv_, ka_launder(a0), j, lds, 7)); gla_output_phase(wv_, ka_launder(a0), j, lds); }
            SEAM(pb + 3);
        }
        if (IN(pb + 4)) {
            const KA a = ka_launder(a0); unsigned char* ws = a->ws; const unsigned char* wl = ws + WS_W;
            pg8::Gemm g{(const bf16*)(ws + WS_A1), (const bf16*)(wl + W_OUT), R, D, D, 0}; pg8::StaticOrder S; S.init(last ? NB * SEQ : R, D, (int)gridDim.x, obx(), last);
            pg8::EpiBf16<0> E{(bf16*)(ws + WS_Y), D};
            PRB(10, (pg8::gemm_phase<pg8::EpiBf16<0>, pg8::StaticOrder, true, true>(lds, g, S, E, otid())));
            pg8::gemm_phase<pg8::EpiBf16<0>, pg8::StaticOrder, true, true>(lds, g, S, E, otid());
            SEAM(pb + 4);
        }
        if (IN(pb + 5)) { if (!last) { convert_layer_weights(wv_, ka_launder(a0), layer + 1, 3, lds); __syncthreads(); } PRB(15, rowwise_post(wv_, ka_launder(a0), layer, 0, lds)); rowwise_post(wv_, ka_launder(a0), layer, 0, lds); SEAM(pb + 5); }
        if (IN(pb + 6)) {
            const KA a = ka_launder(a0); unsigned char* ws = a->ws; const unsigned char* wl = ws + WS_W;
            pg8::Gemm g{(const bf16*)(ws + WS_A1), (const bf16*)(wl + W_1), R, DFF, D, 0}; pg8::StaticOrder S; S.init(last ? NB * SEQ : R, DFF, (int)gridDim.x, obx(), last);
            pg8::EpiBf16<2> E{(bf16*)(ws + WS_PH), DFF};
            PRB(11, (pg8::gemm_phase<pg8::EpiBf16<2>, pg8::StaticOrder, true, true>(lds, g, S, E, otid())));
            if (PROBE_REPEAT == 41) { pg8::EpiBf16<2> E2{(bf16*)(ws + WS_PH), DFF, 1}; pg8::gemm_phase<pg8::EpiBf16<2>, pg8::StaticOrder, true, true>(lds, g, S, E2, otid()); __syncthreads(); }
            pg8::gemm_phase<pg8::EpiBf16<2>, pg8::StaticOrder, true, true>(lds, g, S, E, otid());
            SEAM(pb + 6);
        }
        if (IN(pb + 7)) {
            const KA a = ka_launder(a0); unsigned char* ws = a->ws; const unsigned char* wl = ws + WS_W;
            { pg8::Gemm g{(const bf16*)(ws + WS_PH), (const bf16*)(wl + W_2), R, D, DFF, 0}; pg8::StaticOrder S; S.init(NB * SEQ, D, (int)gridDim.x, obx(), 1);
              pg8::EpiBf16<0> E{(bf16*)(ws + WS_A1), D};
              PRB(12, (pg8::gemm_phase<pg8::EpiBf16<0>, pg8::StaticOrder, true, true>(lds, g, S, E, otid())));
              pg8::gemm_phase<pg8::EpiBf16<0>, pg8::StaticOrder, true, true>(lds, g, S, E, otid()); }
            if (!last) { __syncthreads();
              pg8::Gemm g{(const bf16*)(ws + WS_PH), (const bf16*)(wl + W_2), 4 * 256, D, DFF / 4, DFF}; pg8::CtxSplitOrder<4, 4> S; S.init(DFF / 4, (int)gridDim.x, obx());
              pg8::EpiSlab E{(bf16*)(ws + WS_SLAB), D, (size_t)1024 * D};
              pg8::gemm_phase<pg8::EpiSlab, pg8::CtxSplitOrder<4, 4>, true, true>(lds, g, S, E, otid()); }
            SEAM(pb + 7);
        }
        if (IN(pb + 8)) { if (!last) { convert_layer_weights(wv_, ka_launder(a0), layer + 1, 12, lds); __syncthreads(); } rowwise_post(wv_, ka_launder(a0), layer, 1, lds); SEAM(pb + 8); }
    }
#undef IN
#undef SEAM
}

constexpr int N_PHASES = 2 + 9 * DEPTH;
#ifndef MK_ONE_LAUNCH
#define MK_ONE_LAUNCH 1
#endif
extern "C" void kernel_launch(void* const* d_in, const int* in_sizes, int n_in, void* d_out, int out_size, void* d_ws, size_t ws_size, hipStream_t stream) {
    static int grid = 0;
    if (grid == 0) {
        if (n_in != 27 || in_sizes[0] != NB * SEQ * D || out_size != NB * SEQ * D || ws_size < WS_END) { fprintf(stderr, "kernel_launch: unexpected shapes (n_in %d, in0 %d, out %d, ws %zu)\n", n_in, n_in > 0 ? in_sizes[0] : -1, out_size, ws_size); grid = -1; return; }
        int dev = 0, cus = 0;
        if (hipGetDevice(&dev) != hipSuccess || hipDeviceGetAttribute(&cus, hipDeviceAttributeMultiprocessorCount, dev) != hipSuccess) { grid = -1; return; }
        if (hipFuncSetAttribute((const void*)fwd_kernel, hipFuncAttributeMaxDynamicSharedMemorySize, LDS_BYTES) != hipSuccess) { fprintf(stderr, "kernel_launch: hipFuncSetAttribute failed\n"); grid = -1; return; }
        (void)hipGetLastError();
        grid = cus;
    }
    if (grid < 0) return;
    if (hipMemsetAsync((char*)d_ws + WS_CTL, 0, CTL_ZERO_BYTES, stream) != hipSuccess) return;
    Args a{};
    for (int i = 0; i < 27; ++i) a.in[i] = (const float*)d_in[i];
    a.out = (float*)d_out; a.ws = (unsigned char*)d_ws;
#if MK_ONE_LAUNCH
    a.ph_lo = 0; a.ph_hi = N_PHASES;
    hipLaunchKernelGGL(fwd_kernel, dim3(grid), dim3(NTHR), LDS_BYTES, stream, a);
#else
    for (int k = 0; k < N_PHASES; ++k) { a.ph_lo = k; a.ph_hi = k + 1; hipLaunchKernelGGL(fwd_kernel, dim3(grid), dim3(NTHR), LDS_BYTES, stream, a); }
#endif
}
```

```cpp
#include <hip/hip_runtime.h>
#include <cstdio>
#include <cstdint>
#include <hip/hip_bf16.h>
#include <cmath>

namespace pg8 {
#define PG8_LAS __attribute__((address_space(3)))
typedef unsigned short bf16_t;
typedef short bf16x8 __attribute__((ext_vector_type(8)));
typedef float f32x4 __attribute__((ext_vector_type(4)));
typedef unsigned u32x4 __attribute__((ext_vector_type(4)));
constexpr int BM = 256, BK = 64, HALF = 128, HTB = HALF * BK * 2  , STAGE_BYTES = 8 * HTB, NXCD = 8, WGM = 8;

__host__ __device__ __forceinline__ int lds_byte(int r, int c) { const int st = (r >> 4) * 2 + (c >> 5), rr = r & 15, cc = c & 31, ob = rr * 64 + cc * 2; return st * 1024 + (ob ^ (((ob >> 9) & 1) << 5)); }
__host__ __device__ __forceinline__ void stage_rc(int b, int& R, int& C) { const int st = b / 1024, sb = b % 1024, swz = sb ^ (((sb >> 9) & 1) << 5); R = (st >> 1) * 16 + swz / 64; C = (st & 1) * 32 + (swz % 64) / 2; }
__host__ __device__ __forceinline__ int perm32(int rho) { const int n = rho >> 4, i = rho & 15; return 8 * (i >> 2) + 4 * n + (i & 3); }

struct Unit { int pm, pn, kind; };
struct Gemm { const bf16_t* A; const bf16_t* Bt; int M, N, K; int ld; };

struct StaticOrder {
    int nM, nN, nwg, G, c, skip;
    __host__ __device__ void init(int M, int N, int G_, int c_, int skip_ = 0) { nM = M / BM; nN = N / BM; nwg = nM * nN; G = G_; c = c_; skip = skip_; }
    __host__ __device__ bool next(int i, Unit& u) const {
        const long L = (long)i * G + c; if (L >= nwg) return false;
        int wgid = (int)L; { const int q = nwg / NXCD, r = nwg % NXCD, xcd = wgid % NXCD, off = wgid / NXCD; wgid = (xcd < r ? xcd * (q + 1) : r * (q + 1) + (xcd - r) * q) + off; }
        const int nig = WGM * nN, gid = wgid / nig, fm = gid * WGM, gsz = (nM - fm) < WGM ? (nM - fm) : WGM;
        u.pm = fm + ((wgid % nig) % gsz); u.pn = (wgid % nig) / gsz; u.kind = 0; if (skip) u.pm += (u.pm >> 5) + 1; return true;
    }
    __device__ __forceinline__ const char* abase(const Gemm& g, const Unit& u, size_t tstep) const { return (const char*)g.A + (size_t)u.pm * tstep; }
    __device__ __forceinline__ const char* bbase(const Gemm& g, const Unit& u, size_t tstep) const { return (const char*)g.Bt + (size_t)u.pn * tstep; }
    __device__ __forceinline__ void a_ready(const Unit&) const {}
    __device__ __forceinline__ void done(const Unit&) const {}
};
struct DualOrder {
    StaticOrder s0, s1; const char *A0, *B0, *A1, *B1; int G, c;
    __device__ __forceinline__ void init(const void* a0, const void* b0, int M0, int N0, const void* a1, const void* b1, int M1, int N1, int G_, int c_) {
        s0.init(M0, N0, 1, 0); s1.init(M1, N1, 1, 0); A0 = (const char*)a0; B0 = (const char*)b0; A1 = (const char*)a1; B1 = (const char*)b1; G = G_; c = c_; }
    __device__ __forceinline__ bool next(int i, Unit& u) const {
        const int L = i * G + c;
        if (L < s0.nwg) { s0.next(L, u); u.kind = 0; return true; }
        if (L - s0.nwg < s1.nwg) { s1.next(L - s0.nwg, u); u.kind = 1; return true; }
        return false; }
    __device__ __forceinline__ const char* abase(const Gemm&, const Unit& u, size_t tstep) const { return (u.kind ? A1 : A0) + (size_t)u.pm * tstep; }
    __device__ __forceinline__ const char* bbase(const Gemm&, const Unit& u, size_t tstep) const { return (u.kind ? B1 : B0) + (size_t)u.pn * tstep; }
    __device__ __forceinline__ void a_ready(const Unit&) const {}
    __device__ __forceinline__ void done(const Unit&) const {}
};
template <int NN, int NS> struct CtxSplitOrder {
    int G, c; size_t kbytes;
    __device__ __forceinline__ void init(int Kslice, int G_, int c_) { G = G_; c = c_; kbytes = (size_t)Kslice * 2; }
    __device__ __forceinline__ bool next(int i, Unit& u) const { const int L = i * G + c; if (L >= 4 * NN * NS) return false; u.kind = L % NS; u.pn = (L / NS) % NN; u.pm = L / (NS * NN); return true; }
    __device__ __forceinline__ const char* abase(const Gemm& g, const Unit& u, size_t tstep) const { return (const char*)g.A + (size_t)(33 * u.pm) * tstep + (size_t)u.kind * kbytes; }
    __device__ __forceinline__ const char* bbase(const Gemm& g, const Unit& u, size_t tstep) const { return (const char*)g.Bt + (size_t)u.pn * tstep + (size_t)u.kind * kbytes; }
    __device__ __forceinline__ void a_ready(const Unit&) const {}
    __device__ __forceinline__ void done(const Unit&) const {}
};

__device__ __forceinline__ unsigned cvt_pk_bf16(float lo, float hi) { unsigned r; asm volatile("v_cvt_pk_bf16_f32 %0, %1, %2" : "=v"(r) : "v"(lo), "v"(hi)); return r; }
template <int ACT  > struct EpiBf16 {
    static constexpr bool PERM = true, AFTER_DRAIN = false;
    bf16_t* O; int ldc; int probe_nostore = 0;
    __device__ __forceinline__ void operator()(const f32x4 (&acc)[2][2][4][2], const Unit& u, int wr, int wc, int fr, int fq) const {
        if (probe_nostore && u.pm != 0x7fffffff) { float t = 0.f;
#pragma unroll
            for (int ai = 0; ai < 2; ++ai)
#pragma unroll
                for (int m = 0; m < 4; ++m)
#pragma unroll
                    for (int bj = 0; bj < 2; ++bj) t += acc[ai][bj][m][0][0] + acc[ai][bj][m][1][3];
            if (t == 1234.5678f) O[0] = 1; return; }
        const int row0 = u.pm * BM + wr * 64 + fr; const int col0 = u.pn * BM + wc * 32 + 8 * fq;
        const __amdgpu_buffer_rsrc_t rs = __builtin_amdgcn_make_buffer_rsrc(O, 0, 0x7ffffff0, 0x00020000);
#pragma unroll
        for (int ai = 0; ai < 2; ++ai)
#pragma unroll
            for (int m = 0; m < 4; ++m) { bf16_t* rowp = O + (size_t)(row0 + ai * HALF + m * 16) * ldc + col0;
#pragma unroll
                for (int bj = 0; bj < 2; ++bj) { f32x4 v0 = acc[ai][bj][m][0], v1 = acc[ai][bj][m][1];
                    if (ACT == 2) {
#pragma unroll
                        for (int e = 0; e < 4; ++e) { const float a0 = fmaxf(v0[e], 0.f), a1 = fmaxf(v1[e], 0.f); v0[e] = a0 * a0; v1[e] = a1 * a1; } }
                    u32x4 w; w.x = cvt_pk_bf16(v0[0], v0[1]); w.y = cvt_pk_bf16(v0[2], v0[3]); w.z = cvt_pk_bf16(v1[0], v1[1]); w.w = cvt_pk_bf16(v1[2], v1[3]);
                    if (ACT == 2) __builtin_amdgcn_raw_buffer_store_b128(w, rs, (unsigned)((size_t)((row0 + ai * HALF + m * 16) * (size_t)ldc + col0 + bj * HALF) * 2), 0, 16);
                    else *(u32x4*)(rowp + bj * HALF) = w; } }
    }
};
struct EpiDual {
    static constexpr bool PERM = true, AFTER_DRAIN = false;
    bf16_t* O0; int ldc0; bf16_t* O1; int ldc1;
    __device__ __forceinline__ void operator()(const f32x4 (&acc)[2][2][4][2], const Unit& u, int wr, int wc, int fr, int fq) const {
        const EpiBf16<0> e{u.kind ? O1 : O0, u.kind ? ldc1 : ldc0}; e(acc, u, wr, wc, fr, fq);
    }
};
struct EpiInProj {
    static constexpr bool PERM = true, AFTER_DRAIN = false;
    bf16_t* O0; int ldc0; bf16_t* O1; int ldc1; const float* tab; const float* qkg; int odd; float qscale;
    __device__ __forceinline__ void operator()(const f32x4 (&acc)[2][2][4][2], const Unit& u, int wr, int wc, int fr, int fq) const {
        if (u.kind) { const EpiBf16<0> e{O1, ldc1}; e(acc, u, wr, wc, fr, fq); return; }
        const bool perm = !odd && u.pn >= 6 && u.pn <= 8;
        int mode = 0;
        if (odd) mode = u.pn < 2 ? 1 : (u.pn < 4 ? 2 : 0); else mode = (u.pn == 6 || u.pn == 7) ? 1 : ((u.pn == 8 && wc < 2) ? 2 : 0);
        const int pp = u.pm % 33; const bool rope = mode != 0 && pp != 0; const bool norm = mode != 0 && !odd;
        const int row0 = u.pm * BM + wr * 64 + fr;
        const int colb = u.pn * BM + (perm ? 64 * wc + 8 * fq : 32 * wc + 8 * fq), bjs = perm ? 32 : HALF;
        if (mode == 0) {
#pragma unroll
            for (int ai = 0; ai < 2; ++ai)
#pragma unroll
                for (int m = 0; m < 4; ++m) { bf16_t* rowp = O0 + (size_t)(row0 + ai * HALF + m * 16) * ldc0 + colb;
#pragma unroll
                    for (int bj = 0; bj < 2; ++bj) { const f32x4 v0 = acc[ai][bj][m][0], v1 = acc[ai][bj][m][1];
                        u32x4 w; w.x = cvt_pk_bf16(v0[0], v0[1]); w.y = cvt_pk_bf16(v0[2], v0[3]); w.z = cvt_pk_bf16(v1[0], v1[1]); w.w = cvt_pk_bf16(v1[2], v1[3]);
                        *(u32x4*)(rowp + bj * bjs) = w; } }
            return;
        }
        f32x4 G[2][2];
#pragma unroll
        for (int bj = 0; bj < 2; ++bj)
#pragma unroll
            for (int n = 0; n < 2; ++n) G[bj][n] = norm ? *(const f32x4*)(qkg + (mode == 2 ? 64 : 0) + 32 * bj + 8 * fq + 4 * n) : (f32x4){1.f, 1.f, 1.f, 1.f};
        const float sc = mode == 1 ? qscale : 1.f;
        const float* trow = tab + ((4 * (pp - 1) + wr) * 16 + 4 * fq) * 2;
        const float* tcol = tab + 4096 + (fr * 16 + 4 * fq) * 2;
        const f32x4 ID = (f32x4){1.f, 0.f, 1.f, 0.f};
        f32x4 TR[2][2];
#pragma unroll
        for (int ai = 0; ai < 2; ++ai) { TR[ai][0] = rope ? *(const f32x4*)(trow + ai * 64) : ID; TR[ai][1] = rope ? *(const f32x4*)(trow + ai * 64 + 4) : ID; }
        f32x4 TCn0 = rope ? *(const f32x4*)(tcol) : ID, TCn1 = rope ? *(const f32x4*)(tcol + 4) : ID;
#pragma unroll
        for (int m = 0; m < 4; ++m) {
            const f32x4 TC0 = TCn0, TC1 = TCn1;
            if (m < 3) { TCn0 = rope ? *(const f32x4*)(tcol + (m + 1) * 512) : ID; TCn1 = rope ? *(const f32x4*)(tcol + (m + 1) * 512 + 4) : ID; }
#pragma unroll
            for (int ai = 0; ai < 2; ++ai) {
                f32x4 v[2][2];
#pragma unroll
                for (int bj = 0; bj < 2; ++bj)
#pragma unroll
                    for (int n = 0; n < 2; ++n) v[bj][n] = acc[ai][bj][m][n];
                if (norm) { float ss = 0.f;
#pragma unroll
                    for (int bj = 0; bj < 2; ++bj)
#pragma unroll
                        for (int n = 0; n < 2; ++n) ss += (v[bj][n][0] * v[bj][n][0] + v[bj][n][1] * v[bj][n][1]) + (v[bj][n][2] * v[bj][n][2] + v[bj][n][3] * v[bj][n][3]);
                    { const unsigned u_ = __builtin_bit_cast(unsigned, ss); auto a_ = __builtin_amdgcn_permlane16_swap(u_, u_, false, false); ss = __builtin_bit_cast(float, (unsigned)a_[0]) + __builtin_bit_cast(float, (unsigned)a_[1]);
                      const unsigned w_ = __builtin_bit_cast(unsigned, ss); auto b_ = __builtin_amdgcn_permlane32_swap(w_, w_, false, false); ss = __builtin_bit_cast(float, (unsigned)b_[0]) + __builtin_bit_cast(float, (unsigned)b_[1]); }
                    const float rstd = 1.0f / sqrtf(ss * (1.f / 64.f) + 1e-6f);
#pragma unroll
                    for (int bj = 0; bj < 2; ++bj)
#pragma unroll
                        for (int n = 0; n < 2; ++n) v[bj][n] = (v[bj][n] * rstd) * G[bj][n]; }
                bf16_t* rowp = O0 + (size_t)(row0 + ai * HALF + m * 16) * ldc0 + colb;
#pragma unroll
                for (int bj = 0; bj < 2; ++bj) {
                    if (rope) {
                        const bool colang = odd ? (wc & 1) : (bj == 1);
                        const f32x4 T0 = colang ? TC0 : TR[ai][0], T1 = colang ? TC1 : TR[ai][1];
                        const f32x4 a0 = v[bj][0], a1 = v[bj][1];
                        v[bj][0] = (f32x4){a0[0] * T0[0] - a0[1] * T0[1], a0[0] * T0[1] + a0[1] * T0[0], a0[2] * T0[2] - a0[3] * T0[3], a0[2] * T0[3] + a0[3] * T0[2]};
                        v[bj][1] = (f32x4){a1[0] * T1[0] - a1[1] * T1[1], a1[0] * T1[1] + a1[1] * T1[0], a1[2] * T1[2] - a1[3] * T1[3], a1[2] * T1[3] + a1[3] * T1[2]};
                    }
                    const f32x4 x0 = v[bj][0] * sc, x1 = v[bj][1] * sc;
                    u32x4 w; w.x = cvt_pk_bf16(x0[0], x0[1]); w.y = cvt_pk_bf16(x0[2], x0[3]); w.z = cvt_pk_bf16(x1[0], x1[1]); w.w = cvt_pk_bf16(x1[2], x1[3]);
                    *(u32x4*)(rowp + bj * bjs) = w;
                }
            }
        }
    }
};
struct EpiSlab {
    static constexpr bool PERM = true, AFTER_DRAIN = false;
    bf16_t* O; int ldc; size_t slab;
    __device__ __forceinline__ void operator()(const f32x4 (&acc)[2][2][4][2], const Unit& u, int wr, int wc, int fr, int fq) const {
        const EpiBf16<0> e{O + (size_t)u.kind * slab, ldc}; e(acc, u, wr, wc, fr, fq);
    }
};

template <class Epi, class Sched, bool ALIGN_EPI = false, bool SP2 = false>
__device__ __forceinline__ void gemm_phase(PG8_LAS unsigned char* lds, const Gemm g, const Sched& S, const Epi& E, const int tid_in) {
    int tid_ = tid_in; asm volatile("" : "+v"(tid_));
    const int tid = tid_, wid = __builtin_amdgcn_readfirstlane(tid >> 6), lane = tid & 63, wr = wid >> 2, wc = wid & 3, fr = lane & 15, fq = lane >> 4;
    const int K = g.ld ? g.ld : g.K, nt = g.K / BK;
    unsigned voffA[2], voffB[2];
#pragma unroll
    for (int i = 0; i < 2; ++i) { int R, C; stage_rc(tid * 16 + i * 8192, R, C); const int Rb = Epi::PERM ? ((R & ~31) + perm32(R & 31)) : R;
        voffA[i] = (unsigned)(R * K + C) * 2u; voffB[i] = (unsigned)(Rb * K + C) * 2u; }
    const size_t kstep = (size_t)(BK * 2);
    const size_t hstep = (size_t)HALF * K * 2;
    const size_t tstep = 2 * hstep;
    const unsigned ldsw = (unsigned)wid * 1024u;
    const int aoff = lds_byte(wr * 64 + fr, fq * 8), boff = lds_byte(wc * 32 + fr, fq * 8);
#define PG8_SA(b, h) (((b) * 2 + (h)) * HTB)
#define PG8_SB(b, h) ((4 + (b) * 2 + (h)) * HTB)
#define PG8_STAGE(bufoff, gbase, voff) do { _Pragma("unroll") for (int _i = 0; _i < 2; ++_i) \
        __builtin_amdgcn_global_load_lds((const unsigned*)((const char*)(gbase) + (voff)[_i]), (PG8_LAS unsigned*)(lds + (bufoff) + ldsw + _i * 8192), 16, 0, 0); } while (0)
#define PG8_LDA(dst, b, h) do { _Pragma("unroll") for (int m = 0; m < 4; ++m) _Pragma("unroll") for (int k = 0; k < 2; ++k) dst[m][k] = *(const PG8_LAS bf16x8*)(lds + PG8_SA(b, h) + aoff + m * 2048 + k * 1024); } while (0)
#define PG8_LDB(dst, b, h) do { _Pragma("unroll") for (int n = 0; n < 2; ++n) _Pragma("unroll") for (int k = 0; k < 2; ++k) dst[n][k] = *(const PG8_LAS bf16x8*)(lds + PG8_SB(b, h) + boff + n * 2048 + k * 1024); } while (0)
#define PG8_MMA(ai, bj, At, Bt) do { __builtin_amdgcn_s_setprio(1); _Pragma("unroll") for (int m = 0; m < 4; ++m) _Pragma("unroll") for (int n = 0; n < 2; ++n) _Pragma("unroll") for (int k = 0; k < 2; ++k) \
        acc[ai][bj][m][n] = __builtin_amdgcn_mfma_f32_16x16x32_bf16(Bt[n][k], At[m][k], acc[ai][bj][m][n], 0, 0, 0); __builtin_amdgcn_s_setprio(0); } while (0)
#define PG8_WAIT_V(n) asm volatile("s_waitcnt vmcnt(" #n ")" ::: "memory")
#define PG8_WAIT_L(n) asm volatile("s_waitcnt lgkmcnt(" #n ")" ::: "memory")
#define PG8_BAR __builtin_amdgcn_s_barrier()
#define PG8_SCHED __builtin_amdgcn_sched_barrier(0)
    Unit cur, nxt; int ui = 0;
    if (!S.next(0, cur)) return;
    f32x4 acc[2][2][4][2];
#pragma unroll
    for (int a = 0; a < 2; ++a)
#pragma unroll
        for (int b = 0; b < 2; ++b)
#pragma unroll
            for (int m = 0; m < 4; ++m)
#pragma unroll
                for (int n = 0; n < 2; ++n) acc[a][b][m][n] = (f32x4){0.f, 0.f, 0.f, 0.f};
    bf16x8 At[4][2], B0[2][2], B1[2][2];
    const char* cA = S.abase(g, cur, tstep); const char* cB = S.bbase(g, cur, tstep);
    S.a_ready(cur);
    if constexpr (SP2) {
        PG8_STAGE(PG8_SB(0, 0), cB, voffB); PG8_STAGE(PG8_SB(0, 1), cB + hstep, voffB); PG8_STAGE(PG8_SA(0, 0), cA, voffA); PG8_STAGE(PG8_SA(0, 1), cA + hstep, voffA);
        if (wr == 1) PG8_BAR;
        PG8_WAIT_V(2); PG8_BAR;
        PG8_STAGE(PG8_SB(1, 0), cB + kstep, voffB); PG8_STAGE(PG8_SA(1, 0), cA + kstep, voffA); PG8_STAGE(PG8_SB(1, 1), cB + hstep + kstep, voffB);
        PG8_WAIT_V(6); PG8_BAR;
    } else {
        PG8_STAGE(PG8_SB(0, 0), cB, voffB); PG8_STAGE(PG8_SA(0, 0), cA, voffA); PG8_STAGE(PG8_SB(0, 1), cB + hstep, voffB); PG8_STAGE(PG8_SA(0, 1), cA + hstep, voffA);
        if (wr == 1) PG8_BAR;
        PG8_WAIT_V(4); PG8_BAR;
        PG8_STAGE(PG8_SB(1, 0), cB + kstep, voffB); PG8_STAGE(PG8_SA(1, 0), cA + kstep, voffA); PG8_STAGE(PG8_SB(1, 1), cB + hstep + kstep, voffB);
        PG8_WAIT_V(6); PG8_BAR;
    }
    for (;;) {
        const bool has_next = S.next(ui + 1, nxt);
        const char* nA = has_next ? S.abase(g, nxt, tstep) : cA; const char* nB = has_next ? S.bbase(g, nxt, tstep) : cB;
        for (int t = 0; t < nt; t += 2) {
            const bool last = (t == nt - 2);
            const char* a1 = cA + (size_t)(t + 1) * kstep;
            const char* a2 = last ? nA : cA + (size_t)(t + 2) * kstep; const char* b2 = last ? nB : cB + (size_t)(t + 2) * kstep;
            const char* a3 = a2 + kstep; const char* b3 = b2 + kstep;
            if (last && has_next) S.a_ready(nxt);
            if constexpr (SP2) {
            PG8_LDB(B0, 0, 0); PG8_LDB(B1, 0, 1); PG8_SCHED; PG8_LDA(At, 0, 0); PG8_STAGE(PG8_SA(1, 1), a1 + hstep, voffA);
            PG8_WAIT_V(8); PG8_WAIT_L(0); PG8_BAR; PG8_MMA(0, 0, At, B0); PG8_MMA(0, 1, At, B1); PG8_BAR; PG8_SCHED;
            PG8_LDA(At, 0, 1); PG8_STAGE(PG8_SB(0, 0), b2, voffB); PG8_STAGE(PG8_SB(0, 1), b2 + hstep, voffB); PG8_STAGE(PG8_SA(0, 0), a2, voffA);
            PG8_WAIT_V(8); PG8_WAIT_L(0); PG8_BAR; PG8_MMA(1, 0, At, B0); PG8_MMA(1, 1, At, B1); PG8_BAR; PG8_SCHED;
            PG8_LDB(B0, 1, 0); PG8_LDB(B1, 1, 1); PG8_SCHED; PG8_LDA(At, 1, 0); PG8_STAGE(PG8_SA(0, 1), a2 + hstep, voffA);
            PG8_WAIT_V(8); PG8_WAIT_L(0); PG8_BAR; PG8_MMA(0, 0, At, B0); PG8_MMA(0, 1, At, B1); PG8_BAR; PG8_SCHED;
            PG8_LDA(At, 1, 1); PG8_STAGE(PG8_SB(1, 0), b3, voffB); PG8_STAGE(PG8_SB(1, 1), b3 + hstep, voffB); PG8_STAGE(PG8_SA(1, 0), a3, voffA);
            PG8_WAIT_V(8); PG8_WAIT_L(0); PG8_BAR; PG8_MMA(1, 0, At, B0); PG8_MMA(1, 1, At, B1); PG8_BAR; PG8_SCHED;
            } else {
            PG8_LDB(B0, 0, 0); PG8_SCHED; PG8_LDA(At, 0, 0); PG8_STAGE(PG8_SA(1, 1), a1 + hstep, voffA);
            PG8_WAIT_L(8); PG8_BAR; PG8_WAIT_L(0); PG8_MMA(0, 0, At, B0); PG8_BAR; PG8_SCHED;
            PG8_LDB(B1, 0, 1); PG8_STAGE(PG8_SB(0, 0), b2, voffB);
            PG8_BAR; PG8_WAIT_L(0); PG8_MMA(0, 1, At, B1); PG8_BAR;
            PG8_LDA(At, 0, 1); PG8_STAGE(PG8_SA(0, 0), a2, voffA);
            PG8_BAR; PG8_WAIT_L(0); PG8_MMA(1, 0, At, B0); PG8_BAR; PG8_SCHED;
            PG8_STAGE(PG8_SB(0, 1), b2 + hstep, voffB);
            PG8_WAIT_V(6); PG8_BAR; PG8_MMA(1, 1, At, B1); PG8_BAR;
            PG8_LDB(B0, 1, 0); PG8_SCHED; PG8_LDA(At, 1, 0); PG8_STAGE(PG8_SA(0, 1), a2 + hstep, voffA);
            PG8_WAIT_L(8); PG8_BAR; PG8_WAIT_L(0); PG8_MMA(0, 0, At, B0); PG8_BAR; PG8_SCHED;
            PG8_LDB(B1, 1, 1); PG8_STAGE(PG8_SB(1, 0), b3, voffB);
            PG8_BAR; PG8_WAIT_L(0); PG8_MMA(0, 1, At, B1); PG8_BAR;
            PG8_LDA(At, 1, 1); PG8_STAGE(PG8_SA(1, 0), a3, voffA);
            PG8_BAR; PG8_WAIT_L(0); PG8_MMA(1, 0, At, B0); PG8_BAR; PG8_SCHED;
            PG8_STAGE(PG8_SB(1, 1), b3 + hstep, voffB);
            PG8_WAIT_V(6); PG8_BAR; PG8_MMA(1, 1, At, B1); PG8_BAR;
            }
        }
        if constexpr (ALIGN_EPI) { if (wr == 0) PG8_BAR; }
        if constexpr (!Epi::AFTER_DRAIN) { E(acc, cur, wr, wc, fr, fq); S.done(cur); }
        if (!has_next) break;
#pragma unroll
        for (int a = 0; a < 2; ++a)
#pragma unroll
            for (int b = 0; b < 2; ++b)
#pragma unroll
                for (int m = 0; m < 4; ++m)
#pragma unroll
                    for (int n = 0; n < 2; ++n) acc[a][b][m][n] = (f32x4){0.f, 0.f, 0.f, 0.f};
        cur = nxt; cA = nA; cB = nB; ++ui;
        if constexpr (ALIGN_EPI) { if (wr == 1) PG8_BAR; }
    }
    PG8_WAIT_V(0);
    if constexpr (!ALIGN_EPI) { if (wr == 0) PG8_BAR; }
    PG8_BAR;
    if constexpr (Epi::AFTER_DRAIN) { E.fused(acc, cur, wr, wc, fr, fq, lds, wid, lane); S.done(cur); }
#undef PG8_SA
#undef PG8_SB
#undef PG8_STAGE
#undef PG8_LDA
#undef PG8_LDB
#undef PG8_MMA
#undef PG8_WAIT_V
#undef PG8_WAIT_L
#undef PG8_BAR
#undef PG8_SCHED
}
}

#define GAS __attribute__((address_space(1)))
#define LAS __attribute__((address_space(3)))
typedef unsigned short bf16;
typedef unsigned v4u __attribute__((ext_vector_type(4)));
typedef float f32x4 __attribute__((ext_vector_type(4)));
typedef short bf16x8 __attribute__((ext_vector_type(8)));
typedef GAS unsigned gu32;
typedef GAS unsigned long long gu64;
#define RLX_AGENT __ATOMIC_RELAXED, __HIP_MEMORY_SCOPE_AGENT
#define LDS_WAIT() asm volatile("s_waitcnt lgkmcnt(0)" ::: "memory")
#define VM_WAIT() asm volatile("s_waitcnt vmcnt(0)" ::: "memory")
__device__ __forceinline__ unsigned long long rt() { return __builtin_amdgcn_s_memrealtime(); }
typedef float hw_f32x2 __attribute__((ext_vector_type(2))); typedef __bf16 hw_bf16x2 __attribute__((ext_vector_type(2)));
__device__ __forceinline__ unsigned pk2(float lo, float hi) { const hw_f32x2 v = {lo, hi}; return __builtin_bit_cast(unsigned, __builtin_convertvector(v, hw_bf16x2)); }
__device__ __forceinline__ unsigned f2bf(float f) { return pk2(f, 0.f) & 0xffffu; }

#define XB_TMO      128
#define XB_XCNT(j)  (256  + 64 * (j))
#define XB_XSUB(j)  (1280 + 64 * (j))
#define XB_XGEN(j)  (2304 + 64 * (j))
#define XB_TOP      3328
#define XB_TOPGEN   3392
#define XCD_BAR_WORDS 3456
#define XB_SPIN_CAP (1u << 21)

__device__ __forceinline__ unsigned xb_ld(unsigned* p)              { return __hip_atomic_load(p, __ATOMIC_RELAXED, __HIP_MEMORY_SCOPE_AGENT); }
__device__ __forceinline__ unsigned xb_add(unsigned* p, unsigned v) { return __hip_atomic_fetch_add(p, v, __ATOMIC_RELAXED, __HIP_MEMORY_SCOPE_AGENT); }
__device__ __forceinline__ unsigned xb_xcc_id() { return (unsigned)__builtin_amdgcn_s_getreg((3 << 11) | 20) & 0xFu; }
#define XB_SPIN(cond, bar) do { unsigned _sp = 0; while (cond) { __builtin_amdgcn_s_sleep(1); \
    if ((++_sp & 255u) == 0u) { if (xb_ld(&(bar)[XB_TMO])) break; if (_sp > XB_SPIN_CAP) { atomicAdd(&(bar)[XB_TMO], 1u); break; } } } } while (0)

struct XcdBarrier {
    unsigned* bar; unsigned x;
    volatile LAS unsigned* st;
};

__device__ __forceinline__ XcdBarrier xcd_barrier_post(unsigned* bar, volatile LAS unsigned* st) {
    XcdBarrier b; b.bar = bar; b.x = xb_xcc_id(); b.st = st;
    if (threadIdx.x == 0) (void)xb_add(&bar[XB_XCNT(b.x)], 1u);
    return b;
}
__device__ __forceinline__ void xcd_barrier_complete(unsigned* bar, unsigned x, unsigned& nloc, unsigned& nx) {
    const unsigned G = gridDim.x * gridDim.y * gridDim.z;
    unsigned sum, cnt, mine, sp = 0u;
    for (;;) {
        sum = 0u; cnt = 0u; mine = 0u;
#pragma unroll
        for (unsigned j = 0; j < 16; ++j) { const unsigned c = xb_ld(&bar[XB_XCNT(j)]); sum += c; cnt += (c > 0u) ? 1u : 0u; mine = (j == x) ? c : mine; }
        if (sum == G) break;
        __builtin_amdgcn_s_sleep(1);
        if ((++sp & 255u) == 0u) { if (xb_ld(&bar[XB_TMO])) break; if (sp > XB_SPIN_CAP) { atomicAdd(&bar[XB_TMO], 1u); break; } }
    }
    nloc = mine > 0u ? mine : 1u; nx = cnt > 0u ? cnt : 1u;
}

__device__ __forceinline__ void xcd_barrier(const XcdBarrier& b, const int wv) {
    asm volatile("s_waitcnt vmcnt(0)" ::: "memory");
    __syncthreads();
    int xb_lane; asm volatile("v_mbcnt_lo_u32_b32 %0, -1, 0\n\tv_mbcnt_hi_u32_b32 %0, -1, %0" : "=v"(xb_lane));
    if (wv == 0 && xb_lane == 0) {
        unsigned* bar = b.bar;
        __builtin_amdgcn_s_waitcnt(0);
        unsigned nloc = b.st[0], nx = b.st[1];
        if (nloc == 0u) { xcd_barrier_complete(bar, b.x, nloc, nx); b.st[0] = nloc; b.st[1] = nx; }
        const unsigned old = xb_add(&bar[XB_XSUB(b.x)], 1u);
        const unsigned gen = old / nloc;
        if (old + 1u == (gen + 1u) * nloc) {
            __builtin_amdgcn_fence(__ATOMIC_RELEASE, "agent");
            asm volatile("s_waitcnt vmcnt(0)" ::: "memory");
            const unsigned og = xb_add(&bar[XB_TOP], 1u);
            const unsigned tg = og / nx;
            if (og + 1u == (tg + 1u) * nx) xb_add(&bar[XB_TOPGEN], 1u);
            else XB_SPIN(xb_ld(&bar[XB_TOPGEN]) == tg, bar);
            __builtin_amdgcn_fence(__ATOMIC_ACQUIRE, "agent");
            xb_add(&bar[XB_XGEN(b.x)], 1u);
            asm volatile("s_waitcnt vmcnt(0)" ::: "memory");
        } else {
            XB_SPIN(xb_ld(&bar[XB_XGEN(b.x)]) == gen, bar);
            __builtin_amdgcn_fence(__ATOMIC_ACQUIRE, "agent");
            asm volatile("s_waitcnt vmcnt(0)" ::: "memory");
        }
    }
    __syncthreads();
}

#include <hip/hip_bf16.h>
#include <cmath>
namespace attn_body {
using bf16=__hip_bfloat16;
using bf16x8=__attribute__((ext_vector_type(8)))short;
using s16x4=__attribute__((ext_vector_type(4)))short;
using f32x16=__attribute__((ext_vector_type(16)))float;
using u32x4=__attribute__((ext_vector_type(4)))unsigned;
constexpr int D=64;
constexpr int NW=8,QBLK=32,QB=QBLK*NW,KVBLK=64;
constexpr int ATTN_UNIT_ROWS=QB;
__device__ __forceinline__ int crow(int r,int hi){return (r&3)+8*(r>>2)+4*hi;}
#define SBAR() __builtin_amdgcn_sched_barrier(0)
constexpr int NSLOT=3, SLOTB=8192;
constexpr int LDS_K=0, LDS_V=NSLOT*SLOTB, LDS_WS=2*NSLOT*SLOTB, LDS_OST=LDS_WS+NW*64*4, LDS_BYTES=LDS_OST+NW*4096;
constexpr float C2=0.125f*1.4426950408889634f;
__device__ __forceinline__ void glds16(const void*gsrc,unsigned lds_dst){unsigned keep;
  asm volatile("s_mov_b32 %0, m0\n\ts_mov_b32 m0, %2\n\ts_nop 0\n\tglobal_load_lds_dwordx4 %1, off\n\ts_mov_b32 m0, %0":"=&s"(keep):"v"(gsrc),"s"(lds_dst):"memory");}
__device__ __forceinline__ float max3f(float a,float b,float c){float r;asm("v_max3_f32 %0, %1, %2, %3":"=v"(r):"v"(a),"v"(b),"v"(c));return r;}
__device__ __forceinline__ float max2f(float a,float b){float r;asm("v_max_f32_e32 %0, %1, %2":"=v"(r):"v"(a),"v"(b));return r;}
__device__ __forceinline__ float fadd_s(float a,float b){float r;asm("v_add_f32_e32 %0, %1, %2":"=v"(r):"v"(a),"v"(b));return r;}
__device__ __forceinline__ float fsub_s(float a,float b){float r;asm("v_sub_f32_e32 %0, %1, %2":"=v"(r):"v"(a),"v"(b));return r;}
typedef float f32x2_t __attribute__((ext_vector_type(2))); typedef __bf16 bf16x2_t __attribute__((ext_vector_type(2)));
__device__ __forceinline__ unsigned cvtpk_s(float lo,float hi){f32x2_t v={lo,hi};bf16x2_t b=__builtin_convertvector(v,bf16x2_t);return __builtin_bit_cast(unsigned,b);}
#define WAIT_BAR(N) asm volatile("s_waitcnt vmcnt(" #N ") lgkmcnt(0)\n\ts_barrier":::"memory")

__device__ __forceinline__ void qkt(f32x16&p0,f32x16&p1,const char*Kslot,const bf16x8*qr,const f32x16&negm,int r32,int hi){
  const char*kb=Kslot+hi*1024+r32*16;
  #pragma unroll
  for(int d0=0;d0<4;++d0){
    const bf16x8 b0=*reinterpret_cast<const bf16x8*>(kb+d0*2048);
    const bf16x8 b1=*reinterpret_cast<const bf16x8*>(kb+d0*2048+512);
    if(d0==0){p0=__builtin_amdgcn_mfma_f32_32x32x16_bf16(b0,qr[0],negm,0,0,0);p1=__builtin_amdgcn_mfma_f32_32x32x16_bf16(b1,qr[0],negm,0,0,0);}
    else{p0=__builtin_amdgcn_mfma_f32_32x32x16_bf16(b0,qr[d0],p0,0,0,0);p1=__builtin_amdgcn_mfma_f32_32x32x16_bf16(b1,qr[d0],p1,0,0,0);}}
}
typedef __attribute__((address_space(3))) const char* lds_cptr;
typedef short v4i16_t __attribute__((ext_vector_type(4)));
__device__ __forceinline__ void kload8(bf16x8*kf,lds_cptr kp){
  kf[0]=*(const __attribute__((address_space(3))) bf16x8*)(kp);      kf[1]=*(const __attribute__((address_space(3))) bf16x8*)(kp+512);
  kf[2]=*(const __attribute__((address_space(3))) bf16x8*)(kp+2048); kf[3]=*(const __attribute__((address_space(3))) bf16x8*)(kp+2560);
  kf[4]=*(const __attribute__((address_space(3))) bf16x8*)(kp+4096); kf[5]=*(const __attribute__((address_space(3))) bf16x8*)(kp+4608);
  kf[6]=*(const __attribute__((address_space(3))) bf16x8*)(kp+6144); kf[7]=*(const __attribute__((address_space(3))) bf16x8*)(kp+6656);
}
__device__ __forceinline__ void kload2(bf16x8*kf,lds_cptr kp,int j){ kf[2*j]=*(const __attribute__((address_space(3))) bf16x8*)(kp+j*2048); kf[2*j+1]=*(const __attribute__((address_space(3))) bf16x8*)(kp+j*2048+512); }
__device__ __forceinline__ s16x4 vtr(lds_cptr p){ return __builtin_bit_cast(s16x4,__builtin_amdgcn_ds_read_tr16_b64_v4i16((__attribute__((address_space(3))) v4i16_t*)p)); }
__device__ __forceinline__ float rowmax(const f32x16&p0,const f32x16&p1){
  float a=max3f(p0[0],p0[1],p1[0]),b=max3f(p0[2],p0[3],p1[1]);a=max3f(a,p1[2],p1[3]);
  #pragma unroll
  for(int r=4;r<16;r+=4){a=max3f(a,p0[r],p0[r+1]);b=max3f(b,p0[r+2],p0[r+3]);a=max3f(a,p1[r],p1[r+1]);b=max3f(b,p1[r+2],p1[r+3]);}
  const float m=max2f(a,b);
  auto rr=__builtin_amdgcn_permlane32_swap(__float_as_uint(m),__float_as_uint(m),false,false);
  return max2f(__uint_as_float(rr[0]),__uint_as_float(rr[1]));
}
__device__ __forceinline__ void pv(f32x16*o,int vb,bf16x8 pa0,bf16x8 pa1,bf16x8 pa2,bf16x8 pa3){
  #pragma unroll
  for(int d0=0;d0<2;++d0){s16x4 lo[4],hi[4];
    #pragma unroll
    for(int ks=0;ks<4;++ks){
      asm volatile("ds_read_b64_tr_b16 %0,%1 offset:%c2":"=&v"(lo[ks]):"v"(vb),"i"(d0*4096+ks*1024):"memory");
      asm volatile("ds_read_b64_tr_b16 %0,%1 offset:%c2":"=&v"(hi[ks]):"v"(vb),"i"(d0*4096+ks*1024+512):"memory");}
    asm volatile("s_waitcnt lgkmcnt(0)":::"memory");SBAR();
    #define PK(k) (bf16x8){lo[k][0],lo[k][1],lo[k][2],lo[k][3],hi[k][0],hi[k][1],hi[k][2],hi[k][3]}
    o[d0]=__builtin_amdgcn_mfma_f32_32x32x16_bf16(pa0,PK(0),o[d0],0,0,0);
    o[d0]=__builtin_amdgcn_mfma_f32_32x32x16_bf16(pa1,PK(1),o[d0],0,0,0);
    o[d0]=__builtin_amdgcn_mfma_f32_32x32x16_bf16(pa2,PK(2),o[d0],0,0,0);
    o[d0]=__builtin_amdgcn_mfma_f32_32x32x16_bf16(pa3,PK(3),o[d0],0,0,0);
    #undef PK
  }
}

#ifndef ATTN_STORE16
#define ATTN_STORE16(p,v) (*(u32x4*)(p)=(v))
#endif
template<int THRL> __device__ __forceinline__ void attn_unit(const int tid_in,const bf16*Qu,int qpitch,const bf16*__restrict__ Kh,const bf16*__restrict__ Vh,int kvpitch,bf16*Ou,int opitch,const int NT,char*shm){
  int tid_=tid_in; asm volatile("":"+v"(tid_));
  const int tid=tid_,lane=tid&63,r32=lane&31,hi=lane>>5; const int wid=__builtin_amdgcn_readfirstlane(tid>>6);
  const bf16*Qw=Qu+(long)(wid*QBLK)*qpitch;
  const unsigned lds0=(unsigned)(uintptr_t)shm;
  float*wsf=(float*)(shm+LDS_WS)+wid*64;
  const bf16*ksrc=Kh+(long)lane*kvpitch+wid*8;
  const bf16*vsrc=Vh+(long)(16*(wid&3)+(lane>>2))*kvpitch+(wid>>2)*32+(lane&3)*8;
  const unsigned kdst=lds0+LDS_K+wid*1024, vdst=lds0+LDS_V+wid*1024;
  #define DMA_K(t,slot) glds16(ksrc+(long)(t)*KVBLK*kvpitch,(unsigned)__builtin_amdgcn_readfirstlane(kdst+(slot)))
  #define DMA_V(t,slot) glds16(vsrc+(long)(t)*KVBLK*kvpitch,(unsigned)__builtin_amdgcn_readfirstlane(vdst+(slot)))
  const int vb0=(int)(lds0+LDS_V)+((lane>>4)&1)*32+(lane&3)*8+(4*hi+((lane&15)>>2))*64;
  const char*Kbase=shm+LDS_K; bf16x8 kf[8];
  const lds_cptr shm3=(lds_cptr)shm; const lds_cptr kp0=shm3+LDS_K+hi*1024+r32*16; const lds_cptr vp0=shm3+LDS_V+((lane>>4)&1)*32+(lane&3)*8+(4*hi+((lane&15)>>2))*64;
  DMA_K(0,0);DMA_V(0,0);DMA_K(1,SLOTB);
  bf16x8 qr[4];
  #pragma unroll
  for(int d0=0;d0<4;++d0)qr[d0]=*reinterpret_cast<const bf16x8*>(&Qw[(long)r32*qpitch+d0*16+hi*8]);
  float mhat=0.f,l_reg=0.f;f32x16 o[2];o[0]=f32x16{};o[1]=f32x16{};f32x16 negm=f32x16{};asm volatile("":"+v"(negm));
  #define CMASK(P0,P1,t) do{}while(0)
  bool resc=false;
  #define START(P0,P1) do{ const float rm=rowmax(P0,P1); resc=false; \
    { const float dl=rm; mhat=fadd_s(mhat,dl); \
      _Pragma("unroll") for(int r=0;r<16;++r){P0[r]=fsub_s(P0[r],dl);P1[r]=fsub_s(P1[r],dl);} \
      _Pragma("unroll") for(int r=0;r<16;++r)negm[r]=-mhat; asm volatile("":"+v"(negm)); } \
    _Pragma("unroll") for(int r=0;r<16;++r)P0[r]=__builtin_amdgcn_exp2f(P0[r]); }while(0)
  #define RESC() do{ if(resc){ asm volatile("s_waitcnt lgkmcnt(0)":::"memory"); \
      _Pragma("unroll") for(int d_=0;d_<2;++d_) _Pragma("unroll") for(int r=0;r<16;++r)o[d_][r]*=wsf[crow(r,hi)]; } }while(0)
  f32x16 pA0,pA1,pB0,pB1;
  int sl_prev=0,sl_cur=0,sl_next=SLOTB;
  #define ROT() do{sl_prev=sl_cur;sl_cur=sl_next;sl_next=(sl_next==(NSLOT-1)*SLOTB)?0:sl_next+SLOTB;}while(0)
  DMA_K(2,2*SLOTB);
  WAIT_BAR(3);
  qkt(pA0,pA1,Kbase,qr,negm,r32,hi);asm volatile("s_nop 15\n\ts_nop 7":"+v"(pA0),"+v"(pA1));CMASK(pA0,pA1,0);
  START(pA0,pA1);
  _Pragma("unroll") for(int r=0;r<16;++r)pA1[r]=__builtin_amdgcn_exp2f(pA1[r]);
  WAIT_BAR(0);
  DMA_K(3,0);DMA_V(1,SLOTB);
  ROT();
  kload8(kf,kp0+sl_cur);
  WAIT_BAR(2);
  s16x4 vlo[8],vhi[8]; u32x4 pw0,pw1,pw2,pw3;
  #define PKW(P,B) cvtpk_s(P[B],P[B+1])
  #define PAF(k) __builtin_bit_cast(bf16x8,pw##k)
  #define VFR(i) (bf16x8){vlo[i][0],vlo[i][1],vlo[i][2],vlo[i][3],vhi[i][0],vhi[i][1],vhi[i][2],vhi[i][3]}
  #define PIN(x) asm volatile("":"+v"(x))
  #define MX3(a,b,c) __builtin_fmaxf(__builtin_fmaxf((a),(b)),(c))
  #define GAPA(MF,A0,A1,A2,A3,W0,W1,PW) do{ MF; sacc+=A0; sacc+=A1; sacc+=A2; sacc+=A3; PIN(sacc); W0; W1; PIN(PW); SBAR(); }while(0)
  #define EX(v) __builtin_amdgcn_exp2f(v)
  #define GAPB(MF,X,B) do{ MF; X[B]=EX(X[B]); X[B+1]=EX(X[B+1]); X[B+2]=EX(X[B+2]); X[B+3]=EX(X[B+3]); PIN(X); SBAR(); }while(0)
  #define VRD(i) do{ vlo[i]=vtr(vp_+(((i)>>2)*4096+((i)&3)*1024)); vhi[i]=vtr(vp_+(((i)>>2)*4096+((i)&3)*1024+512)); }while(0)
  #define KRD(G,j) do{ if(G){ kload2(kf,kp0+sl_next,j); SBAR(); } }while(0)
  #define STEP(C0,C1,P0,P1,t,GK,GV,GL) do{ SBAR(); \
    const lds_cptr vp_=vp0+sl_prev; \
    VRD(0); SBAR(); float sacc=(P0[0]+P0[1]); \
    GAPA(C0=__builtin_amdgcn_mfma_f32_32x32x16_bf16(kf[0],qr[0],negm,0,0,0), P0[2],P0[3],P0[4],P0[5],     pw0[0]=PKW(P0,0), pw0[1]=PKW(P0,2), pw0); \
    VRD(4); SBAR(); GAPA(C1=__builtin_amdgcn_mfma_f32_32x32x16_bf16(kf[1],qr[0],negm,0,0,0), P0[6],P0[7],P0[8],P0[9],     pw0[2]=PKW(P0,4), pw0[3]=PKW(P0,6), pw0); \
    VRD(1); SBAR(); GAPA(C0=__builtin_amdgcn_mfma_f32_32x32x16_bf16(kf[2],qr[1],C0,0,0,0),   P0[10],P0[11],P0[12],P0[13], pw1[0]=PKW(P0,8), pw1[1]=PKW(P0,10), pw1); \
    VRD(5); SBAR(); GAPA(C1=__builtin_amdgcn_mfma_f32_32x32x16_bf16(kf[3],qr[1],C1,0,0,0),   P0[14],P0[15],P1[0],P1[1],   pw1[2]=PKW(P0,12),pw1[3]=PKW(P0,14), pw1); \
    VRD(2); SBAR(); GAPA(C0=__builtin_amdgcn_mfma_f32_32x32x16_bf16(kf[4],qr[2],C0,0,0,0),   P1[2],P1[3],P1[4],P1[5],     pw2[0]=PKW(P1,0), pw2[1]=PKW(P1,2), pw2); \
    VRD(6); SBAR(); GAPA(C1=__builtin_amdgcn_mfma_f32_32x32x16_bf16(kf[5],qr[2],C1,0,0,0),   P1[6],P1[7],P1[8],P1[9],     pw2[2]=PKW(P1,4), pw2[3]=PKW(P1,6), pw2); \
    VRD(3); SBAR(); GAPA(C0=__builtin_amdgcn_mfma_f32_32x32x16_bf16(kf[6],qr[3],C0,0,0,0),   P1[10],P1[11],P1[12],P1[13], pw3[0]=PKW(P1,8), pw3[1]=PKW(P1,10), pw3); \
    VRD(7); SBAR(); GAPA(C1=__builtin_amdgcn_mfma_f32_32x32x16_bf16(kf[7],qr[3],C1,0,0,0),   P1[14],P1[15],0.f,0.f,       pw3[2]=PKW(P1,12),pw3[3]=PKW(P1,14), pw3); \
    l_reg+=sacc; \
    if(GK){DMA_K((t)+3,sl_cur);} if(GV){DMA_V((t)+1,sl_next);} \
    CMASK(C0,C1,t); \
    { float a=MX3(C0[0],C0[1],C1[0]),b=MX3(C0[2],C0[3],C1[1]); a=MX3(a,C1[2],C1[3]); \
      _Pragma("unroll") for(int r=4;r<16;r+=4){a=MX3(a,C0[r],C0[r+1]);b=MX3(b,C0[r+2],C0[r+3]);a=MX3(a,C1[r],C1[r+1]);b=MX3(b,C1[r+2],C1[r+3]);} \
      float rm=__builtin_fmaxf(a,b); { auto rr=__builtin_amdgcn_permlane32_swap(__float_as_uint(rm),__float_as_uint(rm),false,false); rm=__builtin_fmaxf(__uint_as_float(rr[0]),__uint_as_float(rr[1])); } \
      resc=false; \
      if(__builtin_expect(__any(rm>(float)THRL),0)){ const float dl=__builtin_fmaxf(rm,0.f); mhat+=dl; \
        _Pragma("unroll") for(int r=0;r<16;++r){C0[r]-=dl;C1[r]-=dl;} \
        _Pragma("unroll") for(int r=0;r<16;++r)negm[r]=-mhat; asm volatile("":"+v"(negm)); \
        const float f=__builtin_amdgcn_exp2f(-dl); l_reg*=f; if(hi==0)wsf[r32]=f; resc=true; } } \
    SBAR(); \
    GAPB(o[0]=__builtin_amdgcn_mfma_f32_32x32x16_bf16(PAF(0),VFR(0),o[0],0,0,0), C0,0); \
    GAPB(o[1]=__builtin_amdgcn_mfma_f32_32x32x16_bf16(PAF(0),VFR(4),o[1],0,0,0), C0,4); \
    KRD(GL,0); GAPB(o[0]=__builtin_amdgcn_mfma_f32_32x32x16_bf16(PAF(1),VFR(1),o[0],0,0,0), C0,8); \
    KRD(GL,1); GAPB(o[1]=__builtin_amdgcn_mfma_f32_32x32x16_bf16(PAF(1),VFR(5),o[1],0,0,0), C0,12); \
    KRD(GL,2); GAPB(o[0]=__builtin_amdgcn_mfma_f32_32x32x16_bf16(PAF(2),VFR(2),o[0],0,0,0), C1,0); \
    KRD(GL,3); GAPB(o[1]=__builtin_amdgcn_mfma_f32_32x32x16_bf16(PAF(2),VFR(6),o[1],0,0,0), C1,4); \
    GAPB(o[0]=__builtin_amdgcn_mfma_f32_32x32x16_bf16(PAF(3),VFR(3),o[0],0,0,0), C1,8); \
    GAPB(o[1]=__builtin_amdgcn_mfma_f32_32x32x16_bf16(PAF(3),VFR(7),o[1],0,0,0), C1,12); \
    }while(0)
  int t=1;
  #undef CMASK
  #define CMASK(P0,P1,t) do{}while(0)
  for(;t+5<NT;t+=2){
    STEP(pB0,pB1,pA0,pA1,t,true,true,true);     WAIT_BAR(2); RESC(); ROT();
    STEP(pA0,pA1,pB0,pB1,t+1,true,true,true);   WAIT_BAR(2); RESC(); ROT();
  }
  #undef CMASK
  #define CMASK(P0,P1,t) do{}while(0)
  #define ENDW(tt) do{ if((tt)+3<NT){WAIT_BAR(2);} else if((tt)+2<NT){WAIT_BAR(1);} else {WAIT_BAR(0);} }while(0)
  for(;t+1<NT;t+=2){
    STEP(pB0,pB1,pA0,pA1,t,(t+3<NT),(t+1<NT),(t+1<NT));       ENDW(t);   RESC(); ROT();
    STEP(pA0,pA1,pB0,pB1,t+1,(t+4<NT),(t+2<NT),(t+2<NT));     ENDW(t+1); RESC(); ROT();
  }
  STEP(pB0,pB1,pA0,pA1,NT-1,false,false,false); RESC();
  { float sacc=pB0[0]+pB0[1]; _Pragma("unroll") for(int r=2;r<16;++r)sacc+=pB0[r]; _Pragma("unroll") for(int r=0;r<16;++r)sacc+=pB1[r]; l_reg+=sacc;
    pw0=(u32x4){PKW(pB0,0),PKW(pB0,2),PKW(pB0,4),PKW(pB0,6)};pw1=(u32x4){PKW(pB0,8),PKW(pB0,10),PKW(pB0,12),PKW(pB0,14)};pw2=(u32x4){PKW(pB1,0),PKW(pB1,2),PKW(pB1,4),PKW(pB1,6)};pw3=(u32x4){PKW(pB1,8),PKW(pB1,10),PKW(pB1,12),PKW(pB1,14)};
    SBAR(); pv(o,vb0+sl_cur,PAF(0),PAF(1),PAF(2),PAF(3)); }
  #undef PKW
  #undef PAF
  #undef VFR
  #undef PIN
  #undef MX3
  #undef GAPA
  #undef GAPB
  #undef EX
  #undef VRD
  #undef KRD
  #undef STEP
  #undef ENDW
  {auto rr=__builtin_amdgcn_permlane32_swap(__float_as_uint(l_reg),__float_as_uint(l_reg),false,false);l_reg=__uint_as_float(rr[0])+__uint_as_float(rr[1]);}
  if(hi==0)wsf[32+r32]=l_reg;asm volatile("s_waitcnt lgkmcnt(0)":::"memory");
  float rli[16];
  #pragma unroll
  for(int r=0;r<16;++r)rli[r]=__builtin_amdgcn_rcpf(wsf[32+crow(r,hi)]);
  bf16*Ow=Ou+(long)(wid*QBLK)*opitch;
  { bf16*stg=(bf16*)(shm+LDS_OST)+wid*2048;
    #pragma unroll
    for(int r=0;r<16;++r){const int orow=crow(r,hi);
      #pragma unroll
      for(int d0=0;d0<2;++d0)stg[orow*64+d0*32+r32]=__float2bfloat16(o[d0][r]*rli[r]);}
    asm volatile("s_waitcnt lgkmcnt(0)":::"memory");
    #pragma unroll
    for(int i=0;i<4;++i){const int row=i*8+(lane>>3),ch=lane&7; const u32x4 v=*(const u32x4*)(stg+row*64+ch*8); ATTN_STORE16(Ow+(long)row*opitch+ch*8,v);} }
  asm volatile("s_waitcnt lgkmcnt(0)\n\ts_barrier":::"memory");
  #undef DMA_K
  #undef DMA_V
  #undef CMASK
  #undef START
  #undef RESC
  #undef ROT
}
__device__ __forceinline__ void pv128(f32x16*o,int vb,bf16x8 pa0,bf16x8 pa1,bf16x8 pa2,bf16x8 pa3){
  #pragma unroll
  for(int d0=0;d0<4;++d0){s16x4 lo[4],hi[4];
    #pragma unroll
    for(int ks=0;ks<4;++ks){
      asm volatile("ds_read_b64_tr_b16 %0,%1 offset:%c2":"=&v"(lo[ks]):"v"(vb),"i"(d0*4096+ks*1024):"memory");
      asm volatile("ds_read_b64_tr_b16 %0,%1 offset:%c2":"=&v"(hi[ks]):"v"(vb),"i"(d0*4096+ks*1024+512):"memory");}
    asm volatile("s_waitcnt lgkmcnt(0)":::"memory");SBAR();
    #define PK(k) (bf16x8){lo[k][0],lo[k][1],lo[k][2],lo[k][3],hi[k][0],hi[k][1],hi[k][2],hi[k][3]}
    o[d0]=__builtin_amdgcn_mfma_f32_32x32x16_bf16(pa0,PK(0),o[d0],0,0,0);
    o[d0]=__builtin_amdgcn_mfma_f32_32x32x16_bf16(pa1,PK(1),o[d0],0,0,0);
    o[d0]=__builtin_amdgcn_mfma_f32_32x32x16_bf16(pa2,PK(2),o[d0],0,0,0);
    o[d0]=__builtin_amdgcn_mfma_f32_32x32x16_bf16(pa3,PK(3),o[d0],0,0,0);
    #undef PK
  }
}
constexpr int LDS_V128=NSLOT*SLOTB, LDS_WS128=LDS_V128+NSLOT*2*SLOTB, LDS_OST128=LDS_WS128+NW*64*4, LDS_BYTES128=LDS_OST128+NW*8192;
template<int THRL> __device__ __forceinline__ void attn_unit128(const int tid_in,const bf16*Qu,int qpitch,const bf16*__restrict__ Kh,const bf16*__restrict__ Vh,int kvpitch,bf16*Ou,int opitch,const int NT,char*shm){
  int tid_=tid_in; asm volatile("":"+v"(tid_));
  const int tid=tid_,lane=tid&63,r32=lane&31,hi=lane>>5; const int wid=__builtin_amdgcn_readfirstlane(tid>>6);
  const bf16*Qw=Qu+(long)(wid*QBLK)*qpitch;
  const unsigned lds0=(unsigned)(uintptr_t)shm;
  float*wsf=(float*)(shm+LDS_WS128)+wid*64;
  const bf16*ksrc=Kh+(long)lane*kvpitch+wid*8;
  const bf16*vsrc=Vh+(long)(16*(wid&3)+(lane>>2))*kvpitch+(wid>>2)*32+(lane&3)*8;
  const unsigned kdst=lds0+LDS_K+wid*1024, vdst=lds0+LDS_V128+wid*1024;
  #define DMA_K(t,slot) glds16(ksrc+(long)(t)*KVBLK*kvpitch,(unsigned)__builtin_amdgcn_readfirstlane(kdst+(slot)))
  #define DMA_V(t,slot) do{ glds16(vsrc+(long)(t)*KVBLK*kvpitch,(unsigned)__builtin_amdgcn_readfirstlane(vdst+2*(slot))); glds16(vsrc+(long)(t)*KVBLK*kvpitch+64,(unsigned)__builtin_amdgcn_readfirstlane(vdst+8192+2*(slot))); }while(0)
  const int vb0=(int)(lds0+LDS_V128)+((lane>>4)&1)*32+(lane&3)*8+(4*hi+((lane&15)>>2))*64;
  const char*Kbase=shm+LDS_K; bf16x8 kf[8];
  const lds_cptr shm3=(lds_cptr)shm; const lds_cptr kp0=shm3+LDS_K+hi*1024+r32*16; const lds_cptr vp0=shm3+LDS_V128+((lane>>4)&1)*32+(lane&3)*8+(4*hi+((lane&15)>>2))*64;
  DMA_K(0,0);DMA_V(0,0);DMA_K(1,SLOTB);
  bf16x8 qr[4];
  #pragma unroll
  for(int d0=0;d0<4;++d0)qr[d0]=*reinterpret_cast<const bf16x8*>(&Qw[(long)r32*qpitch+d0*16+hi*8]);
  float mhat=0.f,l_reg=0.f;f32x16 o[4];o[0]=f32x16{};o[1]=f32x16{};o[2]=f32x16{};o[3]=f32x16{};f32x16 negm=f32x16{};asm volatile("":"+v"(negm));
  #define CMASK(P0,P1,t) do{}while(0)
  bool resc=false;
  #define START(P0,P1) do{ const float rm=rowmax(P0,P1); resc=false; \
    { const float dl=rm; mhat=fadd_s(mhat,dl); \
      _Pragma("unroll") for(int r=0;r<16;++r){P0[r]=fsub_s(P0[r],dl);P1[r]=fsub_s(P1[r],dl);} \
      _Pragma("unroll") for(int r=0;r<16;++r)negm[r]=-mhat; asm volatile("":"+v"(negm)); } \
    _Pragma("unroll") for(int r=0;r<16;++r)P0[r]=__builtin_amdgcn_exp2f(P0[r]); }while(0)
  #define RESC() do{ if(resc){ asm volatile("s_waitcnt lgkmcnt(0)":::"memory"); \
      _Pragma("unroll") for(int d_=0;d_<4;++d_) _Pragma("unroll") for(int r=0;r<16;++r)o[d_][r]*=wsf[crow(r,hi)]; } }while(0)
  f32x16 pA0,pA1,pB0,pB1;
  int sl_prev=0,sl_cur=0,sl_next=SLOTB;
  #define ROT() do{sl_prev=sl_cur;sl_cur=sl_next;sl_next=(sl_next==(NSLOT-1)*SLOTB)?0:sl_next+SLOTB;}while(0)
  DMA_K(2,2*SLOTB);
  WAIT_BAR(4);
  qkt(pA0,pA1,Kbase,qr,negm,r32,hi);asm volatile("s_nop 15\n\ts_nop 7":"+v"(pA0),"+v"(pA1));CMASK(pA0,pA1,0);
  START(pA0,pA1);
  _Pragma("unroll") for(int r=0;r<16;++r)pA1[r]=__builtin_amdgcn_exp2f(pA1[r]);
  WAIT_BAR(0);
  DMA_K(3,0);DMA_V(1,SLOTB);
  ROT();
  kload8(kf,kp0+sl_cur);
  WAIT_BAR(3);
  s16x4 vbl[3],vbh[3]; u32x4 pw0,pw1,pw2,pw3;
  #define PKW(P,B) cvtpk_s(P[B],P[B+1])
  #define PAF(k) __builtin_bit_cast(bf16x8,pw##k)
  #define VFB(s) (bf16x8){vbl[s][0],vbl[s][1],vbl[s][2],vbl[s][3],vbh[s][0],vbh[s][1],vbh[s][2],vbh[s][3]}
  #define PIN(x) asm volatile("":"+v"(x))
  #define MX3(a,b,c) __builtin_fmaxf(__builtin_fmaxf((a),(b)),(c))
  #define GAPA(MF,A0,A1,A2,A3,W0,W1,PW) do{ MF; sacc+=A0; sacc+=A1; sacc+=A2; sacc+=A3; PIN(sacc); W0; W1; PIN(PW); SBAR(); }while(0)
  #define EX(v) __builtin_amdgcn_exp2f(v)
  #define VRD3(s,i) do{ vbl[s]=vtr(vp_+(((i)&3)*4096+((i)>>2)*1024)); vbh[s]=vtr(vp_+(((i)&3)*4096+((i)>>2)*1024+512)); }while(0)
  #define GAPB(i,X,B) do{ o[(i)&3]=__builtin_amdgcn_mfma_f32_32x32x16_bf16(PAFI((i)>>2),VFB((i)%3),o[(i)&3],0,0,0); if((i)+2<16){VRD3(((i)+2)%3,(i)+2);} X[B]=EX(X[B]); X[B+1]=EX(X[B+1]); PIN(X); SBAR(); }while(0)
  #define PAFI(k) ((k)==0?PAF(0):(k)==1?PAF(1):(k)==2?PAF(2):PAF(3))
  #define KRD(G,j) do{ if(G){ kload2(kf,kp0+sl_next,j); SBAR(); } }while(0)
  #define STEP(C0,C1,P0,P1,t,GK,GV,GL) do{ SBAR(); \
    const lds_cptr vp_=vp0+2*sl_prev; \
    float sacc=(P0[0]+P0[1]); \
    GAPA(C0=__builtin_amdgcn_mfma_f32_32x32x16_bf16(kf[0],qr[0],negm,0,0,0), P0[2],P0[3],P0[4],P0[5],     pw0[0]=PKW(P0,0), pw0[1]=PKW(P0,2), pw0); \
    GAPA(C1=__builtin_amdgcn_mfma_f32_32x32x16_bf16(kf[1],qr[0],negm,0,0,0), P0[6],P0[7],P0[8],P0[9],     pw0[2]=PKW(P0,4), pw0[3]=PKW(P0,6), pw0); \
    GAPA(C0=__builtin_amdgcn_mfma_f32_32x32x16_bf16(kf[2],qr[1],C0,0,0,0),   P0[10],P0[11],P0[12],P0[13], pw1[0]=PKW(P0,8), pw1[1]=PKW(P0,10), pw1); \
    GAPA(C1=__builtin_amdgcn_mfma_f32_32x32x16_bf16(kf[3],qr[1],C1,0,0,0),   P0[14],P0[15],P1[0],P1[1],   pw1[2]=PKW(P0,12),pw1[3]=PKW(P0,14), pw1); \
    GAPA(C0=__builtin_amdgcn_mfma_f32_32x32x16_bf16(kf[4],qr[2],C0,0,0,0),   P1[2],P1[3],P1[4],P1[5],     pw2[0]=PKW(P1,0), pw2[1]=PKW(P1,2), pw2); \
    GAPA(C1=__builtin_amdgcn_mfma_f32_32x32x16_bf16(kf[5],qr[2],C1,0,0,0),   P1[6],P1[7],P1[8],P1[9],     pw2[2]=PKW(P1,4), pw2[3]=PKW(P1,6), pw2); \
    VRD3(0,0); SBAR(); GAPA(C0=__builtin_amdgcn_mfma_f32_32x32x16_bf16(kf[6],qr[3],C0,0,0,0),   P1[10],P1[11],P1[12],P1[13], pw3[0]=PKW(P1,8), pw3[1]=PKW(P1,10), pw3); \
    VRD3(1,1); SBAR(); GAPA(C1=__builtin_amdgcn_mfma_f32_32x32x16_bf16(kf[7],qr[3],C1,0,0,0),   P1[14],P1[15],0.f,0.f,       pw3[2]=PKW(P1,12),pw3[3]=PKW(P1,14), pw3); \
    l_reg+=sacc; \
    if(GK){DMA_K((t)+3,sl_cur);} if(GV){DMA_V((t)+1,sl_next);} \
    { float a=MX3(C0[0],C0[1],C1[0]),b=MX3(C0[2],C0[3],C1[1]); a=MX3(a,C1[2],C1[3]); \
      _Pragma("unroll") for(int r=4;r<16;r+=4){a=MX3(a,C0[r],C0[r+1]);b=MX3(b,C0[r+2],C0[r+3]);a=MX3(a,C1[r],C1[r+1]);b=MX3(b,C1[r+2],C1[r+3]);} \
      float rm=__builtin_fmaxf(a,b); { auto rr=__builtin_amdgcn_permlane32_swap(__float_as_uint(rm),__float_as_uint(rm),false,false); rm=__builtin_fmaxf(__uint_as_float(rr[0]),__uint_as_float(rr[1])); } \
      resc=false; \
      if(__builtin_expect(__any(rm>(float)THRL),0)){ const float dl=__builtin_fmaxf(rm,0.f); mhat+=dl; \
        _Pragma("unroll") for(int r=0;r<16;++r){C0[r]-=dl;C1[r]-=dl;} \
        _Pragma("unroll") for(int r=0;r<16;++r)negm[r]=-mhat; asm volatile("":"+v"(negm)); \
        const float f=__builtin_amdgcn_exp2f(-dl); l_reg*=f; if(hi==0)wsf[r32]=f; resc=true; } } \
    SBAR(); \
    GAPB(0,C0,0); GAPB(1,C0,2); GAPB(2,C0,4); GAPB(3,C0,6); \
    KRD(GL,0); GAPB(4,C0,8); GAPB(5,C0,10); KRD(GL,1); GAPB(6,C0,12); GAPB(7,C0,14); \
    KRD(GL,2); GAPB(8,C1,0); GAPB(9,C1,2); KRD(GL,3); GAPB(10,C1,4); GAPB(11,C1,6); \
    GAPB(12,C1,8); GAPB(13,C1,10); GAPB(14,C1,12); GAPB(15,C1,14); \
    }while(0)
  int t=1;
  #undef CMASK
  #define CMASK(P0,P1,t) do{}while(0)
  for(;t+5<NT;t+=2){
    STEP(pB0,pB1,pA0,pA1,t,true,true,true);     WAIT_BAR(3); RESC(); ROT();
    STEP(pA0,pA1,pB0,pB1,t+1,true,true,true);   WAIT_BAR(3); RESC(); ROT();
  }
  #undef CMASK
  #define CMASK(P0,P1,t) do{}while(0)
  #define ENDW(tt) do{ if((tt)+3<NT){WAIT_BAR(3);} else if((tt)+2<NT){WAIT_BAR(2);} else {WAIT_BAR(0);} }while(0)
  for(;t+1<NT;t+=2){
    STEP(pB0,pB1,pA0,pA1,t,(t+3<NT),(t+1<NT),(t+1<NT));       ENDW(t);   RESC(); ROT();
    STEP(pA0,pA1,pB0,pB1,t+1,(t+4<NT),(t+2<NT),(t+2<NT));     ENDW(t+1); RESC(); ROT();
  }
  STEP(pB0,pB1,pA0,pA1,NT-1,false,false,false); RESC();
  { float sacc=pB0[0]+pB0[1]; _Pragma("unroll") for(int r=2;r<16;++r)sacc+=pB0[r]; _Pragma("unroll") for(int r=0;r<16;++r)sacc+=pB1[r]; l_reg+=sacc;
    pw0=(u32x4){PKW(pB0,0),PKW(pB0,2),PKW(pB0,4),PKW(pB0,6)};pw1=(u32x4){PKW(pB0,8),PKW(pB0,10),PKW(pB0,12),PKW(pB0,14)};pw2=(u32x4){PKW(pB1,0),PKW(pB1,2),PKW(pB1,4),PKW(pB1,6)};pw3=(u32x4){PKW(pB1,8),PKW(pB1,10),PKW(pB1,12),PKW(pB1,14)};
    SBAR(); pv128(o,vb0+2*sl_cur,PAF(0),PAF(1),PAF(2),PAF(3)); }
  #undef PKW
  #undef PAF
  #undef VFB
  #undef VRD3
  #undef PAFI
  #undef PIN
  #undef MX3
  #undef GAPA
  #undef GAPB
  #undef EX
  #undef KRD
  #undef STEP
  #undef ENDW
  {auto rr=__builtin_amdgcn_permlane32_swap(__float_as_uint(l_reg),__float_as_uint(l_reg),false,false);l_reg=__uint_as_float(rr[0])+__uint_as_float(rr[1]);}
  if(hi==0)wsf[32+r32]=l_reg;asm volatile("s_waitcnt lgkmcnt(0)":::"memory");
  float rli[16];
  #pragma unroll
  for(int r=0;r<16;++r)rli[r]=__builtin_amdgcn_rcpf(wsf[32+crow(r,hi)]);
  bf16*Ow=Ou+(long)(wid*QBLK)*opitch;
  { bf16*stg=(bf16*)(shm+LDS_OST128)+wid*4096;
    #pragma unroll
    for(int r=0;r<16;++r){const int orow=crow(r,hi);
      #pragma unroll
      for(int d0=0;d0<4;++d0)stg[orow*128+d0*32+r32]=__float2bfloat16(o[d0][r]*rli[r]);}
    asm volatile("s_waitcnt lgkmcnt(0)":::"memory");
    #pragma unroll
    for(int i=0;i<8;++i){const int row=i*4+(lane>>4),ch=lane&15; const u32x4 v=*(const u32x4*)(stg+row*128+ch*8); ATTN_STORE16(Ow+(long)row*opitch+ch*8,v);} }
  asm volatile("s_waitcnt lgkmcnt(0)\n\ts_barrier":::"memory");
  #undef DMA_K
  #undef DMA_V
  #undef CMASK
  #undef START
  #undef RESC
  #undef ROT
}
constexpr int ATTN_LDS_BYTES=LDS_BYTES;
#undef SBAR
#undef WAIT_BAR
}

constexpr int NB = 4, SEQ = 8192, CTXL = 256, PB = SEQ + CTXL, R = NB * PB, D = 1024, DFF = 4096, DEPTH = 4;
constexpr int NP_EV = 2560, NP_OD = 1536;
constexpr float EPS = 1e-6f;
constexpr float C2 = 0.125f * 1.4426950408889634f;
constexpr int EQ = 0, EK = 256, EVV = 512, EG = 1024, EGQ = 1536, EGK = 2048, EGV = 2176, ELR = 2304;
constexpr int ODQ = 0, ODK = 512, ODV = 1024;
constexpr int NWAVES = 8, NTHR = 512;
constexpr int LDS_BYTES = 163840, LDS_MISC = 163840 - 256;

constexpr size_t MiB = 1u << 20;
constexpr size_t WS_CTL = 0, CTL_ZERO_BYTES = 1 * MiB;
constexpr size_t WS_MOD = 1 * MiB;
constexpr size_t WS_TAB = 2 * MiB;
constexpr size_t WS_HID = 3 * MiB;
constexpr size_t WS_XB = 36 * MiB;
constexpr size_t WS_W = 12 * MiB, W_IN = 0, W_OUT = 6 * MiB, W_1 = 8 * MiB, W_2 = 16 * MiB;
constexpr size_t WS_A1 = 108 * MiB;
constexpr size_t WS_Y = 174 * MiB;
constexpr size_t WS_PH = 240 * MiB;
constexpr size_t WS_OGLA = WS_PH + 165 * MiB;
constexpr size_t WS_HF = WS_PH + 198 * MiB;
constexpr size_t WS_SLAB = 504 * MiB;
constexpr size_t WS_END = 512 * MiB;
constexpr int CW_BAR = 4096;

struct Args { const float* in[27]; float* out; unsigned char* ws; int ph_lo, ph_hi; };
enum { I_X = 0, I_C, I_CTX, I_CCTX, I_WADA, I_BADA, I_NORMG, I_W1, I_W2, I_EVWIN, I_EVWLR, I_EVBLR, I_EVGLAG, I_EVQKG, I_EVWOUT,
       I_ODWIN, I_ODCONVW, I_ODCONVB, I_FW1, I_FB1, I_FW2, I_FB2, I_FW3, I_HYBIAS, I_LAM, I_DIFFG, I_ODWOUT };

typedef const __attribute__((address_space(4))) Args* KA;
__device__ __forceinline__ KA ka_launder(KA a) { asm volatile("" : "+s"(a)); return a; }
__device__ __forceinline__ int otid_(int wv) { int l; asm volatile("v_mbcnt_lo_u32_b32 %0, -1, 0\n\tv_mbcnt_hi_u32_b32 %0, -1, %0" : "=v"(l)); return (wv << 6) | l; }
#define otid() otid_(wv_)
__device__ __forceinline__ int obx() { int b = blockIdx.x; asm volatile("" : "+s"(b)); return b; }
__device__ __forceinline__ float bf2f(bf16 v) { return __builtin_bit_cast(float, (unsigned)v << 16); }
template <int CTRL> __device__ __forceinline__ float dpp_mov(float v) { return __builtin_bit_cast(float, __builtin_amdgcn_update_dpp(0, __builtin_bit_cast(int, v), CTRL, 0xF, 0xF, false)); }
__device__ __forceinline__ float sum16(float v) {
    v += dpp_mov<0xB1>(v);
    v += dpp_mov<0x4E>(v);
    v += dpp_mov<0x141>(v);
    v += dpp_mov<0x140>(v);
    return v;
}
__device__ __forceinline__ float sum_rows4(float v) {
    const unsigned u = __builtin_bit_cast(unsigned, v);
    auto a = __builtin_amdgcn_permlane16_swap(u, u, false, false);
    const float w = __builtin_bit_cast(float, (unsigned)a[0]) + __builtin_bit_cast(float, (unsigned)a[1]);
    const unsigned uw = __builtin_bit_cast(unsigned, w);
    auto b = __builtin_amdgcn_permlane32_swap(uw, uw, false, false);
    return __builtin_bit_cast(float, (unsigned)b[0]) + __builtin_bit_cast(float, (unsigned)b[1]);
}
__device__ __forceinline__ float wave_sum(float v) { return sum_rows4(sum16(v)); }
__device__ __forceinline__ float rl(float v, int k) { return __builtin_bit_cast(float, __builtin_amdgcn_readlane(__builtin_bit_cast(int, v), k)); }
__device__ __forceinline__ float siluf(float v) { return v / (1.f + __expf(-v)); }
__device__ __forceinline__ float lam_init_of(int layer) { return 0.8f - 0.6f * expf(-0.3f * (float)layer); }
__device__ __forceinline__ const float* xin_ptr(KA a, int r) {
    const int b = r / PB, p = r - b * PB;
    return p < CTXL ? a->in[I_CTX] + (size_t)(b * CTXL + p) * D : a->in[I_X] + (size_t)(b * SEQ + (p - CTXL)) * D;
}
__device__ __forceinline__ int row_cls(int r) { const int b = r / PB, p = r - b * PB; return p < CTXL ? 4 : b; }

__device__ __forceinline__ void transpose_item(const float* W, int K, int N, int src_n0, bf16* WT, int dst_n0, int k0, LAS float* scr, int lane) {
    if (src_n0 < 0) {
#pragma unroll
        for (int j = 0; j < 4; ++j) { const int n = (lane >> 3) + 8 * j; *(GAS v4u*)(WT + (size_t)(dst_n0 + n) * K + k0 + 8 * (lane & 7)) = (v4u){0u, 0u, 0u, 0u}; }
        return;
    }
#pragma unroll 8
    for (int i = 0; i < 32; ++i) { const int kk = 2 * i + (lane >> 5); scr[kk * 33 + (lane & 31)] = W[(size_t)(k0 + kk) * N + src_n0 + (lane & 31)]; }
    LDS_WAIT(); asm volatile("" ::: "memory");
    const int c = lane & 7;
#pragma unroll
    for (int j = 0; j < 4; ++j) { const int n = (lane >> 3) + 8 * j; const LAS float* s = scr + (8 * c) * 33 + n;
        v4u o; o.x = pk2(s[0 * 33], s[1 * 33]); o.y = pk2(s[2 * 33], s[3 * 33]); o.z = pk2(s[4 * 33], s[5 * 33]); o.w = pk2(s[6 * 33], s[7 * 33]);
        *(GAS v4u*)(WT + (size_t)(dst_n0 + n) * K + k0 + 8 * c) = o; }
    LDS_WAIT(); asm volatile("" ::: "memory");
}
__device__ __forceinline__ int ev_src_col(int j) {
    if (j < 1536) return j;
    if (j < 2304) { const int tile = j >> 8, pb = (j & 255) >> 5, bj = pb >> 2, wc = pb & 3;
        return (tile << 8) + (2 * wc + bj) * 32 + 32; }
    if (j < 2336) return j - 768; return -1;
}
__device__ __forceinline__ void convert_layer_weights(int wv_, KA a, int l, int mask, LAS unsigned char* lds) {
    const int tid = otid(), lane = tid & 63, wave = __builtin_amdgcn_readfirstlane(tid >> 6);
    const int gw = blockIdx.x * NWAVES + wave, NGW = gridDim.x * NWAVES;
    LAS float* scr = (LAS float*)(lds + 49152 + wave * 8448);
    const int odd = l & 1, pr = l >> 1; unsigned char* wl = a->ws + WS_W;
    const int n_in = (mask & 1) ? (odd ? 16 * 96 : 16 * 80) : 0, n_o = (mask & 2) ? 16 * 32 : 0, n_1 = (mask & 4) ? 16 * 128 : 0, n_2 = (mask & 8) ? 64 * 32 : 0;
    for (int it = gw; it < n_in + n_o + n_1 + n_2; it += NGW) {
        int r = it;
        if (r < n_in) { const int nblk = odd ? 96 : 80, kb = r / nblk, nb = r % nblk;
            if (odd) transpose_item(a->in[I_ODWIN] + (size_t)pr * 1024 * 3072, 1024, 3072, nb * 32, (bf16*)(wl + W_IN), nb * 32, kb * 64, scr, lane);
            else     transpose_item(a->in[I_EVWIN] + (size_t)pr * 1024 * 2336, 1024, 2336, ev_src_col(nb * 32), (bf16*)(wl + W_IN), nb * 32, kb * 64, scr, lane);
            continue; }
        r -= n_in;
        if (r < n_o) { const int kb = r / 32, nb = r % 32; transpose_item((odd ? a->in[I_ODWOUT] : a->in[I_EVWOUT]) + (size_t)pr * 1024 * 1024, 1024, 1024, nb * 32, (bf16*)(wl + W_OUT), nb * 32, kb * 64, scr, lane); continue; }
        r -= n_o;
        if (r < n_1) { const int kb = r / 128, nb = r % 128; transpose_item(a->in[I_W1] + (size_t)l * 1024 * 4096, 1024, 4096, nb * 32, (bf16*)(wl + W_1), nb * 32, kb * 64, scr, lane); continue; }
        r -= n_1;
        { const int kb = r / 32, nb = r % 32; transpose_item(a->in[I_W2] + (size_t)l * 4096 * 1024, 4096, 1024, nb * 32, (bf16*)(wl + W_2), nb * 32, kb * 64, scr, lane); }
    }
}
__device__ __forceinline__ void p0a_prologue(int wv_, KA a, LAS unsigned char* lds) {
    const int tid = otid(), lane = tid & 63, wave = __builtin_amdgcn_readfirstlane(tid >> 6);
    const int gw = blockIdx.x * NWAVES + wave, NGW = gridDim.x * NWAVES;
    LAS float* sc = (LAS float*)lds;
    LAS float* red = (LAS float*)(lds + 20480);
    for (int i = tid; i < 5 * 1024; i += NTHR) { const int cls = i >> 10, k = i & 1023; const float v = cls < 4 ? a->in[I_C][cls * 1024 + k] : a->in[I_CCTX][k]; sc[i] = v / (1.f + expf(-v)); }
    __syncthreads();
    float* MOD = (float*)(a->ws + WS_MOD);
    for (int item = blockIdx.x; item < 4 * 48; item += gridDim.x) {
        const int l = item / 48, nb = item % 48;
        const float* W = a->in[I_WADA] + (size_t)l * 1024 * 6144 + nb * 128 + lane * 2;
        float acc[5][2];
#pragma unroll
        for (int c = 0; c < 5; ++c) { acc[c][0] = 0.f; acc[c][1] = 0.f; }
#pragma unroll 4
        for (int kk = 0; kk < 128; ++kk) { const int k = wave * 128 + kk; const float2 w = *(const float2*)(W + (size_t)k * 6144);
#pragma unroll
            for (int c = 0; c < 5; ++c) { const float s = sc[c * 1024 + k]; acc[c][0] += s * w.x; acc[c][1] += s * w.y; } }
#pragma unroll
        for (int c = 0; c < 5; ++c) { red[(wave * 5 + c) * 128 + lane * 2] = acc[c][0]; red[(wave * 5 + c) * 128 + lane * 2 + 1] = acc[c][1]; }
        __syncthreads();
        for (int o = tid; o < 640; o += NTHR) { const int c = o >> 7, cc = o & 127; float s = a->in[I_BADA][l * 6144 + nb * 128 + cc];
#pragma unroll
            for (int w = 0; w < 8; ++w) s += red[(w * 5 + c) * 128 + cc];
            MOD[(size_t)(l * 5 + c) * 6144 + nb * 128 + cc] = s; }
        __syncthreads();
    }
    convert_layer_weights(wv_, a, 0, 15, lds);
    {
        float* tab = (float*)(a->ws + WS_TAB);
        const int gt = blockIdx.x * NTHR + tid;
        if (gt < 3072) { const int pos = gt < 2048 ? gt / 16 : (gt - 2048) / 16, i = gt & 15;
            const float inv = powf(10000.f, -(float)i / 16.f), ang = (float)pos * inv;
            tab[gt * 2] = cosf(ang); tab[gt * 2 + 1] = sinf(ang); }
        if (gw == NGW - 1) {
#pragma unroll
            for (int j = 0; j < 2; ++j) { const float* lp = a->in[I_LAM] + j * 256;
                const float s1 = wave_sum(lp[lane] * lp[64 + lane]), s2 = wave_sum(lp[128 + lane] * lp[192 + lane]);
                if (lane == 0) tab[8192 + j] = expf(s1) - expf(s2) + lam_init_of(2 * j + 1); }
        }
    }
    for (int it = gw; it < 2 * PB; it += NGW) {
        const int j = it / PB, q = it % PB; const bool isctx = q >= SEQ; const int pos = isctx ? q - SEQ : q, L = isctx ? CTXL : SEQ;
        const float t = (float)pos / (float)(L - 1), w = 2.f * 3.14159265358979323846f * (float)pos / (float)L;
        float z = 0.f;
        if (lane == 0) z = t;
        else if (lane <= 16) { const float band = 1e-4f + (float)(lane - 1) * ((15.f - 1e-4f) / 15.f); z = cosf(w * band); }
        else if (lane <= 32) { const float band = 1e-4f + (float)(lane - 17) * ((15.f - 1e-4f) / 15.f); z = -sinf(w * band); }
        const float* w1 = a->in[I_FW1] + j * 33 * 64; const float* w2 = a->in[I_FW2] + j * 64 * 64;
        float h1 = a->in[I_FB1][j * 64 + lane];
#pragma unroll
        for (int e = 0; e < 33; ++e) h1 += rl(z, e) * w1[e * 64 + lane];
        h1 = sinf(h1);
        float h2 = a->in[I_FB2][j * 64 + lane];
#pragma unroll
        for (int e = 0; e < 64; ++e) h2 += rl(h1, e) * w2[e * 64 + lane];
        h2 = sinf(h2);
        float* HID = (float*)(a->ws + WS_HID) + (isctx ? (size_t)(2 * SEQ + j * CTXL + pos) * 64 : (size_t)(j * SEQ + pos) * 64);
        HID[lane] = h2;
    }
}

struct Row16 { f32x4 v[4]; };
__device__ __forceinline__ Row16 ld_row_f32(const float* p, int lane) { Row16 r; const GAS f32x4* q = (const GAS f32x4*)p + lane;
#pragma unroll
    for (int j = 0; j < 4; ++j) r.v[j] = q[64 * j];
    return r; }
__device__ __forceinline__ Row16 ld_row_bf16(const bf16* p, int lane) { Row16 r; const GAS unsigned long long* q = (const GAS unsigned long long*)p + lane;
#pragma unroll
    for (int j = 0; j < 4; ++j) { const unsigned long long w = q[64 * j]; const unsigned lo = (unsigned)w, hi = (unsigned)(w >> 32);
        r.v[j] = (f32x4){__builtin_bit_cast(float, lo << 16), __builtin_bit_cast(float, lo & 0xffff0000u), __builtin_bit_cast(float, hi << 16), __builtin_bit_cast(float, hi & 0xffff0000u)}; }
    return r; }
__device__ __forceinline__ void st_row_f32(float* p, const Row16& r, int lane) { GAS f32x4* q = (GAS f32x4*)p + lane;
#pragma unroll
    for (int j = 0; j < 4; ++j) q[64 * j] = r.v[j]; }
__device__ __forceinline__ void st_row_bf16(bf16* p, const Row16& r, int lane) { GAS unsigned long long* q = (GAS unsigned long long*)p + lane;
#pragma unroll
    for (int j = 0; j < 4; ++j) q[64 * j] = (unsigned long long)pk2(r.v[j].x, r.v[j].y) | ((unsigned long long)pk2(r.v[j].z, r.v[j].w) << 32); }
__device__ __forceinline__ float row_sumsq(const Row16& r) { float s = 0.f;
#pragma unroll
    for (int j = 0; j < 4; ++j) s += (r.v[j].x * r.v[j].x + r.v[j].y * r.v[j].y) + (r.v[j].z * r.v[j].z + r.v[j].w * r.v[j].w);
    return wave_sum(s); }
__device__ __forceinline__ void norm_mod_store(const Row16& x, const float* g, const float* shift, const float* scale, bf16* dst, int lane) {
    const float rstd = 1.f / sqrtf(row_sumsq(x) * (1.f / D) + EPS);
    const Row16 G = ld_row_f32(g, lane), SH = ld_row_f32(shift, lane), SC = ld_row_f32(scale, lane); Row16 o;
#pragma unroll
    for (int j = 0; j < 4; ++j) o.v[j] = (x.v[j] * rstd) * G.v[j] * (SC.v[j] + 1.f) + SH.v[j];
    st_row_bf16(dst, o, lane);
}
__device__ __forceinline__ void p0b_first_norm(int wv_, KA a) {
    const int tid_o = otid(), lane = tid_o & 63, wave = tid_o >> 6, gw = blockIdx.x * NWAVES + wave, NGW = gridDim.x * NWAVES;
    const float* MOD = (const float*)(a->ws + WS_MOD); bf16* A1 = (bf16*)(a->ws + WS_A1);
    for (int rb = gw; rb < R; rb += 2 * NGW) {
        const int r2 = rb + NGW < R ? rb + NGW : rb;
        const Row16 xa = ld_row_f32(xin_ptr(a, rb), lane), xb = ld_row_f32(xin_ptr(a, r2), lane);
        { const float* m = MOD + (size_t)(0 * 5 + row_cls(rb)) * 6144; norm_mod_store(xa, a->in[I_NORMG] + 0, m + 0, m + 1024, A1 + (size_t)rb * D, lane); }
        if (rb + NGW < R) { const float* m = MOD + (size_t)(0 * 5 + row_cls(r2)) * 6144; norm_mod_store(xb, a->in[I_NORMG] + 0, m + 0, m + 1024, A1 + (size_t)r2 * D, lane); }
    }
}
typedef unsigned long long u64_t;
template <bool FIRST> struct RawRow { u64_t xb[FIRST ? 1 : 4]; f32x4 xf[FIRST ? 4 : 1]; u64_t y1[4], y2[4]; };
__device__ __forceinline__ Row16 cvt_raw(const u64_t (&q)[4]) { Row16 r;
#pragma unroll
    for (int j = 0; j < 4; ++j) { const unsigned lo = (unsigned)q[j], hi = (unsigned)(q[j] >> 32);
        r.v[j] = (f32x4){__builtin_bit_cast(float, lo << 16), __builtin_bit_cast(float, lo & 0xffff0000u), __builtin_bit_cast(float, hi << 16), __builtin_bit_cast(float, hi & 0xffff0000u)}; }
    return r; }
template <bool FIRST> __device__ __forceinline__ void rowwise_body(int wv_, KA a, int layer, int which, LAS unsigned char* lds) {
    const int tid = otid(), lane = tid & 63, wave = tid >> 6, gw = blockIdx.x * NWAVES + wave;
    const float* MOD = (const float*)(a->ws + WS_MOD); bf16* A1 = (bf16*)(a->ws + WS_A1); const bf16* Y = (const bf16*)(a->ws + WS_Y); const bf16* SLAB = (const bf16*)(a->ws + WS_SLAB);
    bf16* XB = (bf16*)(a->ws + WS_XB);
    const float* ng = a->in[I_NORMG] + (size_t)layer * 4 * D;
    const bool lastl = layer == DEPTH - 1, lastp = lastl && which == 1;
    constexpr int RPW = 17;
    const int rbl = blockIdx.x * (NWAVES * RPW), rbh = rbl + NWAVES * RPW - 1;
    const int clsA = row_cls(rbl < R ? rbl : R - 1), clsB = row_cls(rbh < R ? rbh : R - 1);
    LAS f32x4* vec = (LAS f32x4*)lds;
    for (int idx = tid; idx < 2 * 7 * 256; idx += NTHR) { const int c = idx / (7 * 256), v = (idx >> 8) % 7, q = idx & 255, cls = c ? clsB : clsA;
        const float* m = MOD + (size_t)(layer * 5 + cls) * 6144; const float* m2 = MOD + (size_t)((lastp || !which ? layer : layer + 1) * 5 + cls) * 6144;
        const float* src = v == 0 ? ng + 1 * D : v == 1 ? ng + 3 * D : v == 2 ? (which ? ng + 4 * D : ng + 2 * D) : v == 3 ? m + 2 * 1024 : v == 4 ? m + 5 * 1024 : v == 5 ? (which ? m2 + 0 : m + 3 * 1024) : (which ? m2 + 1024 : m + 4 * 1024);
        vec[idx] = *(const f32x4*)(src + 4 * q); }
    __syncthreads();
    const int r0 = gw * RPW, r1 = r0 + RPW < R ? r0 + RPW : R;
    if (r0 >= R) return;
    auto load_raw = [&](RawRow<FIRST>& q, int r) {
        if constexpr (FIRST) { const GAS f32x4* xp = (const GAS f32x4*)xin_ptr(a, r) + lane;
#pragma unroll
            for (int j = 0; j < 4; ++j) q.xf[j] = xp[64 * j]; }
        else { const GAS u64_t* xp = (const GAS u64_t*)(XB + (size_t)r * D) + lane;
#pragma unroll
            for (int j = 0; j < 4; ++j) q.xb[j] = xp[64 * j]; }
        const GAS u64_t* yp = (const GAS u64_t*)(Y + (size_t)r * D) + lane;
#pragma unroll
        for (int j = 0; j < 4; ++j) q.y1[j] = yp[64 * j];
        if (which) { const GAS u64_t* zp = (const GAS u64_t*)(A1 + (size_t)r * D) + lane;
#pragma unroll
            for (int j = 0; j < 4; ++j) q.y2[j] = zp[64 * j]; } };
    RawRow<FIRST> q0, q1, q2;
    load_raw(q0, r0); q1 = q0; q2 = q0;
    if (r0 + 1 < r1) load_raw(q1, r0 + 1);
    for (int r = r0; r < r1; ++r) {
        if (r + 2 < r1) load_raw(q2, r + 2);
        const int b = r / PB, p = r - b * PB, cls = p < CTXL ? 4 : b;
        if (!(lastl && cls == 4)) {
            const LAS f32x4* vt = vec + (cls == clsA ? 0 : 7 * 256) + lane;
            Row16 x;
            if constexpr (FIRST) {
#pragma unroll
                for (int jj = 0; jj < 4; ++jj) x.v[jj] = q0.xf[jj]; }
            else x = cvt_raw(q0.xb);
            const Row16 y1 = cvt_raw(q0.y1);
            const float rstd1 = 1.f / sqrtf(row_sumsq(y1) * (1.f / D) + EPS);
#pragma unroll
            for (int jj = 0; jj < 4; ++jj) x.v[jj] = x.v[jj] + vt[3 * 256 + 64 * jj] * ((y1.v[jj] * rstd1) * vt[0 * 256 + 64 * jj]);
            bool done = false;
            if (which) {
                Row16 y2;
                if (p < CTXL) { y2 = ld_row_bf16(SLAB + (size_t)(b * CTXL + p) * D, lane);
#pragma unroll
                    for (int k = 1; k < 4; ++k) { const Row16 sk = ld_row_bf16(SLAB + (size_t)k * 1024 * D + (size_t)(b * CTXL + p) * D, lane);
#pragma unroll
                        for (int jj = 0; jj < 4; ++jj) y2.v[jj] = y2.v[jj] + sk.v[jj]; } }
                else y2 = cvt_raw(q0.y2);
                const float rstd2 = 1.f / sqrtf(row_sumsq(y2) * (1.f / D) + EPS);
#pragma unroll
                for (int jj = 0; jj < 4; ++jj) x.v[jj] = x.v[jj] + vt[4 * 256 + 64 * jj] * ((y2.v[jj] * rstd2) * vt[1 * 256 + 64 * jj]);
                if (lastp) { st_row_f32(a->out + (size_t)(b * SEQ + (p - CTXL)) * D, x, lane); done = true; }
                else st_row_bf16(XB + (size_t)r * D, x, lane);
            }
            if (!done) {
                const float rs2 = 1.f / sqrtf(row_sumsq(x) * (1.f / D) + EPS); Row16 o;
#pragma unroll
                for (int jj = 0; jj < 4; ++jj) o.v[jj] = (x.v[jj] * rs2) * vt[2 * 256 + 64 * jj] * (vt[6 * 256 + 64 * jj] + 1.f) + vt[5 * 256 + 64 * jj];
                st_row_bf16(A1 + (size_t)r * D, o, lane);
            }
        }
        q0 = q1; q1 = q2;
    }
}
__device__ __forceinline__ void rowwise_post(int wv_, KA a, int layer, int which, LAS unsigned char* lds) {
    if (layer == 0) rowwise_body<true>(wv_, a, layer, which, lds); else rowwise_body<false>(wv_, a, layer, which, lds);
}

__device__ __forceinline__ void attn_phase_fast(int wv_, KA a, bool odd, char* lds_generic, bool skip_ctx_q = false) {
    const int G = gridDim.x, bx = blockIdx.x; const int vcu = (G % 8 == 0) ? (bx % 8) * (G / 8) + bx / 8 : bx;
    const int nvh = 8, nheavy = 4 * nvh * 32, ntot = nheavy + (skip_ctx_q ? 0 : 4 * nvh);
    unsigned char* ws = a->ws;
    const attn_body::bf16* P = (const attn_body::bf16*)(ws + WS_PH);
    for (int u = vcu; u < ntot; u += G) {
        int b, vh, panel;
        if (u < nheavy) { const int i = u >> 8, v = u & 255, xcd = v >> 5; b = xcd >> 1; vh = (xcd & 1) * (nvh >> 1) + i; panel = (v & 31) + 1; }
        else { const int lu = u - nheavy; b = lu / nvh; vh = lu % nvh; panel = 0; }
        const size_t row0 = (size_t)b * PB, qrow = row0 + 256 * panel; const int NT = panel == 0 ? CTXL / 64 : PB / 64;
        if (!odd) { const int kvh = vh >> 2;
            attn_body::attn_unit<8>(otid(), P + qrow * NP_EV + EGQ + vh * 64, NP_EV, P + row0 * NP_EV + EGK + kvh * 64, P + row0 * NP_EV + EGV + kvh * 64, NP_EV,
                                    (attn_body::bf16*)(ws + WS_A1) + qrow * D + 512 + vh * 64, D, NT, lds_generic); }
        else { const int hd = vh >> 1, c = vh & 1;
            attn_body::attn_unit128<8>(otid(), P + qrow * NP_OD + ODQ + hd * 128 + c * 64, NP_OD, P + row0 * NP_OD + ODK + hd * 128 + c * 64, P + row0 * NP_OD + ODV + hd * 128, NP_OD,
                                       (attn_body::bf16*)(ws + WS_Y) + qrow * D + hd * 256 + c * 128, D, NT, lds_generic); }
    }
}

constexpr size_t WS_UT = WS_Y, WS_S0T = WS_PH + 165 * MiB, WS_DEC = 504 * MiB;
constexpr int GQP = 144, GVP = 272, GIMG_OFF = 8 * (64 * GQP) + 2 * (64 * GVP) + 2048;
typedef short gbf16x8 __attribute__((ext_vector_type(8)));
typedef short gs16x4 __attribute__((ext_vector_type(4)));
typedef float gf32x4 __attribute__((ext_vector_type(4)));
__device__ __forceinline__ gs16x4 gtr(const LAS unsigned char* p) { return __builtin_bit_cast(gs16x4, __builtin_amdgcn_ds_read_tr16_b64_v4i16((LAS gs16x4*)p)); }
__device__ __forceinline__ gbf16x8 gcat(gs16x4 lo, gs16x4 hi) { return (gbf16x8){lo[0], lo[1], lo[2], lo[3], hi[0], hi[1], hi[2], hi[3]}; }
__device__ __forceinline__ float log_sigmoid_fast(float x) { return fminf(x, 0.f) - __logf(1.f + __expf(-fabsf(x))); }
__device__ __forceinline__ float rls(float v, int k) { return __builtin_bit_cast(float, __builtin_amdgcn_readlane(__builtin_bit_cast(int, v), k)); }

__device__ __forceinline__ void gla_prep_b(KA a, int j, const bf16* P, size_t row0, int head, int pdir, int role, int wave, int lane, LAS float* xch, float (&bv)[2][4][4], float (&tall)[4]) {
    const int g = lane >> 4, l15 = lane & 15; const gbf16x8 zero8 = {0, 0, 0, 0, 0, 0, 0, 0};
    gbf16x8 lrA[2];
#pragma unroll
    for (int tt = 0; tt < 2; ++tt) { lrA[tt] = zero8; if (g < 2) lrA[tt] = *(const gbf16x8*)(P + (row0 + 32 * role + 16 * tt + l15) * NP_EV + ELR + pdir * 16 + 8 * g); }
    gf32x4 gk[2][4];
#pragma unroll
    for (int dt = 0; dt < 4; ++dt) {
        unsigned hw[4] = {0u, 0u, 0u, 0u}, lw[4] = {0u, 0u, 0u, 0u};
        if (g < 2) {
#pragma unroll
            for (int e = 0; e < 8; ++e) { const float w = a->in[I_EVWLR][((size_t)(j * 2 + pdir) * 16 + 8 * g + e) * 256 + head * 64 + 16 * dt + l15];
                const unsigned h = f2bf(w), l = f2bf(w - __builtin_bit_cast(float, h << 16)); hw[e >> 1] |= h << (16 * (e & 1)); lw[e >> 1] |= l << (16 * (e & 1)); } }
        const gbf16x8 wh = __builtin_bit_cast(gbf16x8, (v4u){hw[0], hw[1], hw[2], hw[3]}), wlo = __builtin_bit_cast(gbf16x8, (v4u){lw[0], lw[1], lw[2], lw[3]});
        const float bl = a->in[I_EVBLR][(j * 2 + pdir) * 256 + head * 64 + 16 * dt + l15];
#pragma unroll
        for (int tt = 0; tt < 2; ++tt) { gf32x4 acc = (gf32x4){bl, bl, bl, bl};
            acc = __builtin_amdgcn_mfma_f32_16x16x32_bf16(lrA[tt], wh, acc, 0, 0, 0); acc = __builtin_amdgcn_mfma_f32_16x16x32_bf16(lrA[tt], wlo, acc, 0, 0, 0); gk[tt][dt] = acc; }
    }
    float tot[4];
#pragma unroll
    for (int dt = 0; dt < 4; ++dt) { float t2 = 0.f;
#pragma unroll
        for (int tt = 0; tt < 2; ++tt)
#pragma unroll
            for (int r = 0; r < 4; ++r) { const float x = gk[tt][dt][r]; const float e = __builtin_amdgcn_exp2f(-fabsf(x) * 1.4426950408889634f);
                const float la = (fminf(x, 0.f) - 0.6931471805599453f * __builtin_amdgcn_logf(1.f + e)) * (1.f / 16.f); gk[tt][dt][r] = la; t2 += la; }
        tot[dt] = sum_rows4(t2); }
    if (g == 0) {
#pragma unroll
        for (int dt = 0; dt < 4; ++dt) xch[wave * 64 + 16 * dt + l15] = tot[dt]; }
    gbf16x8 tri[2];
#pragma unroll
    for (int tt = 0; tt < 2; ++tt) { unsigned w[4] = {0u, 0u, 0u, 0u}; const int tl = 16 * tt + l15;
#pragma unroll
        for (int e = 0; e < 8; ++e) { const int tp = e < 4 ? 4 * g + e : 16 + 4 * g + (e - 4); const bool keep = pdir == 0 ? (tp <= tl) : (tp >= tl); w[e >> 1] |= keep ? (0x3F80u << (16 * (e & 1))) : 0u; }
        tri[tt] = __builtin_bit_cast(gbf16x8, (v4u){w[0], w[1], w[2], w[3]}); }
    gf32x4 bl2[2][4];
#pragma unroll
    for (int dt = 0; dt < 4; ++dt) { unsigned hw[4], lw[4];
#pragma unroll
        for (int e = 0; e < 8; e += 2) { const float x0 = gk[e >> 2][dt][e & 3], x1 = gk[e >> 2][dt][(e & 3) + 1];
            const unsigned h0 = f2bf(x0), h1 = f2bf(x1); hw[e >> 1] = h0 | (h1 << 16);
            lw[e >> 1] = f2bf(x0 - __builtin_bit_cast(float, h0 << 16)) | (f2bf(x1 - __builtin_bit_cast(float, h1 << 16)) << 16); }
        const gbf16x8 bh = __builtin_bit_cast(gbf16x8, (v4u){hw[0], hw[1], hw[2], hw[3]}), blo = __builtin_bit_cast(gbf16x8, (v4u){lw[0], lw[1], lw[2], lw[3]});
#pragma unroll
        for (int tt = 0; tt < 2; ++tt) { gf32x4 acc = (gf32x4){0.f, 0.f, 0.f, 0.f};
            acc = __builtin_amdgcn_mfma_f32_16x16x32_bf16(tri[tt], bh, acc, 0, 0, 0); acc = __builtin_amdgcn_mfma_f32_16x16x32_bf16(tri[tt], blo, acc, 0, 0, 0); bl2[tt][dt] = acc; } }
    __syncthreads();
    const bool need_other = pdir == 0 ? (role == 1) : (role == 0);
#pragma unroll
    for (int dt = 0; dt < 4; ++dt) { const float other = xch[(wave ^ 1) * 64 + 16 * dt + l15]; tall[dt] = tot[dt] + other; const float add = need_other ? other : 0.f;
#pragma unroll
        for (int tt = 0; tt < 2; ++tt)
#pragma unroll
            for (int r = 0; r < 4; ++r) bv[tt][dt][r] = bl2[tt][dt][r] + add; }
}
__device__ __forceinline__ void gla_state_phase(int wv_, KA a, int j, LAS unsigned char* lds) {
    const int tid = otid(), lane = tid & 63, wave = __builtin_amdgcn_readfirstlane(tid >> 6);
    const int hl = wave >> 2, dir = (wave >> 1) & 1, role = wave & 1, g = lane >> 4, l15 = lane & 15;
    unsigned char* ws = a->ws; const bf16* P = (const bf16*)(ws + WS_PH);
    LAS unsigned char* kimg = lds + (hl * 2 + dir) * (64 * GQP); LAS unsigned char* vimg = lds + 4 * (64 * GQP) + hl * (64 * GVP); LAS float* xch = (LAS float*)(lds + 4 * (64 * GQP) + 2 * (64 * GVP));
    for (int unit = blockIdx.x; unit < NB * 132 * 2; unit += gridDim.x) {
        const int b = unit / 264, rem = unit % 264, cidx = rem >> 1, hp = rem & 1, head = hp * 2 + hl; const size_t row0 = (size_t)b * PB + cidx * 64;
        const int chain = (b * 4 + head) * 2 + dir;
        __syncthreads();
        { v4u vv[4], kk[2];
#pragma unroll
            for (int it = 0; it < 4; ++it) { const int ch = tid + it * NTHR, hh = ch >> 10, t = (ch >> 4) & 63, c16 = ch & 15; vv[it] = *(const v4u*)(P + (row0 + t) * NP_EV + EVV + (hp * 2 + hh) * 128 + c16 * 8); }
#pragma unroll
            for (int it = 0; it < 2; ++it) { const int ch = tid + it * NTHR, hh = ch >> 9, t = (ch >> 3) & 63, c8 = ch & 7; kk[it] = *(const v4u*)(P + (row0 + t) * NP_EV + EK + (hp * 2 + hh) * 64 + c8 * 8); }
#pragma unroll
            for (int it = 0; it < 4; ++it) { const int ch = tid + it * NTHR, hh = ch >> 10, t = (ch >> 4) & 63, c16 = ch & 15; *(LAS v4u*)(lds + 4 * (64 * GQP) + hh * (64 * GVP) + t * GVP + c16 * 16) = vv[it]; }
#pragma unroll
            for (int it = 0; it < 2; ++it) { const int ch = tid + it * NTHR, hh = ch >> 9, t = (ch >> 3) & 63, c8 = ch & 7;
                *(LAS v4u*)(lds + (hh * 2) * (64 * GQP) + t * GQP + c8 * 16) = kk[it]; *(LAS v4u*)(lds + (hh * 2 + 1) * (64 * GQP) + t * GQP + c8 * 16) = kk[it]; } }
        float bv[2][4][4], tall[4];
        gla_prep_b(a, j, P, row0, head, dir, role, wave, lane, xch, bv, tall);
#pragma unroll
        for (int tt = 0; tt < 2; ++tt)
#pragma unroll
            for (int dt = 0; dt < 4; ++dt)
#pragma unroll
                for (int r = 0; r < 4; ++r) { const int t = 32 * role + 16 * tt + 4 * g + r, dk = 16 * dt + l15;
                    LAS bf16* kp = (LAS bf16*)(kimg + t * GQP + dk * 2);
                    *kp = (bf16)f2bf(bf2f(*kp) * __builtin_amdgcn_exp2f((tall[dt] - bv[tt][dt][r]) * 1.4426950408889634f)); }
        if (role == 0 && g == 0) {
#pragma unroll
            for (int dt = 0; dt < 4; ++dt) ((float*)(ws + WS_DEC))[((size_t)chain * 132 + cidx) * 64 + 16 * dt + l15] = __builtin_amdgcn_exp2f(tall[dt] * 1.4426950408889634f); }
        __syncthreads();
        gf32x4 acc[4][4];
#pragma unroll
        for (int x = 0; x < 4; ++x)
#pragma unroll
            for (int y = 0; y < 4; ++y) acc[x][y] = (gf32x4){0.f, 0.f, 0.f, 0.f};
        const int q = l15 >> 2, p4 = lane & 3;
#pragma unroll
        for (int ks = 0; ks < 2; ++ks) {
            gbf16x8 af[4], bfr[4];
#pragma unroll
            for (int x = 0; x < 4; ++x) { const LAS unsigned char* pa = kimg + (32 * ks + 8 * g + q) * GQP + (16 * x + 4 * p4) * 2; af[x] = gcat(gtr(pa), gtr(pa + 4 * GQP)); }
#pragma unroll
            for (int y = 0; y < 4; ++y) { const LAS unsigned char* pb = vimg + (32 * ks + 8 * g + q) * GVP + (64 * role + 16 * y + 4 * p4) * 2; bfr[y] = gcat(gtr(pb), gtr(pb + 4 * GVP)); }
#pragma unroll
            for (int x = 0; x < 4; ++x)
#pragma unroll
                for (int y = 0; y < 4; ++y) acc[x][y] = __builtin_amdgcn_mfma_f32_16x16x32_bf16(af[x], bfr[y], acc[x][y], 0, 0, 0);
        }
        bf16* UT = (bf16*)(ws + WS_UT) + ((size_t)chain * 132 + cidx) * 8192;
#pragma unroll
        for (int x = 0; x < 4; ++x)
#pragma unroll
            for (int y = 0; y < 4; ++y) { const int dv = 64 * role + 16 * y + l15, dk = 16 * x + 4 * g;
                *(unsigned long long*)(UT + dv * 64 + dk) = (unsigned long long)pk2(acc[x][y][0], acc[x][y][1]) | ((unsigned long long)pk2(acc[x][y][2], acc[x][y][3]) << 32); }
    }
}
__device__ __forceinline__ void gla_scan_phase(int wv_, KA a) {
    const int tid = otid(), lane = tid & 63, wave = tid >> 6;
    const int vt = (blockIdx.x + gridDim.x * wave) * 64 + lane;
    if (vt >= 32 * 1024) return;
    unsigned char* ws = a->ws;
    const int chain = vt >> 10, e = vt & 1023, dir = chain & 1;
    const bf16* UT = (const bf16*)(ws + WS_UT); bf16* S0T = (bf16*)(ws + WS_S0T); const float* DEC = (const float*)(ws + WS_DEC);
    float S[8];
#pragma unroll
    for (int i = 0; i < 8; ++i) S[i] = 0.f;
#pragma unroll 11
    for (int s = 0; s < 132; ++s) {
        const int cidx = dir == 0 ? s : (s < 4 ? 3 - s : 135 - s);
        const size_t off = ((size_t)chain * 132 + cidx) * 8192 + (size_t)e * 8;
        const v4u u = *(const v4u*)(UT + off);
        const f32x4 d0 = *(const f32x4*)(DEC + ((size_t)chain * 132 + cidx) * 64 + (e & 7) * 8), d1 = *(const f32x4*)(DEC + ((size_t)chain * 132 + cidx) * 64 + (e & 7) * 8 + 4);
        v4u o; o.x = pk2(S[0], S[1]); o.y = pk2(S[2], S[3]); o.z = pk2(S[4], S[5]); o.w = pk2(S[6], S[7]);
        *(v4u*)(S0T + off) = o;
        const unsigned uw[4] = {u.x, u.y, u.z, u.w}; const float dd[8] = {d0.x, d0.y, d0.z, d0.w, d1.x, d1.y, d1.z, d1.w};
#pragma unroll
        for (int i = 0; i < 8; ++i) { const float uv = __builtin_bit_cast(float, (i & 1) ? (uw[i >> 1] & 0xffff0000u) : (uw[i >> 1] << 16)); S[i] = S[i] * dd[i] + uv; }
    }
}
__device__ __forceinline__ void gla_output_phase(int wv_, KA a, int j, LAS unsigned char* lds, int skipmask = 0) {
    const int tid = otid(), lane = tid & 63, wave = __builtin_amdgcn_readfirstlane(tid >> 6);
    const int hl = wave >> 2, pdir = (wave >> 1) & 1, role = wave & 1, q4 = wave & 3, g = lane >> 4, l15 = lane & 15;
    unsigned char* ws = a->ws; const bf16* P = (const bf16*)(ws + WS_PH); bf16* MIX = (bf16*)(ws + WS_A1);
    LAS unsigned char* qimg0 = lds + (hl * 2) * (64 * GQP); LAS unsigned char* kimg0 = lds + (4 + hl * 2) * (64 * GQP); LAS unsigned char* vimg = lds + 8 * (64 * GQP) + hl * (64 * GVP);
    for (int unit = blockIdx.x; unit < NB * 132 * 2; unit += gridDim.x) {
        const int b = unit / 264, rem = unit % 264, cidx = rem >> 1, hp = rem & 1, head = hp * 2 + hl; const size_t row0 = (size_t)b * PB + cidx * 64;
        __syncthreads();
        gbf16x8 sfA[8][2], sfB[8][2];
        const bf16* S0f = (const bf16*)(ws + WS_S0T) + ((size_t)((b * 4 + head) * 2) * 132 + cidx) * 8192;
#pragma unroll
        for (int c = 0; c < 8; ++c)
#pragma unroll
            for (int ks = 0; ks < 2; ++ks) sfA[c][ks] = *(const gbf16x8*)(S0f + (16 * c + l15) * 64 + 32 * ks + 8 * g);
        { v4u vv[4], gg[4], qq2[2], kk[2];
#pragma unroll
            for (int it = 0; it < 4; ++it) { const int ch = tid + it * NTHR, hh = ch >> 10, t = (ch >> 4) & 63, c16 = ch & 15; const bf16* src = P + (row0 + t) * NP_EV + (hp * 2 + hh) * 128 + c16 * 8; vv[it] = *(const v4u*)(src + EVV); gg[it] = *(const v4u*)(src + EG); }
#pragma unroll
            for (int it = 0; it < 2; ++it) { const int ch = tid + it * NTHR, hh = ch >> 9, t = (ch >> 3) & 63, c8 = ch & 7; const bf16* src = P + (row0 + t) * NP_EV + (hp * 2 + hh) * 64 + c8 * 8; qq2[it] = *(const v4u*)(src + EQ); kk[it] = *(const v4u*)(src + EK); }
#pragma unroll
            for (int it = 0; it < 4; ++it) { const int ch = tid + it * NTHR, hh = ch >> 10, t = (ch >> 4) & 63, c16 = ch & 15;
                *(LAS v4u*)(lds + 8 * (64 * GQP) + hh * (64 * GVP) + t * GVP + c16 * 16) = vv[it]; *(LAS v4u*)(lds + GIMG_OFF + hh * (64 * GVP) + t * GVP + c16 * 16) = gg[it]; }
#pragma unroll
            for (int it = 0; it < 2; ++it) { const int ch = tid + it * NTHR, hh = ch >> 9, t = (ch >> 3) & 63, c8 = ch & 7;
                *(LAS v4u*)(lds + (hh * 2) * (64 * GQP) + t * GQP + c8 * 16) = qq2[it]; *(LAS v4u*)(lds + (hh * 2 + 1) * (64 * GQP) + t * GQP + c8 * 16) = qq2[it];
                *(LAS v4u*)(lds + (4 + hh * 2) * (64 * GQP) + t * GQP + c8 * 16) = kk[it]; *(LAS v4u*)(lds + (4 + hh * 2 + 1) * (64 * GQP) + t * GQP + c8 * 16) = kk[it]; } }
        {
            float bv[2][4][4], tall[4];
            gla_prep_b(a, j, P, row0, head, pdir, role, wave, lane, (LAS float*)(lds + 8 * (64 * GQP) + 2 * (64 * GVP)), bv, tall);
            LAS unsigned char* qi = qimg0 + pdir * (64 * GQP); LAS unsigned char* ki = kimg0 + pdir * (64 * GQP);
#pragma unroll
            for (int tt = 0; tt < 2; ++tt)
#pragma unroll
                for (int dt = 0; dt < 4; ++dt)
#pragma unroll
                    for (int r = 0; r < 4; ++r) { const int t = 32 * role + 16 * tt + 4 * g + r, dk = 16 * dt + l15;
                        const float e = __builtin_amdgcn_exp2f(bv[tt][dt][r] * 1.4426950408889634f);
                        LAS bf16* qp = (LAS bf16*)(qi + t * GQP + dk * 2); LAS bf16* kp = (LAS bf16*)(ki + t * GQP + dk * 2);
                        *qp = (bf16)f2bf(bf2f(*qp) * 0.125f * e);
                        *kp = (bf16)f2bf(bf2f(*kp) * __builtin_amdgcn_rcpf(e)); }
        }
        __syncthreads();
        gf32x4 o[8];
#pragma unroll
        for (int c = 0; c < 8; ++c) o[c] = (gf32x4){0.f, 0.f, 0.f, 0.f};
        const int qq = l15 >> 2, p4 = lane & 3;
#pragma unroll
        for (int c = 0; c < 8; ++c)
#pragma unroll
            for (int ks = 0; ks < 2; ++ks) sfB[c][ks] = *(const gbf16x8*)(S0f + (size_t)132 * 8192 + (16 * c + l15) * 64 + 32 * ks + 8 * g);
        if (!(skipmask & 2))
#pragma unroll
        for (int dir = 0; dir < 2; ++dir) {
            const LAS unsigned char* qimg = qimg0 + dir * (64 * GQP); const LAS unsigned char* kimg = kimg0 + dir * (64 * GQP);
            gbf16x8 qf[2];
#pragma unroll
            for (int ks = 0; ks < 2; ++ks) qf[ks] = *(const LAS gbf16x8*)(qimg + (16 * q4 + l15) * GQP + (32 * ks + 8 * g) * 2);
            gf32x4 st[4];
#pragma unroll
            for (int jt = 0; jt < 4; ++jt) { st[jt] = (gf32x4){0.f, 0.f, 0.f, 0.f};
#pragma unroll
                for (int ks = 0; ks < 2; ++ks) { const gbf16x8 kf = *(const LAS gbf16x8*)(kimg + (16 * jt + l15) * GQP + (32 * ks + 8 * g) * 2);
                    st[jt] = __builtin_amdgcn_mfma_f32_16x16x32_bf16(kf, qf[ks], st[jt], 0, 0, 0); }
                const int i = 16 * q4 + l15;
#pragma unroll
                for (int r = 0; r < 4; ++r) { const int jj = 16 * jt + 4 * g + r; const bool keep = dir == 0 ? (jj <= i) : (jj >= i); st[jt][r] = keep ? st[jt][r] : 0.f; } }
            gbf16x8 pa[2];
#pragma unroll
            for (int k2 = 0; k2 < 2; ++k2) { const unsigned w0 = pk2(st[2 * k2][0], st[2 * k2][1]), w1 = pk2(st[2 * k2][2], st[2 * k2][3]), w2 = pk2(st[2 * k2 + 1][0], st[2 * k2 + 1][1]), w3 = pk2(st[2 * k2 + 1][2], st[2 * k2 + 1][3]);
                pa[k2] = __builtin_bit_cast(gbf16x8, (v4u){w0, w1, w2, w3}); }
#pragma unroll
            for (int c = 0; c < 8; ++c) {
#pragma unroll
                for (int k2 = 0; k2 < 2; ++k2) { const LAS unsigned char* pv = vimg + (32 * k2 + 4 * g + qq) * GVP + (16 * c + 4 * p4) * 2;
                    const gbf16x8 vf = gcat(gtr(pv), gtr(pv + 16 * GVP));
                    o[c] = __builtin_amdgcn_mfma_f32_16x16x32_bf16(pa[k2], vf, o[c], 0, 0, 0); }
#pragma unroll
                for (int ks = 0; ks < 2; ++ks) o[c] = __builtin_amdgcn_mfma_f32_16x16x32_bf16(qf[ks], dir ? sfB[c][ks] : sfA[c][ks], o[c], 0, 0, 0);
            }
        }
        if (skipmask & 4) continue;
        float ss[4];
#pragma unroll
        for (int r = 0; r < 4; ++r) { float t2 = 0.f;
#pragma unroll
            for (int c = 0; c < 8; ++c) t2 += o[c][r] * o[c][r];
            t2 = sum16(t2);
            ss[r] = 1.f / sqrtf(t2 * (1.f / 128.f) + EPS); }
        LAS unsigned char* gimg = lds + GIMG_OFF + hl * (64 * GVP);
#pragma unroll
        for (int c = 0; c < 8; ++c) { const float gain = a->in[I_EVGLAG][j * 128 + 16 * c + l15];
#pragma unroll
            for (int r = 0; r < 4; ++r) { LAS bf16* gp = (LAS bf16*)(gimg + (16 * q4 + 4 * g + r) * GVP + (16 * c + l15) * 2);
                *gp = (bf16)f2bf(o[c][r] * ss[r] * gain * siluf(bf2f(*gp))); } }
        __syncthreads();
#pragma unroll
        for (int it = 0; it < 4; ++it) { const int ch = tid + it * NTHR, hh = ch >> 10, t = (ch >> 4) & 63, c16 = ch & 15;
            *(v4u*)(MIX + (row0 + t) * D + (hp * 2 + hh) * 128 + c16 * 8) = *(const LAS v4u*)(lds + GIMG_OFF + hh * (64 * GVP) + t * GVP + c16 * 16); }
    }
}

__device__ __forceinline__ void diff_out_phase(int wv_, KA a, int j, int layer) {
    const int tid_o = otid(), lane = tid_o & 63, wave = tid_o >> 6, gw = blockIdx.x * NWAVES + wave, NGW = gridDim.x * NWAVES;
    const bf16* O01 = (const bf16*)(a->ws + WS_Y); bf16* MIX = (bf16*)(a->ws + WS_A1);
    const float lam = ((const float*)(a->ws + WS_TAB))[8192 + j], post = 1.f - lam_init_of(layer);
    const int hd = lane >> 4, d8 = (lane & 15) * 8;
    float gn[8];
#pragma unroll
    for (int e = 0; e < 8; ++e) gn[e] = a->in[I_DIFFG][j * 128 + d8 + e] * post;
    for (int rb = gw; rb < R; rb += 4 * NGW) {
        v4u w0[4], w1[4];
#pragma unroll
        for (int k = 0; k < 4; ++k) { const int r = rb + k * NGW < R ? rb + k * NGW : rb; const bf16* o = O01 + (size_t)r * D + hd * 256 + d8; w0[k] = *(const v4u*)o; w1[k] = *(const v4u*)(o + 128); }
#pragma unroll
        for (int k = 0; k < 4; ++k) { const int r = rb + k * NGW;
            if (r >= R || (layer == DEPTH - 1 && row_cls(r) == 4)) continue;
            const unsigned a0[4] = {w0[k].x, w0[k].y, w0[k].z, w0[k].w}, a1[4] = {w1[k].x, w1[k].y, w1[k].z, w1[k].w};
            float v[8]; float ss = 0.f;
#pragma unroll
            for (int e = 0; e < 8; ++e) { const float x0 = __builtin_bit_cast(float, (e & 1) ? (a0[e >> 1] & 0xffff0000u) : (a0[e >> 1] << 16)), x1 = __builtin_bit_cast(float, (e & 1) ? (a1[e >> 1] & 0xffff0000u) : (a1[e >> 1] << 16));
                v[e] = x0 - lam * x1; ss += v[e] * v[e]; }
            ss = sum16(ss);
            const float rstd = 1.f / sqrtf(ss * (1.f / 128.f) + EPS);
            v4u ow; ow.x = pk2(v[0] * rstd * gn[0], v[1] * rstd * gn[1]); ow.y = pk2(v[2] * rstd * gn[2], v[3] * rstd * gn[3]); ow.z = pk2(v[4] * rstd * gn[4], v[5] * rstd * gn[5]); ow.w = pk2(v[6] * rstd * gn[6], v[7] * rstd * gn[7]);
            *(v4u*)(MIX + (size_t)r * D + 512 + hd * 128 + d8) = ow; }
    }
}

typedef float cf2 __attribute__((ext_vector_type(2)));
constexpr size_t WS_PT = WS_PH + 99 * MiB;
constexpr size_t WS_HYS = WS_A1;
constexpr float TWC[16] = {1.000000000e+00f, 9.807852804e-01f, 9.238795325e-01f, 8.314696123e-01f, 7.071067812e-01f, 5.555702330e-01f, 3.826834324e-01f, 1.950903220e-01f, 6.123233996e-17f, -1.950903220e-01f, -3.826834324e-01f, -5.555702330e-01f, -7.071067812e-01f, -8.314696123e-01f, -9.238795325e-01f, -9.807852804e-01f};
constexpr float TWS[16] = {0.000000000e+00f, 1.950903220e-01f, 3.826834324e-01f, 5.555702330e-01f, 7.071067812e-01f, 8.314696123e-01f, 9.238795325e-01f, 9.807852804e-01f, 1.000000000e+00f, 9.807852804e-01f, 9.238795325e-01f, 8.314696123e-01f, 7.071067812e-01f, 5.555702330e-01f, 3.826834324e-01f, 1.950903220e-01f};
__device__ __forceinline__ cf2 cmul(cf2 a, cf2 b) { return (cf2){a.x * b.x - a.y * b.y, a.x * b.y + a.y * b.x}; }
__device__ __forceinline__ cf2 cmulc(cf2 a, cf2 b) { return (cf2){a.x * b.x + a.y * b.y, a.y * b.x - a.x * b.y}; }
template <bool INV> __device__ __forceinline__ cf2 tw_mul(cf2 d, int ti) {
    if (ti == 0) return d;
    if (ti == 8) return INV ? (cf2){-d.y, d.x} : (cf2){d.y, -d.x};
    const float c = TWC[ti], s = TWS[ti];
    return INV ? (cf2){d.x * c - d.y * s, d.y * c + d.x * s} : (cf2){d.x * c + d.y * s, d.y * c - d.x * s};
}
template <int N, int H, bool INV> struct FftStage {
    static __device__ __forceinline__ void run(cf2 (&x)[N]) {
#pragma unroll
        for (int g = 0; g < N; g += 2 * H)
#pragma unroll
            for (int j = 0; j < H; ++j) { const cf2 a = x[g + j], b = x[g + j + H]; x[g + j] = a + b; x[g + j + H] = tw_mul<INV>(a - b, j * (16 / H)); }
        FftStage<N, H / 2, INV>::run(x);
    }
};
template <int N, bool INV> struct FftStage<N, 0, INV> { static __device__ __forceinline__ void run(cf2 (&)[N]) {} };
template <int N, bool INV> __device__ __forceinline__ void fft_reg(cf2 (&x)[N]) { FftStage<N, N / 2, INV>::run(x); }
__device__ __forceinline__ void fft32_half(cf2 (&x)[32]) {
#pragma unroll
    for (int j = 0; j < 16; ++j) x[j + 16] = tw_mul<false>(x[j], j);
    FftStage<32, 8, false>::run(x);
}
__host__ __device__ constexpr int br5(int i) { return ((i & 1) << 4) | ((i & 2) << 2) | (i & 4) | ((i & 8) >> 2) | ((i & 16) >> 4); }
__host__ __device__ constexpr int br4(int i) { return ((i & 1) << 3) | ((i & 2) << 1) | ((i & 4) >> 1) | ((i & 8) >> 3); }

#define HY_OPAQUE(w) asm volatile("" : "+v"(w.x), "+v"(w.y))
__device__ __forceinline__ void hy_p1_store(LAS cf2* buf, cf2 (&x)[32], int m, cf2 w1) {
    HY_OPAQUE(w1);
    const int base = 17 * (m >> 4) + (m & 15); cf2 pw = (cf2){1.f, 0.f};
#pragma unroll
    for (int k = 0; k < 32; ++k) { if (k) { pw = cmul(pw, w1); x[br5(k)] = cmul(x[br5(k)], pw); } buf[560 * k + base] = x[br5(k)]; }
}
__device__ __forceinline__ void hy_p2(LAS cf2* buf, int tid, cf2 w2) {
    HY_OPAQUE(w2);
    const int base = 560 * (tid >> 4) + (tid & 15); cf2 x[32];
#pragma unroll
    for (int n = 0; n < 32; ++n) x[n] = buf[base + 17 * n];
    fft_reg<32, false>(x);
    cf2 pw = (cf2){1.f, 0.f};
#pragma unroll
    for (int k = 0; k < 32; ++k) { if (k) { pw = cmul(pw, w2); x[br5(k)] = cmul(x[br5(k)], pw); } buf[base + 17 * k] = x[br5(k)]; }
}
template <int MODE> __device__ __forceinline__ void hy_p3(LAS cf2* buf, int tid, cf2* kf) {
#pragma unroll
    for (int i = 0; i < 2; ++i) {
        const int blk = tid + 512 * i, base = 560 * (blk >> 5) + 17 * (blk & 31); cf2 x[16];
#pragma unroll
        for (int n = 0; n < 16; ++n) x[n] = buf[base + n];
        fft_reg<16, false>(x);
        cf2* kp = kf + (size_t)(i * 16) * 512 + tid;
        if (MODE == 0) {
#pragma unroll
            for (int r = 0; r < 16; ++r) kp[r * 512] = x[r] * (1.f / 16384.f);
        } else {
            cf2 y[16];
#pragma unroll
            for (int r = 0; r < 16; ++r) x[r] = cmul(x[r], kp[r * 512]);
#pragma unroll
            for (int k = 0; k < 16; ++k) y[k] = x[br4(k)];
            fft_reg<16, true>(y);
#pragma unroll
            for (int r = 0; r < 16; ++r) buf[base + br4(r)] = y[r];
        }
    }
}
__device__ __forceinline__ void hy_ip2(LAS cf2* buf, int tid, cf2 w2) {
    HY_OPAQUE(w2);
    const int base = 560 * (tid >> 4) + (tid & 15); cf2 x[32]; cf2 pw = (cf2){1.f, 0.f};
#pragma unroll
    for (int k = 0; k < 32; ++k) { x[k] = buf[base + 17 * k]; if (k) { pw = cmulc(pw, w2); x[k] = cmul(x[k], pw); } }
    fft_reg<32, true>(x);
#pragma unroll
    for (int r = 0; r < 32; ++r) buf[base + 17 * br5(r)] = x[r];
}
__device__ __forceinline__ void hy_ip3(const LAS cf2* buf, cf2 (&x)[32], int m, cf2 w1) {
    HY_OPAQUE(w1);
    const int base = 17 * (m >> 4) + (m & 15); cf2 pw = (cf2){1.f, 0.f};
#pragma unroll
    for (int k = 0; k < 32; ++k) { x[k] = buf[560 * k + base]; if (k) { pw = cmulc(pw, w1); x[k] = cmul(x[k], pw); } }
    fft_reg<32, true>(x);
}
__device__ __forceinline__ float hy_sconv(const bf16* row, int L, int t, float w0, float w1, float w2, float cb) {
    float u0 = bf2f(row[t - 1]), u1 = bf2f(row[t]), u2 = bf2f(row[t + 1]); u0 = t > 0 ? u0 : 0.f; u2 = t + 1 < L ? u2 : 0.f;
    return u0 * w0 + u1 * w1 + u2 * w2 + cb;
}
__device__ __forceinline__ void hyena_fft_phase(int wv_, KA a, int j, bool do_ctx, LAS unsigned char* lds, bool dry = false, int skipmask = 0) {
    const int tid0 = otid();
    LAS cf2* buf = (LAS cf2*)lds;
    unsigned char* ws = a->ws;
    bf16* PT = (bf16*)(ws + WS_PT); const float* HF = (const float*)(ws + WS_HF);
    cf2* KF = (cf2*)(ws + WS_HYS + (size_t)blockIdx.x * 262144); float* Z1 = (float*)(ws + WS_HYS + (size_t)blockIdx.x * 262144 + 131072);
    const float* cw = a->in[I_ODCONVW] + (size_t)j * 3 * 1536; const float* cb = a->in[I_ODCONVB] + j * 1536; const float* hb = a->in[I_HYBIAS] + j * 1024;
    const float a1 = -6.283185307179586f * (float)tid0 * (1.f / 16384.f), a2 = -6.283185307179586f * (float)(tid0 & 15) * (1.f / 512.f);
    const cf2 w1 = (cf2){cosf(a1), sinf(a1)}, w2 = (cf2){cosf(a2), sinf(a2)};
    for (int c = blockIdx.x; c < 512; c += gridDim.x) {
#pragma unroll 1
        for (int o = 0; o < 2; ++o) {
            const float bias = hb[o * 512 + c];
            const int chg = 512 * (o + 1) + c;
            const float gw0 = cw[chg], gw1 = cw[1536 + chg], gw2 = cw[3072 + chg], gcb = cb[chg];
            if (!(skipmask & 1)) {
                int tid = tid0; asm volatile("" : "+v"(tid)); const int m = tid;
                const float* hf = HF + (size_t)(o * 1024 + c) * SEQ; const float* hbk = HF + (size_t)(o * 1024 + 512 + c) * SEQ;
                cf2 x[32];
#pragma unroll
                for (int n1 = 0; n1 < 32; ++n1) { float v;
                    if (n1 < 16) v = hf[512 * n1 + m]; else if (n1 == 16) v = m == 0 ? 0.f : hbk[8192 - m]; else v = hbk[16384 - 512 * n1 - m];
                    x[n1] = (cf2){v, 0.f}; }
                fft_reg<32, false>(x);
                hy_p1_store(buf, x, m, w1);
                __syncthreads(); hy_p2(buf, tid, w2); __syncthreads(); hy_p3<0>(buf, tid, KF); __syncthreads();
            }
#pragma unroll 1
            for (int pr = 0; pr < ((skipmask & 2) ? 0 : 2); ++pr) {
                int tid = tid0; asm volatile("" : "+v"(tid)); const int m = tid;
                cf2 xin[16];
                if (o == 0) { const float vw0 = cw[c], vw1 = cw[1536 + c], vw2 = cw[3072 + c], vcb = cb[c];
                    const bf16* r0 = PT + (size_t)c * R + (size_t)(2 * pr) * PB + CTXL; const bf16* r1 = r0 + PB;
#pragma unroll
                    for (int n1 = 0; n1 < 16; ++n1) xin[n1] = (cf2){hy_sconv(r0, SEQ, 512 * n1 + m, vw0, vw1, vw2, vcb), hy_sconv(r1, SEQ, 512 * n1 + m, vw0, vw1, vw2, vcb)}; }
                else {
#pragma unroll
                    for (int n1 = 0; n1 < 16; ++n1) xin[n1] = (cf2){Z1[(2 * pr) * SEQ + 512 * n1 + m], Z1[(2 * pr + 1) * SEQ + 512 * n1 + m]}; }
                cf2 x[32];
#pragma unroll
                for (int n1 = 0; n1 < 16; ++n1) x[n1] = xin[n1];
                fft32_half(x);
                hy_p1_store(buf, x, m, w1);
                __syncthreads(); hy_p2(buf, tid, w2); __syncthreads(); hy_p3<1>(buf, tid, KF); __syncthreads(); hy_ip2(buf, tid, w2); __syncthreads();
                hy_ip3(buf, x, m, w1);
                __syncthreads();
                const bf16* g0 = PT + (size_t)chg * R + (size_t)(2 * pr) * PB + CTXL; const bf16* g1 = g0 + PB;
#pragma unroll
                for (int i = 0; i < 32; ++i) { const int n1 = br5(i); if (n1 >= 16) continue; const int n = 512 * n1 + m;
                    const float z0 = hy_sconv(g0, SEQ, n, gw0, gw1, gw2, gcb) * (x[i].x + xin[n1].x * bias), z1 = hy_sconv(g1, SEQ, n, gw0, gw1, gw2, gcb) * (x[i].y + xin[n1].y * bias);
                    if (o == 0) { Z1[(2 * pr) * SEQ + n] = z0; Z1[(2 * pr + 1) * SEQ + n] = z1; }
                    else if (dry) { Z1[(2 * pr) * SEQ + n] = z0; Z1[(2 * pr + 1) * SEQ + n] = z1; }
                    else { bf16* o0 = PT + (size_t)c * R + (size_t)(2 * pr) * PB + CTXL; o0[n] = (bf16)f2bf(z0); o0[PB + n] = (bf16)f2bf(z1); } }
            }
        }
        if (do_ctx) {
            int tid = tid0; asm volatile("" : "+v"(tid));
            LAS float* uin = (LAS float*)lds;
            LAS float* hfl = uin + 3072;
            LAS float* z1c = hfl + 1024;
            const float* HFC = HF + (size_t)2048 * SEQ;
            __syncthreads();
            for (int idx = tid; idx < 3072; idx += NTHR) { const int k3 = idx >> 10, b = (idx >> 8) & 3, t = idx & 255, ch = 512 * k3 + c;
                uin[idx] = hy_sconv(PT + (size_t)ch * R + (size_t)b * PB, CTXL, t, cw[ch], cw[1536 + ch], cw[3072 + ch], cb[ch]); }
            for (int idx = tid; idx < 1024; idx += NTHR) hfl[idx] = HFC[(size_t)((idx >> 9) * 1024 + ((idx >> 8) & 1) * 512 + c) * CTXL + (idx & 255)];
            __syncthreads();
#pragma unroll 1
            for (int o = 0; o < 2; ++o) {
                const float bias = hb[o * 512 + c];
                float zz[2];
#pragma unroll
                for (int e = 0; e < 2; ++e) { const int oi = tid * 2 + e, b = oi >> 8, t = oi & 255;
                    const LAS float* in = o == 0 ? uin + b * 256 : z1c + b * 256; const LAS float* hfw = hfl + o * 512; const LAS float* hbw = hfw + 256;
                    float acc = 0.f;
                    for (int s = 0; s <= t; ++s) acc += hfw[t - s] * in[s];
                    for (int s = t + 1; s < 256; ++s) acc += hbw[s - t] * in[s];
                    zz[e] = uin[(1 + o) * 1024 + b * 256 + t] * (acc + in[t] * bias); }
                __syncthreads();
#pragma unroll
                for (int e = 0; e < 2; ++e) { const int oi = tid * 2 + e, b = oi >> 8, t = oi & 255;
                    if (o == 0 || dry) z1c[b * 256 + t] = zz[e]; else PT[(size_t)c * R + (size_t)b * PB + t] = (bf16)f2bf(zz[e]); }
                __syncthreads();
            }
        }
    }
}
__device__ __forceinline__ void hyena_transpose_phase(int wv_, KA a, LAS unsigned char* lds) {
    const int tid = otid();
    unsigned char* ws = a->ws; const bf16* PT = (const bf16*)(ws + WS_PT); bf16* MIX = (bf16*)(ws + WS_A1);
    constexpr int NT = 8 * (R / 64), TSZ = 64 * 66;
    for (int tb = blockIdx.x * 4; tb < NT; tb += gridDim.x * 4) {
        __syncthreads();
        v4u v[4];
#pragma unroll
        for (int k = 0; k < 4; ++k) { const int t = tb + k < NT ? tb + k : NT - 1; const int c0 = (t & 7) * 64, r0 = (t >> 3) * 64, cc = tid >> 3, rc = tid & 7;
            v[k] = *(const v4u*)(PT + (size_t)(c0 + cc) * R + r0 + rc * 8); }
#pragma unroll
        for (int k = 0; k < 4; ++k) { const int cc = tid >> 3, rc = tid & 7; LAS unsigned* d = (LAS unsigned*)((LAS bf16*)lds + k * TSZ + cc * 66 + rc * 8); d[0] = v[k].x; d[1] = v[k].y; d[2] = v[k].z; d[3] = v[k].w; }
        __syncthreads();
#pragma unroll
        for (int k = 0; k < 4; ++k) { if (tb + k >= NT) break; const int t = tb + k, c0 = (t & 7) * 64, r0 = (t >> 3) * 64, rr = tid >> 3, cch = tid & 7; const LAS bf16* tile = (const LAS bf16*)lds + k * TSZ; unsigned w[4];
#pragma unroll
            for (int e = 0; e < 4; ++e) w[e] = (unsigned)tile[(cch * 8 + 2 * e) * 66 + rr] | ((unsigned)tile[(cch * 8 + 2 * e + 1) * 66 + rr] << 16);
            *(v4u*)(MIX + (size_t)(r0 + rr) * D + c0 + cch * 8) = (v4u){w[0], w[1], w[2], w[3]}; }
    }
}

__device__ __forceinline__ void hyena_filter_phase(int wv_, KA a, int j) {
    typedef float f32x16_t __attribute__((ext_vector_type(16)));
    const int tid = otid(), lane = tid & 63, wave = tid >> 6, gw = blockIdx.x * NWAVES + wave, NGW = gridDim.x * NWAVES, l31 = lane & 31, h = lane >> 5;
    const float* w3 = a->in[I_FW3] + (size_t)j * 64 * 2048; unsigned char* ws = a->ws;
    const float da = logf(1e-2f) / 0.3f, db = logf(1e-2f) / 1.5f;
    for (int it = gw; it < 64 * 33; it += NGW) {
        const int ct = it & 63, tg = it >> 6; const bool isctx = tg == 32; const int L = isctx ? CTXL : SEQ;
        const float* hid = (const float*)(ws + WS_HID) + (isctx ? (size_t)(2 * SEQ + j * CTXL) * 64 : (size_t)(j * SEQ) * 64);
        float* HF = (float*)(ws + WS_HF) + (isctx ? (size_t)2048 * SEQ : 0);
        float aw[32];
#pragma unroll
        for (int sx = 0; sx < 32; ++sx) aw[sx] = w3[(size_t)(32 * h + sx) * 2048 + ct * 32 + l31];
        float dl[16];
#pragma unroll
        for (int r = 0; r < 16; ++r) { const int col = ct * 32 + (r & 3) + 8 * (r >> 2) + 4 * h; dl[r] = fabsf(da + (float)(col & 511) * ((db - da) / 511.f)); }
#pragma unroll 1
        for (int tt = 0; tt < 8; ++tt) {
            const int t0 = (isctx ? tt : 8 * tg + tt) * 32, t = t0 + l31;
            const f32x4* hr = (const f32x4*)(hid + (size_t)t * 64 + 32 * h);
            float bv[32];
#pragma unroll
            for (int q4 = 0; q4 < 8; ++q4) { const f32x4 v = hr[q4]; bv[4 * q4] = v.x; bv[4 * q4 + 1] = v.y; bv[4 * q4 + 2] = v.z; bv[4 * q4 + 3] = v.w; }
            f32x16_t acc = {};
#pragma unroll
            for (int sx = 0; sx < 32; ++sx) acc = __builtin_amdgcn_mfma_f32_32x32x2f32(aw[sx], bv[sx], acc, 0, 0, 0);
            const float tf = (float)t / (float)(L - 1);
#pragma unroll
            for (int r = 0; r < 16; ++r) { const int col = ct * 32 + (r & 3) + 8 * (r >> 2) + 4 * h; HF[(size_t)col * L + t] = acc[r] * __expf(-tf * dl[r]); }
        }
    }
}
#ifndef PROBE_REPEAT
#define PROBE_REPEAT 0
#endif
#define PRB(id, stmt) do { if (PROBE_REPEAT == (id)) { stmt; __syncthreads(); } } while (0)
__global__ void __launch_bounds__(NTHR, 2) fwd_kernel(Args a_unused) {
    extern __shared__ __attribute__((aligned(16))) unsigned char lds_raw[];
    LAS unsigned char* lds = (LAS unsigned char*)lds_raw;
    volatile LAS unsigned* MISC = (volatile LAS unsigned*)(lds + LDS_MISC);
    const KA a0 = (KA)__builtin_amdgcn_kernarg_segment_ptr();
    if (threadIdx.x < 64) MISC[threadIdx.x] = 0u;
    const int wv_ = __builtin_amdgcn_readfirstlane(threadIdx.x >> 6);
    __syncthreads();
    const int lo = a0->ph_lo, hi = a0->ph_hi;
    XcdBarrier bar; bar.bar = (unsigned*)(a0->ws + WS_CTL) + CW_BAR; bar.x = 0; bar.st = MISC + 8;
    if (hi - lo > 1) bar = xcd_barrier_post((unsigned*)(a0->ws + WS_CTL) + CW_BAR, MISC + 8);
#define IN(k) (lo <= (k) && (k) < hi)
#define SEAM(k) do { if (IN((k) + 1)) { xcd_barrier(bar, wv_); if (PROBE_REPEAT == 20) xcd_barrier(bar, wv_); } } while (0)
    if (IN(0)) { PRB(13, p0a_prologue(wv_, ka_launder(a0), lds)); p0a_prologue(wv_, ka_launder(a0), lds); SEAM(0); }
    if (IN(1)) { PRB(14, p0b_first_norm(wv_, ka_launder(a0))); p0b_first_norm(wv_, ka_launder(a0)); SEAM(1); }
#pragma unroll 1
    for (int layer = 0; layer < DEPTH; ++layer) {
        const int pb = 2 + 9 * layer, j = layer >> 1; const bool odd = layer & 1; const int last = layer == DEPTH - 1;
        if (IN(pb + 0)) {
            const KA a = ka_launder(a0); unsigned char* ws = a->ws; const unsigned char* wl = ws + WS_W;
            if (odd) { hyena_filter_phase(wv_, ka_launder(a0), j); __syncthreads(); }
            if (odd) {
                pg8::Gemm g{nullptr, nullptr, R, NP_OD, D, 0}; pg8::DualOrder S;
                S.init(ws + WS_A1, wl + W_IN + (size_t)1536 * D * 2, R, 1536, wl + W_IN, ws + WS_A1, 1536, R, (int)gridDim.x, obx());
                pg8::EpiInProj E{(bf16*)(ws + WS_PH), NP_OD, (bf16*)(ws + WS_PT), R, (const float*)(ws + WS_TAB), nullptr, 1, C2};
                PRB(1, (pg8::gemm_phase<pg8::EpiInProj, pg8::DualOrder, true, true>(lds, g, S, E, otid())));
                pg8::gemm_phase<pg8::EpiInProj, pg8::DualOrder, true, true>(lds, g, S, E, otid());
            } else {
                pg8::Gemm g{(const bf16*)(ws + WS_A1), (const bf16*)(wl + W_IN), R, NP_EV, D, 0}; pg8::StaticOrder S; S.init(R, NP_EV, (int)gridDim.x, obx());
                pg8::EpiInProj E{(bf16*)(ws + WS_PH), NP_EV, nullptr, 0, (const float*)(ws + WS_TAB), a->in[I_EVQKG] + j * 128, 0, C2};
                PRB(1, (pg8::gemm_phase<pg8::EpiInProj, pg8::StaticOrder, true, true>(lds, g, S, E, otid())));
                pg8::gemm_phase<pg8::EpiInProj, pg8::StaticOrder, true, true>(lds, g, S, E, otid());
            }
            SEAM(pb + 0);
        }
        if (IN(pb + 1)) {
            if (!odd) { PRB(2, gla_state_phase(wv_, ka_launder(a0), j, lds)); gla_state_phase(wv_, ka_launder(a0), j, lds); SEAM(pb + 1); }
        }
        if (IN(pb + 2)) {
            if (odd) { PRB(7, hyena_fft_phase(wv_, ka_launder(a0), j, layer != DEPTH - 1, lds, true)); PRB(71, hyena_fft_phase(wv_, ka_launder(a0), j, false, lds, true, 2)); PRB(72, hyena_fft_phase(wv_, ka_launder(a0), j, false, lds, true, 1)); hyena_fft_phase(wv_, ka_launder(a0), j, layer != DEPTH - 1, lds); __syncthreads(); PRB(6, attn_phase_fast(wv_, ka_launder(a0), true, (char*)lds_raw, last)); attn_phase_fast(wv_, ka_launder(a0), true, (char*)lds_raw, last); }
            else { PRB(4, gla_scan_phase(wv_, ka_launder(a0))); gla_scan_phase(wv_, ka_launder(a0)); __syncthreads(); PRB(5, attn_phase_fast(wv_, ka_launder(a0), false, (char*)lds_raw)); attn_phase_fast(wv_, ka_launder(a0), false, (char*)lds_raw); }
            SEAM(pb + 2);
        }
        if (IN(pb + 3)) {
            if (odd) { PRB(9, (diff_out_phase(wv_, ka_launder(a0), j, layer), hyena_transpose_phase(wv_, ka_launder(a0), lds))); diff_out_phase(wv_, ka_launder(a0), j, layer); hyena_transpose_phase(wv_, ka_launder(a0), lds); } else { PRB(8, gla_output_phase(wv_, ka_launder(a0), j, lds)); PRB(31, gla_output_phase(wv_, ka_launder(a0), j, lds, 1)); PRB(32, gla_output_phase(wv_, ka_launder(a0), j, lds, 2)); PRB(34, gla_output_phase(wv_, ka_launder(a0), j, lds, 4)); PRB(37, gla_output_phase(wv_, ka_launder(a0), j, lds, 7)); gla_output_phase(wv_, ka_launder(a0), j, lds); }
            SEAM(pb + 3);
        }
        if (IN(pb + 4)) {
            const KA a = ka_launder(a0); unsigned char* ws = a->ws; const unsigned char* wl = ws + WS_W;
            pg8::Gemm g{(const bf16*)(ws + WS_A1), (const bf16*)(wl + W_OUT), R, D, D, 0}; pg8::StaticOrder S; S.init(last ? NB * SEQ : R, D, (int)gridDim.x, obx(), last);
            pg8::EpiBf16<0> E{(bf16*)(ws + WS_Y), D};
            PRB(10, (pg8::gemm_phase<pg8::EpiBf16<0>, pg8::StaticOrder, true, true>(lds, g, S, E, otid())));
            pg8::gemm_phase<pg8::EpiBf16<0>, pg8::StaticOrder, true, true>(lds, g, S, E, otid());
            SEAM(pb + 4);
        }
        if (IN(pb + 5)) { if (!last) { convert_layer_weights(wv_, ka_launder(a0), layer + 1, 3, lds); __syncthreads(); } PRB(15, rowwise_post(wv_, ka_launder(a0), layer, 0, lds)); rowwise_post(wv_, ka_launder(a0), layer, 0, lds); SEAM(pb + 5); }
        if (IN(pb + 6)) {
            const KA a = ka_launder(a0); unsigned char* ws = a->ws; const unsigned char* wl = ws + WS_W;
            pg8::Gemm g{(const bf16*)(ws + WS_A1), (const bf16*)(wl + W_1), R, DFF, D, 0}; pg8::StaticOrder S; S.init(last ? NB * SEQ : R, DFF, (int)gridDim.x, obx(), last);
            pg8::EpiBf16<2> E{(bf16*)(ws + WS_PH), DFF};
            PRB(11, (pg8::gemm_phase<pg8::EpiBf16<2>, pg8::StaticOrder, true, true>(lds, g, S, E, otid())));
            if (PROBE_REPEAT == 41) { pg8::EpiBf16<2> E2{(bf16*)(ws + WS_PH), DFF, 1}; pg8::gemm_phase<pg8::EpiBf16<2>, pg8::StaticOrder, true, true>(lds, g, S, E2, otid()); __syncthreads(); }
            pg8::gemm_phase<pg8::EpiBf16<2>, pg8::StaticOrder, true, true>(lds, g, S, E, otid());
            SEAM(pb + 6);
        }
        if (IN(pb + 7)) {
            const KA a = ka_launder(a0); unsigned char* ws = a->ws; const unsigned char* wl = ws + WS_W;
            { pg8::Gemm g{(const bf16*)(ws + WS_PH), (const bf16*)(wl + W_2), R, D, DFF, 0}; pg8::StaticOrder S; S.init(NB * SEQ, D, (int)gridDim.x, obx(), 1);
              pg8::EpiBf16<0> E{(bf16*)(ws + WS_A1), D};
              PRB(12, (pg8::gemm_phase<pg8::EpiBf16<0>, pg8::StaticOrder, true, true>(lds, g, S, E, otid())));
              pg8::gemm_phase<pg8::EpiBf16<0>, pg8::StaticOrder, true, true>(lds, g, S, E, otid()); }
            if (!last) { __syncthreads();
              pg8::Gemm g{(const bf16*)(ws + WS_PH), (const bf16*)(wl + W_2), 4 * 256, D, DFF / 4, DFF}; pg8::CtxSplitOrder<4, 4> S; S.init(DFF / 4, (int)gridDim.x, obx());
              pg8::EpiSlab E{(bf16*)(ws + WS_SLAB), D, (size_t)1024 * D};
              pg8::gemm_phase<pg8::EpiSlab, pg8::CtxSplitOrder<4, 4>, true, true>(lds, g, S, E, otid()); }
            SEAM(pb + 7);
        }
        if (IN(pb + 8)) { if (!last) { convert_layer_weights(wv_, ka_launder(a0), layer + 1, 12, lds); __syncthreads(); } rowwise_post(wv_, ka_launder(a0), layer, 1, lds); SEAM(pb + 8); }
    }
#undef IN
#undef SEAM
}

constexpr int N_PHASES = 2 + 9 * DEPTH;
#ifndef MK_ONE_LAUNCH
#define MK_ONE_LAUNCH 1
#endif
extern "C" void kernel_launch(void* const* d_in, const int* in_sizes, int n_in, void* d_out, int out_size, void* d_ws, size_t ws_size, hipStream_t stream) {
    static int grid = 0;
    if (grid == 0) {
        if (n_in != 27 || in_sizes[0] != NB * SEQ * D || out_size != NB * SEQ * D || ws_size < WS_END) { fprintf(stderr, "kernel_launch: unexpected shapes (n_in %d, in0 %d, out %d, ws %zu)\n", n_in, n_in > 0 ? in_sizes[0] : -1, out_size, ws_size); grid = -1; return; }
        int dev = 0, cus = 0;
        if (hipGetDevice(&dev) != hipSuccess || hipDeviceGetAttribute(&cus, hipDeviceAttributeMultiprocessorCount, dev) != hipSuccess) { grid = -1; return; }
        if (hipFuncSetAttribute((const void*)fwd_kernel, hipFuncAttributeMaxDynamicSharedMemorySize, LDS_BYTES) != hipSuccess) { fprintf(stderr, "kernel_launch: hipFuncSetAttribute failed\n"); grid = -1; return; }
        (void)hipGetLastError();
        grid = cus;
    }
    if (grid < 0) return;
    if (hipMemsetAsync((char*)d_ws + WS_CTL, 0, CTL_ZERO_BYTES, stream) != hipSuccess) return;
    Args a{};
    for (int i = 0; i < 27; ++i) a.in[i] = (const float*)d_in[i];
    a.out = (float*)d_out; a.ws = (unsigned char*)d_ws;
#if MK_ONE_LAUNCH
    a.ph_lo = 0; a.ph_hi = N_PHASES;
    hipLaunchKernelGGL(fwd_kernel, dim3(grid), dim3(NTHR), LDS_BYTES, stream, a);
#else
    for (int k = 0; k < N_PHASES; ++k) { a.ph_lo = k; a.ph_hi = k + 1; hipLaunchKernelGGL(fwd_kernel, dim3(grid), dim3(NTHR), LDS_BYTES, stream, a); }
#endif
}
```

```cpp
#include <hip/hip_runtime.h>
#include <cstdio>
#include <cstdint>
#include <hip/hip_bf16.h>
#include <cmath>

namespace pg8 {
#define PG8_LAS __attribute__((address_space(3)))
typedef unsigned short bf16_t;
typedef short bf16x8 __attribute__((ext_vector_type(8)));
typedef float f32x4 __attribute__((ext_vector_type(4)));
typedef unsigned u32x4 __attribute__((ext_vector_type(4)));
constexpr int BM = 256, BK = 64, HALF = 128, HTB = HALF * BK * 2  , STAGE_BYTES = 8 * HTB, NXCD = 8, WGM = 8;

__host__ __device__ __forceinline__ int lds_byte(int r, int c) { const int st = (r >> 4) * 2 + (c >> 5), rr = r & 15, cc = c & 31, ob = rr * 64 + cc * 2; return st * 1024 + (ob ^ (((ob >> 9) & 1) << 5)); }
__host__ __device__ __forceinline__ void stage_rc(int b, int& R, int& C) { const int st = b / 1024, sb = b % 1024, swz = sb ^ (((sb >> 9) & 1) << 5); R = (st >> 1) * 16 + swz / 64; C = (st & 1) * 32 + (swz % 64) / 2; }
__host__ __device__ __forceinline__ int perm32(int rho) { const int n = rho >> 4, i = rho & 15; return 8 * (i >> 2) + 4 * n + (i & 3); }

struct Unit { int pm, pn, kind; };
struct Gemm { const bf16_t* A; const bf16_t* Bt; int M, N, K; int ld; };

struct StaticOrder {
    int nM, nN, nwg, G, c, skip;
    __host__ __device__ void init(int M, int N, int G_, int c_, int skip_ = 0) { nM = M / BM; nN = N / BM; nwg = nM * nN; G = G_; c = c_; skip = skip_; }
    __host__ __device__ bool next(int i, Unit& u) const {
        const long L = (long)i * G + c; if (L >= nwg) return false;
        int wgid = (int)L; { const int q = nwg / NXCD, r = nwg % NXCD, xcd = wgid % NXCD, off = wgid / NXCD; wgid = (xcd < r ? xcd * (q + 1) : r * (q + 1) + (xcd - r) * q) + off; }
        const int nig = WGM * nN, gid = wgid / nig, fm = gid * WGM, gsz = (nM - fm) < WGM ? (nM - fm) : WGM;
        u.pm = fm + ((wgid % nig) % gsz); u.pn = (wgid % nig) / gsz; u.kind = 0; if (skip) u.pm += (u.pm >> 5) + 1; return true;
    }
    __device__ __forceinline__ const char* abase(const Gemm& g, const Unit& u, size_t tstep) const { return (const char*)g.A + (size_t)u.pm * tstep; }
    __device__ __forceinline__ const char* bbase(const Gemm& g, const Unit& u, size_t tstep) const { return (const char*)g.Bt + (size_t)u.pn * tstep; }
    __device__ __forceinline__ void a_ready(const Unit&) const {}
    __device__ __forceinline__ void done(const Unit&) const {}
};
struct DualOrder {
    StaticOrder s0, s1; const char *A0, *B0, *A1, *B1; int G, c;
    __device__ __forceinline__ void init(const void* a0, const void* b0, int M0, int N0, const void* a1, const void* b1, int M1, int N1, int G_, int c_) {
        s0.init(M0, N0, 1, 0); s1.init(M1, N1, 1, 0); A0 = (const char*)a0; B0 = (const char*)b0; A1 = (const char*)a1; B1 = (const char*)b1; G = G_; c = c_; }
    __device__ __forceinline__ bool next(int i, Unit& u) const {
        const int L = i * G + c;
        if (L < s0.nwg) { s0.next(L, u); u.kind = 0; return true; }
        if (L - s0.nwg < s1.nwg) { s1.next(L - s0.nwg, u); u.kind = 1; return true; }
        return false; }
    __device__ __forceinline__ const char* abase(const Gemm&, const Unit& u, size_t tstep) const { return (u.kind ? A1 : A0) + (size_t)u.pm * tstep; }
    __device__ __forceinline__ const char* bbase(const Gemm&, const Unit& u, size_t tstep) const { return (u.kind ? B1 : B0) + (size_t)u.pn * tstep; }
    __device__ __forceinline__ void a_ready(const Unit&) const {}
    __device__ __forceinline__ void done(const Unit&) const {}
};
template <int NN, int NS> struct CtxSplitOrder {
    int G, c; size_t kbytes;
    __device__ __forceinline__ void init(int Kslice, int G_, int c_) { G = G_; c = c_; kbytes = (size_t)Kslice * 2; }
    __device__ __forceinline__ bool next(int i, Unit& u) const { const int L = i * G + c; if (L >= 4 * NN * NS) return false; u.kind = L % NS; u.pn = (L / NS) % NN; u.pm = L / (NS * NN); return true; }
    __device__ __forceinline__ const char* abase(const Gemm& g, const Unit& u, size_t tstep) const { return (const char*)g.A + (size_t)(33 * u.pm) * tstep + (size_t)u.kind * kbytes; }
    __device__ __forceinline__ const char* bbase(const Gemm& g, const Unit& u, size_t tstep) const { return (const char*)g.Bt + (size_t)u.pn * tstep + (size_t)u.kind * kbytes; }
    __device__ __forceinline__ void a_ready(const Unit&) const {}
    __device__ __forceinline__ void done(const Unit&) const {}
};

__device__ __forceinline__ unsigned cvt_pk_bf16(float lo, float hi) { unsigned r; asm volatile("v_cvt_pk_bf16_f32 %0, %1, %2" : "=v"(r) : "v"(lo), "v"(hi)); return r; }
template <int ACT  > struct EpiBf16 {
    static constexpr bool PERM = true, AFTER_DRAIN = false;
    bf16_t* O; int ldc; int probe_nostore = 0;
    __device__ __forceinline__ void operator()(const f32x4 (&acc)[2][2][4][2], const Unit& u, int wr, int wc, int fr, int fq) const {
        if (probe_nostore && u.pm != 0x7fffffff) { float t = 0.f;
#pragma unroll
            for (int ai = 0; ai < 2; ++ai)
#pragma unroll
                for (int m = 0; m < 4; ++m)
#pragma unroll
                    for (int bj = 0; bj < 2; ++bj) t += acc[ai][bj][m][0][0] + acc[ai][bj][m][1][3];
            if (t == 1234.5678f) O[0] = 1; return; }
        const int row0 = u.pm * BM + wr * 64 + fr; const int col0 = u.pn * BM + wc * 32 + 8 * fq;
#pragma unroll
        for (int ai = 0; ai < 2; ++ai)
#pragma unroll
            for (int m = 0; m < 4; ++m) { bf16_t* rowp = O + (size_t)(row0 + ai * HALF + m * 16) * ldc + col0;
#pragma unroll
                for (int bj = 0; bj < 2; ++bj) { f32x4 v0 = acc[ai][bj][m][0], v1 = acc[ai][bj][m][1];
                    if (ACT == 2) {
#pragma unroll
                        for (int e = 0; e < 4; ++e) { const float a0 = fmaxf(v0[e], 0.f), a1 = fmaxf(v1[e], 0.f); v0[e] = a0 * a0; v1[e] = a1 * a1; } }
                    u32x4 w; w.x = cvt_pk_bf16(v0[0], v0[1]); w.y = cvt_pk_bf16(v0[2], v0[3]); w.z = cvt_pk_bf16(v1[0], v1[1]); w.w = cvt_pk_bf16(v1[2], v1[3]);
                    *(u32x4*)(rowp + bj * HALF) = w; } }
    }
};
struct EpiDual {
    static constexpr bool PERM = true, AFTER_DRAIN = false;
    bf16_t* O0; int ldc0; bf16_t* O1; int ldc1;
    __device__ __forceinline__ void operator()(const f32x4 (&acc)[2][2][4][2], const Unit& u, int wr, int wc, int fr, int fq) const {
        const EpiBf16<0> e{u.kind ? O1 : O0, u.kind ? ldc1 : ldc0}; e(acc, u, wr, wc, fr, fq);
    }
};
struct EpiInProj {
    static constexpr bool PERM = true, AFTER_DRAIN = false;
    bf16_t* O0; int ldc0; bf16_t* O1; int ldc1; const float* tab; const float* qkg; int odd; float qscale;
    __device__ __forceinline__ void operator()(const f32x4 (&acc)[2][2][4][2], const Unit& u, int wr, int wc, int fr, int fq) const {
        if (u.kind) { const EpiBf16<0> e{O1, ldc1}; e(acc, u, wr, wc, fr, fq); return; }
        const bool perm = !odd && u.pn >= 6 && u.pn <= 8;
        int mode = 0;
        if (odd) mode = u.pn < 2 ? 1 : (u.pn < 4 ? 2 : 0); else mode = (u.pn == 6 || u.pn == 7) ? 1 : ((u.pn == 8 && wc < 2) ? 2 : 0);
        const int pp = u.pm % 33; const bool rope = mode != 0 && pp != 0; const bool norm = mode != 0 && !odd;
        const int row0 = u.pm * BM + wr * 64 + fr;
        const int colb = u.pn * BM + (perm ? 64 * wc + 8 * fq : 32 * wc + 8 * fq), bjs = perm ? 32 : HALF;
        if (mode == 0) {
#pragma unroll
            for (int ai = 0; ai < 2; ++ai)
#pragma unroll
                for (int m = 0; m < 4; ++m) { bf16_t* rowp = O0 + (size_t)(row0 + ai * HALF + m * 16) * ldc0 + colb;
#pragma unroll
                    for (int bj = 0; bj < 2; ++bj) { const f32x4 v0 = acc[ai][bj][m][0], v1 = acc[ai][bj][m][1];
                        u32x4 w; w.x = cvt_pk_bf16(v0[0], v0[1]); w.y = cvt_pk_bf16(v0[2], v0[3]); w.z = cvt_pk_bf16(v1[0], v1[1]); w.w = cvt_pk_bf16(v1[2], v1[3]);
                        *(u32x4*)(rowp + bj * bjs) = w; } }
            return;
        }
        f32x4 G[2][2];
#pragma unroll
        for (int bj = 0; bj < 2; ++bj)
#pragma unroll
            for (int n = 0; n < 2; ++n) G[bj][n] = norm ? *(const f32x4*)(qkg + (mode == 2 ? 64 : 0) + 32 * bj + 8 * fq + 4 * n) : (f32x4){1.f, 1.f, 1.f, 1.f};
        const float sc = mode == 1 ? qscale : 1.f;
        const float* trow = tab + ((4 * (pp - 1) + wr) * 16 + 4 * fq) * 2;
        const float* tcol = tab + 4096 + (fr * 16 + 4 * fq) * 2;
        const f32x4 ID = (f32x4){1.f, 0.f, 1.f, 0.f};
        f32x4 TR[2][2];
#pragma unroll
        for (int ai = 0; ai < 2; ++ai) { TR[ai][0] = rope ? *(const f32x4*)(trow + ai * 64) : ID; TR[ai][1] = rope ? *(const f32x4*)(trow + ai * 64 + 4) : ID; }
        f32x4 TCn0 = rope ? *(const f32x4*)(tcol) : ID, TCn1 = rope ? *(const f32x4*)(tcol + 4) : ID;
#pragma unroll
        for (int m = 0; m < 4; ++m) {
            const f32x4 TC0 = TCn0, TC1 = TCn1;
            if (m < 3) { TCn0 = rope ? *(const f32x4*)(tcol + (m + 1) * 512) : ID; TCn1 = rope ? *(const f32x4*)(tcol + (m + 1) * 512 + 4) : ID; }
#pragma unroll
            for (int ai = 0; ai < 2; ++ai) {
                f32x4 v[2][2];
#pragma unroll
                for (int bj = 0; bj < 2; ++bj)
#pragma unroll
                    for (int n = 0; n < 2; ++n) v[bj][n] = acc[ai][bj][m][n];
                if (norm) { float ss = 0.f;
#pragma unroll
                    for (int bj = 0; bj < 2; ++bj)
#pragma unroll
                        for (int n = 0; n < 2; ++n) ss += (v[bj][n][0] * v[bj][n][0] + v[bj][n][1] * v[bj][n][1]) + (v[bj][n][2] * v[bj][n][2] + v[bj][n][3] * v[bj][n][3]);
                    { const unsigned u_ = __builtin_bit_cast(unsigned, ss); auto a_ = __builtin_amdgcn_permlane16_swap(u_, u_, false, false); ss = __builtin_bit_cast(float, (unsigned)a_[0]) + __builtin_bit_cast(float, (unsigned)a_[1]);
                      const unsigned w_ = __builtin_bit_cast(unsigned, ss); auto b_ = __builtin_amdgcn_permlane32_swap(w_, w_, false, false); ss = __builtin_bit_cast(float, (unsigned)b_[0]) + __builtin_bit_cast(float, (unsigned)b_[1]); }
                    const float rstd = 1.0f / sqrtf(ss * (1.f / 64.f) + 1e-6f);
#pragma unroll
                    for (int bj = 0; bj < 2; ++bj)
#pragma unroll
                        for (int n = 0; n < 2; ++n) v[bj][n] = (v[bj][n] * rstd) * G[bj][n]; }
                bf16_t* rowp = O0 + (size_t)(row0 + ai * HALF + m * 16) * ldc0 + colb;
#pragma unroll
                for (int bj = 0; bj < 2; ++bj) {
                    if (rope) {
                        const bool colang = odd ? (wc & 1) : (bj == 1);
                        const f32x4 T0 = colang ? TC0 : TR[ai][0], T1 = colang ? TC1 : TR[ai][1];
                        const f32x4 a0 = v[bj][0], a1 = v[bj][1];
                        v[bj][0] = (f32x4){a0[0] * T0[0] - a0[1] * T0[1], a0[0] * T0[1] + a0[1] * T0[0], a0[2] * T0[2] - a0[3] * T0[3], a0[2] * T0[3] + a0[3] * T0[2]};
                        v[bj][1] = (f32x4){a1[0] * T1[0] - a1[1] * T1[1], a1[0] * T1[1] + a1[1] * T1[0], a1[2] * T1[2] - a1[3] * T1[3], a1[2] * T1[3] + a1[3] * T1[2]};
                    }
                    const f32x4 x0 = v[bj][0] * sc, x1 = v[bj][1] * sc;
                    u32x4 w; w.x = cvt_pk_bf16(x0[0], x0[1]); w.y = cvt_pk_bf16(x0[2], x0[3]); w.z = cvt_pk_bf16(x1[0], x1[1]); w.w = cvt_pk_bf16(x1[2], x1[3]);
                    *(u32x4*)(rowp + bj * bjs) = w;
                }
            }
        }
    }
};
struct EpiSlab {
    static constexpr bool PERM = true, AFTER_DRAIN = false;
    bf16_t* O; int ldc; size_t slab;
    __device__ __forceinline__ void operator()(const f32x4 (&acc)[2][2][4][2], const Unit& u, int wr, int wc, int fr, int fq) const {
        const EpiBf16<0> e{O + (size_t)u.kind * slab, ldc}; e(acc, u, wr, wc, fr, fq);
    }
};

template <class Epi, class Sched, bool ALIGN_EPI = false, bool SP2 = false>
__device__ __forceinline__ void gemm_phase(PG8_LAS unsigned char* lds, const Gemm g, const Sched& S, const Epi& E, const int tid_in) {
    int tid_ = tid_in; asm volatile("" : "+v"(tid_));
    const int tid = tid_, wid = __builtin_amdgcn_readfirstlane(tid >> 6), lane = tid & 63, wr = wid >> 2, wc = wid & 3, fr = lane & 15, fq = lane >> 4;
    const int K = g.ld ? g.ld : g.K, nt = g.K / BK;
    unsigned voffA[2], voffB[2];
#pragma unroll
    for (int i = 0; i < 2; ++i) { int R, C; stage_rc(tid * 16 + i * 8192, R, C); const int Rb = Epi::PERM ? ((R & ~31) + perm32(R & 31)) : R;
        voffA[i] = (unsigned)(R * K + C) * 2u; voffB[i] = (unsigned)(Rb * K + C) * 2u; }
    const size_t kstep = (size_t)(BK * 2);
    const size_t hstep = (size_t)HALF * K * 2;
    const size_t tstep = 2 * hstep;
    const unsigned ldsw = (unsigned)wid * 1024u;
    const int aoff = lds_byte(wr * 64 + fr, fq * 8), boff = lds_byte(wc * 32 + fr, fq * 8);
#define PG8_SA(b, h) (((b) * 2 + (h)) * HTB)
#define PG8_SB(b, h) ((4 + (b) * 2 + (h)) * HTB)
#define PG8_STAGE(bufoff, gbase, voff) do { _Pragma("unroll") for (int _i = 0; _i < 2; ++_i) \
        __builtin_amdgcn_global_load_lds((const unsigned*)((const char*)(gbase) + (voff)[_i]), (PG8_LAS unsigned*)(lds + (bufoff) + ldsw + _i * 8192), 16, 0, 0); } while (0)
#define PG8_LDA(dst, b, h) do { _Pragma("unroll") for (int m = 0; m < 4; ++m) _Pragma("unroll") for (int k = 0; k < 2; ++k) dst[m][k] = *(const PG8_LAS bf16x8*)(lds + PG8_SA(b, h) + aoff + m * 2048 + k * 1024); } while (0)
#define PG8_LDB(dst, b, h) do { _Pragma("unroll") for (int n = 0; n < 2; ++n) _Pragma("unroll") for (int k = 0; k < 2; ++k) dst[n][k] = *(const PG8_LAS bf16x8*)(lds + PG8_SB(b, h) + boff + n * 2048 + k * 1024); } while (0)
#define PG8_MMA(ai, bj, At, Bt) do { __builtin_amdgcn_s_setprio(1); _Pragma("unroll") for (int m = 0; m < 4; ++m) _Pragma("unroll") for (int n = 0; n < 2; ++n) _Pragma("unroll") for (int k = 0; k < 2; ++k) \
        acc[ai][bj][m][n] = __builtin_amdgcn_mfma_f32_16x16x32_bf16(Bt[n][k], At[m][k], acc[ai][bj][m][n], 0, 0, 0); __builtin_amdgcn_s_setprio(0); } while (0)
#define PG8_WAIT_V(n) asm volatile("s_waitcnt vmcnt(" #n ")" ::: "memory")
#define PG8_WAIT_L(n) asm volatile("s_waitcnt lgkmcnt(" #n ")" ::: "memory")
#define PG8_BAR __builtin_amdgcn_s_barrier()
#define PG8_SCHED __builtin_amdgcn_sched_barrier(0)
    Unit cur, nxt; int ui = 0;
    if (!S.next(0, cur)) return;
    f32x4 acc[2][2][4][2];
#pragma unroll
    for (int a = 0; a < 2; ++a)
#pragma unroll
        for (int b = 0; b < 2; ++b)
#pragma unroll
            for (int m = 0; m < 4; ++m)
#pragma unroll
                for (int n = 0; n < 2; ++n) acc[a][b][m][n] = (f32x4){0.f, 0.f, 0.f, 0.f};
    bf16x8 At[4][2], B0[2][2], B1[2][2];
    const char* cA = S.abase(g, cur, tstep); const char* cB = S.bbase(g, cur, tstep);
    S.a_ready(cur);
    if constexpr (SP2) {
        PG8_STAGE(PG8_SB(0, 0), cB, voffB); PG8_STAGE(PG8_SB(0, 1), cB + hstep, voffB); PG8_STAGE(PG8_SA(0, 0), cA, voffA); PG8_STAGE(PG8_SA(0, 1), cA + hstep, voffA);
        if (wr == 1) PG8_BAR;
        PG8_WAIT_V(2); PG8_BAR;
        PG8_STAGE(PG8_SB(1, 0), cB + kstep, voffB); PG8_STAGE(PG8_SA(1, 0), cA + kstep, voffA); PG8_STAGE(PG8_SB(1, 1), cB + hstep + kstep, voffB);
        PG8_WAIT_V(6); PG8_BAR;
    } else {
        PG8_STAGE(PG8_SB(0, 0), cB, voffB); PG8_STAGE(PG8_SA(0, 0), cA, voffA); PG8_STAGE(PG8_SB(0, 1), cB + hstep, voffB); PG8_STAGE(PG8_SA(0, 1), cA + hstep, voffA);
        if (wr == 1) PG8_BAR;
        PG8_WAIT_V(4); PG8_BAR;
        PG8_STAGE(PG8_SB(1, 0), cB + kstep, voffB); PG8_STAGE(PG8_SA(1, 0), cA + kstep, voffA); PG8_STAGE(PG8_SB(1, 1), cB + hstep + kstep, voffB);
        PG8_WAIT_V(6); PG8_BAR;
    }
    for (;;) {
        const bool has_next = S.next(ui + 1, nxt);
        const char* nA = has_next ? S.abase(g, nxt, tstep) : cA; const char* nB = has_next ? S.bbase(g, nxt, tstep) : cB;
        for (int t = 0; t < nt; t += 2) {
            const bool last = (t == nt - 2);
            const char* a1 = cA + (size_t)(t + 1) * kstep;
            const char* a2 = last ? nA : cA + (size_t)(t + 2) * kstep; const char* b2 = last ? nB : cB + (size_t)(t + 2) * kstep;
            const char* a3 = a2 + kstep; const char* b3 = b2 + kstep;
            if (last && has_next) S.a_ready(nxt);
            if constexpr (SP2) {
            PG8_LDB(B0, 0, 0); PG8_LDB(B1, 0, 1); PG8_SCHED; PG8_LDA(At, 0, 0); PG8_STAGE(PG8_SA(1, 1), a1 + hstep, voffA);
            PG8_WAIT_V(8); PG8_WAIT_L(0); PG8_BAR; PG8_MMA(0, 0, At, B0); PG8_MMA(0, 1, At, B1); PG8_BAR; PG8_SCHED;
            PG8_LDA(At, 0, 1); PG8_STAGE(PG8_SB(0, 0), b2, voffB); PG8_STAGE(PG8_SB(0, 1), b2 + hstep, voffB); PG8_STAGE(PG8_SA(0, 0), a2, voffA);
            PG8_WAIT_V(8); PG8_WAIT_L(0); PG8_BAR; PG8_MMA(1, 0, At, B0); PG8_MMA(1, 1, At, B1); PG8_BAR; PG8_SCHED;
            PG8_LDB(B0, 1, 0); PG8_LDB(B1, 1, 1); PG8_SCHED; PG8_LDA(At, 1, 0); PG8_STAGE(PG8_SA(0, 1), a2 + hstep, voffA);
            PG8_WAIT_V(8); PG8_WAIT_L(0); PG8_BAR; PG8_MMA(0, 0, At, B0); PG8_MMA(0, 1, At, B1); PG8_BAR; PG8_SCHED;
            PG8_LDA(At, 1, 1); PG8_STAGE(PG8_SB(1, 0), b3, voffB); PG8_STAGE(PG8_SB(1, 1), b3 + hstep, voffB); PG8_STAGE(PG8_SA(1, 0), a3, voffA);
            PG8_WAIT_V(8); PG8_WAIT_L(0); PG8_BAR; PG8_MMA(1, 0, At, B0); PG8_MMA(1, 1, At, B1); PG8_BAR; PG8_SCHED;
            } else {
            PG8_LDB(B0, 0, 0); PG8_SCHED; PG8_LDA(At, 0, 0); PG8_STAGE(PG8_SA(1, 1), a1 + hstep, voffA);
            PG8_WAIT_L(8); PG8_BAR; PG8_WAIT_L(0); PG8_MMA(0, 0, At, B0); PG8_BAR; PG8_SCHED;
            PG8_LDB(B1, 0, 1); PG8_STAGE(PG8_SB(0, 0), b2, voffB);
            PG8_BAR; PG8_WAIT_L(0); PG8_MMA(0, 1, At, B1); PG8_BAR;
            PG8_LDA(At, 0, 1); PG8_STAGE(PG8_SA(0, 0), a2, voffA);
            PG8_BAR; PG8_WAIT_L(0); PG8_MMA(1, 0, At, B0); PG8_BAR; PG8_SCHED;
            PG8_STAGE(PG8_SB(0, 1), b2 + hstep, voffB);
            PG8_WAIT_V(6); PG8_BAR; PG8_MMA(1, 1, At, B1); PG8_BAR;
            PG8_LDB(B0, 1, 0); PG8_SCHED; PG8_LDA(At, 1, 0); PG8_STAGE(PG8_SA(0, 1), a2 + hstep, voffA);
            PG8_WAIT_L(8); PG8_BAR; PG8_WAIT_L(0); PG8_MMA(0, 0, At, B0); PG8_BAR; PG8_SCHED;
            PG8_LDB(B1, 1, 1); PG8_STAGE(PG8_SB(1, 0), b3, voffB);
            PG8_BAR; PG8_WAIT_L(0); PG8_MMA(0, 1, At, B1); PG8_BAR;
            PG8_LDA(At, 1, 1); PG8_STAGE(PG8_SA(1, 0), a3, voffA);
            PG8_BAR; PG8_WAIT_L(0); PG8_MMA(1, 0, At, B0); PG8_BAR; PG8_SCHED;
            PG8_STAGE(PG8_SB(1, 1), b3 + hstep, voffB);
            PG8_WAIT_V(6); PG8_BAR; PG8_MMA(1, 1, At, B1); PG8_BAR;
            }
        }
        if constexpr (ALIGN_EPI) { if (wr == 0) PG8_BAR; }
        if constexpr (!Epi::AFTER_DRAIN) { E(acc, cur, wr, wc, fr, fq); S.done(cur); }
        if (!has_next) break;
#pragma unroll
        for (int a = 0; a < 2; ++a)
#pragma unroll
            for (int b = 0; b < 2; ++b)
#pragma unroll
                for (int m = 0; m < 4; ++m)
#pragma unroll
                    for (int n = 0; n < 2; ++n) acc[a][b][m][n] = (f32x4){0.f, 0.f, 0.f, 0.f};
        cur = nxt; cA = nA; cB = nB; ++ui;
        if constexpr (ALIGN_EPI) { if (wr == 1) PG8_BAR; }
    }
    PG8_WAIT_V(0);
    if constexpr (!ALIGN_EPI) { if (wr == 0) PG8_BAR; }
    PG8_BAR;
    if constexpr (Epi::AFTER_DRAIN) { E.fused(acc, cur, wr, wc, fr, fq, lds, wid, lane); S.done(cur); }
#undef PG8_SA
#undef PG8_SB
#undef PG8_STAGE
#undef PG8_LDA
#undef PG8_LDB
#undef PG8_MMA
#undef PG8_WAIT_V
#undef PG8_WAIT_L
#undef PG8_BAR
#undef PG8_SCHED
}
}

#define GAS __attribute__((address_space(1)))
#define LAS __attribute__((address_space(3)))
typedef unsigned short bf16;
typedef unsigned v4u __attribute__((ext_vector_type(4)));
typedef float f32x4 __attribute__((ext_vector_type(4)));
typedef short bf16x8 __attribute__((ext_vector_type(8)));
typedef GAS unsigned gu32;
typedef GAS unsigned long long gu64;
#define RLX_AGENT __ATOMIC_RELAXED, __HIP_MEMORY_SCOPE_AGENT
#define LDS_WAIT() asm volatile("s_waitcnt lgkmcnt(0)" ::: "memory")
#define VM_WAIT() asm volatile("s_waitcnt vmcnt(0)" ::: "memory")
__device__ __forceinline__ unsigned long long rt() { return __builtin_amdgcn_s_memrealtime(); }
typedef float hw_f32x2 __attribute__((ext_vector_type(2))); typedef __bf16 hw_bf16x2 __attribute__((ext_vector_type(2)));
__device__ __forceinline__ unsigned pk2(float lo, float hi) { const hw_f32x2 v = {lo, hi}; return __builtin_bit_cast(unsigned, __builtin_convertvector(v, hw_bf16x2)); }
__device__ __forceinline__ unsigned f2bf(float f) { return pk2(f, 0.f) & 0xffffu; }

#define XB_TMO      128
#define XB_XCNT(j)  (256  + 64 * (j))
#define XB_XSUB(j)  (1280 + 64 * (j))
#define XB_XGEN(j)  (2304 + 64 * (j))
#define XB_TOP      3328
#define XB_TOPGEN   3392
#define XCD_BAR_WORDS 3456
#define XB_SPIN_CAP (1u << 21)

__device__ __forceinline__ unsigned xb_ld(unsigned* p)              { return __hip_atomic_load(p, __ATOMIC_RELAXED, __HIP_MEMORY_SCOPE_AGENT); }
__device__ __forceinline__ unsigned xb_add(unsigned* p, unsigned v) { return __hip_atomic_fetch_add(p, v, __ATOMIC_RELAXED, __HIP_MEMORY_SCOPE_AGENT); }
__device__ __forceinline__ unsigned xb_xcc_id() { return (unsigned)__builtin_amdgcn_s_getreg((3 << 11) | 20) & 0xFu; }
#define XB_SPIN(cond, bar) do { unsigned _sp = 0; while (cond) { __builtin_amdgcn_s_sleep(1); \
    if ((++_sp & 255u) == 0u) { if (xb_ld(&(bar)[XB_TMO])) break; if (_sp > XB_SPIN_CAP) { atomicAdd(&(bar)[XB_TMO], 1u); break; } } } } while (0)

struct XcdBarrier {
    unsigned* bar; unsigned x;
    volatile LAS unsigned* st;
};

__device__ __forceinline__ XcdBarrier xcd_barrier_post(unsigned* bar, volatile LAS unsigned* st) {
    XcdBarrier b; b.bar = bar; b.x = xb_xcc_id(); b.st = st;
    if (threadIdx.x == 0) (void)xb_add(&bar[XB_XCNT(b.x)], 1u);
    return b;
}
__device__ __forceinline__ void xcd_barrier_complete(unsigned* bar, unsigned x, unsigned& nloc, unsigned& nx) {
    const unsigned G = gridDim.x * gridDim.y * gridDim.z;
    unsigned sum, cnt, mine, sp = 0u;
    for (;;) {
        sum = 0u; cnt = 0u; mine = 0u;
#pragma unroll
        for (unsigned j = 0; j < 16; ++j) { const unsigned c = xb_ld(&bar[XB_XCNT(j)]); sum += c; cnt += (c > 0u) ? 1u : 0u; mine = (j == x) ? c : mine; }
        if (sum == G) break;
        __builtin_amdgcn_s_sleep(1);
        if ((++sp & 255u) == 0u) { if (xb_ld(&bar[XB_TMO])) break; if (sp > XB_SPIN_CAP) { atomicAdd(&bar[XB_TMO], 1u); break; } }
    }
    nloc = mine > 0u ? mine : 1u; nx = cnt > 0u ? cnt : 1u;
}

__device__ __forceinline__ void xcd_barrier(const XcdBarrier& b, const int wv) {
    asm volatile("s_waitcnt vmcnt(0)" ::: "memory");
    __syncthreads();
    int xb_lane; asm volatile("v_mbcnt_lo_u32_b32 %0, -1, 0\n\tv_mbcnt_hi_u32_b32 %0, -1, %0" : "=v"(xb_lane));
    if (wv == 0 && xb_lane == 0) {
        unsigned* bar = b.bar;
        __builtin_amdgcn_s_waitcnt(0);
        unsigned nloc = b.st[0], nx = b.st[1];
        if (nloc == 0u) { xcd_barrier_complete(bar, b.x, nloc, nx); b.st[0] = nloc; b.st[1] = nx; }
        const unsigned old = xb_add(&bar[XB_XSUB(b.x)], 1u);
        const unsigned gen = old / nloc;
        if (old + 1u == (gen + 1u) * nloc) {
            __builtin_amdgcn_fence(__ATOMIC_RELEASE, "agent");
            asm volatile("s_waitcnt vmcnt(0)" ::: "memory");
            const unsigned og = xb_add(&bar[XB_TOP], 1u);
            const unsigned tg = og / nx;
            if (og + 1u == (tg + 1u) * nx) xb_add(&bar[XB_TOPGEN], 1u);
            else XB_SPIN(xb_ld(&bar[XB_TOPGEN]) == tg, bar);
            __builtin_amdgcn_fence(__ATOMIC_ACQUIRE, "agent");
            xb_add(&bar[XB_XGEN(b.x)], 1u);
            asm volatile("s_waitcnt vmcnt(0)" ::: "memory");
        } else {
            XB_SPIN(xb_ld(&bar[XB_XGEN(b.x)]) == gen, bar);
            __builtin_amdgcn_fence(__ATOMIC_ACQUIRE, "agent");
            asm volatile("s_waitcnt vmcnt(0)" ::: "memory");
        }
    }
    __syncthreads();
}

#include <hip/hip_bf16.h>
#include <cmath>
namespace attn_body {
using bf16=__hip_bfloat16;
using bf16x8=__attribute__((ext_vector_type(8)))short;
using s16x4=__attribute__((ext_vector_type(4)))short;
using f32x16=__attribute__((ext_vector_type(16)))float;
using u32x4=__attribute__((ext_vector_type(4)))unsigned;
constexpr int D=64;
constexpr int NW=8,QBLK=32,QB=QBLK*NW,KVBLK=64;
constexpr int ATTN_UNIT_ROWS=QB;
__device__ __forceinline__ int crow(int r,int hi){return (r&3)+8*(r>>2)+4*hi;}
#define SBAR() __builtin_amdgcn_sched_barrier(0)
constexpr int NSLOT=3, SLOTB=8192;
constexpr int LDS_K=0, LDS_V=NSLOT*SLOTB, LDS_WS=2*NSLOT*SLOTB, LDS_OST=LDS_WS+NW*64*4, LDS_BYTES=LDS_OST+NW*4096;
constexpr float C2=0.125f*1.4426950408889634f;
__device__ __forceinline__ void glds16(const void*gsrc,unsigned lds_dst){unsigned keep;
  asm volatile("s_mov_b32 %0, m0\n\ts_mov_b32 m0, %2\n\ts_nop 0\n\tglobal_load_lds_dwordx4 %1, off\n\ts_mov_b32 m0, %0":"=&s"(keep):"v"(gsrc),"s"(lds_dst):"memory");}
__device__ __forceinline__ float max3f(float a,float b,float c){float r;asm("v_max3_f32 %0, %1, %2, %3":"=v"(r):"v"(a),"v"(b),"v"(c));return r;}
__device__ __forceinline__ float max2f(float a,float b){float r;asm("v_max_f32_e32 %0, %1, %2":"=v"(r):"v"(a),"v"(b));return r;}
__device__ __forceinline__ float fadd_s(float a,float b){float r;asm("v_add_f32_e32 %0, %1, %2":"=v"(r):"v"(a),"v"(b));return r;}
__device__ __forceinline__ float fsub_s(float a,float b){float r;asm("v_sub_f32_e32 %0, %1, %2":"=v"(r):"v"(a),"v"(b));return r;}
typedef float f32x2_t __attribute__((ext_vector_type(2))); typedef __bf16 bf16x2_t __attribute__((ext_vector_type(2)));
__device__ __forceinline__ unsigned cvtpk_s(float lo,float hi){f32x2_t v={lo,hi};bf16x2_t b=__builtin_convertvector(v,bf16x2_t);return __builtin_bit_cast(unsigned,b);}
#define WAIT_BAR(N) asm volatile("s_waitcnt vmcnt(" #N ") lgkmcnt(0)\n\ts_barrier":::"memory")

__device__ __forceinline__ void qkt(f32x16&p0,f32x16&p1,const char*Kslot,const bf16x8*qr,const f32x16&negm,int r32,int hi){
  const char*kb=Kslot+hi*1024+r32*16;
  #pragma unroll
  for(int d0=0;d0<4;++d0){
    const bf16x8 b0=*reinterpret_cast<const bf16x8*>(kb+d0*2048);
    const bf16x8 b1=*reinterpret_cast<const bf16x8*>(kb+d0*2048+512);
    if(d0==0){p0=__builtin_amdgcn_mfma_f32_32x32x16_bf16(b0,qr[0],negm,0,0,0);p1=__builtin_amdgcn_mfma_f32_32x32x16_bf16(b1,qr[0],negm,0,0,0);}
    else{p0=__builtin_amdgcn_mfma_f32_32x32x16_bf16(b0,qr[d0],p0,0,0,0);p1=__builtin_amdgcn_mfma_f32_32x32x16_bf16(b1,qr[d0],p1,0,0,0);}}
}
typedef __attribute__((address_space(3))) const char* lds_cptr;
typedef short v4i16_t __attribute__((ext_vector_type(4)));
__device__ __forceinline__ void kload8(bf16x8*kf,lds_cptr kp){
  kf[0]=*(const __attribute__((address_space(3))) bf16x8*)(kp);      kf[1]=*(const __attribute__((address_space(3))) bf16x8*)(kp+512);
  kf[2]=*(const __attribute__((address_space(3))) bf16x8*)(kp+2048); kf[3]=*(const __attribute__((address_space(3))) bf16x8*)(kp+2560);
  kf[4]=*(const __attribute__((address_space(3))) bf16x8*)(kp+4096); kf[5]=*(const __attribute__((address_space(3))) bf16x8*)(kp+4608);
  kf[6]=*(const __attribute__((address_space(3))) bf16x8*)(kp+6144); kf[7]=*(const __attribute__((address_space(3))) bf16x8*)(kp+6656);
}
__device__ __forceinline__ void kload2(bf16x8*kf,lds_cptr kp,int j){ kf[2*j]=*(const __attribute__((address_space(3))) bf16x8*)(kp+j*2048); kf[2*j+1]=*(const __attribute__((address_space(3))) bf16x8*)(kp+j*2048+512); }
__device__ __forceinline__ s16x4 vtr(lds_cptr p){ return __builtin_bit_cast(s16x4,__builtin_amdgcn_ds_read_tr16_b64_v4i16((__attribute__((address_space(3))) v4i16_t*)p)); }
__device__ __forceinline__ float rowmax(const f32x16&p0,const f32x16&p1){
  float a=max3f(p0[0],p0[1],p1[0]),b=max3f(p0[2],p0[3],p1[1]);a=max3f(a,p1[2],p1[3]);
  #pragma unroll
  for(int r=4;r<16;r+=4){a=max3f(a,p0[r],p0[r+1]);b=max3f(b,p0[r+2],p0[r+3]);a=max3f(a,p1[r],p1[r+1]);b=max3f(b,p1[r+2],p1[r+3]);}
  const float m=max2f(a,b);
  auto rr=__builtin_amdgcn_permlane32_swap(__float_as_uint(m),__float_as_uint(m),false,false);
  return max2f(__uint_as_float(rr[0]),__uint_as_float(rr[1]));
}
__device__ __forceinline__ void pv(f32x16*o,int vb,bf16x8 pa0,bf16x8 pa1,bf16x8 pa2,bf16x8 pa3){
  #pragma unroll
  for(int d0=0;d0<2;++d0){s16x4 lo[4],hi[4];
    #pragma unroll
    for(int ks=0;ks<4;++ks){
      asm volatile("ds_read_b64_tr_b16 %0,%1 offset:%c2":"=&v"(lo[ks]):"v"(vb),"i"(d0*4096+ks*1024):"memory");
      asm volatile("ds_read_b64_tr_b16 %0,%1 offset:%c2":"=&v"(hi[ks]):"v"(vb),"i"(d0*4096+ks*1024+512):"memory");}
    asm volatile("s_waitcnt lgkmcnt(0)":::"memory");SBAR();
    #define PK(k) (bf16x8){lo[k][0],lo[k][1],lo[k][2],lo[k][3],hi[k][0],hi[k][1],hi[k][2],hi[k][3]}
    o[d0]=__builtin_amdgcn_mfma_f32_32x32x16_bf16(pa0,PK(0),o[d0],0,0,0);
    o[d0]=__builtin_amdgcn_mfma_f32_32x32x16_bf16(pa1,PK(1),o[d0],0,0,0);
    o[d0]=__builtin_amdgcn_mfma_f32_32x32x16_bf16(pa2,PK(2),o[d0],0,0,0);
    o[d0]=__builtin_amdgcn_mfma_f32_32x32x16_bf16(pa3,PK(3),o[d0],0,0,0);
    #undef PK
  }
}

#ifndef ATTN_STORE16
#define ATTN_STORE16(p,v) (*(u32x4*)(p)=(v))
#endif
template<int THRL> __device__ __forceinline__ void attn_unit(const int tid_in,const bf16*Qu,int qpitch,const bf16*__restrict__ Kh,const bf16*__restrict__ Vh,int kvpitch,bf16*Ou,int opitch,const int NT,char*shm){
  int tid_=tid_in; asm volatile("":"+v"(tid_));
  const int tid=tid_,lane=tid&63,r32=lane&31,hi=lane>>5; const int wid=__builtin_amdgcn_readfirstlane(tid>>6);
  const bf16*Qw=Qu+(long)(wid*QBLK)*qpitch;
  const unsigned lds0=(unsigned)(uintptr_t)shm;
  float*wsf=(float*)(shm+LDS_WS)+wid*64;
  const bf16*ksrc=Kh+(long)lane*kvpitch+wid*8;
  const bf16*vsrc=Vh+(long)(16*(wid&3)+(lane>>2))*kvpitch+(wid>>2)*32+(lane&3)*8;
  const unsigned kdst=lds0+LDS_K+wid*1024, vdst=lds0+LDS_V+wid*1024;
  #define DMA_K(t,slot) glds16(ksrc+(long)(t)*KVBLK*kvpitch,(unsigned)__builtin_amdgcn_readfirstlane(kdst+(slot)))
  #define DMA_V(t,slot) glds16(vsrc+(long)(t)*KVBLK*kvpitch,(unsigned)__builtin_amdgcn_readfirstlane(vdst+(slot)))
  const int vb0=(int)(lds0+LDS_V)+((lane>>4)&1)*32+(lane&3)*8+(4*hi+((lane&15)>>2))*64;
  const char*Kbase=shm+LDS_K; bf16x8 kf[8];
  const lds_cptr shm3=(lds_cptr)shm; const lds_cptr kp0=shm3+LDS_K+hi*1024+r32*16; const lds_cptr vp0=shm3+LDS_V+((lane>>4)&1)*32+(lane&3)*8+(4*hi+((lane&15)>>2))*64;
  DMA_K(0,0);DMA_V(0,0);DMA_K(1,SLOTB);
  bf16x8 qr[4];
  #pragma unroll
  for(int d0=0;d0<4;++d0)qr[d0]=*reinterpret_cast<const bf16x8*>(&Qw[(long)r32*qpitch+d0*16+hi*8]);
  float mhat=0.f,l_reg=0.f;f32x16 o[2];o[0]=f32x16{};o[1]=f32x16{};f32x16 negm=f32x16{};asm volatile("":"+v"(negm));
  #define CMASK(P0,P1,t) do{}while(0)
  bool resc=false;
  #define START(P0,P1) do{ const float rm=rowmax(P0,P1); resc=false; \
    { const float dl=rm; mhat=fadd_s(mhat,dl); \
      _Pragma("unroll") for(int r=0;r<16;++r){P0[r]=fsub_s(P0[r],dl);P1[r]=fsub_s(P1[r],dl);} \
      _Pragma("unroll") for(int r=0;r<16;++r)negm[r]=-mhat; asm volatile("":"+v"(negm)); } \
    _Pragma("unroll") for(int r=0;r<16;++r)P0[r]=__builtin_amdgcn_exp2f(P0[r]); }while(0)
  #define RESC() do{ if(resc){ asm volatile("s_waitcnt lgkmcnt(0)":::"memory"); \
      _Pragma("unroll") for(int d_=0;d_<2;++d_) _Pragma("unroll") for(int r=0;r<16;++r)o[d_][r]*=wsf[crow(r,hi)]; } }while(0)
  f32x16 pA0,pA1,pB0,pB1;
  int sl_prev=0,sl_cur=0,sl_next=SLOTB;
  #define ROT() do{sl_prev=sl_cur;sl_cur=sl_next;sl_next=(sl_next==(NSLOT-1)*SLOTB)?0:sl_next+SLOTB;}while(0)
  DMA_K(2,2*SLOTB);
  WAIT_BAR(3);
  qkt(pA0,pA1,Kbase,qr,negm,r32,hi);asm volatile("s_nop 15\n\ts_nop 7":"+v"(pA0),"+v"(pA1));CMASK(pA0,pA1,0);
  START(pA0,pA1);
  _Pragma("unroll") for(int r=0;r<16;++r)pA1[r]=__builtin_amdgcn_exp2f(pA1[r]);
  WAIT_BAR(0);
  DMA_K(3,0);DMA_V(1,SLOTB);
  ROT();
  kload8(kf,kp0+sl_cur);
  WAIT_BAR(2);
  s16x4 vlo[8],vhi[8]; u32x4 pw0,pw1,pw2,pw3;
  #define PKW(P,B) cvtpk_s(P[B],P[B+1])
  #define PAF(k) __builtin_bit_cast(bf16x8,pw##k)
  #define VFR(i) (bf16x8){vlo[i][0],vlo[i][1],vlo[i][2],vlo[i][3],vhi[i][0],vhi[i][1],vhi[i][2],vhi[i][3]}
  #define PIN(x) asm volatile("":"+v"(x))
  #define MX3(a,b,c) __builtin_fmaxf(__builtin_fmaxf((a),(b)),(c))
  #define GAPA(MF,A0,A1,A2,A3,W0,W1,PW) do{ MF; sacc+=A0; sacc+=A1; sacc+=A2; sacc+=A3; PIN(sacc); W0; W1; PIN(PW); SBAR(); }while(0)
  #define EX(v) __builtin_amdgcn_exp2f(v)
  #define GAPB(MF,X,B) do{ MF; X[B]=EX(X[B]); X[B+1]=EX(X[B+1]); X[B+2]=EX(X[B+2]); X[B+3]=EX(X[B+3]); PIN(X); SBAR(); }while(0)
  #define VRD(i) do{ vlo[i]=vtr(vp_+(((i)>>2)*4096+((i)&3)*1024)); vhi[i]=vtr(vp_+(((i)>>2)*4096+((i)&3)*1024+512)); }while(0)
  #define KRD(G,j) do{ if(G){ kload2(kf,kp0+sl_next,j); SBAR(); } }while(0)
  #define STEP(C0,C1,P0,P1,t,GK,GV,GL) do{ SBAR(); \
    const lds_cptr vp_=vp0+sl_prev; \
    VRD(0); SBAR(); float sacc=(P0[0]+P0[1]); \
    GAPA(C0=__builtin_amdgcn_mfma_f32_32x32x16_bf16(kf[0],qr[0],negm,0,0,0), P0[2],P0[3],P0[4],P0[5],     pw0[0]=PKW(P0,0), pw0[1]=PKW(P0,2), pw0); \
    VRD(4); SBAR(); GAPA(C1=__builtin_amdgcn_mfma_f32_32x32x16_bf16(kf[1],qr[0],negm,0,0,0), P0[6],P0[7],P0[8],P0[9],     pw0[2]=PKW(P0,4), pw0[3]=PKW(P0,6), pw0); \
    VRD(1); SBAR(); GAPA(C0=__builtin_amdgcn_mfma_f32_32x32x16_bf16(kf[2],qr[1],C0,0,0,0),   P0[10],P0[11],P0[12],P0[13], pw1[0]=PKW(P0,8), pw1[1]=PKW(P0,10), pw1); \
    VRD(5); SBAR(); GAPA(C1=__builtin_amdgcn_mfma_f32_32x32x16_bf16(kf[3],qr[1],C1,0,0,0),   P0[14],P0[15],P1[0],P1[1],   pw1[2]=PKW(P0,12),pw1[3]=PKW(P0,14), pw1); \
    VRD(2); SBAR(); GAPA(C0=__builtin_amdgcn_mfma_f32_32x32x16_bf16(kf[4],qr[2],C0,0,0,0),   P1[2],P1[3],P1[4],P1[5],     pw2[0]=PKW(P1,0), pw2[1]=PKW(P1,2), pw2); \
    VRD(6); SBAR(); GAPA(C1=__builtin_amdgcn_mfma_f32_32x32x16_bf16(kf[5],qr[2],C1,0,0,0),   P1[6],P1[7],P1[8],P1[9],     pw2[2]=PKW(P1,4), pw2[3]=PKW(P1,6), pw2); \
    VRD(3); SBAR(); GAPA(C0=__builtin_amdgcn_mfma_f32_32x32x16_bf16(kf[6],qr[3],C0,0,0,0),   P1[10],P1[11],P1[12],P1[13], pw3[0]=PKW(P1,8), pw3[1]=PKW(P1,10), pw3); \
    VRD(7); SBAR(); GAPA(C1=__builtin_amdgcn_mfma_f32_32x32x16_bf16(kf[7],qr[3],C1,0,0,0),   P1[14],P1[15],0.f,0.f,       pw3[2]=PKW(P1,12),pw3[3]=PKW(P1,14), pw3); \
    l_reg+=sacc; \
    if(GK){DMA_K((t)+3,sl_cur);} if(GV){DMA_V((t)+1,sl_next);} \
    CMASK(C0,C1,t); \
    { float a=MX3(C0[0],C0[1],C1[0]),b=MX3(C0[2],C0[3],C1[1]); a=MX3(a,C1[2],C1[3]); \
      _Pragma("unroll") for(int r=4;r<16;r+=4){a=MX3(a,C0[r],C0[r+1]);b=MX3(b,C0[r+2],C0[r+3]);a=MX3(a,C1[r],C1[r+1]);b=MX3(b,C1[r+2],C1[r+3]);} \
      float rm=__builtin_fmaxf(a,b); { auto rr=__builtin_amdgcn_permlane32_swap(__float_as_uint(rm),__float_as_uint(rm),false,false); rm=__builtin_fmaxf(__uint_as_float(rr[0]),__uint_as_float(rr[1])); } \
      resc=false; \
      if(__builtin_expect(__any(rm>(float)THRL),0)){ const float dl=__builtin_fmaxf(rm,0.f); mhat+=dl; \
        _Pragma("unroll") for(int r=0;r<16;++r){C0[r]-=dl;C1[r]-=dl;} \
        _Pragma("unroll") for(int r=0;r<16;++r)negm[r]=-mhat; asm volatile("":"+v"(negm)); \
        const float f=__builtin_amdgcn_exp2f(-dl); l_reg*=f; if(hi==0)wsf[r32]=f; resc=true; } } \
    SBAR(); \
    GAPB(o[0]=__builtin_amdgcn_mfma_f32_32x32x16_bf16(PAF(0),VFR(0),o[0],0,0,0), C0,0); \
    GAPB(o[1]=__builtin_amdgcn_mfma_f32_32x32x16_bf16(PAF(0),VFR(4),o[1],0,0,0), C0,4); \
    KRD(GL,0); GAPB(o[0]=__builtin_amdgcn_mfma_f32_32x32x16_bf16(PAF(1),VFR(1),o[0],0,0,0), C0,8); \
    KRD(GL,1); GAPB(o[1]=__builtin_amdgcn_mfma_f32_32x32x16_bf16(PAF(1),VFR(5),o[1],0,0,0), C0,12); \
    KRD(GL,2); GAPB(o[0]=__builtin_amdgcn_mfma_f32_32x32x16_bf16(PAF(2),VFR(2),o[0],0,0,0), C1,0); \
    KRD(GL,3); GAPB(o[1]=__builtin_amdgcn_mfma_f32_32x32x16_bf16(PAF(2),VFR(6),o[1],0,0,0), C1,4); \
    GAPB(o[0]=__builtin_amdgcn_mfma_f32_32x32x16_bf16(PAF(3),VFR(3),o[0],0,0,0), C1,8); \
    GAPB(o[1]=__builtin_amdgcn_mfma_f32_32x32x16_bf16(PAF(3),VFR(7),o[1],0,0,0), C1,12); \
    }while(0)
  int t=1;
  #undef CMASK
  #define CMASK(P0,P1,t) do{}while(0)
  for(;t+5<NT;t+=2){
    STEP(pB0,pB1,pA0,pA1,t,true,true,true);     WAIT_BAR(2); RESC(); ROT();
    STEP(pA0,pA1,pB0,pB1,t+1,true,true,true);   WAIT_BAR(2); RESC(); ROT();
  }
  #undef CMASK
  #define CMASK(P0,P1,t) do{}while(0)
  #define ENDW(tt) do{ if((tt)+3<NT){WAIT_BAR(2);} else if((tt)+2<NT){WAIT_BAR(1);} else {WAIT_BAR(0);} }while(0)
  for(;t+1<NT;t+=2){
    STEP(pB0,pB1,pA0,pA1,t,(t+3<NT),(t+1<NT),(t+1<NT));       ENDW(t);   RESC(); ROT();
    STEP(pA0,pA1,pB0,pB1,t+1,(t+4<NT),(t+2<NT),(t+2<NT));     ENDW(t+1); RESC(); ROT();
  }
  STEP(pB0,pB1,pA0,pA1,NT-1,false,false,false); RESC();
  { float sacc=pB0[0]+pB0[1]; _Pragma("unroll") for(int r=2;r<16;++r)sacc+=pB0[r]; _Pragma("unroll") for(int r=0;r<16;++r)sacc+=pB1[r]; l_reg+=sacc;
    pw0=(u32x4){PKW(pB0,0),PKW(pB0,2),PKW(pB0,4),PKW(pB0,6)};pw1=(u32x4){PKW(pB0,8),PKW(pB0,10),PKW(pB0,12),PKW(pB0,14)};pw2=(u32x4){PKW(pB1,0),PKW(pB1,2),PKW(pB1,4),PKW(pB1,6)};pw3=(u32x4){PKW(pB1,8),PKW(pB1,10),PKW(pB1,12),PKW(pB1,14)};
    SBAR(); pv(o,vb0+sl_cur,PAF(0),PAF(1),PAF(2),PAF(3)); }
  #undef PKW
  #undef PAF
  #undef VFR
  #undef PIN
  #undef MX3
  #undef GAPA
  #undef GAPB
  #undef EX
  #undef VRD
  #undef KRD
  #undef STEP
  #undef ENDW
  {auto rr=__builtin_amdgcn_permlane32_swap(__float_as_uint(l_reg),__float_as_uint(l_reg),false,false);l_reg=__uint_as_float(rr[0])+__uint_as_float(rr[1]);}
  if(hi==0)wsf[32+r32]=l_reg;asm volatile("s_waitcnt lgkmcnt(0)":::"memory");
  float rli[16];
  #pragma unroll
  for(int r=0;r<16;++r)rli[r]=__builtin_amdgcn_rcpf(wsf[32+crow(r,hi)]);
  bf16*Ow=Ou+(long)(wid*QBLK)*opitch;
  { bf16*stg=(bf16*)(shm+LDS_OST)+wid*2048;
    #pragma unroll
    for(int r=0;r<16;++r){const int orow=crow(r,hi);
      #pragma unroll
      for(int d0=0;d0<2;++d0)stg[orow*64+d0*32+r32]=__float2bfloat16(o[d0][r]*rli[r]);}
    asm volatile("s_waitcnt lgkmcnt(0)":::"memory");
    #pragma unroll
    for(int i=0;i<4;++i){const int row=i*8+(lane>>3),ch=lane&7; const u32x4 v=*(const u32x4*)(stg+row*64+ch*8); ATTN_STORE16(Ow+(long)row*opitch+ch*8,v);} }
  asm volatile("s_waitcnt lgkmcnt(0)\n\ts_barrier":::"memory");
  #undef DMA_K
  #undef DMA_V
  #undef CMASK
  #undef START
  #undef RESC
  #undef ROT
}
__device__ __forceinline__ void pv128(f32x16*o,int vb,bf16x8 pa0,bf16x8 pa1,bf16x8 pa2,bf16x8 pa3){
  #pragma unroll
  for(int d0=0;d0<4;++d0){s16x4 lo[4],hi[4];
    #pragma unroll
    for(int ks=0;ks<4;++ks){
      asm volatile("ds_read_b64_tr_b16 %0,%1 offset:%c2":"=&v"(lo[ks]):"v"(vb),"i"(d0*4096+ks*1024):"memory");
      asm volatile("ds_read_b64_tr_b16 %0,%1 offset:%c2":"=&v"(hi[ks]):"v"(vb),"i"(d0*4096+ks*1024+512):"memory");}
    asm volatile("s_waitcnt lgkmcnt(0)":::"memory");SBAR();
    #define PK(k) (bf16x8){lo[k][0],lo[k][1],lo[k][2],lo[k][3],hi[k][0],hi[k][1],hi[k][2],hi[k][3]}
    o[d0]=__builtin_amdgcn_mfma_f32_32x32x16_bf16(pa0,PK(0),o[d0],0,0,0);
    o[d0]=__builtin_amdgcn_mfma_f32_32x32x16_bf16(pa1,PK(1),o[d0],0,0,0);
    o[d0]=__builtin_amdgcn_mfma_f32_32x32x16_bf16(pa2,PK(2),o[d0],0,0,0);
    o[d0]=__builtin_amdgcn_mfma_f32_32x32x16_bf16(pa3,PK(3),o[d0],0,0,0);
    #undef PK
  }
}
constexpr int LDS_V128=NSLOT*SLOTB, LDS_WS128=LDS_V128+NSLOT*2*SLOTB, LDS_OST128=LDS_WS128+NW*64*4, LDS_BYTES128=LDS_OST128+NW*8192;
template<int THRL> __device__ __forceinline__ void attn_unit128(const int tid_in,const bf16*Qu,int qpitch,const bf16*__restrict__ Kh,const bf16*__restrict__ Vh,int kvpitch,bf16*Ou,int opitch,const int NT,char*shm){
  int tid_=tid_in; asm volatile("":"+v"(tid_));
  const int tid=tid_,lane=tid&63,r32=lane&31,hi=lane>>5; const int wid=__builtin_amdgcn_readfirstlane(tid>>6);
  const bf16*Qw=Qu+(long)(wid*QBLK)*qpitch;
  const unsigned lds0=(unsigned)(uintptr_t)shm;
  float*wsf=(float*)(shm+LDS_WS128)+wid*64;
  const bf16*ksrc=Kh+(long)lane*kvpitch+wid*8;
  const bf16*vsrc=Vh+(long)(16*(wid&3)+(lane>>2))*kvpitch+(wid>>2)*32+(lane&3)*8;
  const unsigned kdst=lds0+LDS_K+wid*1024, vdst=lds0+LDS_V128+wid*1024;
  #define DMA_K(t,slot) glds16(ksrc+(long)(t)*KVBLK*kvpitch,(unsigned)__builtin_amdgcn_readfirstlane(kdst+(slot)))
  #define DMA_V(t,slot) do{ glds16(vsrc+(long)(t)*KVBLK*kvpitch,(unsigned)__builtin_amdgcn_readfirstlane(vdst+2*(slot))); glds16(vsrc+(long)(t)*KVBLK*kvpitch+64,(unsigned)__builtin_amdgcn_readfirstlane(vdst+8192+2*(slot))); }while(0)
  const int vb0=(int)(lds0+LDS_V128)+((lane>>4)&1)*32+(lane&3)*8+(4*hi+((lane&15)>>2))*64;
  const char*Kbase=shm+LDS_K; bf16x8 kf[8];
  const lds_cptr shm3=(lds_cptr)shm; const lds_cptr kp0=shm3+LDS_K+hi*1024+r32*16; const lds_cptr vp0=shm3+LDS_V128+((lane>>4)&1)*32+(lane&3)*8+(4*hi+((lane&15)>>2))*64;
  DMA_K(0,0);DMA_V(0,0);DMA_K(1,SLOTB);
  bf16x8 qr[4];
  #pragma unroll
  for(int d0=0;d0<4;++d0)qr[d0]=*reinterpret_cast<const bf16x8*>(&Qw[(long)r32*qpitch+d0*16+hi*8]);
  float mhat=0.f,l_reg=0.f;f32x16 o[4];o[0]=f32x16{};o[1]=f32x16{};o[2]=f32x16{};o[3]=f32x16{};f32x16 negm=f32x16{};asm volatile("":"+v"(negm));
  #define CMASK(P0,P1,t) do{}while(0)
  bool resc=false;
  #define START(P0,P1) do{ const float rm=rowmax(P0,P1); resc=false; \
    { const float dl=rm; mhat=fadd_s(mhat,dl); \
      _Pragma("unroll") for(int r=0;r<16;++r){P0[r]=fsub_s(P0[r],dl);P1[r]=fsub_s(P1[r],dl);} \
      _Pragma("unroll") for(int r=0;r<16;++r)negm[r]=-mhat; asm volatile("":"+v"(negm)); } \
    _Pragma("unroll") for(int r=0;r<16;++r)P0[r]=__builtin_amdgcn_exp2f(P0[r]); }while(0)
  #define RESC() do{ if(resc){ asm volatile("s_waitcnt lgkmcnt(0)":::"memory"); \
      _Pragma("unroll") for(int d_=0;d_<4;++d_) _Pragma("unroll") for(int r=0;r<16;++r)o[d_][r]*=wsf[crow(r,hi)]; } }while(0)
  f32x16 pA0,pA1,pB0,pB1;
  int sl_prev=0,sl_cur=0,sl_next=SLOTB;
  #define ROT() do{sl_prev=sl_cur;sl_cur=sl_next;sl_next=(sl_next==(NSLOT-1)*SLOTB)?0:sl_next+SLOTB;}while(0)
  DMA_K(2,2*SLOTB);
  WAIT_BAR(4);
  qkt(pA0,pA1,Kbase,qr,negm,r32,hi);asm volatile("s_nop 15\n\ts_nop 7":"+v"(pA0),"+v"(pA1));CMASK(pA0,pA1,0);
  START(pA0,pA1);
  _Pragma("unroll") for(int r=0;r<16;++r)pA1[r]=__builtin_amdgcn_exp2f(pA1[r]);
  WAIT_BAR(0);
  DMA_K(3,0);DMA_V(1,SLOTB);
  ROT();
  kload8(kf,kp0+sl_cur);
  WAIT_BAR(3);
  s16x4 vbl[3],vbh[3]; u32x4 pw0,pw1,pw2,pw3;
  #define PKW(P,B) cvtpk_s(P[B],P[B+1])
  #define PAF(k) __builtin_bit_cast(bf16x8,pw##k)
  #define VFB(s) (bf16x8){vbl[s][0],vbl[s][1],vbl[s][2],vbl[s][3],vbh[s][0],vbh[s][1],vbh[s][2],vbh[s][3]}
  #define PIN(x) asm volatile("":"+v"(x))
  #define MX3(a,b,c) __builtin_fmaxf(__builtin_fmaxf((a),(b)),(c))
  #define GAPA(MF,A0,A1,A2,A3,W0,W1,PW) do{ MF; sacc+=A0; sacc+=A1; sacc+=A2; sacc+=A3; PIN(sacc); W0; W1; PIN(PW); SBAR(); }while(0)
  #define EX(v) __builtin_amdgcn_exp2f(v)
  #define VRD3(s,i) do{ vbl[s]=vtr(vp_+(((i)&3)*4096+((i)>>2)*1024)); vbh[s]=vtr(vp_+(((i)&3)*4096+((i)>>2)*1024+512)); }while(0)
  #define GAPB(i,X,B) do{ o[(i)&3]=__builtin_amdgcn_mfma_f32_32x32x16_bf16(PAFI((i)>>2),VFB((i)%3),o[(i)&3],0,0,0); if((i)+2<16){VRD3(((i)+2)%3,(i)+2);} X[B]=EX(X[B]); X[B+1]=EX(X[B+1]); PIN(X); SBAR(); }while(0)
  #define PAFI(k) ((k)==0?PAF(0):(k)==1?PAF(1):(k)==2?PAF(2):PAF(3))
  #define KRD(G,j) do{ if(G){ kload2(kf,kp0+sl_next,j); SBAR(); } }while(0)
  #define STEP(C0,C1,P0,P1,t,GK,GV,GL) do{ SBAR(); \
    const lds_cptr vp_=vp0+2*sl_prev; \
    float sacc=(P0[0]+P0[1]); \
    GAPA(C0=__builtin_amdgcn_mfma_f32_32x32x16_bf16(kf[0],qr[0],negm,0,0,0), P0[2],P0[3],P0[4],P0[5],     pw0[0]=PKW(P0,0), pw0[1]=PKW(P0,2), pw0); \
    GAPA(C1=__builtin_amdgcn_mfma_f32_32x32x16_bf16(kf[1],qr[0],negm,0,0,0), P0[6],P0[7],P0[8],P0[9],     pw0[2]=PKW(P0,4), pw0[3]=PKW(P0,6), pw0); \
    GAPA(C0=__builtin_amdgcn_mfma_f32_32x32x16_bf16(kf[2],qr[1],C0,0,0,0),   P0[10],P0[11],P0[12],P0[13], pw1[0]=PKW(P0,8), pw1[1]=PKW(P0,10), pw1); \
    GAPA(C1=__builtin_amdgcn_mfma_f32_32x32x16_bf16(kf[3],qr[1],C1,0,0,0),   P0[14],P0[15],P1[0],P1[1],   pw1[2]=PKW(P0,12),pw1[3]=PKW(P0,14), pw1); \
    GAPA(C0=__builtin_amdgcn_mfma_f32_32x32x16_bf16(kf[4],qr[2],C0,0,0,0),   P1[2],P1[3],P1[4],P1[5],     pw2[0]=PKW(P1,0), pw2[1]=PKW(P1,2), pw2); \
    GAPA(C1=__builtin_amdgcn_mfma_f32_32x32x16_bf16(kf[5],qr[2],C1,0,0,0),   P1[6],P1[7],P1[8],P1[9],     pw2[2]=PKW(P1,4), pw2[3]=PKW(P1,6), pw2); \
    VRD3(0,0); SBAR(); GAPA(C0=__builtin_amdgcn_mfma_f32_32x32x16_bf16(kf[6],qr[3],C0,0,0,0),   P1[10],P1[11],P1[12],P1[13], pw3[0]=PKW(P1,8), pw3[1]=PKW(P1,10), pw3); \
    VRD3(1,1); SBAR(); GAPA(C1=__builtin_amdgcn_mfma_f32_32x32x16_bf16(kf[7],qr[3],C1,0,0,0),   P1[14],P1[15],0.f,0.f,       pw3[2]=PKW(P1,12),pw3[3]=PKW(P1,14), pw3); \
    l_reg+=sacc; \
    if(GK){DMA_K((t)+3,sl_cur);} if(GV){DMA_V((t)+1,sl_next);} \
    { float a=MX3(C0[0],C0[1],C1[0]),b=MX3(C0[2],C0[3],C1[1]); a=MX3(a,C1[2],C1[3]); \
      _Pragma("unroll") for(int r=4;r<16;r+=4){a=MX3(a,C0[r],C0[r+1]);b=MX3(b,C0[r+2],C0[r+3]);a=MX3(a,C1[r],C1[r+1]);b=MX3(b,C1[r+2],C1[r+3]);} \
      float rm=__builtin_fmaxf(a,b); { auto rr=__builtin_amdgcn_permlane32_swap(__float_as_uint(rm),__float_as_uint(rm),false,false); rm=__builtin_fmaxf(__uint_as_float(rr[0]),__uint_as_float(rr[1])); } \
      resc=false; \
      if(__builtin_expect(__any(rm>(float)THRL),0)){ const float dl=__builtin_fmaxf(rm,0.f); mhat+=dl; \
        _Pragma("unroll") for(int r=0;r<16;++r){C0[r]-=dl;C1[r]-=dl;} \
        _Pragma("unroll") for(int r=0;r<16;++r)negm[r]=-mhat; asm volatile("":"+v"(negm)); \
        const float f=__builtin_amdgcn_exp2f(-dl); l_reg*=f; if(hi==0)wsf[r32]=f; resc=true; } } \
    SBAR(); \
    GAPB(0,C0,0); GAPB(1,C0,2); GAPB(2,C0,4); GAPB(3,C0,6); \
    KRD(GL,0); GAPB(4,C0,8); GAPB(5,C0,10); KRD(GL,1); GAPB(6,C0,12); GAPB(7,C0,14); \
    KRD(GL,2); GAPB(8,C1,0); GAPB(9,C1,2); KRD(GL,3); GAPB(10,C1,4); GAPB(11,C1,6); \
    GAPB(12,C1,8); GAPB(13,C1,10); GAPB(14,C1,12); GAPB(15,C1,14); \
    }while(0)
  int t=1;
  #undef CMASK
  #define CMASK(P0,P1,t) do{}while(0)
  for(;t+5<NT;t+=2){
    STEP(pB0,pB1,pA0,pA1,t,true,true,true);     WAIT_BAR(3); RESC(); ROT();
    STEP(pA0,pA1,pB0,pB1,t+1,true,true,true);   WAIT_BAR(3); RESC(); ROT();
  }
  #undef CMASK
  #define CMASK(P0,P1,t) do{}while(0)
  #define ENDW(tt) do{ if((tt)+3<NT){WAIT_BAR(3);} else if((tt)+2<NT){WAIT_BAR(2);} else {WAIT_BAR(0);} }while(0)
  for(;t+1<NT;t+=2){
    STEP(pB0,pB1,pA0,pA1,t,(t+3<NT),(t+1<NT),(t+1<NT));       ENDW(t);   RESC(); ROT();
    STEP(pA0,pA1,pB0,pB1,t+1,(t+4<NT),(t+2<NT),(t+2<NT));     ENDW(t+1); RESC(); ROT();
  }
  STEP(pB0,pB1,pA0,pA1,NT-1,false,false,false); RESC();
  { float sacc=pB0[0]+pB0[1]; _Pragma("unroll") for(int r=2;r<16;++r)sacc+=pB0[r]; _Pragma("unroll") for(int r=0;r<16;++r)sacc+=pB1[r]; l_reg+=sacc;
    pw0=(u32x4){PKW(pB0,0),PKW(pB0,2),PKW(pB0,4),PKW(pB0,6)};pw1=(u32x4){PKW(pB0,8),PKW(pB0,10),PKW(pB0,12),PKW(pB0,14)};pw2=(u32x4){PKW(pB1,0),PKW(pB1,2),PKW(pB1,4),PKW(pB1,6)};pw3=(u32x4){PKW(pB1,8),PKW(pB1,10),PKW(pB1,12),PKW(pB1,14)};
    SBAR(); pv128(o,vb0+2*sl_cur,PAF(0),PAF(1),PAF(2),PAF(3)); }
  #undef PKW
  #undef PAF
  #undef VFB
  #undef VRD3
  #undef PAFI
  #undef PIN
  #undef MX3
  #undef GAPA
  #undef GAPB
  #undef EX
  #undef KRD
  #undef STEP
  #undef ENDW
  {auto rr=__builtin_amdgcn_permlane32_swap(__float_as_uint(l_reg),__float_as_uint(l_reg),false,false);l_reg=__uint_as_float(rr[0])+__uint_as_float(rr[1]);}
  if(hi==0)wsf[32+r32]=l_reg;asm volatile("s_waitcnt lgkmcnt(0)":::"memory");
  float rli[16];
  #pragma unroll
  for(int r=0;r<16;++r)rli[r]=__builtin_amdgcn_rcpf(wsf[32+crow(r,hi)]);
  bf16*Ow=Ou+(long)(wid*QBLK)*opitch;
  { bf16*stg=(bf16*)(shm+LDS_OST128)+wid*4096;
    #pragma unroll
    for(int r=0;r<16;++r){const int orow=crow(r,hi);
      #pragma unroll
      for(int d0=0;d0<4;++d0)stg[orow*128+d0*32+r32]=__float2bfloat16(o[d0][r]*rli[r]);}
    asm volatile("s_waitcnt lgkmcnt(0)":::"memory");
    #pragma unroll
    for(int i=0;i<8;++i){const int row=i*4+(lane>>4),ch=lane&15; const u32x4 v=*(const u32x4*)(stg+row*128+ch*8); ATTN_STORE16(Ow+(long)row*opitch+ch*8,v);} }
  asm volatile("s_waitcnt lgkmcnt(0)\n\ts_barrier":::"memory");
  #undef DMA_K
  #undef DMA_V
  #undef CMASK
  #undef START
  #undef RESC
  #undef ROT
}
constexpr int ATTN_LDS_BYTES=LDS_BYTES;
#undef SBAR
#undef WAIT_BAR
}

constexpr int NB = 4, SEQ = 8192, CTXL = 256, PB = SEQ + CTXL, R = NB * PB, D = 1024, DFF = 4096, DEPTH = 4;
constexpr int NP_EV = 2560, NP_OD = 1536;
constexpr float EPS = 1e-6f;
constexpr float C2 = 0.125f * 1.4426950408889634f;
constexpr int EQ = 0, EK = 256, EVV = 512, EG = 1024, EGQ = 1536, EGK = 2048, EGV = 2176, ELR = 2304;
constexpr int ODQ = 0, ODK = 512, ODV = 1024;
constexpr int NWAVES = 8, NTHR = 512;
constexpr int LDS_BYTES = 163840, LDS_MISC = 163840 - 256;

constexpr size_t MiB = 1u << 20;
constexpr size_t WS_CTL = 0, CTL_ZERO_BYTES = 1 * MiB;
constexpr size_t WS_MOD = 1 * MiB;
constexpr size_t WS_TAB = 2 * MiB;
constexpr size_t WS_HID = 3 * MiB;
constexpr size_t WS_XB = 36 * MiB;
constexpr size_t WS_W = 12 * MiB, W_IN = 0, W_OUT = 6 * MiB, W_1 = 8 * MiB, W_2 = 16 * MiB;
constexpr size_t WS_A1 = 108 * MiB;
constexpr size_t WS_Y = 174 * MiB;
constexpr size_t WS_PH = 240 * MiB;
constexpr size_t WS_OGLA = WS_PH + 165 * MiB;
constexpr size_t WS_HF = WS_PH + 198 * MiB;
constexpr size_t WS_SLAB = 504 * MiB;
constexpr size_t WS_END = 512 * MiB;
constexpr int CW_BAR = 4096;

struct Args { const float* in[27]; float* out; unsigned char* ws; int ph_lo, ph_hi; };
enum { I_X = 0, I_C, I_CTX, I_CCTX, I_WADA, I_BADA, I_NORMG, I_W1, I_W2, I_EVWIN, I_EVWLR, I_EVBLR, I_EVGLAG, I_EVQKG, I_EVWOUT,
       I_ODWIN, I_ODCONVW, I_ODCONVB, I_FW1, I_FB1, I_FW2, I_FB2, I_FW3, I_HYBIAS, I_LAM, I_DIFFG, I_ODWOUT };

typedef const __attribute__((address_space(4))) Args* KA;
__device__ __forceinline__ KA ka_launder(KA a) { asm volatile("" : "+s"(a)); return a; }
__device__ __forceinline__ int otid_(int wv) { int l; asm volatile("v_mbcnt_lo_u32_b32 %0, -1, 0\n\tv_mbcnt_hi_u32_b32 %0, -1, %0" : "=v"(l)); return (wv << 6) | l; }
#define otid() otid_(wv_)
__device__ __forceinline__ int obx() { int b = blockIdx.x; asm volatile("" : "+s"(b)); return b; }
__device__ __forceinline__ float bf2f(bf16 v) { return __builtin_bit_cast(float, (unsigned)v << 16); }
template <int CTRL> __device__ __forceinline__ float dpp_mov(float v) { return __builtin_bit_cast(float, __builtin_amdgcn_update_dpp(0, __builtin_bit_cast(int, v), CTRL, 0xF, 0xF, false)); }
__device__ __forceinline__ float sum16(float v) {
    v += dpp_mov<0xB1>(v);
    v += dpp_mov<0x4E>(v);
    v += dpp_mov<0x141>(v);
    v += dpp_mov<0x140>(v);
    return v;
}
__device__ __forceinline__ float sum_rows4(float v) {
    const unsigned u = __builtin_bit_cast(unsigned, v);
    auto a = __builtin_amdgcn_permlane16_swap(u, u, false, false);
    const float w = __builtin_bit_cast(float, (unsigned)a[0]) + __builtin_bit_cast(float, (unsigned)a[1]);
    const unsigned uw = __builtin_bit_cast(unsigned, w);
    auto b = __builtin_amdgcn_permlane32_swap(uw, uw, false, false);
    return __builtin_bit_cast(float, (unsigned)b[0]) + __builtin_bit_cast(float, (unsigned)b[1]);
}
__device__ __forceinline__ float wave_sum(float v) { return sum_rows4(sum16(v)); }
__device__ __forceinline__ float rl(float v, int k) { return __builtin_bit_cast(float, __builtin_amdgcn_readlane(__builtin_bit_cast(int, v), k)); }
__device__ __forceinline__ float siluf(float v) { return v / (1.f + __expf(-v)); }
__device__ __forceinline__ float lam_init_of(int layer) { return 0.8f - 0.6f * expf(-0.3f * (float)layer); }
__device__ __forceinline__ const float* xin_ptr(KA a, int r) {
    const int b = r / PB, p = r - b * PB;
    return p < CTXL ? a->in[I_CTX] + (size_t)(b * CTXL + p) * D : a->in[I_X] + (size_t)(b * SEQ + (p - CTXL)) * D;
}
__device__ __forceinline__ int row_cls(int r) { const int b = r / PB, p = r - b * PB; return p < CTXL ? 4 : b; }

__device__ __forceinline__ void transpose_item(const float* W, int K, int N, int src_n0, bf16* WT, int dst_n0, int k0, LAS float* scr, int lane) {
    if (src_n0 < 0) {
#pragma unroll
        for (int j = 0; j < 4; ++j) { const int n = (lane >> 3) + 8 * j; *(GAS v4u*)(WT + (size_t)(dst_n0 + n) * K + k0 + 8 * (lane & 7)) = (v4u){0u, 0u, 0u, 0u}; }
        return;
    }
#pragma unroll 8
    for (int i = 0; i < 32; ++i) { const int kk = 2 * i + (lane >> 5); scr[kk * 33 + (lane & 31)] = W[(size_t)(k0 + kk) * N + src_n0 + (lane & 31)]; }
    LDS_WAIT(); asm volatile("" ::: "memory");
    const int c = lane & 7;
#pragma unroll
    for (int j = 0; j < 4; ++j) { const int n = (lane >> 3) + 8 * j; const LAS float* s = scr + (8 * c) * 33 + n;
        v4u o; o.x = pk2(s[0 * 33], s[1 * 33]); o.y = pk2(s[2 * 33], s[3 * 33]); o.z = pk2(s[4 * 33], s[5 * 33]); o.w = pk2(s[6 * 33], s[7 * 33]);
        *(GAS v4u*)(WT + (size_t)(dst_n0 + n) * K + k0 + 8 * c) = o; }
    LDS_WAIT(); asm volatile("" ::: "memory");
}
__device__ __forceinline__ int ev_src_col(int j) {
    if (j < 1536) return j;
    if (j < 2304) { const int tile = j >> 8, pb = (j & 255) >> 5, bj = pb >> 2, wc = pb & 3;
        return (tile << 8) + (2 * wc + bj) * 32 + 32; }
    if (j < 2336) return j - 768; return -1;
}
__device__ __forceinline__ void convert_layer_weights(int wv_, KA a, int l, int mask, LAS unsigned char* lds) {
    const int tid = otid(), lane = tid & 63, wave = __builtin_amdgcn_readfirstlane(tid >> 6);
    const int gw = blockIdx.x * NWAVES + wave, NGW = gridDim.x * NWAVES;
    LAS float* scr = (LAS float*)(lds + 49152 + wave * 8448);
    const int odd = l & 1, pr = l >> 1; unsigned char* wl = a->ws + WS_W;
    const int n_in = (mask & 1) ? (odd ? 16 * 96 : 16 * 80) : 0, n_o = (mask & 2) ? 16 * 32 : 0, n_1 = (mask & 4) ? 16 * 128 : 0, n_2 = (mask & 8) ? 64 * 32 : 0;
    for (int it = gw; it < n_in + n_o + n_1 + n_2; it += NGW) {
        int r = it;
        if (r < n_in) { const int nblk = odd ? 96 : 80, kb = r / nblk, nb = r % nblk;
            if (odd) transpose_item(a->in[I_ODWIN] + (size_t)pr * 1024 * 3072, 1024, 3072, nb * 32, (bf16*)(wl + W_IN), nb * 32, kb * 64, scr, lane);
            else     transpose_item(a->in[I_EVWIN] + (size_t)pr * 1024 * 2336, 1024, 2336, ev_src_col(nb * 32), (bf16*)(wl + W_IN), nb * 32, kb * 64, scr, lane);
            continue; }
        r -= n_in;
        if (r < n_o) { const int kb = r / 32, nb = r % 32; transpose_item((odd ? a->in[I_ODWOUT] : a->in[I_EVWOUT]) + (size_t)pr * 1024 * 1024, 1024, 1024, nb * 32, (bf16*)(wl + W_OUT), nb * 32, kb * 64, scr, lane); continue; }
        r -= n_o;
        if (r < n_1) { const int kb = r / 128, nb = r % 128; transpose_item(a->in[I_W1] + (size_t)l * 1024 * 4096, 1024, 4096, nb * 32, (bf16*)(wl + W_1), nb * 32, kb * 64, scr, lane); continue; }
        r -= n_1;
        { const int kb = r / 32, nb = r % 32; transpose_item(a->in[I_W2] + (size_t)l * 4096 * 1024, 4096, 1024, nb * 32, (bf16*)(wl + W_2), nb * 32, kb * 64, scr, lane); }
    }
}
__device__ __forceinline__ void p0a_prologue(int wv_, KA a, LAS unsigned char* lds) {
    const int tid = otid(), lane = tid & 63, wave = __builtin_amdgcn_readfirstlane(tid >> 6);
    const int gw = blockIdx.x * NWAVES + wave, NGW = gridDim.x * NWAVES;
    LAS float* sc = (LAS float*)lds;
    LAS float* red = (LAS float*)(lds + 20480);
    for (int i = tid; i < 5 * 1024; i += NTHR) { const int cls = i >> 10, k = i & 1023; const float v = cls < 4 ? a->in[I_C][cls * 1024 + k] : a->in[I_CCTX][k]; sc[i] = v / (1.f + expf(-v)); }
    __syncthreads();
    float* MOD = (float*)(a->ws + WS_MOD);
    for (int item = blockIdx.x; item < 4 * 48; item += gridDim.x) {
        const int l = item / 48, nb = item % 48;
        const float* W = a->in[I_WADA] + (size_t)l * 1024 * 6144 + nb * 128 + lane * 2;
        float acc[5][2];
#pragma unroll
        for (int c = 0; c < 5; ++c) { acc[c][0] = 0.f; acc[c][1] = 0.f; }
#pragma unroll 4
        for (int kk = 0; kk < 128; ++kk) { const int k = wave * 128 + kk; const float2 w = *(const float2*)(W + (size_t)k * 6144);
#pragma unroll
            for (int c = 0; c < 5; ++c) { const float s = sc[c * 1024 + k]; acc[c][0] += s * w.x; acc[c][1] += s * w.y; } }
#pragma unroll
        for (int c = 0; c < 5; ++c) { red[(wave * 5 + c) * 128 + lane * 2] = acc[c][0]; red[(wave * 5 + c) * 128 + lane * 2 + 1] = acc[c][1]; }
        __syncthreads();
        for (int o = tid; o < 640; o += NTHR) { const int c = o >> 7, cc = o & 127; float s = a->in[I_BADA][l * 6144 + nb * 128 + cc];
#pragma unroll
            for (int w = 0; w < 8; ++w) s += red[(w * 5 + c) * 128 + cc];
            MOD[(size_t)(l * 5 + c) * 6144 + nb * 128 + cc] = s; }
        __syncthreads();
    }
    convert_layer_weights(wv_, a, 0, 15, lds);
    {
        float* tab = (float*)(a->ws + WS_TAB);
        const int gt = blockIdx.x * NTHR + tid;
        if (gt < 3072) { const int pos = gt < 2048 ? gt / 16 : (gt - 2048) / 16, i = gt & 15;
            const float inv = powf(10000.f, -(float)i / 16.f), ang = (float)pos * inv;
            tab[gt * 2] = cosf(ang); tab[gt * 2 + 1] = sinf(ang); }
        if (gw == NGW - 1) {
#pragma unroll
            for (int j = 0; j < 2; ++j) { const float* lp = a->in[I_LAM] + j * 256;
                const float s1 = wave_sum(lp[lane] * lp[64 + lane]), s2 = wave_sum(lp[128 + lane] * lp[192 + lane]);
                if (lane == 0) tab[8192 + j] = expf(s1) - expf(s2) + lam_init_of(2 * j + 1); }
        }
    }
    for (int it = gw; it < 2 * PB; it += NGW) {
        const int j = it / PB, q = it % PB; const bool isctx = q >= SEQ; const int pos = isctx ? q - SEQ : q, L = isctx ? CTXL : SEQ;
        const float t = (float)pos / (float)(L - 1), w = 2.f * 3.14159265358979323846f * (float)pos / (float)L;
        float z = 0.f;
        if (lane == 0) z = t;
        else if (lane <= 16) { const float band = 1e-4f + (float)(lane - 1) * ((15.f - 1e-4f) / 15.f); z = cosf(w * band); }
        else if (lane <= 32) { const float band = 1e-4f + (float)(lane - 17) * ((15.f - 1e-4f) / 15.f); z = -sinf(w * band); }
        const float* w1 = a->in[I_FW1] + j * 33 * 64; const float* w2 = a->in[I_FW2] + j * 64 * 64;
        float h1 = a->in[I_FB1][j * 64 + lane];
#pragma unroll
        for (int e = 0; e < 33; ++e) h1 += rl(z, e) * w1[e * 64 + lane];
        h1 = sinf(h1);
        float h2 = a->in[I_FB2][j * 64 + lane];
#pragma unroll
        for (int e = 0; e < 64; ++e) h2 += rl(h1, e) * w2[e * 64 + lane];
        h2 = sinf(h2);
        float* HID = (float*)(a->ws + WS_HID) + (isctx ? (size_t)(2 * SEQ + j * CTXL + pos) * 64 : (size_t)(j * SEQ + pos) * 64);
        HID[lane] = h2;
    }
}

struct Row16 { f32x4 v[4]; };
__device__ __forceinline__ Row16 ld_row_f32(const float* p, int lane) { Row16 r; const GAS f32x4* q = (const GAS f32x4*)p + lane;
#pragma unroll
    for (int j = 0; j < 4; ++j) r.v[j] = q[64 * j];
    return r; }
__device__ __forceinline__ Row16 ld_row_bf16(const bf16* p, int lane) { Row16 r; const GAS unsigned long long* q = (const GAS unsigned long long*)p + lane;
#pragma unroll
    for (int j = 0; j < 4; ++j) { const unsigned long long w = q[64 * j]; const unsigned lo = (unsigned)w, hi = (unsigned)(w >> 32);
        r.v[j] = (f32x4){__builtin_bit_cast(float, lo << 16), __builtin_bit_cast(float, lo & 0xffff0000u), __builtin_bit_cast(float, hi << 16), __builtin_bit_cast(float, hi & 0xffff0000u)}; }
    return r; }
__device__ __forceinline__ void st_row_f32(float* p, const Row16& r, int lane) { GAS f32x4* q = (GAS f32x4*)p + lane;
#pragma unroll
    for (int j = 0; j < 4; ++j) q[64 * j] = r.v[j]; }
__device__ __forceinline__ void st_row_bf16(bf16* p, const Row16& r, int lane) { GAS unsigned long long* q = (GAS unsigned long long*)p + lane;
#pragma unroll
    for (int j = 0; j < 4; ++j) q[64 * j] = (unsigned long long)pk2(r.v[j].x, r.v[j].y) | ((unsigned long long)pk2(r.v[j].z, r.v[j].w) << 32); }
__device__ __forceinline__ float row_sumsq(const Row16& r) { float s = 0.f;
#pragma unroll
    for (int j = 0; j < 4; ++j) s += (r.v[j].x * r.v[j].x + r.v[j].y * r.v[j].y) + (r.v[j].z * r.v[j].z + r.v[j].w * r.v[j].w);
    return wave_sum(s); }
__device__ __forceinline__ void norm_mod_store(const Row16& x, const float* g, const float* shift, const float* scale, bf16* dst, int lane) {
    const float rstd = 1.f / sqrtf(row_sumsq(x) * (1.f / D) + EPS);
    const Row16 G = ld_row_f32(g, lane), SH = ld_row_f32(shift, lane), SC = ld_row_f32(scale, lane); Row16 o;
#pragma unroll
    for (int j = 0; j < 4; ++j) o.v[j] = (x.v[j] * rstd) * G.v[j] * (SC.v[j] + 1.f) + SH.v[j];
    st_row_bf16(dst, o, lane);
}
__device__ __forceinline__ void p0b_first_norm(int wv_, KA a) {
    const int tid_o = otid(), lane = tid_o & 63, wave = tid_o >> 6, gw = blockIdx.x * NWAVES + wave, NGW = gridDim.x * NWAVES;
    const float* MOD = (const float*)(a->ws + WS_MOD); bf16* A1 = (bf16*)(a->ws + WS_A1);
    for (int rb = gw; rb < R; rb += 2 * NGW) {
        const int r2 = rb + NGW < R ? rb + NGW : rb;
        const Row16 xa = ld_row_f32(xin_ptr(a, rb), lane), xb = ld_row_f32(xin_ptr(a, r2), lane);
        { const float* m = MOD + (size_t)(0 * 5 + row_cls(rb)) * 6144; norm_mod_store(xa, a->in[I_NORMG] + 0, m + 0, m + 1024, A1 + (size_t)rb * D, lane); }
        if (rb + NGW < R) { const float* m = MOD + (size_t)(0 * 5 + row_cls(r2)) * 6144; norm_mod_store(xb, a->in[I_NORMG] + 0, m + 0, m + 1024, A1 + (size_t)r2 * D, lane); }
    }
}
typedef unsigned long long u64_t;
template <bool FIRST> struct RawRow { u64_t xb[FIRST ? 1 : 4]; f32x4 xf[FIRST ? 4 : 1]; u64_t y1[4], y2[4]; };
__device__ __forceinline__ Row16 cvt_raw(const u64_t (&q)[4]) { Row16 r;
#pragma unroll
    for (int j = 0; j < 4; ++j) { const unsigned lo = (unsigned)q[j], hi = (unsigned)(q[j] >> 32);
        r.v[j] = (f32x4){__builtin_bit_cast(float, lo << 16), __builtin_bit_cast(float, lo & 0xffff0000u), __builtin_bit_cast(float, hi << 16), __builtin_bit_cast(float, hi & 0xffff0000u)}; }
    return r; }
template <bool FIRST> __device__ __forceinline__ void rowwise_body(int wv_, KA a, int layer, int which, LAS unsigned char* lds) {
    const int tid = otid(), lane = tid & 63, wave = tid >> 6, gw = blockIdx.x * NWAVES + wave;
    const float* MOD = (const float*)(a->ws + WS_MOD); bf16* A1 = (bf16*)(a->ws + WS_A1); const bf16* Y = (const bf16*)(a->ws + WS_Y); const bf16* SLAB = (const bf16*)(a->ws + WS_SLAB);
    bf16* XB = (bf16*)(a->ws + WS_XB);
    const float* ng = a->in[I_NORMG] + (size_t)layer * 4 * D;
    const bool lastl = layer == DEPTH - 1, lastp = lastl && which == 1;
    constexpr int RPW = 17;
    const int rbl = blockIdx.x * (NWAVES * RPW), rbh = rbl + NWAVES * RPW - 1;
    const int clsA = row_cls(rbl < R ? rbl : R - 1), clsB = row_cls(rbh < R ? rbh : R - 1);
    LAS f32x4* vec = (LAS f32x4*)lds;
    for (int idx = tid; idx < 2 * 7 * 256; idx += NTHR) { const int c = idx / (7 * 256), v = (idx >> 8) % 7, q = idx & 255, cls = c ? clsB : clsA;
        const float* m = MOD + (size_t)(layer * 5 + cls) * 6144; const float* m2 = MOD + (size_t)((lastp || !which ? layer : layer + 1) * 5 + cls) * 6144;
        const float* src = v == 0 ? ng + 1 * D : v == 1 ? ng + 3 * D : v == 2 ? (which ? ng + 4 * D : ng + 2 * D) : v == 3 ? m + 2 * 1024 : v == 4 ? m + 5 * 1024 : v == 5 ? (which ? m2 + 0 : m + 3 * 1024) : (which ? m2 + 1024 : m + 4 * 1024);
        vec[idx] = *(const f32x4*)(src + 4 * q); }
    __syncthreads();
    const int r0 = gw * RPW, r1 = r0 + RPW < R ? r0 + RPW : R;
    if (r0 >= R) return;
    auto load_raw = [&](RawRow<FIRST>& q, int r) {
        if constexpr (FIRST) { const GAS f32x4* xp = (const GAS f32x4*)xin_ptr(a, r) + lane;
#pragma unroll
            for (int j = 0; j < 4; ++j) q.xf[j] = xp[64 * j]; }
        else { const GAS u64_t* xp = (const GAS u64_t*)(XB + (size_t)r * D) + lane;
#pragma unroll
            for (int j = 0; j < 4; ++j) q.xb[j] = xp[64 * j]; }
        const GAS u64_t* yp = (const GAS u64_t*)(Y + (size_t)r * D) + lane;
#pragma unroll
        for (int j = 0; j < 4; ++j) q.y1[j] = yp[64 * j];
        if (which) { const GAS u64_t* zp = (const GAS u64_t*)(A1 + (size_t)r * D) + lane;
#pragma unroll
            for (int j = 0; j < 4; ++j) q.y2[j] = zp[64 * j]; } };
    RawRow<FIRST> q0, q1, q2;
    load_raw(q0, r0); q1 = q0; q2 = q0;
    if (r0 + 1 < r1) load_raw(q1, r0 + 1);
    for (int r = r0; r < r1; ++r) {
        if (r + 2 < r1) load_raw(q2, r + 2);
        const int b = r / PB, p = r - b * PB, cls = p < CTXL ? 4 : b;
        if (!(lastl && cls == 4)) {
            const LAS f32x4* vt = vec + (cls == clsA ? 0 : 7 * 256) + lane;
            Row16 x;
            if constexpr (FIRST) {
#pragma unroll
                for (int jj = 0; jj < 4; ++jj) x.v[jj] = q0.xf[jj]; }
            else x = cvt_raw(q0.xb);
            const Row16 y1 = cvt_raw(q0.y1);
            const float rstd1 = 1.f / sqrtf(row_sumsq(y1) * (1.f / D) + EPS);
#pragma unroll
            for (int jj = 0; jj < 4; ++jj) x.v[jj] = x.v[jj] + vt[3 * 256 + 64 * jj] * ((y1.v[jj] * rstd1) * vt[0 * 256 + 64 * jj]);
            bool done = false;
            if (which) {
                Row16 y2;
                if (p < CTXL) { y2 = ld_row_bf16(SLAB + (size_t)(b * CTXL + p) * D, lane);
#pragma unroll
                    for (int k = 1; k < 4; ++k) { const Row16 sk = ld_row_bf16(SLAB + (size_t)k * 1024 * D + (size_t)(b * CTXL + p) * D, lane);
#pragma unroll
                        for (int jj = 0; jj < 4; ++jj) y2.v[jj] = y2.v[jj] + sk.v[jj]; } }
                else y2 = cvt_raw(q0.y2);
                const float rstd2 = 1.f / sqrtf(row_sumsq(y2) * (1.f / D) + EPS);
#pragma unroll
                for (int jj = 0; jj < 4; ++jj) x.v[jj] = x.v[jj] + vt[4 * 256 + 64 * jj] * ((y2.v[jj] * rstd2) * vt[1 * 256 + 64 * jj]);
                if (lastp) { st_row_f32(a->out + (size_t)(b * SEQ + (p - CTXL)) * D, x, lane); done = true; }
                else st_row_bf16(XB + (size_t)r * D, x, lane);
            }
            if (!done) {
                const float rs2 = 1.f / sqrtf(row_sumsq(x) * (1.f / D) + EPS); Row16 o;
#pragma unroll
                for (int jj = 0; jj < 4; ++jj) o.v[jj] = (x.v[jj] * rs2) * vt[2 * 256 + 64 * jj] * (vt[6 * 256 + 64 * jj] + 1.f) + vt[5 * 256 + 64 * jj];
                st_row_bf16(A1 + (size_t)r * D, o, lane);
            }
        }
        q0 = q1; q1 = q2;
    }
}
__device__ __forceinline__ void rowwise_post(int wv_, KA a, int layer, int which, LAS unsigned char* lds) {
    if (layer == 0) rowwise_body<true>(wv_, a, layer, which, lds); else rowwise_body<false>(wv_, a, layer, which, lds);
}

__device__ __forceinline__ void attn_phase_fast(int wv_, KA a, bool odd, char* lds_generic, bool skip_ctx_q = false) {
    const int G = gridDim.x, bx = blockIdx.x; const int vcu = (G % 8 == 0) ? (bx % 8) * (G / 8) + bx / 8 : bx;
    const int nvh = 8, nheavy = 4 * nvh * 32, ntot = nheavy + (skip_ctx_q ? 0 : 4 * nvh);
    unsigned char* ws = a->ws;
    const attn_body::bf16* P = (const attn_body::bf16*)(ws + WS_PH);
    for (int u = vcu; u < ntot; u += G) {
        int b, vh, panel;
        if (u < nheavy) { const int i = u >> 8, v = u & 255, xcd = v >> 5; b = xcd >> 1; vh = (xcd & 1) * (nvh >> 1) + i; panel = (v & 31) + 1; }
        else { const int lu = u - nheavy; b = lu / nvh; vh = lu % nvh; panel = 0; }
        const size_t row0 = (size_t)b * PB, qrow = row0 + 256 * panel; const int NT = panel == 0 ? CTXL / 64 : PB / 64;
        if (!odd) { const int kvh = vh >> 2;
            attn_body::attn_unit<8>(otid(), P + qrow * NP_EV + EGQ + vh * 64, NP_EV, P + row0 * NP_EV + EGK + kvh * 64, P + row0 * NP_EV + EGV + kvh * 64, NP_EV,
                                    (attn_body::bf16*)(ws + WS_A1) + qrow * D + 512 + vh * 64, D, NT, lds_generic); }
        else { const int hd = vh >> 1, c = vh & 1;
            attn_body::attn_unit128<8>(otid(), P + qrow * NP_OD + ODQ + hd * 128 + c * 64, NP_OD, P + row0 * NP_OD + ODK + hd * 128 + c * 64, P + row0 * NP_OD + ODV + hd * 128, NP_OD,
                                       (attn_body::bf16*)(ws + WS_Y) + qrow * D + hd * 256 + c * 128, D, NT, lds_generic); }
    }
}

constexpr size_t WS_UT = WS_Y, WS_S0T = WS_PH + 165 * MiB, WS_DEC = 504 * MiB;
constexpr int GQP = 144, GVP = 272, GIMG_OFF = 8 * (64 * GQP) + 2 * (64 * GVP) + 2048;
typedef short gbf16x8 __attribute__((ext_vector_type(8)));
typedef short gs16x4 __attribute__((ext_vector_type(4)));
typedef float gf32x4 __attribute__((ext_vector_type(4)));
__device__ __forceinline__ gs16x4 gtr(const LAS unsigned char* p) { return __builtin_bit_cast(gs16x4, __builtin_amdgcn_ds_read_tr16_b64_v4i16((LAS gs16x4*)p)); }
__device__ __forceinline__ gbf16x8 gcat(gs16x4 lo, gs16x4 hi) { return (gbf16x8){lo[0], lo[1], lo[2], lo[3], hi[0], hi[1], hi[2], hi[3]}; }
__device__ __forceinline__ float log_sigmoid_fast(float x) { return fminf(x, 0.f) - __logf(1.f + __expf(-fabsf(x))); }
__device__ __forceinline__ float rls(float v, int k) { return __builtin_bit_cast(float, __builtin_amdgcn_readlane(__builtin_bit_cast(int, v), k)); }

__device__ __forceinline__ void gla_prep_b(KA a, int j, const bf16* P, size_t row0, int head, int pdir, int role, int wave, int lane, LAS float* xch, float (&bv)[2][4][4], float (&tall)[4]) {
    const int g = lane >> 4, l15 = lane & 15; const gbf16x8 zero8 = {0, 0, 0, 0, 0, 0, 0, 0};
    gbf16x8 lrA[2];
#pragma unroll
    for (int tt = 0; tt < 2; ++tt) { lrA[tt] = zero8; if (g < 2) lrA[tt] = *(const gbf16x8*)(P + (row0 + 32 * role + 16 * tt + l15) * NP_EV + ELR + pdir * 16 + 8 * g); }
    gf32x4 gk[2][4];
#pragma unroll
    for (int dt = 0; dt < 4; ++dt) {
        unsigned hw[4] = {0u, 0u, 0u, 0u}, lw[4] = {0u, 0u, 0u, 0u};
        if (g < 2) {
#pragma unroll
            for (int e = 0; e < 8; ++e) { const float w = a->in[I_EVWLR][((size_t)(j * 2 + pdir) * 16 + 8 * g + e) * 256 + head * 64 + 16 * dt + l15];
                const unsigned h = f2bf(w), l = f2bf(w - __builtin_bit_cast(float, h << 16)); hw[e >> 1] |= h << (16 * (e & 1)); lw[e >> 1] |= l << (16 * (e & 1)); } }
        const gbf16x8 wh = __builtin_bit_cast(gbf16x8, (v4u){hw[0], hw[1], hw[2], hw[3]}), wlo = __builtin_bit_cast(gbf16x8, (v4u){lw[0], lw[1], lw[2], lw[3]});
        const float bl = a->in[I_EVBLR][(j * 2 + pdir) * 256 + head * 64 + 16 * dt + l15];
#pragma unroll
        for (int tt = 0; tt < 2; ++tt) { gf32x4 acc = (gf32x4){bl, bl, bl, bl};
            acc = __builtin_amdgcn_mfma_f32_16x16x32_bf16(lrA[tt], wh, acc, 0, 0, 0); acc = __builtin_amdgcn_mfma_f32_16x16x32_bf16(lrA[tt], wlo, acc, 0, 0, 0); gk[tt][dt] = acc; }
    }
    float tot[4];
#pragma unroll
    for (int dt = 0; dt < 4; ++dt) { float t2 = 0.f;
#pragma unroll
        for (int tt = 0; tt < 2; ++tt)
#pragma unroll
            for (int r = 0; r < 4; ++r) { const float x = gk[tt][dt][r]; const float e = __builtin_amdgcn_exp2f(-fabsf(x) * 1.4426950408889634f);
                const float la = (fminf(x, 0.f) - 0.6931471805599453f * __builtin_amdgcn_logf(1.f + e)) * (1.f / 16.f); gk[tt][dt][r] = la; t2 += la; }
        tot[dt] = sum_rows4(t2); }
    if (g == 0) {
#pragma unroll
        for (int dt = 0; dt < 4; ++dt) xch[wave * 64 + 16 * dt + l15] = tot[dt]; }
    gbf16x8 tri[2];
#pragma unroll
    for (int tt = 0; tt < 2; ++tt) { unsigned w[4] = {0u, 0u, 0u, 0u}; const int tl = 16 * tt + l15;
#pragma unroll
        for (int e = 0; e < 8; ++e) { const int tp = e < 4 ? 4 * g + e : 16 + 4 * g + (e - 4); const bool keep = pdir == 0 ? (tp <= tl) : (tp >= tl); w[e >> 1] |= keep ? (0x3F80u << (16 * (e & 1))) : 0u; }
        tri[tt] = __builtin_bit_cast(gbf16x8, (v4u){w[0], w[1], w[2], w[3]}); }
    gf32x4 bl2[2][4];
#pragma unroll
    for (int dt = 0; dt < 4; ++dt) { unsigned hw[4], lw[4];
#pragma unroll
        for (int e = 0; e < 8; e += 2) { const float x0 = gk[e >> 2][dt][e & 3], x1 = gk[e >> 2][dt][(e & 3) + 1];
            const unsigned h0 = f2bf(x0), h1 = f2bf(x1); hw[e >> 1] = h0 | (h1 << 16);
            lw[e >> 1] = f2bf(x0 - __builtin_bit_cast(float, h0 << 16)) | (f2bf(x1 - __builtin_bit_cast(float, h1 << 16)) << 16); }
        const gbf16x8 bh = __builtin_bit_cast(gbf16x8, (v4u){hw[0], hw[1], hw[2], hw[3]}), blo = __builtin_bit_cast(gbf16x8, (v4u){lw[0], lw[1], lw[2], lw[3]});
#pragma unroll
        for (int tt = 0; tt < 2; ++tt) { gf32x4 acc = (gf32x4){0.f, 0.f, 0.f, 0.f};
            acc = __builtin_amdgcn_mfma_f32_16x16x32_bf16(tri[tt], bh, acc, 0, 0, 0); acc = __builtin_amdgcn_mfma_f32_16x16x32_bf16(tri[tt], blo, acc, 0, 0, 0); bl2[tt][dt] = acc; } }
    __syncthreads();
    const bool need_other = pdir == 0 ? (role == 1) : (role == 0);
#pragma unroll
    for (int dt = 0; dt < 4; ++dt) { const float other = xch[(wave ^ 1) * 64 + 16 * dt + l15]; tall[dt] = tot[dt] + other; const float add = need_other ? other : 0.f;
#pragma unroll
        for (int tt = 0; tt < 2; ++tt)
#pragma unroll
            for (int r = 0; r < 4; ++r) bv[tt][dt][r] = bl2[tt][dt][r] + add; }
}
__device__ __forceinline__ void gla_state_phase(int wv_, KA a, int j, LAS unsigned char* lds) {
    const int tid = otid(), lane = tid & 63, wave = __builtin_amdgcn_readfirstlane(tid >> 6);
    const int hl = wave >> 2, dir = (wave >> 1) & 1, role = wave & 1, g = lane >> 4, l15 = lane & 15;
    unsigned char* ws = a->ws; const bf16* P = (const bf16*)(ws + WS_PH);
    LAS unsigned char* kimg = lds + (hl * 2 + dir) * (64 * GQP); LAS unsigned char* vimg = lds + 4 * (64 * GQP) + hl * (64 * GVP); LAS float* xch = (LAS float*)(lds + 4 * (64 * GQP) + 2 * (64 * GVP));
    for (int unit = blockIdx.x; unit < NB * 132 * 2; unit += gridDim.x) {
        const int b = unit / 264, rem = unit % 264, cidx = rem >> 1, hp = rem & 1, head = hp * 2 + hl; const size_t row0 = (size_t)b * PB + cidx * 64;
        const int chain = (b * 4 + head) * 2 + dir;
        __syncthreads();
        { v4u vv[4], kk[2];
#pragma unroll
            for (int it = 0; it < 4; ++it) { const int ch = tid + it * NTHR, hh = ch >> 10, t = (ch >> 4) & 63, c16 = ch & 15; vv[it] = *(const v4u*)(P + (row0 + t) * NP_EV + EVV + (hp * 2 + hh) * 128 + c16 * 8); }
#pragma unroll
            for (int it = 0; it < 2; ++it) { const int ch = tid + it * NTHR, hh = ch >> 9, t = (ch >> 3) & 63, c8 = ch & 7; kk[it] = *(const v4u*)(P + (row0 + t) * NP_EV + EK + (hp * 2 + hh) * 64 + c8 * 8); }
#pragma unroll
            for (int it = 0; it < 4; ++it) { const int ch = tid + it * NTHR, hh = ch >> 10, t = (ch >> 4) & 63, c16 = ch & 15; *(LAS v4u*)(lds + 4 * (64 * GQP) + hh * (64 * GVP) + t * GVP + c16 * 16) = vv[it]; }
#pragma unroll
            for (int it = 0; it < 2; ++it) { const int ch = tid + it * NTHR, hh = ch >> 9, t = (ch >> 3) & 63, c8 = ch & 7;
                *(LAS v4u*)(lds + (hh * 2) * (64 * GQP) + t * GQP + c8 * 16) = kk[it]; *(LAS v4u*)(lds + (hh * 2 + 1) * (64 * GQP) + t * GQP + c8 * 16) = kk[it]; } }
        float bv[2][4][4], tall[4];
        gla_prep_b(a, j, P, row0, head, dir, role, wave, lane, xch, bv, tall);
#pragma unroll
        for (int tt = 0; tt < 2; ++tt)
#pragma unroll
            for (int dt = 0; dt < 4; ++dt)
#pragma unroll
                for (int r = 0; r < 4; ++r) { const int t = 32 * role + 16 * tt + 4 * g + r, dk = 16 * dt + l15;
                    LAS bf16* kp = (LAS bf16*)(kimg + t * GQP + dk * 2);
                    *kp = (bf16)f2bf(bf2f(*kp) * __builtin_amdgcn_exp2f((tall[dt] - bv[tt][dt][r]) * 1.4426950408889634f)); }
        if (role == 0 && g == 0) {
#pragma unroll
            for (int dt = 0; dt < 4; ++dt) ((float*)(ws + WS_DEC))[((size_t)chain * 132 + cidx) * 64 + 16 * dt + l15] = __builtin_amdgcn_exp2f(tall[dt] * 1.4426950408889634f); }
        __syncthreads();
        gf32x4 acc[4][4];
#pragma unroll
        for (int x = 0; x < 4; ++x)
#pragma unroll
            for (int y = 0; y < 4; ++y) acc[x][y] = (gf32x4){0.f, 0.f, 0.f, 0.f};
        const int q = l15 >> 2, p4 = lane & 3;
#pragma unroll
        for (int ks = 0; ks < 2; ++ks) {
            gbf16x8 af[4], bfr[4];
#pragma unroll
            for (int x = 0; x < 4; ++x) { const LAS unsigned char* pa = kimg + (32 * ks + 8 * g + q) * GQP + (16 * x + 4 * p4) * 2; af[x] = gcat(gtr(pa), gtr(pa + 4 * GQP)); }
#pragma unroll
            for (int y = 0; y < 4; ++y) { const LAS unsigned char* pb = vimg + (32 * ks + 8 * g + q) * GVP + (64 * role + 16 * y + 4 * p4) * 2; bfr[y] = gcat(gtr(pb), gtr(pb + 4 * GVP)); }
#pragma unroll
            for (int x = 0; x < 4; ++x)
#pragma unroll
                for (int y = 0; y < 4; ++y) acc[x][y] = __builtin_amdgcn_mfma_f32_16x16x32_bf16(af[x], bfr[y], acc[x][y], 0, 0, 0);
        }
        bf16* UT = (bf16*)(ws + WS_UT) + ((size_t)chain * 132 + cidx) * 8192;
#pragma unroll
        for (int x = 0; x < 4; ++x)
#pragma unroll
            for (int y = 0; y < 4; ++y) { const int dv = 64 * role + 16 * y + l15, dk = 16 * x + 4 * g;
                *(unsigned long long*)(UT + dv * 64 + dk) = (unsigned long long)pk2(acc[x][y][0], acc[x][y][1]) | ((unsigned long long)pk2(acc[x][y][2], acc[x][y][3]) << 32); }
    }
}
__device__ __forceinline__ void gla_scan_phase(int wv_, KA a) {
    const int tid = otid(), lane = tid & 63, wave = tid >> 6;
    const int vt = (blockIdx.x + gridDim.x * wave) * 64 + lane;
    if (vt >= 32 * 1024) return;
    unsigned char* ws = a->ws;
    const int chain = vt >> 10, e = vt & 1023, dir = chain & 1;
    const bf16* UT = (const bf16*)(ws + WS_UT); bf16* S0T = (bf16*)(ws + WS_S0T); const float* DEC = (const float*)(ws + WS_DEC);
    float S[8];
#pragma unroll
    for (int i = 0; i < 8; ++i) S[i] = 0.f;
#pragma unroll 11
    for (int s = 0; s < 132; ++s) {
        const int cidx = dir == 0 ? s : (s < 4 ? 3 - s : 135 - s);
        const size_t off = ((size_t)chain * 132 + cidx) * 8192 + (size_t)e * 8;
        const v4u u = *(const v4u*)(UT + off);
        const f32x4 d0 = *(const f32x4*)(DEC + ((size_t)chain * 132 + cidx) * 64 + (e & 7) * 8), d1 = *(const f32x4*)(DEC + ((size_t)chain * 132 + cidx) * 64 + (e & 7) * 8 + 4);
        v4u o; o.x = pk2(S[0], S[1]); o.y = pk2(S[2], S[3]); o.z = pk2(S[4], S[5]); o.w = pk2(S[6], S[7]);
        *(v4u*)(S0T + off) = o;
        const unsigned uw[4] = {u.x, u.y, u.z, u.w}; const float dd[8] = {d0.x, d0.y, d0.z, d0.w, d1.x, d1.y, d1.z, d1.w};
#pragma unroll
        for (int i = 0; i < 8; ++i) { const float uv = __builtin_bit_cast(float, (i & 1) ? (uw[i >> 1] & 0xffff0000u) : (uw[i >> 1] << 16)); S[i] = S[i] * dd[i] + uv; }
    }
}
__device__ __forceinline__ void gla_output_phase(int wv_, KA a, int j, LAS unsigned char* lds, int skipmask = 0) {
    const int tid = otid(), lane = tid & 63, wave = __builtin_amdgcn_readfirstlane(tid >> 6);
    const int hl = wave >> 2, pdir = (wave >> 1) & 1, role = wave & 1, q4 = wave & 3, g = lane >> 4, l15 = lane & 15;
    unsigned char* ws = a->ws; const bf16* P = (const bf16*)(ws + WS_PH); bf16* MIX = (bf16*)(ws + WS_A1);
    LAS unsigned char* qimg0 = lds + (hl * 2) * (64 * GQP); LAS unsigned char* kimg0 = lds + (4 + hl * 2) * (64 * GQP); LAS unsigned char* vimg = lds + 8 * (64 * GQP) + hl * (64 * GVP);
    for (int unit = blockIdx.x; unit < NB * 132 * 2; unit += gridDim.x) {
        const int b = unit / 264, rem = unit % 264, cidx = rem >> 1, hp = rem & 1, head = hp * 2 + hl; const size_t row0 = (size_t)b * PB + cidx * 64;
        __syncthreads();
        gbf16x8 sfA[8][2], sfB[8][2];
        const bf16* S0f = (const bf16*)(ws + WS_S0T) + ((size_t)((b * 4 + head) * 2) * 132 + cidx) * 8192;
#pragma unroll
        for (int c = 0; c < 8; ++c)
#pragma unroll
            for (int ks = 0; ks < 2; ++ks) sfA[c][ks] = *(const gbf16x8*)(S0f + (16 * c + l15) * 64 + 32 * ks + 8 * g);
        { v4u vv[4], gg[4], qq2[2], kk[2];
#pragma unroll
            for (int it = 0; it < 4; ++it) { const int ch = tid + it * NTHR, hh = ch >> 10, t = (ch >> 4) & 63, c16 = ch & 15; const bf16* src = P + (row0 + t) * NP_EV + (hp * 2 + hh) * 128 + c16 * 8; vv[it] = *(const v4u*)(src + EVV); gg[it] = *(const v4u*)(src + EG); }
#pragma unroll
            for (int it = 0; it < 2; ++it) { const int ch = tid + it * NTHR, hh = ch >> 9, t = (ch >> 3) & 63, c8 = ch & 7; const bf16* src = P + (row0 + t) * NP_EV + (hp * 2 + hh) * 64 + c8 * 8; qq2[it] = *(const v4u*)(src + EQ); kk[it] = *(const v4u*)(src + EK); }
#pragma unroll
            for (int it = 0; it < 4; ++it) { const int ch = tid + it * NTHR, hh = ch >> 10, t = (ch >> 4) & 63, c16 = ch & 15;
                *(LAS v4u*)(lds + 8 * (64 * GQP) + hh * (64 * GVP) + t * GVP + c16 * 16) = vv[it]; *(LAS v4u*)(lds + GIMG_OFF + hh * (64 * GVP) + t * GVP + c16 * 16) = gg[it]; }
#pragma unroll
            for (int it = 0; it < 2; ++it) { const int ch = tid + it * NTHR, hh = ch >> 9, t = (ch >> 3) & 63, c8 = ch & 7;
                *(LAS v4u*)(lds + (hh * 2) * (64 * GQP) + t * GQP + c8 * 16) = qq2[it]; *(LAS v4u*)(lds + (hh * 2 + 1) * (64 * GQP) + t * GQP + c8 * 16) = qq2[it];
                *(LAS v4u*)(lds + (4 + hh * 2) * (64 * GQP) + t * GQP + c8 * 16) = kk[it]; *(LAS v4u*)(lds + (4 + hh * 2 + 1) * (64 * GQP) + t * GQP + c8 * 16) = kk[it]; } }
        {
            float bv[2][4][4], tall[4];
            gla_prep_b(a, j, P, row0, head, pdir, role, wave, lane, (LAS float*)(lds + 8 * (64 * GQP) + 2 * (64 * GVP)), bv, tall);
            LAS unsigned char* qi = qimg0 + pdir * (64 * GQP); LAS unsigned char* ki = kimg0 + pdir * (64 * GQP);
#pragma unroll
            for (int tt = 0; tt < 2; ++tt)
#pragma unroll
                for (int dt = 0; dt < 4; ++dt)
#pragma unroll
                    for (int r = 0; r < 4; ++r) { const int t = 32 * role + 16 * tt + 4 * g + r, dk = 16 * dt + l15;
                        const float e = __builtin_amdgcn_exp2f(bv[tt][dt][r] * 1.4426950408889634f);
                        LAS bf16* qp = (LAS bf16*)(qi + t * GQP + dk * 2); LAS bf16* kp = (LAS bf16*)(ki + t * GQP + dk * 2);
                        *qp = (bf16)f2bf(bf2f(*qp) * 0.125f * e);
                        *kp = (bf16)f2bf(bf2f(*kp) * __builtin_amdgcn_rcpf(e)); }
        }
        __syncthreads();
        gf32x4 o[8];
#pragma unroll
        for (int c = 0; c < 8; ++c) o[c] = (gf32x4){0.f, 0.f, 0.f, 0.f};
        const int qq = l15 >> 2, p4 = lane & 3;
#pragma unroll
        for (int c = 0; c < 8; ++c)
#pragma unroll
            for (int ks = 0; ks < 2; ++ks) sfB[c][ks] = *(const gbf16x8*)(S0f + (size_t)132 * 8192 + (16 * c + l15) * 64 + 32 * ks + 8 * g);
        if (!(skipmask & 2))
#pragma unroll
        for (int dir = 0; dir < 2; ++dir) {
            const LAS unsigned char* qimg = qimg0 + dir * (64 * GQP); const LAS unsigned char* kimg = kimg0 + dir * (64 * GQP);
            gbf16x8 qf[2];
#pragma unroll
            for (int ks = 0; ks < 2; ++ks) qf[ks] = *(const LAS gbf16x8*)(qimg + (16 * q4 + l15) * GQP + (32 * ks + 8 * g) * 2);
            gf32x4 st[4];
#pragma unroll
            for (int jt = 0; jt < 4; ++jt) { st[jt] = (gf32x4){0.f, 0.f, 0.f, 0.f};
#pragma unroll
                for (int ks = 0; ks < 2; ++ks) { const gbf16x8 kf = *(const LAS gbf16x8*)(kimg + (16 * jt + l15) * GQP + (32 * ks + 8 * g) * 2);
                    st[jt] = __builtin_amdgcn_mfma_f32_16x16x32_bf16(kf, qf[ks], st[jt], 0, 0, 0); }
                const int i = 16 * q4 + l15;
#pragma unroll
                for (int r = 0; r < 4; ++r) { const int jj = 16 * jt + 4 * g + r; const bool keep = dir == 0 ? (jj <= i) : (jj >= i); st[jt][r] = keep ? st[jt][r] : 0.f; } }
            gbf16x8 pa[2];
#pragma unroll
            for (int k2 = 0; k2 < 2; ++k2) { const unsigned w0 = pk2(st[2 * k2][0], st[2 * k2][1]), w1 = pk2(st[2 * k2][2], st[2 * k2][3]), w2 = pk2(st[2 * k2 + 1][0], st[2 * k2 + 1][1]), w3 = pk2(st[2 * k2 + 1][2], st[2 * k2 + 1][3]);
                pa[k2] = __builtin_bit_cast(gbf16x8, (v4u){w0, w1, w2, w3}); }
#pragma unroll
            for (int c = 0; c < 8; ++c) {
#pragma unroll
                for (int k2 = 0; k2 < 2; ++k2) { const LAS unsigned char* pv = vimg + (32 * k2 + 4 * g + qq) * GVP + (16 * c + 4 * p4) * 2;
                    const gbf16x8 vf = gcat(gtr(pv), gtr(pv + 16 * GVP));
                    o[c] = __builtin_amdgcn_mfma_f32_16x16x32_bf16(pa[k2], vf, o[c], 0, 0, 0); }
#pragma unroll
                for (int ks = 0; ks < 2; ++ks) o[c] = __builtin_amdgcn_mfma_f32_16x16x32_bf16(qf[ks], dir ? sfB[c][ks] : sfA[c][ks], o[c], 0, 0, 0);
            }
        }
        if (skipmask & 4) continue;
        float ss[4];
#pragma unroll
        for (int r = 0; r < 4; ++r) { float t2 = 0.f;
#pragma unroll
            for (int c = 0; c < 8; ++c) t2 += o[c][r] * o[c][r];
            t2 = sum16(t2);
            ss[r] = 1.f / sqrtf(t2 * (1.f / 128.f) + EPS); }
        LAS unsigned char* gimg = lds + GIMG_OFF + hl * (64 * GVP);
#pragma unroll
        for (int c = 0; c < 8; ++c) { const float gain = a->in[I_EVGLAG][j * 128 + 16 * c + l15];
#pragma unroll
            for (int r = 0; r < 4; ++r) { LAS bf16* gp = (LAS bf16*)(gimg + (16 * q4 + 4 * g + r) * GVP + (16 * c + l15) * 2);
                *gp = (bf16)f2bf(o[c][r] * ss[r] * gain * siluf(bf2f(*gp))); } }
        __syncthreads();
#pragma unroll
        for (int it = 0; it < 4; ++it) { const int ch = tid + it * NTHR, hh = ch >> 10, t = (ch >> 4) & 63, c16 = ch & 15;
            *(v4u*)(MIX + (row0 + t) * D + (hp * 2 + hh) * 128 + c16 * 8) = *(const LAS v4u*)(lds + GIMG_OFF + hh * (64 * GVP) + t * GVP + c16 * 16); }
    }
}

__device__ __forceinline__ void diff_out_phase(int wv_, KA a, int j, int layer) {
    const int tid_o = otid(), lane = tid_o & 63, wave = tid_o >> 6, gw = blockIdx.x * NWAVES + wave, NGW = gridDim.x * NWAVES;
    const bf16* O01 = (const bf16*)(a->ws + WS_Y); bf16* MIX = (bf16*)(a->ws + WS_A1);
    const float lam = ((const float*)(a->ws + WS_TAB))[8192 + j], post = 1.f - lam_init_of(layer);
    const int hd = lane >> 4, d8 = (lane & 15) * 8;
    float gn[8];
#pragma unroll
    for (int e = 0; e < 8; ++e) gn[e] = a->in[I_DIFFG][j * 128 + d8 + e] * post;
    for (int rb = gw; rb < R; rb += 4 * NGW) {
        v4u w0[4], w1[4];
#pragma unroll
        for (int k = 0; k < 4; ++k) { const int r = rb + k * NGW < R ? rb + k * NGW : rb; const bf16* o = O01 + (size_t)r * D + hd * 256 + d8; w0[k] = *(const v4u*)o; w1[k] = *(const v4u*)(o + 128); }
#pragma unroll
        for (int k = 0; k < 4; ++k) { const int r = rb + k * NGW;
            if (r >= R || (layer == DEPTH - 1 && row_cls(r) == 4)) continue;
            const unsigned a0[4] = {w0[k].x, w0[k].y, w0[k].z, w0[k].w}, a1[4] = {w1[k].x, w1[k].y, w1[k].z, w1[k].w};
            float v[8]; float ss = 0.f;
#pragma unroll
            for (int e = 0; e < 8; ++e) { const float x0 = __builtin_bit_cast(float, (e & 1) ? (a0[e >> 1] & 0xffff0000u) : (a0[e >> 1] << 16)), x1 = __builtin_bit_cast(float, (e & 1) ? (a1[e >> 1] & 0xffff0000u) : (a1[e >> 1] << 16));
                v[e] = x0 - lam * x1; ss += v[e] * v[e]; }
            ss = sum16(ss);
            const float rstd = 1.f / sqrtf(ss * (1.f / 128.f) + EPS);
            v4u ow; ow.x = pk2(v[0] * rstd * gn[0], v[1] * rstd * gn[1]); ow.y = pk2(v[2] * rstd * gn[2], v[3] * rstd * gn[3]); ow.z = pk2(v[4] * rstd * gn[4], v[5] * rstd * gn[5]); ow.w = pk2(v[6] * rstd * gn[6], v[7] * rstd * gn[7]);
            *(v4u*)(MIX + (size_t)r * D + 512 + hd * 128 + d8) = ow; }
    }
}

typedef float cf2 __attribute__((ext_vector_type(2)));
constexpr size_t WS_PT = WS_PH + 99 * MiB;
constexpr size_t WS_HYS = WS_A1;
constexpr float TWC[16] = {1.000000000e+00f, 9.807852804e-01f, 9.238795325e-01f, 8.314696123e-01f, 7.071067812e-01f, 5.555702330e-01f, 3.826834324e-01f, 1.950903220e-01f, 6.123233996e-17f, -1.950903220e-01f, -3.826834324e-01f, -5.555702330e-01f, -7.071067812e-01f, -8.314696123e-01f, -9.238795325e-01f, -9.807852804e-01f};
constexpr float TWS[16] = {0.000000000e+00f, 1.950903220e-01f, 3.826834324e-01f, 5.555702330e-01f, 7.071067812e-01f, 8.314696123e-01f, 9.238795325e-01f, 9.807852804e-01f, 1.000000000e+00f, 9.807852804e-01f, 9.238795325e-01f, 8.314696123e-01f, 7.071067812e-01f, 5.555702330e-01f, 3.826834324e-01f, 1.950903220e-01f};
__device__ __forceinline__ cf2 cmul(cf2 a, cf2 b) { return (cf2){a.x * b.x - a.y * b.y, a.x * b.y + a.y * b.x}; }
__device__ __forceinline__ cf2 cmulc(cf2 a, cf2 b) { return (cf2){a.x * b.x + a.y * b.y, a.y * b.x - a.x * b.y}; }
template <bool INV> __device__ __forceinline__ cf2 tw_mul(cf2 d, int ti) {
    if (ti == 0) return d;
    if (ti == 8) return INV ? (cf2){-d.y, d.x} : (cf2){d.y, -d.x};
    const float c = TWC[ti], s = TWS[ti];
    return INV ? (cf2){d.x * c - d.y * s, d.y * c + d.x * s} : (cf2){d.x * c + d.y * s, d.y * c - d.x * s};
}
template <int N, int H, bool INV> struct FftStage {
    static __device__ __forceinline__ void run(cf2 (&x)[N]) {
#pragma unroll
        for (int g = 0; g < N; g += 2 * H)
#pragma unroll
            for (int j = 0; j < H; ++j) { const cf2 a = x[g + j], b = x[g + j + H]; x[g + j] = a + b; x[g + j + H] = tw_mul<INV>(a - b, j * (16 / H)); }
        FftStage<N, H / 2, INV>::run(x);
    }
};
template <int N, bool INV> struct FftStage<N, 0, INV> { static __device__ __forceinline__ void run(cf2 (&)[N]) {} };
template <int N, bool INV> __device__ __forceinline__ void fft_reg(cf2 (&x)[N]) { FftStage<N, N / 2, INV>::run(x); }
__device__ __forceinline__ void fft32_half(cf2 (&x)[32]) {
#pragma unroll
    for (int j = 0; j < 16; ++j) x[j + 16] = tw_mul<false>(x[j], j);
    FftStage<32, 8, false>::run(x);
}
__host__ __device__ constexpr int br5(int i) { return ((i & 1) << 4) | ((i & 2) << 2) | (i & 4) | ((i & 8) >> 2) | ((i & 16) >> 4); }
__host__ __device__ constexpr int br4(int i) { return ((i & 1) << 3) | ((i & 2) << 1) | ((i & 4) >> 1) | ((i & 8) >> 3); }

#define HY_OPAQUE(w) asm volatile("" : "+v"(w.x), "+v"(w.y))
#define HY_WAVE_HANDOFF() asm volatile("s_waitcnt lgkmcnt(0)" ::: "memory")
__device__ __forceinline__ void hy_p1_store(LAS cf2* buf, cf2 (&x)[32], int m, cf2 w1) {
    HY_OPAQUE(w1);
    const int base = 17 * (m >> 4) + (m & 15); cf2 pw = (cf2){1.f, 0.f};
#pragma unroll
    for (int k = 0; k < 32; ++k) { if (k) { pw = cmul(pw, w1); x[br5(k)] = cmul(x[br5(k)], pw); } buf[560 * k + base] = x[br5(k)]; }
}
__device__ __forceinline__ void hy_p2(LAS cf2* buf, int tid, cf2 w2) {
    HY_OPAQUE(w2);
    const int base = 560 * (tid >> 4) + (tid & 15); cf2 x[32];
#pragma unroll
    for (int n = 0; n < 32; ++n) x[n] = buf[base + 17 * n];
    fft_reg<32, false>(x);
    cf2 pw = (cf2){1.f, 0.f};
#pragma unroll
    for (int k = 0; k < 32; ++k) { if (k) { pw = cmul(pw, w2); x[br5(k)] = cmul(x[br5(k)], pw); } buf[base + 17 * k] = x[br5(k)]; }
}
template <int MODE> __device__ __forceinline__ void hy_p3(LAS cf2* buf, int tid, cf2* kf) {
#pragma unroll
    for (int i = 0; i < 2; ++i) {
        const int blk = tid + 512 * i, base = 560 * (4 * (tid >> 6) + 2 * i + ((tid >> 5) & 1)) + 17 * (tid & 31); cf2 x[16];
#pragma unroll
        for (int n = 0; n < 16; ++n) x[n] = buf[base + n];
        fft_reg<16, false>(x);
        cf2* kp = kf + (size_t)(i * 16) * 512 + tid;
        if (MODE == 0) {
#pragma unroll
            for (int r = 0; r < 16; ++r) kp[r * 512] = x[r] * (1.f / 16384.f);
        } else {
            cf2 y[16];
#pragma unroll
            for (int r = 0; r < 16; ++r) x[r] = cmul(x[r], kp[r * 512]);
#pragma unroll
            for (int k = 0; k < 16; ++k) y[k] = x[br4(k)];
            fft_reg<16, true>(y);
#pragma unroll
            for (int r = 0; r < 16; ++r) buf[base + br4(r)] = y[r];
        }
    }
}
__device__ __forceinline__ void hy_ip2(LAS cf2* buf, int tid, cf2 w2) {
    HY_OPAQUE(w2);
    const int base = 560 * (tid >> 4) + (tid & 15); cf2 x[32]; cf2 pw = (cf2){1.f, 0.f};
#pragma unroll
    for (int k = 0; k < 32; ++k) { x[k] = buf[base + 17 * k]; if (k) { pw = cmulc(pw, w2); x[k] = cmul(x[k], pw); } }
    fft_reg<32, true>(x);
#pragma unroll
    for (int r = 0; r < 32; ++r) buf[base + 17 * br5(r)] = x[r];
}
__device__ __forceinline__ void hy_ip3(const LAS cf2* buf, cf2 (&x)[32], int m, cf2 w1) {
    HY_OPAQUE(w1);
    const int base = 17 * (m >> 4) + (m & 15); cf2 pw = (cf2){1.f, 0.f};
#pragma unroll
    for (int k = 0; k < 32; ++k) { x[k] = buf[560 * k + base]; if (k) { pw = cmulc(pw, w1); x[k] = cmul(x[k], pw); } }
    fft_reg<32, true>(x);
}
__device__ __forceinline__ float hy_sconv(const bf16* row, int L, int t, float w0, float w1, float w2, float cb) {
    float u0 = bf2f(row[t - 1]), u1 = bf2f(row[t]), u2 = bf2f(row[t + 1]); u0 = t > 0 ? u0 : 0.f; u2 = t + 1 < L ? u2 : 0.f;
    return u0 * w0 + u1 * w1 + u2 * w2 + cb;
}
__device__ __forceinline__ void hyena_fft_phase(int wv_, KA a, int j, bool do_ctx, LAS unsigned char* lds, bool dry = false, int skipmask = 0) {
    const int tid0 = otid();
    LAS cf2* buf = (LAS cf2*)lds;
    unsigned char* ws = a->ws;
    bf16* PT = (bf16*)(ws + WS_PT); const float* HF = (const float*)(ws + WS_HF);
    cf2* KF = (cf2*)(ws + WS_HYS + (size_t)blockIdx.x * 262144); float* Z1 = (float*)(ws + WS_HYS + (size_t)blockIdx.x * 262144 + 131072);
    const float* cw = a->in[I_ODCONVW] + (size_t)j * 3 * 1536; const float* cb = a->in[I_ODCONVB] + j * 1536; const float* hb = a->in[I_HYBIAS] + j * 1024;
    const float a1 = -6.283185307179586f * (float)tid0 * (1.f / 16384.f), a2 = -6.283185307179586f * (float)(tid0 & 15) * (1.f / 512.f);
    const cf2 w1 = (cf2){cosf(a1), sinf(a1)}, w2 = (cf2){cosf(a2), sinf(a2)};
    for (int c = blockIdx.x; c < 512; c += gridDim.x) {
#pragma unroll 1
        for (int o = 0; o < 2; ++o) {
            const float bias = hb[o * 512 + c];
            const int chg = 512 * (o + 1) + c;
            const float gw0 = cw[chg], gw1 = cw[1536 + chg], gw2 = cw[3072 + chg], gcb = cb[chg];
            if (!(skipmask & 1)) {
                int tid = tid0; asm volatile("" : "+v"(tid)); const int m = tid;
                const float* hf = HF + (size_t)(o * 1024 + c) * SEQ; const float* hbk = HF + (size_t)(o * 1024 + 512 + c) * SEQ;
                cf2 x[32];
#pragma unroll
                for (int n1 = 0; n1 < 32; ++n1) { float v;
                    if (n1 < 16) v = hf[512 * n1 + m]; else if (n1 == 16) v = m == 0 ? 0.f : hbk[8192 - m]; else v = hbk[16384 - 512 * n1 - m];
                    x[n1] = (cf2){v, 0.f}; }
                fft_reg<32, false>(x);
                hy_p1_store(buf, x, m, w1);
                __syncthreads(); hy_p2(buf, tid, w2); HY_WAVE_HANDOFF(); hy_p3<0>(buf, tid, KF); __syncthreads();
            }
#pragma unroll 1
            for (int pr = 0; pr < ((skipmask & 2) ? 0 : 2); ++pr) {
                int tid = tid0; asm volatile("" : "+v"(tid)); const int m = tid;
                cf2 xin[16];
                if (o == 0) { const float vw0 = cw[c], vw1 = cw[1536 + c], vw2 = cw[3072 + c], vcb = cb[c];
                    const bf16* r0 = PT + (size_t)c * R + (size_t)(2 * pr) * PB + CTXL; const bf16* r1 = r0 + PB;
#pragma unroll
                    for (int n1 = 0; n1 < 16; ++n1) xin[n1] = (cf2){hy_sconv(r0, SEQ, 512 * n1 + m, vw0, vw1, vw2, vcb), hy_sconv(r1, SEQ, 512 * n1 + m, vw0, vw1, vw2, vcb)}; }
                else {
#pragma unroll
                    for (int n1 = 0; n1 < 16; ++n1) xin[n1] = (cf2){Z1[(2 * pr) * SEQ + 512 * n1 + m], Z1[(2 * pr + 1) * SEQ + 512 * n1 + m]}; }
                cf2 x[32];
#pragma unroll
                for (int n1 = 0; n1 < 16; ++n1) x[n1] = xin[n1];
                fft32_half(x);
                hy_p1_store(buf, x, m, w1);
                __syncthreads(); hy_p2(buf, tid, w2); HY_WAVE_HANDOFF(); hy_p3<1>(buf, tid, KF); HY_WAVE_HANDOFF(); hy_ip2(buf, tid, w2); __syncthreads();
                hy_ip3(buf, x, m, w1);
                __syncthreads();
                const bf16* g0 = PT + (size_t)chg * R + (size_t)(2 * pr) * PB + CTXL; const bf16* g1 = g0 + PB;
#pragma unroll
                for (int i = 0; i < 32; ++i) { const int n1 = br5(i); if (n1 >= 16) continue; const int n = 512 * n1 + m;
                    const float z0 = hy_sconv(g0, SEQ, n, gw0, gw1, gw2, gcb) * (x[i].x + xin[n1].x * bias), z1 = hy_sconv(g1, SEQ, n, gw0, gw1, gw2, gcb) * (x[i].y + xin[n1].y * bias);
                    if (o == 0) { Z1[(2 * pr) * SEQ + n] = z0; Z1[(2 * pr + 1) * SEQ + n] = z1; }
                    else if (dry) { Z1[(2 * pr) * SEQ + n] = z0; Z1[(2 * pr + 1) * SEQ + n] = z1; }
                    else { bf16* o0 = PT + (size_t)c * R + (size_t)(2 * pr) * PB + CTXL; o0[n] = (bf16)f2bf(z0); o0[PB + n] = (bf16)f2bf(z1); } }
            }
        }
        if (do_ctx) {
            int tid = tid0; asm volatile("" : "+v"(tid));
            LAS float* uin = (LAS float*)lds;
            LAS float* hfl = uin + 3072;
            LAS float* z1c = hfl + 1024;
            const float* HFC = HF + (size_t)2048 * SEQ;
            __syncthreads();
            for (int idx = tid; idx < 3072; idx += NTHR) { const int k3 = idx >> 10, b = (idx >> 8) & 3, t = idx & 255, ch = 512 * k3 + c;
                uin[idx] = hy_sconv(PT + (size_t)ch * R + (size_t)b * PB, CTXL, t, cw[ch], cw[1536 + ch], cw[3072 + ch], cb[ch]); }
            for (int idx = tid; idx < 1024; idx += NTHR) hfl[idx] = HFC[(size_t)((idx >> 9) * 1024 + ((idx >> 8) & 1) * 512 + c) * CTXL + (idx & 255)];
            __syncthreads();
#pragma unroll 1
            for (int o = 0; o < 2; ++o) {
                const float bias = hb[o * 512 + c];
                float zz[2];
#pragma unroll
                for (int e = 0; e < 2; ++e) { const int oi = tid * 2 + e, b = oi >> 8, t = oi & 255;
                    const LAS float* in = o == 0 ? uin + b * 256 : z1c + b * 256; const LAS float* hfw = hfl + o * 512; const LAS float* hbw = hfw + 256;
                    float acc = 0.f;
                    for (int s = 0; s <= t; ++s) acc += hfw[t - s] * in[s];
                    for (int s = t + 1; s < 256; ++s) acc += hbw[s - t] * in[s];
                    zz[e] = uin[(1 + o) * 1024 + b * 256 + t] * (acc + in[t] * bias); }
                __syncthreads();
#pragma unroll
                for (int e = 0; e < 2; ++e) { const int oi = tid * 2 + e, b = oi >> 8, t = oi & 255;
                    if (o == 0 || dry) z1c[b * 256 + t] = zz[e]; else PT[(size_t)c * R + (size_t)b * PB + t] = (bf16)f2bf(zz[e]); }
                __syncthreads();
            }
        }
    }
}
__device__ __forceinline__ void hyena_transpose_phase(int wv_, KA a, LAS unsigned char* lds) {
    const int tid = otid();
    unsigned char* ws = a->ws; const bf16* PT = (const bf16*)(ws + WS_PT); bf16* MIX = (bf16*)(ws + WS_A1);
    constexpr int NT = 8 * (R / 64), TSZ = 64 * 66;
    for (int tb = blockIdx.x * 4; tb < NT; tb += gridDim.x * 4) {
        __syncthreads();
        v4u v[4];
#pragma unroll
        for (int k = 0; k < 4; ++k) { const int t = tb + k < NT ? tb + k : NT - 1; const int c0 = (t & 7) * 64, r0 = (t >> 3) * 64, cc = tid >> 3, rc = tid & 7;
            v[k] = *(const v4u*)(PT + (size_t)(c0 + cc) * R + r0 + rc * 8); }
#pragma unroll
        for (int k = 0; k < 4; ++k) { const int cc = tid >> 3, rc = tid & 7; LAS unsigned* d = (LAS unsigned*)((LAS bf16*)lds + k * TSZ + cc * 66 + rc * 8); d[0] = v[k].x; d[1] = v[k].y; d[2] = v[k].z; d[3] = v[k].w; }
        __syncthreads();
#pragma unroll
        for (int k = 0; k < 4; ++k) { if (tb + k >= NT) break; const int t = tb + k, c0 = (t & 7) * 64, r0 = (t >> 3) * 64, rr = tid >> 3, cch = tid & 7; const LAS bf16* tile = (const LAS bf16*)lds + k * TSZ; unsigned w[4];
#pragma unroll
            for (int e = 0; e < 4; ++e) w[e] = (unsigned)tile[(cch * 8 + 2 * e) * 66 + rr] | ((unsigned)tile[(cch * 8 + 2 * e + 1) * 66 + rr] << 16);
            *(v4u*)(MIX + (size_t)(r0 + rr) * D + c0 + cch * 8) = (v4u){w[0], w[1], w[2], w[3]}; }
    }
}

__device__ __forceinline__ void hyena_filter_phase(int wv_, KA a, int j) {
    typedef float f32x16_t __attribute__((ext_vector_type(16)));
    const int tid = otid(), lane = tid & 63, wave = tid >> 6, gw = blockIdx.x * NWAVES + wave, NGW = gridDim.x * NWAVES, l31 = lane & 31, h = lane >> 5;
    const float* w3 = a->in[I_FW3] + (size_t)j * 64 * 2048; unsigned char* ws = a->ws;
    const float da = logf(1e-2f) / 0.3f, db = logf(1e-2f) / 1.5f;
    for (int it = gw; it < 64 * 33; it += NGW) {
        const int ct = it & 63, tg = it >> 6; const bool isctx = tg == 32; const int L = isctx ? CTXL : SEQ;
        const float* hid = (const float*)(ws + WS_HID) + (isctx ? (size_t)(2 * SEQ + j * CTXL) * 64 : (size_t)(j * SEQ) * 64);
        float* HF = (float*)(ws + WS_HF) + (isctx ? (size_t)2048 * SEQ : 0);
        float aw[32];
#pragma unroll
        for (int sx = 0; sx < 32; ++sx) aw[sx] = w3[(size_t)(32 * h + sx) * 2048 + ct * 32 + l31];
        float dl[16];
#pragma unroll
        for (int r = 0; r < 16; ++r) { const int col = ct * 32 + (r & 3) + 8 * (r >> 2) + 4 * h; dl[r] = fabsf(da + (float)(col & 511) * ((db - da) / 511.f)); }
#pragma unroll 1
        for (int tt = 0; tt < 8; ++tt) {
            const int t0 = (isctx ? tt : 8 * tg + tt) * 32, t = t0 + l31;
            const f32x4* hr = (const f32x4*)(hid + (size_t)t * 64 + 32 * h);
            float bv[32];
#pragma unroll
            for (int q4 = 0; q4 < 8; ++q4) { const f32x4 v = hr[q4]; bv[4 * q4] = v.x; bv[4 * q4 + 1] = v.y; bv[4 * q4 + 2] = v.z; bv[4 * q4 + 3] = v.w; }
            f32x16_t acc = {};
#pragma unroll
            for (int sx = 0; sx < 32; ++sx) acc = __builtin_amdgcn_mfma_f32_32x32x2f32(aw[sx], bv[sx], acc, 0, 0, 0);
            const float tf = (float)t / (float)(L - 1);
#pragma unroll
            for (int r = 0; r < 16; ++r) { const int col = ct * 32 + (r & 3) + 8 * (r >> 2) + 4 * h; HF[(size_t)col * L + t] = acc[r] * __expf(-tf * dl[r]); }
        }
    }
}
#ifndef PROBE_REPEAT
#define PROBE_REPEAT 0
#endif
#define PRB(id, stmt) do { if (PROBE_REPEAT == (id)) { stmt; __syncthreads(); } } while (0)
__global__ void __launch_bounds__(NTHR, 2) fwd_kernel(Args a_unused) {
    extern __shared__ __attribute__((aligned(16))) unsigned char lds_raw[];
    LAS unsigned char* lds = (LAS unsigned char*)lds_raw;
    volatile LAS unsigned* MISC = (volatile LAS unsigned*)(lds + LDS_MISC);
    const KA a0 = (KA)__builtin_amdgcn_kernarg_segment_ptr();
    if (threadIdx.x < 64) MISC[threadIdx.x] = 0u;
    const int wv_ = __builtin_amdgcn_readfirstlane(threadIdx.x >> 6);
    __syncthreads();
    const int lo = a0->ph_lo, hi = a0->ph_hi;
    XcdBarrier bar; bar.bar = (unsigned*)(a0->ws + WS_CTL) + CW_BAR; bar.x = 0; bar.st = MISC + 8;
    if (hi - lo > 1) bar = xcd_barrier_post((unsigned*)(a0->ws + WS_CTL) + CW_BAR, MISC + 8);
#define IN(k) (lo <= (k) && (k) < hi)
#define SEAM(k) do { if (IN((k) + 1)) { xcd_barrier(bar, wv_); if (PROBE_REPEAT == 20) xcd_barrier(bar, wv_); } } while (0)
    if (IN(0)) { PRB(13, p0a_prologue(wv_, ka_launder(a0), lds)); p0a_prologue(wv_, ka_launder(a0), lds); SEAM(0); }
    if (IN(1)) { PRB(14, p0b_first_norm(wv_, ka_launder(a0))); p0b_first_norm(wv_, ka_launder(a0)); SEAM(1); }
#pragma unroll 1
    for (int layer = 0; layer < DEPTH; ++layer) {
        const int pb = 2 + 9 * layer, j = layer >> 1; const bool odd = layer & 1; const int last = layer == DEPTH - 1;
        if (IN(pb + 0)) {
            const KA a = ka_launder(a0); unsigned char* ws = a->ws; const unsigned char* wl = ws + WS_W;
            if (odd) { hyena_filter_phase(wv_, ka_launder(a0), j); __syncthreads(); }
            if (odd) {
                pg8::Gemm g{nullptr, nullptr, R, NP_OD, D, 0}; pg8::DualOrder S;
                S.init(ws + WS_A1, wl + W_IN + (size_t)1536 * D * 2, R, 1536, wl + W_IN, ws + WS_A1, 1536, R, (int)gridDim.x, obx());
                pg8::EpiInProj E{(bf16*)(ws + WS_PH), NP_OD, (bf16*)(ws + WS_PT), R, (const float*)(ws + WS_TAB), nullptr, 1, C2};
                PRB(1, (pg8::gemm_phase<pg8::EpiInProj, pg8::DualOrder, true, true>(lds, g, S, E, otid())));
                pg8::gemm_phase<pg8::EpiInProj, pg8::DualOrder, true, true>(lds, g, S, E, otid());
            } else {
                pg8::Gemm g{(const bf16*)(ws + WS_A1), (const bf16*)(wl + W_IN), R, NP_EV, D, 0}; pg8::StaticOrder S; S.init(R, NP_EV, (int)gridDim.x, obx());
                pg8::EpiInProj E{(bf16*)(ws + WS_PH), NP_EV, nullptr, 0, (const float*)(ws + WS_TAB), a->in[I_EVQKG] + j * 128, 0, C2};
                PRB(1, (pg8::gemm_phase<pg8::EpiInProj, pg8::StaticOrder, true, true>(lds, g, S, E, otid())));
                pg8::gemm_phase<pg8::EpiInProj, pg8::StaticOrder, true, true>(lds, g, S, E, otid());
            }
            SEAM(pb + 0);
        }
        if (IN(pb + 1)) {
            if (!odd) { PRB(2, gla_state_phase(wv_, ka_launder(a0), j, lds)); gla_state_phase(wv_, ka_launder(a0), j, lds); SEAM(pb + 1); }
        }
        if (IN(pb + 2)) {
            if (odd) { PRB(7, hyena_fft_phase(wv_, ka_launder(a0), j, layer != DEPTH - 1, lds, true)); PRB(71, hyena_fft_phase(wv_, ka_launder(a0), j, false, lds, true, 2)); PRB(72, hyena_fft_phase(wv_, ka_launder(a0), j, false, lds, true, 1)); hyena_fft_phase(wv_, ka_launder(a0), j, layer != DEPTH - 1, lds); __syncthreads(); PRB(6, attn_phase_fast(wv_, ka_launder(a0), true, (char*)lds_raw, last)); attn_phase_fast(wv_, ka_launder(a0), true, (char*)lds_raw, last); }
            else { PRB(4, gla_scan_phase(wv_, ka_launder(a0))); gla_scan_phase(wv_, ka_launder(a0)); __syncthreads(); PRB(5, attn_phase_fast(wv_, ka_launder(a0), false, (char*)lds_raw)); attn_phase_fast(wv_, ka_launder(a0), false, (char*)lds_raw); }
            SEAM(pb + 2);
        }
        if (IN(pb + 3)) {
            if (odd) { PRB(9, (diff_out_phase(wv_, ka_launder(a0), j, layer), hyena_transpose_phase(wv_, ka_launder(a0), lds))); diff_out_phase(wv_, ka_launder(a0), j, layer); hyena_transpose_phase(wv_, ka_launder(a0), lds); } else { PRB(8, gla_output_phase(wv_, ka_launder(a0), j, lds)); PRB(31, gla_output_phase(wv_, ka_launder(a0), j, lds, 1)); PRB(32, gla_output_phase(wv_, ka_launder(a0), j, lds, 2)); PRB(34, gla_output_phase(wv_, ka_launder(a0), j, lds, 4)); PRB(37, gla_output_phase(wv_, ka_launder(a0), j, lds, 7)); gla_output_phase(wv_, ka_launder(a0), j, lds); }
            SEAM(pb + 3);
        }
        if (IN(pb + 4)) {
            const KA a = ka_launder(a0); unsigned char* ws = a->ws; const unsigned char* wl = ws + WS_W;
            pg8::Gemm g{(const bf16*)(ws + WS_A1), (const bf16*)(wl + W_OUT), R, D, D, 0}; pg8::StaticOrder S; S.init(last ? NB * SEQ : R, D, (int)gridDim.x, obx(), last);
            pg8::EpiBf16<0> E{(bf16*)(ws + WS_Y), D};
            PRB(10, (pg8::gemm_phase<pg8::EpiBf16<0>, pg8::StaticOrder, true, true>(lds, g, S, E, otid())));
            pg8::gemm_phase<pg8::EpiBf16<0>, pg8::StaticOrder, true, true>(lds, g, S, E, otid());
            SEAM(pb + 4);
        }
        if (IN(pb + 5)) { if (!last) { convert_layer_weights(wv_, ka_launder(a0), layer + 1, 3, lds); __syncthreads(); } PRB(15, rowwise_post(wv_, ka_launder(a0), layer, 0, lds)); rowwise_post(wv_, ka_launder(a0), layer, 0, lds); SEAM(pb + 5); }
        if (IN(pb + 6)) {
            const KA a = ka_launder(a0); unsigned char* ws = a->ws; const unsigned char* wl = ws + WS_W;
            pg8::Gemm g{(const bf16*)(ws + WS_A1), (const bf16*)(wl + W_1), R, DFF, D, 0}; pg8::StaticOrder S; S.init(last ? NB * SEQ : R, DFF, (int)gridDim.x, obx(), last);
            pg8::EpiBf16<2> E{(bf16*)(ws + WS_PH), DFF};
            PRB(11, (pg8::gemm_phase<pg8::EpiBf16<2>, pg8::StaticOrder, true, true>(lds, g, S, E, otid())));
            if (PROBE_REPEAT == 41) { pg8::EpiBf16<2> E2{(bf16*)(ws + WS_PH), DFF, 1}; pg8::gemm_phase<pg8::EpiBf16<2>, pg8::StaticOrder, true, true>(lds, g, S, E2, otid()); __syncthreads(); }
            pg8::gemm_phase<pg8::EpiBf16<2>, pg8::StaticOrder, true, true>(lds, g, S, E, otid());
            SEAM(pb + 6);
        }
        if (IN(pb + 7)) {
            const KA a = ka_launder(a0); unsigned char* ws = a->ws; const unsigned char* wl = ws + WS_W;
            { pg8::Gemm g{(const bf16*)(ws + WS_PH), (const bf16*)(wl + W_2), R, D, DFF, 0}; pg8::StaticOrder S; S.init(NB * SEQ, D, (int)gridDim.x, obx(), 1);
              pg8::EpiBf16<0> E{(bf16*)(ws + WS_A1), D};
              PRB(12, (pg8::gemm_phase<pg8::EpiBf16<0>, pg8::StaticOrder, true, true>(lds, g, S, E, otid())));
              pg8::gemm_phase<pg8::EpiBf16<0>, pg8::StaticOrder, true, true>(lds, g, S, E, otid()); }
            if (!last) { __syncthreads();
              pg8::Gemm g{(const bf16*)(ws + WS_PH), (const bf16*)(wl + W_2), 4 * 256, D, DFF / 4, DFF}; pg8::CtxSplitOrder<4, 4> S; S.init(DFF / 4, (int)gridDim.x, obx());
              pg8::EpiSlab E{(bf16*)(ws + WS_SLAB), D, (size_t)1024 * D};
              pg8::gemm_phase<pg8::EpiSlab, pg8::CtxSplitOrder<4, 4>, true, true>(lds, g, S, E, otid()); }
            SEAM(pb + 7);
        }
        if (IN(pb + 8)) { if (!last) { convert_layer_weights(wv_, ka_launder(a0), layer + 1, 12, lds); __syncthreads(); } rowwise_post(wv_, ka_launder(a0), layer, 1, lds); SEAM(pb + 8); }
    }
#undef IN
#undef SEAM
}

constexpr int N_PHASES = 2 + 9 * DEPTH;
#ifndef MK_ONE_LAUNCH
#define MK_ONE_LAUNCH 1
#endif
extern "C" void kernel_launch(void* const* d_in, const int* in_sizes, int n_in, void* d_out, int out_size, void* d_ws, size_t ws_size, hipStream_t stream) {
    static int grid = 0;
    if (grid == 0) {
        if (n_in != 27 || in_sizes[0] != NB * SEQ * D || out_size != NB * SEQ * D || ws_size < WS_END) { fprintf(stderr, "kernel_launch: unexpected shapes (n_in %d, in0 %d, out %d, ws %zu)\n", n_in, n_in > 0 ? in_sizes[0] : -1, out_size, ws_size); grid = -1; return; }
        int dev = 0, cus = 0;
        if (hipGetDevice(&dev) != hipSuccess || hipDeviceGetAttribute(&cus, hipDeviceAttributeMultiprocessorCount, dev) != hipSuccess) { grid = -1; return; }
        if (hipFuncSetAttribute((const void*)fwd_kernel, hipFuncAttributeMaxDynamicSharedMemorySize, LDS_BYTES) != hipSuccess) { fprintf(stderr, "kernel_launch: hipFuncSetAttribute failed\n"); grid = -1; return; }
        (void)hipGetLastError();
        grid = cus;
    }
    if (grid < 0) return;
    if (hipMemsetAsync((char*)d_ws + WS_CTL, 0, CTL_ZERO_BYTES, stream) != hipSuccess) return;
    Args a{};
    for (int i = 0; i < 27; ++i) a.in[i] = (const float*)d_in[i];
    a.out = (float*)d_out; a.ws = (unsigned char*)d_ws;
#if MK_ONE_LAUNCH
    a.ph_lo = 0; a.ph_hi = N_PHASES;
    hipLaunchKernelGGL(fwd_kernel, dim3(grid), dim3(NTHR), LDS_BYTES, stream, a);
#else
    for (int k = 0; k < N_PHASES; ++k) { a.ph_lo = k; a.ph_hi = k + 1; hipLaunchKernelGGL(fwd_kernel, dim3(grid), dim3(NTHR), LDS_BYTES, stream, a); }
#endif
}
```

```cpp
#include <hip/hip_runtime.h>
#include <cstdio>
#include <cstdint>
#include <hip/hip_bf16.h>
#include <cmath>

namespace pg8 {
#define PG8_LAS __attribute__((address_space(3)))
typedef unsigned short bf16_t;
typedef short bf16x8 __attribute__((ext_vector_type(8)));
typedef float f32x4 __attribute__((ext_vector_type(4)));
typedef unsigned u32x4 __attribute__((ext_vector_type(4)));
constexpr int BM = 256, BK = 64, HALF = 128, HTB = HALF * BK * 2  , STAGE_BYTES = 8 * HTB, NXCD = 8, WGM = 8;

__host__ __device__ __forceinline__ int lds_byte(int r, int c) { const int st = (r >> 4) * 2 + (c >> 5), rr = r & 15, cc = c & 31, ob = rr * 64 + cc * 2; return st * 1024 + (ob ^ (((ob >> 9) & 1) << 5)); }
__host__ __device__ __forceinline__ void stage_rc(int b, int& R, int& C) { const int st = b / 1024, sb = b % 1024, swz = sb ^ (((sb >> 9) & 1) << 5); R = (st >> 1) * 16 + swz / 64; C = (st & 1) * 32 + (swz % 64) / 2; }
__host__ __device__ __forceinline__ int perm32(int rho) { const int n = rho >> 4, i = rho & 15; return 8 * (i >> 2) + 4 * n + (i & 3); }

struct Unit { int pm, pn, kind; };
struct Gemm { const bf16_t* A; const bf16_t* Bt; int M, N, K; int ld; };

struct StaticOrder {
    int nM, nN, nwg, G, c, skip;
    __host__ __device__ void init(int M, int N, int G_, int c_, int skip_ = 0) { nM = M / BM; nN = N / BM; nwg = nM * nN; G = G_; c = c_; skip = skip_; }
    __host__ __device__ bool next(int i, Unit& u) const {
        const long L = (long)i * G + c; if (L >= nwg) return false;
        int wgid = (int)L; { const int q = nwg / NXCD, r = nwg % NXCD, xcd = wgid % NXCD, off = wgid / NXCD; wgid = (xcd < r ? xcd * (q + 1) : r * (q + 1) + (xcd - r) * q) + off; }
        const int nig = WGM * nN, gid = wgid / nig, fm = gid * WGM, gsz = (nM - fm) < WGM ? (nM - fm) : WGM;
        u.pm = fm + ((wgid % nig) % gsz); u.pn = (wgid % nig) / gsz; u.kind = 0; if (skip) u.pm += (u.pm >> 5) + 1; return true;
    }
    __device__ __forceinline__ const char* abase(const Gemm& g, const Unit& u, size_t tstep) const { return (const char*)g.A + (size_t)u.pm * tstep; }
    __device__ __forceinline__ const char* bbase(const Gemm& g, const Unit& u, size_t tstep) const { return (const char*)g.Bt + (size_t)u.pn * tstep; }
    __device__ __forceinline__ void a_ready(const Unit&) const {}
    __device__ __forceinline__ void done(const Unit&) const {}
};
struct DualOrder {
    StaticOrder s0, s1; const char *A0, *B0, *A1, *B1; int G, c;
    __device__ __forceinline__ void init(const void* a0, const void* b0, int M0, int N0, const void* a1, const void* b1, int M1, int N1, int G_, int c_) {
        s0.init(M0, N0, 1, 0); s1.init(M1, N1, 1, 0); A0 = (const char*)a0; B0 = (const char*)b0; A1 = (const char*)a1; B1 = (const char*)b1; G = G_; c = c_; }
    __device__ __forceinline__ bool next(int i, Unit& u) const {
        const int L = i * G + c;
        if (L < s0.nwg) { s0.next(L, u); u.kind = 0; return true; }
        if (L - s0.nwg < s1.nwg) { s1.next(L - s0.nwg, u); u.kind = 1; return true; }
        return false; }
    __device__ __forceinline__ const char* abase(const Gemm&, const Unit& u, size_t tstep) const { return (u.kind ? A1 : A0) + (size_t)u.pm * tstep; }
    __device__ __forceinline__ const char* bbase(const Gemm&, const Unit& u, size_t tstep) const { return (u.kind ? B1 : B0) + (size_t)u.pn * tstep; }
    __device__ __forceinline__ void a_ready(const Unit&) const {}
    __device__ __forceinline__ void done(const Unit&) const {}
};
template <int NN, int NS> struct CtxSplitOrder {
    int G, c; size_t kbytes;
    __device__ __forceinline__ void init(int Kslice, int G_, int c_) { G = G_; c = c_; kbytes = (size_t)Kslice * 2; }
    __device__ __forceinline__ bool next(int i, Unit& u) const { const int L = i * G + c; if (L >= 4 * NN * NS) return false; u.kind = L % NS; u.pn = (L / NS) % NN; u.pm = L / (NS * NN); return true; }
    __device__ __forceinline__ const char* abase(const Gemm& g, const Unit& u, size_t tstep) const { return (const char*)g.A + (size_t)(33 * u.pm) * tstep + (size_t)u.kind * kbytes; }
    __device__ __forceinline__ const char* bbase(const Gemm& g, const Unit& u, size_t tstep) const { return (const char*)g.Bt + (size_t)u.pn * tstep + (size_t)u.kind * kbytes; }
    __device__ __forceinline__ void a_ready(const Unit&) const {}
    __device__ __forceinline__ void done(const Unit&) const {}
};

__device__ __forceinline__ unsigned cvt_pk_bf16(float lo, float hi) { unsigned r; asm volatile("v_cvt_pk_bf16_f32 %0, %1, %2" : "=v"(r) : "v"(lo), "v"(hi)); return r; }
template <int ACT  > struct EpiBf16 {
    static constexpr bool PERM = true, AFTER_DRAIN = false;
    bf16_t* O; int ldc; int probe_nostore = 0;
    __device__ __forceinline__ void operator()(const f32x4 (&acc)[2][2][4][2], const Unit& u, int wr, int wc, int fr, int fq) const {
        if (probe_nostore && u.pm != 0x7fffffff) { float t = 0.f;
#pragma unroll
            for (int ai = 0; ai < 2; ++ai)
#pragma unroll
                for (int m = 0; m < 4; ++m)
#pragma unroll
                    for (int bj = 0; bj < 2; ++bj) t += acc[ai][bj][m][0][0] + acc[ai][bj][m][1][3];
            if (t == 1234.5678f) O[0] = 1; return; }
        const int row0 = u.pm * BM + wr * 64 + fr; const int col0 = u.pn * BM + wc * 32 + 8 * fq;
#pragma unroll
        for (int ai = 0; ai < 2; ++ai)
#pragma unroll
            for (int m = 0; m < 4; ++m) { bf16_t* rowp = O + (size_t)(row0 + ai * HALF + m * 16) * ldc + col0;
#pragma unroll
                for (int bj = 0; bj < 2; ++bj) { f32x4 v0 = acc[ai][bj][m][0], v1 = acc[ai][bj][m][1];
                    if (ACT == 2) {
#pragma unroll
                        for (int e = 0; e < 4; ++e) { const float a0 = fmaxf(v0[e], 0.f), a1 = fmaxf(v1[e], 0.f); v0[e] = a0 * a0; v1[e] = a1 * a1; } }
                    u32x4 w; w.x = cvt_pk_bf16(v0[0], v0[1]); w.y = cvt_pk_bf16(v0[2], v0[3]); w.z = cvt_pk_bf16(v1[0], v1[1]); w.w = cvt_pk_bf16(v1[2], v1[3]);
                    *(u32x4*)(rowp + bj * HALF) = w; } }
    }
};
struct EpiDual {
    static constexpr bool PERM = true, AFTER_DRAIN = false;
    bf16_t* O0; int ldc0; bf16_t* O1; int ldc1;
    __device__ __forceinline__ void operator()(const f32x4 (&acc)[2][2][4][2], const Unit& u, int wr, int wc, int fr, int fq) const {
        const EpiBf16<0> e{u.kind ? O1 : O0, u.kind ? ldc1 : ldc0}; e(acc, u, wr, wc, fr, fq);
    }
};
struct EpiInProj {
    static constexpr bool PERM = true, AFTER_DRAIN = false;
    bf16_t* O0; int ldc0; bf16_t* O1; int ldc1; const float* tab; const float* qkg; int odd; float qscale;
    __device__ __forceinline__ void operator()(const f32x4 (&acc)[2][2][4][2], const Unit& u, int wr, int wc, int fr, int fq) const {
        if (u.kind) { const EpiBf16<0> e{O1, ldc1}; e(acc, u, wr, wc, fr, fq); return; }
        const bool perm = !odd && u.pn >= 6 && u.pn <= 8;
        int mode = 0;
        if (odd) mode = u.pn < 2 ? 1 : (u.pn < 4 ? 2 : 0); else mode = (u.pn == 6 || u.pn == 7) ? 1 : ((u.pn == 8 && wc < 2) ? 2 : 0);
        const int pp = u.pm % 33; const bool rope = mode != 0 && pp != 0; const bool norm = mode != 0 && !odd;
        const int row0 = u.pm * BM + wr * 64 + fr;
        const int colb = u.pn * BM + (perm ? 64 * wc + 8 * fq : 32 * wc + 8 * fq), bjs = perm ? 32 : HALF;
        if (mode == 0) {
#pragma unroll
            for (int ai = 0; ai < 2; ++ai)
#pragma unroll
                for (int m = 0; m < 4; ++m) { bf16_t* rowp = O0 + (size_t)(row0 + ai * HALF + m * 16) * ldc0 + colb;
#pragma unroll
                    for (int bj = 0; bj < 2; ++bj) { const f32x4 v0 = acc[ai][bj][m][0], v1 = acc[ai][bj][m][1];
                        u32x4 w; w.x = cvt_pk_bf16(v0[0], v0[1]); w.y = cvt_pk_bf16(v0[2], v0[3]); w.z = cvt_pk_bf16(v1[0], v1[1]); w.w = cvt_pk_bf16(v1[2], v1[3]);
                        *(u32x4*)(rowp + bj * bjs) = w; } }
            return;
        }
        f32x4 G[2][2];
#pragma unroll
        for (int bj = 0; bj < 2; ++bj)
#pragma unroll
            for (int n = 0; n < 2; ++n) G[bj][n] = norm ? *(const f32x4*)(qkg + (mode == 2 ? 64 : 0) + 32 * bj + 8 * fq + 4 * n) : (f32x4){1.f, 1.f, 1.f, 1.f};
        const float sc = mode == 1 ? qscale : 1.f;
        const float* trow = tab + ((4 * (pp - 1) + wr) * 16 + 4 * fq) * 2;
        const float* tcol = tab + 4096 + (fr * 16 + 4 * fq) * 2;
        const f32x4 ID = (f32x4){1.f, 0.f, 1.f, 0.f};
        f32x4 TR[2][2];
#pragma unroll
        for (int ai = 0; ai < 2; ++ai) { TR[ai][0] = rope ? *(const f32x4*)(trow + ai * 64) : ID; TR[ai][1] = rope ? *(const f32x4*)(trow + ai * 64 + 4) : ID; }
        f32x4 TCn0 = rope ? *(const f32x4*)(tcol) : ID, TCn1 = rope ? *(const f32x4*)(tcol + 4) : ID;
#pragma unroll
        for (int m = 0; m < 4; ++m) {
            const f32x4 TC0 = TCn0, TC1 = TCn1;
            if (m < 3) { TCn0 = rope ? *(const f32x4*)(tcol + (m + 1) * 512) : ID; TCn1 = rope ? *(const f32x4*)(tcol + (m + 1) * 512 + 4) : ID; }
#pragma unroll
            for (int ai = 0; ai < 2; ++ai) {
                f32x4 v[2][2];
#pragma unroll
                for (int bj = 0; bj < 2; ++bj)
#pragma unroll
                    for (int n = 0; n < 2; ++n) v[bj][n] = acc[ai][bj][m][n];
                if (norm) { float ss = 0.f;
#pragma unroll
                    for (int bj = 0; bj < 2; ++bj)
#pragma unroll
                        for (int n = 0; n < 2; ++n) ss += (v[bj][n][0] * v[bj][n][0] + v[bj][n][1] * v[bj][n][1]) + (v[bj][n][2] * v[bj][n][2] + v[bj][n][3] * v[bj][n][3]);
                    { const unsigned u_ = __builtin_bit_cast(unsigned, ss); auto a_ = __builtin_amdgcn_permlane16_swap(u_, u_, false, false); ss = __builtin_bit_cast(float, (unsigned)a_[0]) + __builtin_bit_cast(float, (unsigned)a_[1]);
                      const unsigned w_ = __builtin_bit_cast(unsigned, ss); auto b_ = __builtin_amdgcn_permlane32_swap(w_, w_, false, false); ss = __builtin_bit_cast(float, (unsigned)b_[0]) + __builtin_bit_cast(float, (unsigned)b_[1]); }
                    const float rstd = 1.0f / sqrtf(ss * (1.f / 64.f) + 1e-6f);
#pragma unroll
                    for (int bj = 0; bj < 2; ++bj)
#pragma unroll
                        for (int n = 0; n < 2; ++n) v[bj][n] = (v[bj][n] * rstd) * G[bj][n]; }
                bf16_t* rowp = O0 + (size_t)(row0 + ai * HALF + m * 16) * ldc0 + colb;
#pragma unroll
                for (int bj = 0; bj < 2; ++bj) {
                    if (rope) {
                        const bool colang = odd ? (wc & 1) : (bj == 1);
                        const f32x4 T0 = colang ? TC0 : TR[ai][0], T1 = colang ? TC1 : TR[ai][1];
                        const f32x4 a0 = v[bj][0], a1 = v[bj][1];
                        v[bj][0] = (f32x4){a0[0] * T0[0] - a0[1] * T0[1], a0[0] * T0[1] + a0[1] * T0[0], a0[2] * T0[2] - a0[3] * T0[3], a0[2] * T0[3] + a0[3] * T0[2]};
                        v[bj][1] = (f32x4){a1[0] * T1[0] - a1[1] * T1[1], a1[0] * T1[1] + a1[1] * T1[0], a1[2] * T1[2] - a1[3] * T1[3], a1[2] * T1[3] + a1[3] * T1[2]};
                    }
                    const f32x4 x0 = v[bj][0] * sc, x1 = v[bj][1] * sc;
                    u32x4 w; w.x = cvt_pk_bf16(x0[0], x0[1]); w.y = cvt_pk_bf16(x0[2], x0[3]); w.z = cvt_pk_bf16(x1[0], x1[1]); w.w = cvt_pk_bf16(x1[2], x1[3]);
                    *(u32x4*)(rowp + bj * bjs) = w;
                }
            }
        }
    }
};
struct EpiSlab {
    static constexpr bool PERM = true, AFTER_DRAIN = false;
    bf16_t* O; int ldc; size_t slab;
    __device__ __forceinline__ void operator()(const f32x4 (&acc)[2][2][4][2], const Unit& u, int wr, int wc, int fr, int fq) const {
        const EpiBf16<0> e{O + (size_t)u.kind * slab, ldc}; e(acc, u, wr, wc, fr, fq);
    }
};

template <class Epi, class Sched, bool ALIGN_EPI = false, bool SP2 = false>
__device__ __forceinline__ void gemm_phase(PG8_LAS unsigned char* lds, const Gemm g, const Sched& S, const Epi& E, const int tid_in) {
    int tid_ = tid_in; asm volatile("" : "+v"(tid_));
    const int tid = tid_, wid = __builtin_amdgcn_readfirstlane(tid >> 6), lane = tid & 63, wr = wid >> 2, wc = wid & 3, fr = lane & 15, fq = lane >> 4;
    const int K = g.ld ? g.ld : g.K, nt = g.K / BK;
    unsigned voffA[2], voffB[2];
#pragma unroll
    for (int i = 0; i < 2; ++i) { int R, C; stage_rc(tid * 16 + i * 8192, R, C); const int Rb = Epi::PERM ? ((R & ~31) + perm32(R & 31)) : R;
        voffA[i] = (unsigned)(R * K + C) * 2u; voffB[i] = (unsigned)(Rb * K + C) * 2u; }
    const size_t kstep = (size_t)(BK * 2);
    const size_t hstep = (size_t)HALF * K * 2;
    const size_t tstep = 2 * hstep;
    const unsigned ldsw = (unsigned)wid * 1024u;
    const int aoff = lds_byte(wr * 64 + fr, fq * 8), boff = lds_byte(wc * 32 + fr, fq * 8);
#define PG8_SA(b, h) (((b) * 2 + (h)) * HTB)
#define PG8_SB(b, h) ((4 + (b) * 2 + (h)) * HTB)
#define PG8_STAGE(bufoff, gbase, voff) do { _Pragma("unroll") for (int _i = 0; _i < 2; ++_i) \
        __builtin_amdgcn_global_load_lds((const unsigned*)((const char*)(gbase) + (voff)[_i]), (PG8_LAS unsigned*)(lds + (bufoff) + ldsw + _i * 8192), 16, 0, 0); } while (0)
#define PG8_LDA(dst, b, h) do { _Pragma("unroll") for (int m = 0; m < 4; ++m) _Pragma("unroll") for (int k = 0; k < 2; ++k) dst[m][k] = *(const PG8_LAS bf16x8*)(lds + PG8_SA(b, h) + aoff + m * 2048 + k * 1024); } while (0)
#define PG8_LDB(dst, b, h) do { _Pragma("unroll") for (int n = 0; n < 2; ++n) _Pragma("unroll") for (int k = 0; k < 2; ++k) dst[n][k] = *(const PG8_LAS bf16x8*)(lds + PG8_SB(b, h) + boff + n * 2048 + k * 1024); } while (0)
#define PG8_MMA(ai, bj, At, Bt) do { __builtin_amdgcn_s_setprio(1); _Pragma("unroll") for (int m = 0; m < 4; ++m) _Pragma("unroll") for (int n = 0; n < 2; ++n) _Pragma("unroll") for (int k = 0; k < 2; ++k) \
        acc[ai][bj][m][n] = __builtin_amdgcn_mfma_f32_16x16x32_bf16(Bt[n][k], At[m][k], acc[ai][bj][m][n], 0, 0, 0); __builtin_amdgcn_s_setprio(0); } while (0)
#define PG8_WAIT_V(n) asm volatile("s_waitcnt vmcnt(" #n ")" ::: "memory")
#define PG8_WAIT_L(n) asm volatile("s_waitcnt lgkmcnt(" #n ")" ::: "memory")
#define PG8_BAR __builtin_amdgcn_s_barrier()
#define PG8_SCHED __builtin_amdgcn_sched_barrier(0)
    Unit cur, nxt; int ui = 0;
    if (!S.next(0, cur)) return;
    f32x4 acc[2][2][4][2];
#pragma unroll
    for (int a = 0; a < 2; ++a)
#pragma unroll
        for (int b = 0; b < 2; ++b)
#pragma unroll
            for (int m = 0; m < 4; ++m)
#pragma unroll
                for (int n = 0; n < 2; ++n) acc[a][b][m][n] = (f32x4){0.f, 0.f, 0.f, 0.f};
    bf16x8 At[4][2], B0[2][2], B1[2][2];
    const char* cA = S.abase(g, cur, tstep); const char* cB = S.bbase(g, cur, tstep);
    S.a_ready(cur);
    if constexpr (SP2) {
        PG8_STAGE(PG8_SB(0, 0), cB, voffB); PG8_STAGE(PG8_SB(0, 1), cB + hstep, voffB); PG8_STAGE(PG8_SA(0, 0), cA, voffA); PG8_STAGE(PG8_SA(0, 1), cA + hstep, voffA);
        if (wr == 1) PG8_BAR;
        PG8_WAIT_V(2); PG8_BAR;
        PG8_STAGE(PG8_SB(1, 0), cB + kstep, voffB); PG8_STAGE(PG8_SA(1, 0), cA + kstep, voffA); PG8_STAGE(PG8_SB(1, 1), cB + hstep + kstep, voffB);
        PG8_WAIT_V(6); PG8_BAR;
    } else {
        PG8_STAGE(PG8_SB(0, 0), cB, voffB); PG8_STAGE(PG8_SA(0, 0), cA, voffA); PG8_STAGE(PG8_SB(0, 1), cB + hstep, voffB); PG8_STAGE(PG8_SA(0, 1), cA + hstep, voffA);
        if (wr == 1) PG8_BAR;
        PG8_WAIT_V(4); PG8_BAR;
        PG8_STAGE(PG8_SB(1, 0), cB + kstep, voffB); PG8_STAGE(PG8_SA(1, 0), cA + kstep, voffA); PG8_STAGE(PG8_SB(1, 1), cB + hstep + kstep, voffB);
        PG8_WAIT_V(6); PG8_BAR;
    }
    for (;;) {
        const bool has_next = S.next(ui + 1, nxt);
        const char* nA = has_next ? S.abase(g, nxt, tstep) : cA; const char* nB = has_next ? S.bbase(g, nxt, tstep) : cB;
        for (int t = 0; t < nt; t += 2) {
            const bool last = (t == nt - 2);
            const char* a1 = cA + (size_t)(t + 1) * kstep;
            const char* a2 = last ? nA : cA + (size_t)(t + 2) * kstep; const char* b2 = last ? nB : cB + (size_t)(t + 2) * kstep;
            const char* a3 = a2 + kstep; const char* b3 = b2 + kstep;
            if (last && has_next) S.a_ready(nxt);
            if constexpr (SP2) {
            PG8_LDB(B0, 0, 0); PG8_LDB(B1, 0, 1); PG8_SCHED; PG8_LDA(At, 0, 0); PG8_STAGE(PG8_SA(1, 1), a1 + hstep, voffA);
            PG8_WAIT_V(8); PG8_WAIT_L(0); PG8_BAR; PG8_MMA(0, 0, At, B0); PG8_MMA(0, 1, At, B1); PG8_BAR; PG8_SCHED;
            PG8_LDA(At, 0, 1); PG8_STAGE(PG8_SB(0, 0), b2, voffB); PG8_STAGE(PG8_SB(0, 1), b2 + hstep, voffB); PG8_STAGE(PG8_SA(0, 0), a2, voffA);
            PG8_WAIT_V(8); PG8_WAIT_L(0); PG8_BAR; PG8_MMA(1, 0, At, B0); PG8_MMA(1, 1, At, B1); PG8_BAR; PG8_SCHED;
            PG8_LDB(B0, 1, 0); PG8_LDB(B1, 1, 1); PG8_SCHED; PG8_LDA(At, 1, 0); PG8_STAGE(PG8_SA(0, 1), a2 + hstep, voffA);
            PG8_WAIT_V(8); PG8_WAIT_L(0); PG8_BAR; PG8_MMA(0, 0, At, B0); PG8_MMA(0, 1, At, B1); PG8_BAR; PG8_SCHED;
            PG8_LDA(At, 1, 1); PG8_STAGE(PG8_SB(1, 0), b3, voffB); PG8_STAGE(PG8_SB(1, 1), b3 + hstep, voffB); PG8_STAGE(PG8_SA(1, 0), a3, voffA);
            PG8_WAIT_V(8); PG8_WAIT_L(0); PG8_BAR; PG8_MMA(1, 0, At, B0); PG8_MMA(1, 1, At, B1); PG8_BAR; PG8_SCHED;
            } else {
            PG8_LDB(B0, 0, 0); PG8_SCHED; PG8_LDA(At, 0, 0); PG8_STAGE(PG8_SA(1, 1), a1 + hstep, voffA);
            PG8_WAIT_L(8); PG8_BAR; PG8_WAIT_L(0); PG8_MMA(0, 0, At, B0); PG8_BAR; PG8_SCHED;
            PG8_LDB(B1, 0, 1); PG8_STAGE(PG8_SB(0, 0), b2, voffB);
            PG8_BAR; PG8_WAIT_L(0); PG8_MMA(0, 1, At, B1); PG8_BAR;
            PG8_LDA(At, 0, 1); PG8_STAGE(PG8_SA(0, 0), a2, voffA);
            PG8_BAR; PG8_WAIT_L(0); PG8_MMA(1, 0, At, B0); PG8_BAR; PG8_SCHED;
            PG8_STAGE(PG8_SB(0, 1), b2 + hstep, voffB);
            PG8_WAIT_V(6); PG8_BAR; PG8_MMA(1, 1, At, B1); PG8_BAR;
            PG8_LDB(B0, 1, 0); PG8_SCHED; PG8_LDA(At, 1, 0); PG8_STAGE(PG8_SA(0, 1), a2 + hstep, voffA);
            PG8_WAIT_L(8); PG8_BAR; PG8_WAIT_L(0); PG8_MMA(0, 0, At, B0); PG8_BAR; PG8_SCHED;
            PG8_LDB(B1, 1, 1); PG8_STAGE(PG8_SB(1, 0), b3, voffB);
            PG8_BAR; PG8_WAIT_L(0); PG8_MMA(0, 1, At, B1); PG8_BAR;
            PG8_LDA(At, 1, 1); PG8_STAGE(PG8_SA(1, 0), a3, voffA);
            PG8_BAR; PG8_WAIT_L(0); PG8_MMA(1, 0, At, B0); PG8_BAR; PG8_SCHED;
            PG8_STAGE(PG8_SB(1, 1), b3 + hstep, voffB);
            PG8_WAIT_V(6); PG8_BAR; PG8_MMA(1, 1, At, B1); PG8_BAR;
            }
        }
        if constexpr (ALIGN_EPI) { if (wr == 0) PG8_BAR; }
        if constexpr (!Epi::AFTER_DRAIN) { E(acc, cur, wr, wc, fr, fq); S.done(cur); }
        if (!has_next) break;
#pragma unroll
        for (int a = 0; a < 2; ++a)
#pragma unroll
            for (int b = 0; b < 2; ++b)
#pragma unroll
                for (int m = 0; m < 4; ++m)
#pragma unroll
                    for (int n = 0; n < 2; ++n) acc[a][b][m][n] = (f32x4){0.f, 0.f, 0.f, 0.f};
        cur = nxt; cA = nA; cB = nB; ++ui;
        if constexpr (ALIGN_EPI) { if (wr == 1) PG8_BAR; }
    }
    PG8_WAIT_V(0);
    if constexpr (!ALIGN_EPI) { if (wr == 0) PG8_BAR; }
    PG8_BAR;
    if constexpr (Epi::AFTER_DRAIN) { E.fused(acc, cur, wr, wc, fr, fq, lds, wid, lane); S.done(cur); }
#undef PG8_SA
#undef PG8_SB
#undef PG8_STAGE
#undef PG8_LDA
#undef PG8_LDB
#undef PG8_MMA
#undef PG8_WAIT_V
#undef PG8_WAIT_L
#undef PG8_BAR
#undef PG8_SCHED
}
}

#define GAS __attribute__((address_space(1)))
#define LAS __attribute__((address_space(3)))
typedef unsigned short bf16;
typedef unsigned v4u __attribute__((ext_vector_type(4)));
typedef float f32x4 __attribute__((ext_vector_type(4)));
typedef short bf16x8 __attribute__((ext_vector_type(8)));
typedef GAS unsigned gu32;
typedef GAS unsigned long long gu64;
#define RLX_AGENT __ATOMIC_RELAXED, __HIP_MEMORY_SCOPE_AGENT
#define LDS_WAIT() asm volatile("s_waitcnt lgkmcnt(0)" ::: "memory")
#define VM_WAIT() asm volatile("s_waitcnt vmcnt(0)" ::: "memory")
__device__ __forceinline__ unsigned long long rt() { return __builtin_amdgcn_s_memrealtime(); }
typedef float hw_f32x2 __attribute__((ext_vector_type(2))); typedef __bf16 hw_bf16x2 __attribute__((ext_vector_type(2)));
__device__ __forceinline__ unsigned pk2(float lo, float hi) { const hw_f32x2 v = {lo, hi}; return __builtin_bit_cast(unsigned, __builtin_convertvector(v, hw_bf16x2)); }
__device__ __forceinline__ unsigned f2bf(float f) { return pk2(f, 0.f) & 0xffffu; }

#define XB_TMO      128
#define XB_XCNT(j)  (256  + 64 * (j))
#define XB_XSUB(j)  (1280 + 64 * (j))
#define XB_XGEN(j)  (2304 + 64 * (j))
#define XB_TOP      3328
#define XB_TOPGEN   3392
#define XCD_BAR_WORDS 3456
#define XB_SPIN_CAP (1u << 21)

__device__ __forceinline__ unsigned xb_ld(unsigned* p)              { return __hip_atomic_load(p, __ATOMIC_RELAXED, __HIP_MEMORY_SCOPE_AGENT); }
__device__ __forceinline__ unsigned xb_add(unsigned* p, unsigned v) { return __hip_atomic_fetch_add(p, v, __ATOMIC_RELAXED, __HIP_MEMORY_SCOPE_AGENT); }
__device__ __forceinline__ unsigned xb_xcc_id() { return (unsigned)__builtin_amdgcn_s_getreg((3 << 11) | 20) & 0xFu; }
#define XB_SPIN(cond, bar) do { unsigned _sp = 0; while (cond) { __builtin_amdgcn_s_sleep(1); \
    if ((++_sp & 255u) == 0u) { if (xb_ld(&(bar)[XB_TMO])) break; if (_sp > XB_SPIN_CAP) { atomicAdd(&(bar)[XB_TMO], 1u); break; } } } } while (0)

struct XcdBarrier {
    unsigned* bar; unsigned x;
    volatile LAS unsigned* st;
};

__device__ __forceinline__ XcdBarrier xcd_barrier_post(unsigned* bar, volatile LAS unsigned* st) {
    XcdBarrier b; b.bar = bar; b.x = xb_xcc_id(); b.st = st;
    if (threadIdx.x == 0) (void)xb_add(&bar[XB_XCNT(b.x)], 1u);
    return b;
}
__device__ __forceinline__ void xcd_barrier_complete(unsigned* bar, unsigned x, unsigned& nloc, unsigned& nx) {
    const unsigned G = gridDim.x * gridDim.y * gridDim.z;
    unsigned sum, cnt, mine, sp = 0u;
    for (;;) {
        sum = 0u; cnt = 0u; mine = 0u;
#pragma unroll
        for (unsigned j = 0; j < 16; ++j) { const unsigned c = xb_ld(&bar[XB_XCNT(j)]); sum += c; cnt += (c > 0u) ? 1u : 0u; mine = (j == x) ? c : mine; }
        if (sum == G) break;
        __builtin_amdgcn_s_sleep(1);
        if ((++sp & 255u) == 0u) { if (xb_ld(&bar[XB_TMO])) break; if (sp > XB_SPIN_CAP) { atomicAdd(&bar[XB_TMO], 1u); break; } }
    }
    nloc = mine > 0u ? mine : 1u; nx = cnt > 0u ? cnt : 1u;
}

__device__ __forceinline__ void xcd_barrier(const XcdBarrier& b, const int wv) {
    asm volatile("s_waitcnt vmcnt(0)" ::: "memory");
    __syncthreads();
    int xb_lane; asm volatile("v_mbcnt_lo_u32_b32 %0, -1, 0\n\tv_mbcnt_hi_u32_b32 %0, -1, %0" : "=v"(xb_lane));
    if (wv == 0 && xb_lane == 0) {
        unsigned* bar = b.bar;
        __builtin_amdgcn_s_waitcnt(0);
        unsigned nloc = b.st[0], nx = b.st[1];
        if (nloc == 0u) { xcd_barrier_complete(bar, b.x, nloc, nx); b.st[0] = nloc; b.st[1] = nx; }
        const unsigned old = xb_add(&bar[XB_XSUB(b.x)], 1u);
        const unsigned gen = old / nloc;
        if (old + 1u == (gen + 1u) * nloc) {
            __builtin_amdgcn_fence(__ATOMIC_RELEASE, "agent");
            asm volatile("s_waitcnt vmcnt(0)" ::: "memory");
            const unsigned og = xb_add(&bar[XB_TOP], 1u);
            const unsigned tg = og / nx;
            if (og + 1u == (tg + 1u) * nx) xb_add(&bar[XB_TOPGEN], 1u);
            else XB_SPIN(xb_ld(&bar[XB_TOPGEN]) == tg, bar);
            __builtin_amdgcn_fence(__ATOMIC_ACQUIRE, "agent");
            xb_add(&bar[XB_XGEN(b.x)], 1u);
            asm volatile("s_waitcnt vmcnt(0)" ::: "memory");
        } else {
            XB_SPIN(xb_ld(&bar[XB_XGEN(b.x)]) == gen, bar);
            __builtin_amdgcn_fence(__ATOMIC_ACQUIRE, "agent");
            asm volatile("s_waitcnt vmcnt(0)" ::: "memory");
        }
    }
    __syncthreads();
}

#include <hip/hip_bf16.h>
#include <cmath>
namespace attn_body {
using bf16=__hip_bfloat16;
using bf16x8=__attribute__((ext_vector_type(8)))short;
using s16x4=__attribute__((ext_vector_type(4)))short;
using f32x16=__attribute__((ext_vector_type(16)))float;
using u32x4=__attribute__((ext_vector_type(4)))unsigned;
constexpr int D=64;
constexpr int NW=8,QBLK=32,QB=QBLK*NW,KVBLK=64;
constexpr int ATTN_UNIT_ROWS=QB;
__device__ __forceinline__ int crow(int r,int hi){return (r&3)+8*(r>>2)+4*hi;}
#define SBAR() __builtin_amdgcn_sched_barrier(0)
constexpr int NSLOT=3, SLOTB=8192;
constexpr int LDS_K=0, LDS_V=NSLOT*SLOTB, LDS_WS=2*NSLOT*SLOTB, LDS_OST=LDS_WS+NW*64*4, LDS_BYTES=LDS_OST+NW*4096;
constexpr float C2=0.125f*1.4426950408889634f;
__device__ __forceinline__ void glds16(const void*gsrc,unsigned lds_dst){unsigned keep;
  asm volatile("s_mov_b32 %0, m0\n\ts_mov_b32 m0, %2\n\ts_nop 0\n\tglobal_load_lds_dwordx4 %1, off\n\ts_mov_b32 m0, %0":"=&s"(keep):"v"(gsrc),"s"(lds_dst):"memory");}
__device__ __forceinline__ float max3f(float a,float b,float c){float r;asm("v_max3_f32 %0, %1, %2, %3":"=v"(r):"v"(a),"v"(b),"v"(c));return r;}
__device__ __forceinline__ float max2f(float a,float b){float r;asm("v_max_f32_e32 %0, %1, %2":"=v"(r):"v"(a),"v"(b));return r;}
__device__ __forceinline__ float fadd_s(float a,float b){float r;asm("v_add_f32_e32 %0, %1, %2":"=v"(r):"v"(a),"v"(b));return r;}
__device__ __forceinline__ float fsub_s(float a,float b){float r;asm("v_sub_f32_e32 %0, %1, %2":"=v"(r):"v"(a),"v"(b));return r;}
typedef float f32x2_t __attribute__((ext_vector_type(2))); typedef __bf16 bf16x2_t __attribute__((ext_vector_type(2)));
__device__ __forceinline__ unsigned cvtpk_s(float lo,float hi){f32x2_t v={lo,hi};bf16x2_t b=__builtin_convertvector(v,bf16x2_t);return __builtin_bit_cast(unsigned,b);}
#define WAIT_BAR(N) asm volatile("s_waitcnt vmcnt(" #N ") lgkmcnt(0)\n\ts_barrier":::"memory")

__device__ __forceinline__ void qkt(f32x16&p0,f32x16&p1,const char*Kslot,const bf16x8*qr,const f32x16&negm,int r32,int hi){
  const char*kb=Kslot+hi*1024+r32*16;
  #pragma unroll
  for(int d0=0;d0<4;++d0){
    const bf16x8 b0=*reinterpret_cast<const bf16x8*>(kb+d0*2048);
    const bf16x8 b1=*reinterpret_cast<const bf16x8*>(kb+d0*2048+512);
    if(d0==0){p0=__builtin_amdgcn_mfma_f32_32x32x16_bf16(b0,qr[0],negm,0,0,0);p1=__builtin_amdgcn_mfma_f32_32x32x16_bf16(b1,qr[0],negm,0,0,0);}
    else{p0=__builtin_amdgcn_mfma_f32_32x32x16_bf16(b0,qr[d0],p0,0,0,0);p1=__builtin_amdgcn_mfma_f32_32x32x16_bf16(b1,qr[d0],p1,0,0,0);}}
}
typedef __attribute__((address_space(3))) const char* lds_cptr;
typedef short v4i16_t __attribute__((ext_vector_type(4)));
__device__ __forceinline__ void kload8(bf16x8*kf,lds_cptr kp){
  kf[0]=*(const __attribute__((address_space(3))) bf16x8*)(kp);      kf[1]=*(const __attribute__((address_space(3))) bf16x8*)(kp+512);
  kf[2]=*(const __attribute__((address_space(3))) bf16x8*)(kp+2048); kf[3]=*(const __attribute__((address_space(3))) bf16x8*)(kp+2560);
  kf[4]=*(const __attribute__((address_space(3))) bf16x8*)(kp+4096); kf[5]=*(const __attribute__((address_space(3))) bf16x8*)(kp+4608);
  kf[6]=*(const __attribute__((address_space(3))) bf16x8*)(kp+6144); kf[7]=*(const __attribute__((address_space(3))) bf16x8*)(kp+6656);
}
__device__ __forceinline__ void kload2(bf16x8*kf,lds_cptr kp,int j){ kf[2*j]=*(const __attribute__((address_space(3))) bf16x8*)(kp+j*2048); kf[2*j+1]=*(const __attribute__((address_space(3))) bf16x8*)(kp+j*2048+512); }
__device__ __forceinline__ s16x4 vtr(lds_cptr p){ return __builtin_bit_cast(s16x4,__builtin_amdgcn_ds_read_tr16_b64_v4i16((__attribute__((address_space(3))) v4i16_t*)p)); }
__device__ __forceinline__ float rowmax(const f32x16&p0,const f32x16&p1){
  float a=max3f(p0[0],p0[1],p1[0]),b=max3f(p0[2],p0[3],p1[1]);a=max3f(a,p1[2],p1[3]);
  #pragma unroll
  for(int r=4;r<16;r+=4){a=max3f(a,p0[r],p0[r+1]);b=max3f(b,p0[r+2],p0[r+3]);a=max3f(a,p1[r],p1[r+1]);b=max3f(b,p1[r+2],p1[r+3]);}
  const float m=max2f(a,b);
  auto rr=__builtin_amdgcn_permlane32_swap(__float_as_uint(m),__float_as_uint(m),false,false);
  return max2f(__uint_as_float(rr[0]),__uint_as_float(rr[1]));
}
__device__ __forceinline__ void pv(f32x16*o,int vb,bf16x8 pa0,bf16x8 pa1,bf16x8 pa2,bf16x8 pa3){
  #pragma unroll
  for(int d0=0;d0<2;++d0){s16x4 lo[4],hi[4];
    #pragma unroll
    for(int ks=0;ks<4;++ks){
      asm volatile("ds_read_b64_tr_b16 %0,%1 offset:%c2":"=&v"(lo[ks]):"v"(vb),"i"(d0*4096+ks*1024):"memory");
      asm volatile("ds_read_b64_tr_b16 %0,%1 offset:%c2":"=&v"(hi[ks]):"v"(vb),"i"(d0*4096+ks*1024+512):"memory");}
    asm volatile("s_waitcnt lgkmcnt(0)":::"memory");SBAR();
    #define PK(k) (bf16x8){lo[k][0],lo[k][1],lo[k][2],lo[k][3],hi[k][0],hi[k][1],hi[k][2],hi[k][3]}
    o[d0]=__builtin_amdgcn_mfma_f32_32x32x16_bf16(pa0,PK(0),o[d0],0,0,0);
    o[d0]=__builtin_amdgcn_mfma_f32_32x32x16_bf16(pa1,PK(1),o[d0],0,0,0);
    o[d0]=__builtin_amdgcn_mfma_f32_32x32x16_bf16(pa2,PK(2),o[d0],0,0,0);
    o[d0]=__builtin_amdgcn_mfma_f32_32x32x16_bf16(pa3,PK(3),o[d0],0,0,0);
    #undef PK
  }
}

#ifndef ATTN_STORE16
#define ATTN_STORE16(p,v) (*(u32x4*)(p)=(v))
#endif
template<int THRL> __device__ __forceinline__ void attn_unit(const int tid_in,const bf16*Qu,int qpitch,const bf16*__restrict__ Kh,const bf16*__restrict__ Vh,int kvpitch,bf16*Ou,int opitch,const int NT,char*shm){
  int tid_=tid_in; asm volatile("":"+v"(tid_));
  const int tid=tid_,lane=tid&63,r32=lane&31,hi=lane>>5; const int wid=__builtin_amdgcn_readfirstlane(tid>>6);
  const bf16*Qw=Qu+(long)(wid*QBLK)*qpitch;
  const unsigned lds0=(unsigned)(uintptr_t)shm;
  float*wsf=(float*)(shm+LDS_WS)+wid*64;
  const bf16*ksrc=Kh+(long)lane*kvpitch+wid*8;
  const bf16*vsrc=Vh+(long)(16*(wid&3)+(lane>>2))*kvpitch+(wid>>2)*32+(lane&3)*8;
  const unsigned kdst=lds0+LDS_K+wid*1024, vdst=lds0+LDS_V+wid*1024;
  #define DMA_K(t,slot) glds16(ksrc+(long)(t)*KVBLK*kvpitch,(unsigned)__builtin_amdgcn_readfirstlane(kdst+(slot)))
  #define DMA_V(t,slot) glds16(vsrc+(long)(t)*KVBLK*kvpitch,(unsigned)__builtin_amdgcn_readfirstlane(vdst+(slot)))
  const int vb0=(int)(lds0+LDS_V)+((lane>>4)&1)*32+(lane&3)*8+(4*hi+((lane&15)>>2))*64;
  const char*Kbase=shm+LDS_K; bf16x8 kf[8];
  const lds_cptr shm3=(lds_cptr)shm; const lds_cptr kp0=shm3+LDS_K+hi*1024+r32*16; const lds_cptr vp0=shm3+LDS_V+((lane>>4)&1)*32+(lane&3)*8+(4*hi+((lane&15)>>2))*64;
  DMA_K(0,0);DMA_V(0,0);DMA_K(1,SLOTB);
  bf16x8 qr[4];
  #pragma unroll
  for(int d0=0;d0<4;++d0)qr[d0]=*reinterpret_cast<const bf16x8*>(&Qw[(long)r32*qpitch+d0*16+hi*8]);
  float mhat=0.f,l_reg=0.f;f32x16 o[2];o[0]=f32x16{};o[1]=f32x16{};f32x16 negm=f32x16{};asm volatile("":"+v"(negm));
  #define CMASK(P0,P1,t) do{}while(0)
  bool resc=false;
  #define START(P0,P1) do{ const float rm=rowmax(P0,P1); resc=false; \
    { const float dl=rm; mhat=fadd_s(mhat,dl); \
      _Pragma("unroll") for(int r=0;r<16;++r){P0[r]=fsub_s(P0[r],dl);P1[r]=fsub_s(P1[r],dl);} \
      _Pragma("unroll") for(int r=0;r<16;++r)negm[r]=-mhat; asm volatile("":"+v"(negm)); } \
    _Pragma("unroll") for(int r=0;r<16;++r)P0[r]=__builtin_amdgcn_exp2f(P0[r]); }while(0)
  #define RESC() do{ if(resc){ asm volatile("s_waitcnt lgkmcnt(0)":::"memory"); \
      _Pragma("unroll") for(int d_=0;d_<2;++d_) _Pragma("unroll") for(int r=0;r<16;++r)o[d_][r]*=wsf[crow(r,hi)]; } }while(0)
  f32x16 pA0,pA1,pB0,pB1;
  int sl_prev=0,sl_cur=0,sl_next=SLOTB;
  #define ROT() do{sl_prev=sl_cur;sl_cur=sl_next;sl_next=(sl_next==(NSLOT-1)*SLOTB)?0:sl_next+SLOTB;}while(0)
  DMA_K(2,2*SLOTB);
  WAIT_BAR(3);
  qkt(pA0,pA1,Kbase,qr,negm,r32,hi);asm volatile("s_nop 15\n\ts_nop 7":"+v"(pA0),"+v"(pA1));CMASK(pA0,pA1,0);
  START(pA0,pA1);
  _Pragma("unroll") for(int r=0;r<16;++r)pA1[r]=__builtin_amdgcn_exp2f(pA1[r]);
  WAIT_BAR(0);
  DMA_K(3,0);DMA_V(1,SLOTB);
  ROT();
  kload8(kf,kp0+sl_cur);
  WAIT_BAR(2);
  s16x4 vlo[8],vhi[8]; u32x4 pw0,pw1,pw2,pw3;
  #define PKW(P,B) cvtpk_s(P[B],P[B+1])
  #define PAF(k) __builtin_bit_cast(bf16x8,pw##k)
  #define VFR(i) (bf16x8){vlo[i][0],vlo[i][1],vlo[i][2],vlo[i][3],vhi[i][0],vhi[i][1],vhi[i][2],vhi[i][3]}
  #define PIN(x) asm volatile("":"+v"(x))
  #define MX3(a,b,c) __builtin_fmaxf(__builtin_fmaxf((a),(b)),(c))
  #define GAPA(MF,A0,A1,A2,A3,W0,W1,PW) do{ MF; sacc+=A0; sacc+=A1; sacc+=A2; sacc+=A3; PIN(sacc); W0; W1; PIN(PW); SBAR(); }while(0)
  #define EX(v) __builtin_amdgcn_exp2f(v)
  #define GAPB(MF,X,B) do{ MF; X[B]=EX(X[B]); X[B+1]=EX(X[B+1]); X[B+2]=EX(X[B+2]); X[B+3]=EX(X[B+3]); PIN(X); SBAR(); }while(0)
  #define VRD(i) do{ vlo[i]=vtr(vp_+(((i)>>2)*4096+((i)&3)*1024)); vhi[i]=vtr(vp_+(((i)>>2)*4096+((i)&3)*1024+512)); }while(0)
  #define KRD(G,j) do{ if(G){ kload2(kf,kp0+sl_next,j); SBAR(); } }while(0)
  #define STEP(C0,C1,P0,P1,t,GK,GV,GL) do{ SBAR(); \
    const lds_cptr vp_=vp0+sl_prev; \
    VRD(0); SBAR(); float sacc=(P0[0]+P0[1]); \
    GAPA(C0=__builtin_amdgcn_mfma_f32_32x32x16_bf16(kf[0],qr[0],negm,0,0,0), P0[2],P0[3],P0[4],P0[5],     pw0[0]=PKW(P0,0), pw0[1]=PKW(P0,2), pw0); \
    VRD(4); SBAR(); GAPA(C1=__builtin_amdgcn_mfma_f32_32x32x16_bf16(kf[1],qr[0],negm,0,0,0), P0[6],P0[7],P0[8],P0[9],     pw0[2]=PKW(P0,4), pw0[3]=PKW(P0,6), pw0); \
    VRD(1); SBAR(); GAPA(C0=__builtin_amdgcn_mfma_f32_32x32x16_bf16(kf[2],qr[1],C0,0,0,0),   P0[10],P0[11],P0[12],P0[13], pw1[0]=PKW(P0,8), pw1[1]=PKW(P0,10), pw1); \
    VRD(5); SBAR(); GAPA(C1=__builtin_amdgcn_mfma_f32_32x32x16_bf16(kf[3],qr[1],C1,0,0,0),   P0[14],P0[15],P1[0],P1[1],   pw1[2]=PKW(P0,12),pw1[3]=PKW(P0,14), pw1); \
    VRD(2); SBAR(); GAPA(C0=__builtin_amdgcn_mfma_f32_32x32x16_bf16(kf[4],qr[2],C0,0,0,0),   P1[2],P1[3],P1[4],P1[5],     pw2[0]=PKW(P1,0), pw2[1]=PKW(P1,2), pw2); \
    VRD(6); SBAR(); GAPA(C1=__builtin_amdgcn_mfma_f32_32x32x16_bf16(kf[5],qr[2],C1,0,0,0),   P1[6],P1[7],P1[8],P1[9],     pw2[2]=PKW(P1,4), pw2[3]=PKW(P1,6), pw2); \
    VRD(3); SBAR(); GAPA(C0=__builtin_amdgcn_mfma_f32_32x32x16_bf16(kf[6],qr[3],C0,0,0,0),   P1[10],P1[11],P1[12],P1[13], pw3[0]=PKW(P1,8), pw3[1]=PKW(P1,10), pw3); \
    VRD(7); SBAR(); GAPA(C1=__builtin_amdgcn_mfma_f32_32x32x16_bf16(kf[7],qr[3],C1,0,0,0),   P1[14],P1[15],0.f,0.f,       pw3[2]=PKW(P1,12),pw3[3]=PKW(P1,14), pw3); \
    l_reg+=sacc; \
    if(GK){DMA_K((t)+3,sl_cur);} if(GV){DMA_V((t)+1,sl_next);} \
    CMASK(C0,C1,t); \
    { float a=MX3(C0[0],C0[1],C1[0]),b=MX3(C0[2],C0[3],C1[1]); a=MX3(a,C1[2],C1[3]); \
      _Pragma("unroll") for(int r=4;r<16;r+=4){a=MX3(a,C0[r],C0[r+1]);b=MX3(b,C0[r+2],C0[r+3]);a=MX3(a,C1[r],C1[r+1]);b=MX3(b,C1[r+2],C1[r+3]);} \
      float rm=__builtin_fmaxf(a,b); { auto rr=__builtin_amdgcn_permlane32_swap(__float_as_uint(rm),__float_as_uint(rm),false,false); rm=__builtin_fmaxf(__uint_as_float(rr[0]),__uint_as_float(rr[1])); } \
      resc=false; \
      if(__builtin_expect(__any(rm>(float)THRL),0)){ const float dl=__builtin_fmaxf(rm,0.f); mhat+=dl; \
        _Pragma("unroll") for(int r=0;r<16;++r){C0[r]-=dl;C1[r]-=dl;} \
        _Pragma("unroll") for(int r=0;r<16;++r)negm[r]=-mhat; asm volatile("":"+v"(negm)); \
        const float f=__builtin_amdgcn_exp2f(-dl); l_reg*=f; if(hi==0)wsf[r32]=f; resc=true; } } \
    SBAR(); \
    GAPB(o[0]=__builtin_amdgcn_mfma_f32_32x32x16_bf16(PAF(0),VFR(0),o[0],0,0,0), C0,0); \
    GAPB(o[1]=__builtin_amdgcn_mfma_f32_32x32x16_bf16(PAF(0),VFR(4),o[1],0,0,0), C0,4); \
    KRD(GL,0); GAPB(o[0]=__builtin_amdgcn_mfma_f32_32x32x16_bf16(PAF(1),VFR(1),o[0],0,0,0), C0,8); \
    KRD(GL,1); GAPB(o[1]=__builtin_amdgcn_mfma_f32_32x32x16_bf16(PAF(1),VFR(5),o[1],0,0,0), C0,12); \
    KRD(GL,2); GAPB(o[0]=__builtin_amdgcn_mfma_f32_32x32x16_bf16(PAF(2),VFR(2),o[0],0,0,0), C1,0); \
    KRD(GL,3); GAPB(o[1]=__builtin_amdgcn_mfma_f32_32x32x16_bf16(PAF(2),VFR(6),o[1],0,0,0), C1,4); \
    GAPB(o[0]=__builtin_amdgcn_mfma_f32_32x32x16_bf16(PAF(3),VFR(3),o[0],0,0,0), C1,8); \
    GAPB(o[1]=__builtin_amdgcn_mfma_f32_32x32x16_bf16(PAF(3),VFR(7),o[1],0,0,0), C1,12); \
    }while(0)
  int t=1;
  #undef CMASK
  #define CMASK(P0,P1,t) do{}while(0)
  for(;t+5<NT;t+=2){
    STEP(pB0,pB1,pA0,pA1,t,true,true,true);     WAIT_BAR(2); RESC(); ROT();
    STEP(pA0,pA1,pB0,pB1,t+1,true,true,true);   WAIT_BAR(2); RESC(); ROT();
  }
  #undef CMASK
  #define CMASK(P0,P1,t) do{}while(0)
  #define ENDW(tt) do{ if((tt)+3<NT){WAIT_BAR(2);} else if((tt)+2<NT){WAIT_BAR(1);} else {WAIT_BAR(0);} }while(0)
  for(;t+1<NT;t+=2){
    STEP(pB0,pB1,pA0,pA1,t,(t+3<NT),(t+1<NT),(t+1<NT));       ENDW(t);   RESC(); ROT();
    STEP(pA0,pA1,pB0,pB1,t+1,(t+4<NT),(t+2<NT),(t+2<NT));     ENDW(t+1); RESC(); ROT();
  }
  STEP(pB0,pB1,pA0,pA1,NT-1,false,false,false); RESC();
  { float sacc=pB0[0]+pB0[1]; _Pragma("unroll") for(int r=2;r<16;++r)sacc+=pB0[r]; _Pragma("unroll") for(int r=0;r<16;++r)sacc+=pB1[r]; l_reg+=sacc;
    pw0=(u32x4){PKW(pB0,0),PKW(pB0,2),PKW(pB0,4),PKW(pB0,6)};pw1=(u32x4){PKW(pB0,8),PKW(pB0,10),PKW(pB0,12),PKW(pB0,14)};pw2=(u32x4){PKW(pB1,0),PKW(pB1,2),PKW(pB1,4),PKW(pB1,6)};pw3=(u32x4){PKW(pB1,8),PKW(pB1,10),PKW(pB1,12),PKW(pB1,14)};
    SBAR(); pv(o,vb0+sl_cur,PAF(0),PAF(1),PAF(2),PAF(3)); }
  #undef PKW
  #undef PAF
  #undef VFR
  #undef PIN
  #undef MX3
  #undef GAPA
  #undef GAPB
  #undef EX
  #undef VRD
  #undef KRD
  #undef STEP
  #undef ENDW
  {auto rr=__builtin_amdgcn_permlane32_swap(__float_as_uint(l_reg),__float_as_uint(l_reg),false,false);l_reg=__uint_as_float(rr[0])+__uint_as_float(rr[1]);}
  if(hi==0)wsf[32+r32]=l_reg;asm volatile("s_waitcnt lgkmcnt(0)":::"memory");
  float rli[16];
  #pragma unroll
  for(int r=0;r<16;++r)rli[r]=__builtin_amdgcn_rcpf(wsf[32+crow(r,hi)]);
  bf16*Ow=Ou+(long)(wid*QBLK)*opitch;
  { bf16*stg=(bf16*)(shm+LDS_OST)+wid*2048;
    #pragma unroll
    for(int r=0;r<16;++r){const int orow=crow(r,hi);
      #pragma unroll
      for(int d0=0;d0<2;++d0)stg[orow*64+d0*32+r32]=__float2bfloat16(o[d0][r]*rli[r]);}
    asm volatile("s_waitcnt lgkmcnt(0)":::"memory");
    #pragma unroll
    for(int i=0;i<4;++i){const int row=i*8+(lane>>3),ch=lane&7; const u32x4 v=*(const u32x4*)(stg+row*64+ch*8); ATTN_STORE16(Ow+(long)row*opitch+ch*8,v);} }
  asm volatile("s_waitcnt lgkmcnt(0)\n\ts_barrier":::"memory");
  #undef DMA_K
  #undef DMA_V
  #undef CMASK
  #undef START
  #undef RESC
  #undef ROT
}
__device__ __forceinline__ void pv128(f32x16*o,int vb,bf16x8 pa0,bf16x8 pa1,bf16x8 pa2,bf16x8 pa3){
  #pragma unroll
  for(int d0=0;d0<4;++d0){s16x4 lo[4],hi[4];
    #pragma unroll
    for(int ks=0;ks<4;++ks){
      asm volatile("ds_read_b64_tr_b16 %0,%1 offset:%c2":"=&v"(lo[ks]):"v"(vb),"i"(d0*4096+ks*1024):"memory");
      asm volatile("ds_read_b64_tr_b16 %0,%1 offset:%c2":"=&v"(hi[ks]):"v"(vb),"i"(d0*4096+ks*1024+512):"memory");}
    asm volatile("s_waitcnt lgkmcnt(0)":::"memory");SBAR();
    #define PK(k) (bf16x8){lo[k][0],lo[k][1],lo[k][2],lo[k][3],hi[k][0],hi[k][1],hi[k][2],hi[k][3]}
    o[d0]=__builtin_amdgcn_mfma_f32_32x32x16_bf16(pa0,PK(0),o[d0],0,0,0);
    o[d0]=__builtin_amdgcn_mfma_f32_32x32x16_bf16(pa1,PK(1),o[d0],0,0,0);
    o[d0]=__builtin_amdgcn_mfma_f32_32x32x16_bf16(pa2,PK(2),o[d0],0,0,0);
    o[d0]=__builtin_amdgcn_mfma_f32_32x32x16_bf16(pa3,PK(3),o[d0],0,0,0);
    #undef PK
  }
}
constexpr int LDS_V128=NSLOT*SLOTB, LDS_WS128=LDS_V128+NSLOT*2*SLOTB, LDS_OST128=LDS_WS128+NW*64*4, LDS_BYTES128=LDS_OST128+NW*8192;
template<int THRL> __device__ __forceinline__ void attn_unit128(const int tid_in,const bf16*Qu,int qpitch,const bf16*__restrict__ Kh,const bf16*__restrict__ Vh,int kvpitch,bf16*Ou,int opitch,const int NT,char*shm){
  int tid_=tid_in; asm volatile("":"+v"(tid_));
  const int tid=tid_,lane=tid&63,r32=lane&31,hi=lane>>5; const int wid=__builtin_amdgcn_readfirstlane(tid>>6);
  const bf16*Qw=Qu+(long)(wid*QBLK)*qpitch;
  const unsigned lds0=(unsigned)(uintptr_t)shm;
  float*wsf=(float*)(shm+LDS_WS128)+wid*64;
  const bf16*ksrc=Kh+(long)lane*kvpitch+wid*8;
  const bf16*vsrc=Vh+(long)(16*(wid&3)+(lane>>2))*kvpitch+(wid>>2)*32+(lane&3)*8;
  const unsigned kdst=lds0+LDS_K+wid*1024, vdst=lds0+LDS_V128+wid*1024;
  #define DMA_K(t,slot) glds16(ksrc+(long)(t)*KVBLK*kvpitch,(unsigned)__builtin_amdgcn_readfirstlane(kdst+(slot)))
  #define DMA_V(t,slot) do{ glds16(vsrc+(long)(t)*KVBLK*kvpitch,(unsigned)__builtin_amdgcn_readfirstlane(vdst+2*(slot))); glds16(vsrc+(long)(t)*KVBLK*kvpitch+64,(unsigned)__builtin_amdgcn_readfirstlane(vdst+8192+2*(slot))); }while(0)
  const int vb0=(int)(lds0+LDS_V128)+((lane>>4)&1)*32+(lane&3)*8+(4*hi+((lane&15)>>2))*64;
  const char*Kbase=shm+LDS_K; bf16x8 kf[8];
  const lds_cptr shm3=(lds_cptr)shm; const lds_cptr kp0=shm3+LDS_K+hi*1024+r32*16; const lds_cptr vp0=shm3+LDS_V128+((lane>>4)&1)*32+(lane&3)*8+(4*hi+((lane&15)>>2))*64;
  DMA_K(0,0);DMA_V(0,0);DMA_K(1,SLOTB);
  bf16x8 qr[4];
  #pragma unroll
  for(int d0=0;d0<4;++d0)qr[d0]=*reinterpret_cast<const bf16x8*>(&Qw[(long)r32*qpitch+d0*16+hi*8]);
  float mhat=0.f,l_reg=0.f;f32x16 o[4];o[0]=f32x16{};o[1]=f32x16{};o[2]=f32x16{};o[3]=f32x16{};f32x16 negm=f32x16{};asm volatile("":"+v"(negm));
  #define CMASK(P0,P1,t) do{}while(0)
  bool resc=false;
  #define START(P0,P1) do{ const float rm=rowmax(P0,P1); resc=false; \
    { const float dl=rm; mhat=fadd_s(mhat,dl); \
      _Pragma("unroll") for(int r=0;r<16;++r){P0[r]=fsub_s(P0[r],dl);P1[r]=fsub_s(P1[r],dl);} \
      _Pragma("unroll") for(int r=0;r<16;++r)negm[r]=-mhat; asm volatile("":"+v"(negm)); } \
    _Pragma("unroll") for(int r=0;r<16;++r)P0[r]=__builtin_amdgcn_exp2f(P0[r]); }while(0)
  #define RESC() do{ if(resc){ asm volatile("s_waitcnt lgkmcnt(0)":::"memory"); \
      _Pragma("unroll") for(int d_=0;d_<4;++d_) _Pragma("unroll") for(int r=0;r<16;++r)o[d_][r]*=wsf[crow(r,hi)]; } }while(0)
  f32x16 pA0,pA1,pB0,pB1;
  int sl_prev=0,sl_cur=0,sl_next=SLOTB;
  #define ROT() do{sl_prev=sl_cur;sl_cur=sl_next;sl_next=(sl_next==(NSLOT-1)*SLOTB)?0:sl_next+SLOTB;}while(0)
  DMA_K(2,2*SLOTB);
  WAIT_BAR(4);
  qkt(pA0,pA1,Kbase,qr,negm,r32,hi);asm volatile("s_nop 15\n\ts_nop 7":"+v"(pA0),"+v"(pA1));CMASK(pA0,pA1,0);
  START(pA0,pA1);
  _Pragma("unroll") for(int r=0;r<16;++r)pA1[r]=__builtin_amdgcn_exp2f(pA1[r]);
  WAIT_BAR(0);
  DMA_K(3,0);DMA_V(1,SLOTB);
  ROT();
  kload8(kf,kp0+sl_cur);
  WAIT_BAR(3);
  s16x4 vbl[3],vbh[3]; u32x4 pw0,pw1,pw2,pw3;
  #define PKW(P,B) cvtpk_s(P[B],P[B+1])
  #define PAF(k) __builtin_bit_cast(bf16x8,pw##k)
  #define VFB(s) (bf16x8){vbl[s][0],vbl[s][1],vbl[s][2],vbl[s][3],vbh[s][0],vbh[s][1],vbh[s][2],vbh[s][3]}
  #define PIN(x) asm volatile("":"+v"(x))
  #define MX3(a,b,c) __builtin_fmaxf(__builtin_fmaxf((a),(b)),(c))
  #define GAPA(MF,A0,A1,A2,A3,W0,W1,PW) do{ MF; sacc+=A0; sacc+=A1; sacc+=A2; sacc+=A3; PIN(sacc); W0; W1; PIN(PW); SBAR(); }while(0)
  #define EX(v) __builtin_amdgcn_exp2f(v)
  #define VRD3(s,i) do{ vbl[s]=vtr(vp_+(((i)&3)*4096+((i)>>2)*1024)); vbh[s]=vtr(vp_+(((i)&3)*4096+((i)>>2)*1024+512)); }while(0)
  #define GAPB(i,X,B) do{ o[(i)&3]=__builtin_amdgcn_mfma_f32_32x32x16_bf16(PAFI((i)>>2),VFB((i)%3),o[(i)&3],0,0,0); if((i)+2<16){VRD3(((i)+2)%3,(i)+2);} X[B]=EX(X[B]); X[B+1]=EX(X[B+1]); PIN(X); SBAR(); }while(0)
  #define PAFI(k) ((k)==0?PAF(0):(k)==1?PAF(1):(k)==2?PAF(2):PAF(3))
  #define KRD(G,j) do{ if(G){ kload2(kf,kp0+sl_next,j); SBAR(); } }while(0)
  #define STEP(C0,C1,P0,P1,t,GK,GV,GL) do{ SBAR(); \
    const lds_cptr vp_=vp0+2*sl_prev; \
    float sacc=(P0[0]+P0[1]); \
    GAPA(C0=__builtin_amdgcn_mfma_f32_32x32x16_bf16(kf[0],qr[0],negm,0,0,0), P0[2],P0[3],P0[4],P0[5],     pw0[0]=PKW(P0,0), pw0[1]=PKW(P0,2), pw0); \
    GAPA(C1=__builtin_amdgcn_mfma_f32_32x32x16_bf16(kf[1],qr[0],negm,0,0,0), P0[6],P0[7],P0[8],P0[9],     pw0[2]=PKW(P0,4), pw0[3]=PKW(P0,6), pw0); \
    GAPA(C0=__builtin_amdgcn_mfma_f32_32x32x16_bf16(kf[2],qr[1],C0,0,0,0),   P0[10],P0[11],P0[12],P0[13], pw1[0]=PKW(P0,8), pw1[1]=PKW(P0,10), pw1); \
    GAPA(C1=__builtin_amdgcn_mfma_f32_32x32x16_bf16(kf[3],qr[1],C1,0,0,0),   P0[14],P0[15],P1[0],P1[1],   pw1[2]=PKW(P0,12),pw1[3]=PKW(P0,14), pw1); \
    GAPA(C0=__builtin_amdgcn_mfma_f32_32x32x16_bf16(kf[4],qr[2],C0,0,0,0),   P1[2],P1[3],P1[4],P1[5],     pw2[0]=PKW(P1,0), pw2[1]=PKW(P1,2), pw2); \
    GAPA(C1=__builtin_amdgcn_mfma_f32_32x32x16_bf16(kf[5],qr[2],C1,0,0,0),   P1[6],P1[7],P1[8],P1[9],     pw2[2]=PKW(P1,4), pw2[3]=PKW(P1,6), pw2); \
    VRD3(0,0); SBAR(); GAPA(C0=__builtin_amdgcn_mfma_f32_32x32x16_bf16(kf[6],qr[3],C0,0,0,0),   P1[10],P1[11],P1[12],P1[13], pw3[0]=PKW(P1,8), pw3[1]=PKW(P1,10), pw3); \
    VRD3(1,1); SBAR(); GAPA(C1=__builtin_amdgcn_mfma_f32_32x32x16_bf16(kf[7],qr[3],C1,0,0,0),   P1[14],P1[15],0.f,0.f,       pw3[2]=PKW(P1,12),pw3[3]=PKW(P1,14), pw3); \
    l_reg+=sacc; \
    if(GK){DMA_K((t)+3,sl_cur);} if(GV){DMA_V((t)+1,sl_next);} \
    { float a=MX3(C0[0],C0[1],C1[0]),b=MX3(C0[2],C0[3],C1[1]); a=MX3(a,C1[2],C1[3]); \
      _Pragma("unroll") for(int r=4;r<16;r+=4){a=MX3(a,C0[r],C0[r+1]);b=MX3(b,C0[r+2],C0[r+3]);a=MX3(a,C1[r],C1[r+1]);b=MX3(b,C1[r+2],C1[r+3]);} \
      float rm=__builtin_fmaxf(a,b); { auto rr=__builtin_amdgcn_permlane32_swap(__float_as_uint(rm),__float_as_uint(rm),false,false); rm=__builtin_fmaxf(__uint_as_float(rr[0]),__uint_as_float(rr[1])); } \
      resc=false; \
      if(__builtin_expect(__any(rm>(float)THRL),0)){ const float dl=__builtin_fmaxf(rm,0.f); mhat+=dl; \
        _Pragma("unroll") for(int r=0;r<16;++r){C0[r]-=dl;C1[r]-=dl;} \
        _Pragma("unroll") for(int r=0;r<16;++r)negm[r]=-mhat; asm volatile("":"+v"(negm)); \
        const float f=__builtin_amdgcn_exp2f(-dl); l_reg*=f; if(hi==0)wsf[r32]=f; resc=true; } } \
    SBAR(); \
    GAPB(0,C0,0); GAPB(1,C0,2); GAPB(2,C0,4); GAPB(3,C0,6); \
    KRD(GL,0); GAPB(4,C0,8); GAPB(5,C0,10); KRD(GL,1); GAPB(6,C0,12); GAPB(7,C0,14); \
    KRD(GL,2); GAPB(8,C1,0); GAPB(9,C1,2); KRD(GL,3); GAPB(10,C1,4); GAPB(11,C1,6); \
    GAPB(12,C1,8); GAPB(13,C1,10); GAPB(14,C1,12); GAPB(15,C1,14); \
    }while(0)
  int t=1;
  #undef CMASK
  #define CMASK(P0,P1,t) do{}while(0)
  for(;t+5<NT;t+=2){
    STEP(pB0,pB1,pA0,pA1,t,true,true,true);     WAIT_BAR(3); RESC(); ROT();
    STEP(pA0,pA1,pB0,pB1,t+1,true,true,true);   WAIT_BAR(3); RESC(); ROT();
  }
  #undef CMASK
  #define CMASK(P0,P1,t) do{}while(0)
  #define ENDW(tt) do{ if((tt)+3<NT){WAIT_BAR(3);} else if((tt)+2<NT){WAIT_BAR(2);} else {WAIT_BAR(0);} }while(0)
  for(;t+1<NT;t+=2){
    STEP(pB0,pB1,pA0,pA1,t,(t+3<NT),(t+1<NT),(t+1<NT));       ENDW(t);   RESC(); ROT();
    STEP(pA0,pA1,pB0,pB1,t+1,(t+4<NT),(t+2<NT),(t+2<NT));     ENDW(t+1); RESC(); ROT();
  }
  STEP(pB0,pB1,pA0,pA1,NT-1,false,false,false); RESC();
  { float sacc=pB0[0]+pB0[1]; _Pragma("unroll") for(int r=2;r<16;++r)sacc+=pB0[r]; _Pragma("unroll") for(int r=0;r<16;++r)sacc+=pB1[r]; l_reg+=sacc;
    pw0=(u32x4){PKW(pB0,0),PKW(pB0,2),PKW(pB0,4),PKW(pB0,6)};pw1=(u32x4){PKW(pB0,8),PKW(pB0,10),PKW(pB0,12),PKW(pB0,14)};pw2=(u32x4){PKW(pB1,0),PKW(pB1,2),PKW(pB1,4),PKW(pB1,6)};pw3=(u32x4){PKW(pB1,8),PKW(pB1,10),PKW(pB1,12),PKW(pB1,14)};
    SBAR(); pv128(o,vb0+2*sl_cur,PAF(0),PAF(1),PAF(2),PAF(3)); }
  #undef PKW
  #undef PAF
  #undef VFB
  #undef VRD3
  #undef PAFI
  #undef PIN
  #undef MX3
  #undef GAPA
  #undef GAPB
  #undef EX
  #undef KRD
  #undef STEP
  #undef ENDW
  {auto rr=__builtin_amdgcn_permlane32_swap(__float_as_uint(l_reg),__float_as_uint(l_reg),false,false);l_reg=__uint_as_float(rr[0])+__uint_as_float(rr[1]);}
  if(hi==0)wsf[32+r32]=l_reg;asm volatile("s_waitcnt lgkmcnt(0)":::"memory");
  float rli[16];
  #pragma unroll
  for(int r=0;r<16;++r)rli[r]=__builtin_amdgcn_rcpf(wsf[32+crow(r,hi)]);
  bf16*Ow=Ou+(long)(wid*QBLK)*opitch;
  { bf16*stg=(bf16*)(shm+LDS_OST128)+wid*4096;
    #pragma unroll
    for(int r=0;r<16;++r){const int orow=crow(r,hi);
      #pragma unroll
      for(int d0=0;d0<4;++d0)stg[orow*128+d0*32+r32]=__float2bfloat16(o[d0][r]*rli[r]);}
    asm volatile("s_waitcnt lgkmcnt(0)":::"memory");
    #pragma unroll
    for(int i=0;i<8;++i){const int row=i*4+(lane>>4),ch=lane&15; const u32x4 v=*(const u32x4*)(stg+row*128+ch*8); ATTN_STORE16(Ow+(long)row*opitch+ch*8,v);} }
  asm volatile("s_waitcnt lgkmcnt(0)\n\ts_barrier":::"memory");
  #undef DMA_K
  #undef DMA_V
  #undef CMASK
  #undef START
  #undef RESC
  #undef ROT
}
constexpr int ATTN_LDS_BYTES=LDS_BYTES;
#undef SBAR
#undef WAIT_BAR
}

constexpr int NB = 4, SEQ = 8192, CTXL = 256, PB = SEQ + CTXL, R = NB * PB, D = 1024, DFF = 4096, DEPTH = 4;
constexpr int NP_EV = 2560, NP_OD = 1536;
constexpr float EPS = 1e-6f;
constexpr float C2 = 0.125f * 1.4426950408889634f;
constexpr int EQ = 0, EK = 256, EVV = 512, EG = 1024, EGQ = 1536, EGK = 2048, EGV = 2176, ELR = 2304;
constexpr int ODQ = 0, ODK = 512, ODV = 1024;
constexpr int NWAVES = 8, NTHR = 512;
constexpr int LDS_BYTES = 163840, LDS_MISC = 163840 - 256;

constexpr size_t MiB = 1u << 20;
constexpr size_t WS_CTL = 0, CTL_ZERO_BYTES = 1 * MiB;
constexpr size_t WS_MOD = 1 * MiB;
constexpr size_t WS_TAB = 2 * MiB;
constexpr size_t WS_HID = 3 * MiB;
constexpr size_t WS_XB = 36 * MiB;
constexpr size_t WS_W = 12 * MiB, W_IN = 0, W_OUT = 6 * MiB, W_1 = 8 * MiB, W_2 = 16 * MiB;
constexpr size_t WS_A1 = 108 * MiB;
constexpr size_t WS_Y = 174 * MiB;
constexpr size_t WS_PH = 240 * MiB;
constexpr size_t WS_OGLA = WS_PH + 165 * MiB;
constexpr size_t WS_HF = WS_PH + 198 * MiB;
constexpr size_t WS_SLAB = 504 * MiB;
constexpr size_t WS_END = 512 * MiB;
constexpr int CW_BAR = 4096;

struct Args { const float* in[27]; float* out; unsigned char* ws; int ph_lo, ph_hi; };
enum { I_X = 0, I_C, I_CTX, I_CCTX, I_WADA, I_BADA, I_NORMG, I_W1, I_W2, I_EVWIN, I_EVWLR, I_EVBLR, I_EVGLAG, I_EVQKG, I_EVWOUT,
       I_ODWIN, I_ODCONVW, I_ODCONVB, I_FW1, I_FB1, I_FW2, I_FB2, I_FW3, I_HYBIAS, I_LAM, I_DIFFG, I_ODWOUT };

typedef const __attribute__((address_space(4))) Args* KA;
__device__ __forceinline__ KA ka_launder(KA a) { asm volatile("" : "+s"(a)); return a; }
__device__ __forceinline__ int otid_(int wv) { int l; asm volatile("v_mbcnt_lo_u32_b32 %0, -1, 0\n\tv_mbcnt_hi_u32_b32 %0, -1, %0" : "=v"(l)); return (wv << 6) | l; }
#define otid() otid_(wv_)
__device__ __forceinline__ int obx() { int b = blockIdx.x; asm volatile("" : "+s"(b)); return b; }
__device__ __forceinline__ float bf2f(bf16 v) { return __builtin_bit_cast(float, (unsigned)v << 16); }
template <int CTRL> __device__ __forceinline__ float dpp_mov(float v) { return __builtin_bit_cast(float, __builtin_amdgcn_update_dpp(0, __builtin_bit_cast(int, v), CTRL, 0xF, 0xF, false)); }
__device__ __forceinline__ float sum16(float v) {
    v += dpp_mov<0xB1>(v);
    v += dpp_mov<0x4E>(v);
    v += dpp_mov<0x141>(v);
    v += dpp_mov<0x140>(v);
    return v;
}
__device__ __forceinline__ float sum_rows4(float v) {
    const unsigned u = __builtin_bit_cast(unsigned, v);
    auto a = __builtin_amdgcn_permlane16_swap(u, u, false, false);
    const float w = __builtin_bit_cast(float, (unsigned)a[0]) + __builtin_bit_cast(float, (unsigned)a[1]);
    const unsigned uw = __builtin_bit_cast(unsigned, w);
    auto b = __builtin_amdgcn_permlane32_swap(uw, uw, false, false);
    return __builtin_bit_cast(float, (unsigned)b[0]) + __builtin_bit_cast(float, (unsigned)b[1]);
}
__device__ __forceinline__ float wave_sum(float v) { return sum_rows4(sum16(v)); }
__device__ __forceinline__ float rl(float v, int k) { return __builtin_bit_cast(float, __builtin_amdgcn_readlane(__builtin_bit_cast(int, v), k)); }
__device__ __forceinline__ float siluf(float v) { return v / (1.f + __expf(-v)); }
__device__ __forceinline__ float lam_init_of(int layer) { return 0.8f - 0.6f * expf(-0.3f * (float)layer); }
__device__ __forceinline__ const float* xin_ptr(KA a, int r) {
    const int b = r / PB, p = r - b * PB;
    return p < CTXL ? a->in[I_CTX] + (size_t)(b * CTXL + p) * D : a->in[I_X] + (size_t)(b * SEQ + (p - CTXL)) * D;
}
__device__ __forceinline__ int row_cls(int r) { const int b = r / PB, p = r - b * PB; return p < CTXL ? 4 : b; }

__device__ __forceinline__ void transpose_item(const float* W, int K, int N, int src_n0, bf16* WT, int dst_n0, int k0, LAS float* scr, int lane) {
    if (src_n0 < 0) {
#pragma unroll
        for (int j = 0; j < 4; ++j) { const int n = (lane >> 3) + 8 * j; *(GAS v4u*)(WT + (size_t)(dst_n0 + n) * K + k0 + 8 * (lane & 7)) = (v4u){0u, 0u, 0u, 0u}; }
        return;
    }
#pragma unroll 8
    for (int i = 0; i < 32; ++i) { const int kk = 2 * i + (lane >> 5); scr[kk * 33 + (lane & 31)] = W[(size_t)(k0 + kk) * N + src_n0 + (lane & 31)]; }
    LDS_WAIT(); asm volatile("" ::: "memory");
    const int c = lane & 7;
#pragma unroll
    for (int j = 0; j < 4; ++j) { const int n = (lane >> 3) + 8 * j; const LAS float* s = scr + (8 * c) * 33 + n;
        v4u o; o.x = pk2(s[0 * 33], s[1 * 33]); o.y = pk2(s[2 * 33], s[3 * 33]); o.z = pk2(s[4 * 33], s[5 * 33]); o.w = pk2(s[6 * 33], s[7 * 33]);
        *(GAS v4u*)(WT + (size_t)(dst_n0 + n) * K + k0 + 8 * c) = o; }
    LDS_WAIT(); asm volatile("" ::: "memory");
}
__device__ __forceinline__ int ev_src_col(int j) {
    if (j < 1536) return j;
    if (j < 2304) { const int tile = j >> 8, pb = (j & 255) >> 5, bj = pb >> 2, wc = pb & 3;
        return (tile << 8) + (2 * wc + bj) * 32 + 32; }
    if (j < 2336) return j - 768; return -1;
}
__device__ __forceinline__ void convert_layer_weights(int wv_, KA a, int l, int mask, LAS unsigned char* lds, int rank, int nranks) {
    const int tid = otid(), lane = tid & 63, wave = __builtin_amdgcn_readfirstlane(tid >> 6);
    const int gw = rank * NWAVES + wave, NGW = nranks * NWAVES;
    LAS float* scr = (LAS float*)(lds + 49152 + wave * 8448);
    const int odd = l & 1, pr = l >> 1; unsigned char* wl = a->ws + WS_W;
    const int n_in = (mask & 1) ? (odd ? 16 * 96 : 16 * 80) : 0, n_o = (mask & 2) ? 16 * 32 : 0, n_1 = (mask & 4) ? 16 * 128 : 0, n_2 = (mask & 8) ? 64 * 32 : 0;
    for (int it = gw; it < n_in + n_o + n_1 + n_2; it += NGW) {
        int r = it;
        if (r < n_in) { const int nblk = odd ? 96 : 80, kb = r / nblk, nb = r % nblk;
            if (odd) transpose_item(a->in[I_ODWIN] + (size_t)pr * 1024 * 3072, 1024, 3072, nb * 32, (bf16*)(wl + W_IN), nb * 32, kb * 64, scr, lane);
            else     transpose_item(a->in[I_EVWIN] + (size_t)pr * 1024 * 2336, 1024, 2336, ev_src_col(nb * 32), (bf16*)(wl + W_IN), nb * 32, kb * 64, scr, lane);
            continue; }
        r -= n_in;
        if (r < n_o) { const int kb = r / 32, nb = r % 32; transpose_item((odd ? a->in[I_ODWOUT] : a->in[I_EVWOUT]) + (size_t)pr * 1024 * 1024, 1024, 1024, nb * 32, (bf16*)(wl + W_OUT), nb * 32, kb * 64, scr, lane); continue; }
        r -= n_o;
        if (r < n_1) { const int kb = r / 128, nb = r % 128; transpose_item(a->in[I_W1] + (size_t)l * 1024 * 4096, 1024, 4096, nb * 32, (bf16*)(wl + W_1), nb * 32, kb * 64, scr, lane); continue; }
        r -= n_1;
        { const int kb = r / 32, nb = r % 32; transpose_item(a->in[I_W2] + (size_t)l * 4096 * 1024, 4096, 1024, nb * 32, (bf16*)(wl + W_2), nb * 32, kb * 64, scr, lane); }
    }
}
__device__ __forceinline__ void p0a_prologue(int wv_, KA a, LAS unsigned char* lds) {
    const int tid = otid(), lane = tid & 63, wave = __builtin_amdgcn_readfirstlane(tid >> 6);
    const int gw = blockIdx.x * NWAVES + wave, NGW = gridDim.x * NWAVES;
    LAS float* sc = (LAS float*)lds;
    LAS float* red = (LAS float*)(lds + 20480);
    for (int i = tid; i < 5 * 1024; i += NTHR) { const int cls = i >> 10, k = i & 1023; const float v = cls < 4 ? a->in[I_C][cls * 1024 + k] : a->in[I_CCTX][k]; sc[i] = v / (1.f + expf(-v)); }
    __syncthreads();
    float* MOD = (float*)(a->ws + WS_MOD);
    for (int item = blockIdx.x; item < 4 * 48; item += gridDim.x) {
        const int l = item / 48, nb = item % 48;
        const float* W = a->in[I_WADA] + (size_t)l * 1024 * 6144 + nb * 128 + lane * 2;
        float acc[5][2];
#pragma unroll
        for (int c = 0; c < 5; ++c) { acc[c][0] = 0.f; acc[c][1] = 0.f; }
#pragma unroll 4
        for (int kk = 0; kk < 128; ++kk) { const int k = wave * 128 + kk; const float2 w = *(const float2*)(W + (size_t)k * 6144);
#pragma unroll
            for (int c = 0; c < 5; ++c) { const float s = sc[c * 1024 + k]; acc[c][0] += s * w.x; acc[c][1] += s * w.y; } }
#pragma unroll
        for (int c = 0; c < 5; ++c) { red[(wave * 5 + c) * 128 + lane * 2] = acc[c][0]; red[(wave * 5 + c) * 128 + lane * 2 + 1] = acc[c][1]; }
        __syncthreads();
        for (int o = tid; o < 640; o += NTHR) { const int c = o >> 7, cc = o & 127; float s = a->in[I_BADA][l * 6144 + nb * 128 + cc];
#pragma unroll
            for (int w = 0; w < 8; ++w) s += red[(w * 5 + c) * 128 + cc];
            MOD[(size_t)(l * 5 + c) * 6144 + nb * 128 + cc] = s; }
        __syncthreads();
    }
    convert_layer_weights(wv_, a, 0, 15, lds, blockIdx.x, gridDim.x);
    {
        float* tab = (float*)(a->ws + WS_TAB);
        const int gt = blockIdx.x * NTHR + tid;
        if (gt < 3072) { const int pos = gt < 2048 ? gt / 16 : (gt - 2048) / 16, i = gt & 15;
            const float inv = powf(10000.f, -(float)i / 16.f), ang = (float)pos * inv;
            tab[gt * 2] = cosf(ang); tab[gt * 2 + 1] = sinf(ang); }
        if (gw == NGW - 1) {
#pragma unroll
            for (int j = 0; j < 2; ++j) { const float* lp = a->in[I_LAM] + j * 256;
                const float s1 = wave_sum(lp[lane] * lp[64 + lane]), s2 = wave_sum(lp[128 + lane] * lp[192 + lane]);
                if (lane == 0) tab[8192 + j] = expf(s1) - expf(s2) + lam_init_of(2 * j + 1); }
        }
    }
    for (int it = gw; it < 2 * PB; it += NGW) {
        const int j = it / PB, q = it % PB; const bool isctx = q >= SEQ; const int pos = isctx ? q - SEQ : q, L = isctx ? CTXL : SEQ;
        const float t = (float)pos / (float)(L - 1), w = 2.f * 3.14159265358979323846f * (float)pos / (float)L;
        float z = 0.f;
        if (lane == 0) z = t;
        else if (lane <= 16) { const float band = 1e-4f + (float)(lane - 1) * ((15.f - 1e-4f) / 15.f); z = cosf(w * band); }
        else if (lane <= 32) { const float band = 1e-4f + (float)(lane - 17) * ((15.f - 1e-4f) / 15.f); z = -sinf(w * band); }
        const float* w1 = a->in[I_FW1] + j * 33 * 64; const float* w2 = a->in[I_FW2] + j * 64 * 64;
        float h1 = a->in[I_FB1][j * 64 + lane];
#pragma unroll
        for (int e = 0; e < 33; ++e) h1 += rl(z, e) * w1[e * 64 + lane];
        h1 = sinf(h1);
        float h2 = a->in[I_FB2][j * 64 + lane];
#pragma unroll
        for (int e = 0; e < 64; ++e) h2 += rl(h1, e) * w2[e * 64 + lane];
        h2 = sinf(h2);
        float* HID = (float*)(a->ws + WS_HID) + (isctx ? (size_t)(2 * SEQ + j * CTXL + pos) * 64 : (size_t)(j * SEQ + pos) * 64);
        HID[lane] = h2;
    }
}

struct Row16 { f32x4 v[4]; };
__device__ __forceinline__ Row16 ld_row_f32(const float* p, int lane) { Row16 r; const GAS f32x4* q = (const GAS f32x4*)p + lane;
#pragma unroll
    for (int j = 0; j < 4; ++j) r.v[j] = q[64 * j];
    return r; }
__device__ __forceinline__ Row16 ld_row_bf16(const bf16* p, int lane) { Row16 r; const GAS unsigned long long* q = (const GAS unsigned long long*)p + lane;
#pragma unroll
    for (int j = 0; j < 4; ++j) { const unsigned long long w = q[64 * j]; const unsigned lo = (unsigned)w, hi = (unsigned)(w >> 32);
        r.v[j] = (f32x4){__builtin_bit_cast(float, lo << 16), __builtin_bit_cast(float, lo & 0xffff0000u), __builtin_bit_cast(float, hi << 16), __builtin_bit_cast(float, hi & 0xffff0000u)}; }
    return r; }
__device__ __forceinline__ void st_row_f32(float* p, const Row16& r, int lane) { GAS f32x4* q = (GAS f32x4*)p + lane;
#pragma unroll
    for (int j = 0; j < 4; ++j) q[64 * j] = r.v[j]; }
__device__ __forceinline__ void st_row_bf16(bf16* p, const Row16& r, int lane) { GAS unsigned long long* q = (GAS unsigned long long*)p + lane;
#pragma unroll
    for (int j = 0; j < 4; ++j) q[64 * j] = (unsigned long long)pk2(r.v[j].x, r.v[j].y) | ((unsigned long long)pk2(r.v[j].z, r.v[j].w) << 32); }
__device__ __forceinline__ float row_sumsq(const Row16& r) { float s = 0.f;
#pragma unroll
    for (int j = 0; j < 4; ++j) s += (r.v[j].x * r.v[j].x + r.v[j].y * r.v[j].y) + (r.v[j].z * r.v[j].z + r.v[j].w * r.v[j].w);
    return wave_sum(s); }
__device__ __forceinline__ void norm_mod_store(const Row16& x, const float* g, const float* shift, const float* scale, bf16* dst, int lane) {
    const float rstd = 1.f / sqrtf(row_sumsq(x) * (1.f / D) + EPS);
    const Row16 G = ld_row_f32(g, lane), SH = ld_row_f32(shift, lane), SC = ld_row_f32(scale, lane); Row16 o;
#pragma unroll
    for (int j = 0; j < 4; ++j) o.v[j] = (x.v[j] * rstd) * G.v[j] * (SC.v[j] + 1.f) + SH.v[j];
    st_row_bf16(dst, o, lane);
}
__device__ __forceinline__ void p0b_first_norm(int wv_, KA a) {
    const int tid_o = otid(), lane = tid_o & 63, wave = tid_o >> 6, gw = blockIdx.x * NWAVES + wave, NGW = gridDim.x * NWAVES;
    const float* MOD = (const float*)(a->ws + WS_MOD); bf16* A1 = (bf16*)(a->ws + WS_A1);
    for (int rb = gw; rb < R; rb += 2 * NGW) {
        const int r2 = rb + NGW < R ? rb + NGW : rb;
        const Row16 xa = ld_row_f32(xin_ptr(a, rb), lane), xb = ld_row_f32(xin_ptr(a, r2), lane);
        { const float* m = MOD + (size_t)(0 * 5 + row_cls(rb)) * 6144; norm_mod_store(xa, a->in[I_NORMG] + 0, m + 0, m + 1024, A1 + (size_t)rb * D, lane); }
        if (rb + NGW < R) { const float* m = MOD + (size_t)(0 * 5 + row_cls(r2)) * 6144; norm_mod_store(xb, a->in[I_NORMG] + 0, m + 0, m + 1024, A1 + (size_t)r2 * D, lane); }
    }
}
typedef unsigned long long u64_t;
template <bool FIRST> struct RawRow { u64_t xb[FIRST ? 1 : 4]; f32x4 xf[FIRST ? 4 : 1]; u64_t y1[4], y2[4]; };
__device__ __forceinline__ Row16 cvt_raw(const u64_t (&q)[4]) { Row16 r;
#pragma unroll
    for (int j = 0; j < 4; ++j) { const unsigned lo = (unsigned)q[j], hi = (unsigned)(q[j] >> 32);
        r.v[j] = (f32x4){__builtin_bit_cast(float, lo << 16), __builtin_bit_cast(float, lo & 0xffff0000u), __builtin_bit_cast(float, hi << 16), __builtin_bit_cast(float, hi & 0xffff0000u)}; }
    return r; }
template <bool FIRST> __device__ __forceinline__ void rowwise_body(int wv_, KA a, int layer, int which, LAS unsigned char* lds) {
    const int tid = otid(), lane = tid & 63, wave = tid >> 6, gw = blockIdx.x * NWAVES + wave;
    const float* MOD = (const float*)(a->ws + WS_MOD); bf16* A1 = (bf16*)(a->ws + WS_A1); const bf16* Y = (const bf16*)(a->ws + WS_Y); const bf16* SLAB = (const bf16*)(a->ws + WS_SLAB);
    bf16* XB = (bf16*)(a->ws + WS_XB);
    const float* ng = a->in[I_NORMG] + (size_t)layer * 4 * D;
    const bool lastl = layer == DEPTH - 1, lastp = lastl && which == 1;
    constexpr int RPW = 17;
    const int rbl = blockIdx.x * (NWAVES * RPW), rbh = rbl + NWAVES * RPW - 1;
    const int clsA = row_cls(rbl < R ? rbl : R - 1), clsB = row_cls(rbh < R ? rbh : R - 1);
    LAS f32x4* vec = (LAS f32x4*)lds;
    for (int idx = tid; idx < 2 * 7 * 256; idx += NTHR) { const int c = idx / (7 * 256), v = (idx >> 8) % 7, q = idx & 255, cls = c ? clsB : clsA;
        const float* m = MOD + (size_t)(layer * 5 + cls) * 6144; const float* m2 = MOD + (size_t)((lastp || !which ? layer : layer + 1) * 5 + cls) * 6144;
        const float* src = v == 0 ? ng + 1 * D : v == 1 ? ng + 3 * D : v == 2 ? (which ? ng + 4 * D : ng + 2 * D) : v == 3 ? m + 2 * 1024 : v == 4 ? m + 5 * 1024 : v == 5 ? (which ? m2 + 0 : m + 3 * 1024) : (which ? m2 + 1024 : m + 4 * 1024);
        vec[idx] = *(const f32x4*)(src + 4 * q); }
    __syncthreads();
    const int r0 = gw * RPW, r1 = r0 + RPW < R ? r0 + RPW : R;
    if (r0 >= R) return;
    auto load_raw = [&](RawRow<FIRST>& q, int r) {
        if constexpr (FIRST) { const GAS f32x4* xp = (const GAS f32x4*)xin_ptr(a, r) + lane;
#pragma unroll
            for (int j = 0; j < 4; ++j) q.xf[j] = xp[64 * j]; }
        else { const GAS u64_t* xp = (const GAS u64_t*)(XB + (size_t)r * D) + lane;
#pragma unroll
            for (int j = 0; j < 4; ++j) q.xb[j] = xp[64 * j]; }
        const GAS u64_t* yp = (const GAS u64_t*)(Y + (size_t)r * D) + lane;
#pragma unroll
        for (int j = 0; j < 4; ++j) q.y1[j] = yp[64 * j];
        if (which) { const GAS u64_t* zp = (const GAS u64_t*)(A1 + (size_t)r * D) + lane;
#pragma unroll
            for (int j = 0; j < 4; ++j) q.y2[j] = zp[64 * j]; } };
    RawRow<FIRST> q0, q1, q2;
    load_raw(q0, r0); q1 = q0; q2 = q0;
    if (r0 + 1 < r1) load_raw(q1, r0 + 1);
    for (int r = r0; r < r1; ++r) {
        if (r + 2 < r1) load_raw(q2, r + 2);
        const int b = r / PB, p = r - b * PB, cls = p < CTXL ? 4 : b;
        if (!(lastl && cls == 4)) {
            const LAS f32x4* vt = vec + (cls == clsA ? 0 : 7 * 256) + lane;
            Row16 x;
            if constexpr (FIRST) {
#pragma unroll
                for (int jj = 0; jj < 4; ++jj) x.v[jj] = q0.xf[jj]; }
            else x = cvt_raw(q0.xb);
            const Row16 y1 = cvt_raw(q0.y1);
            const float rstd1 = 1.f / sqrtf(row_sumsq(y1) * (1.f / D) + EPS);
#pragma unroll
            for (int jj = 0; jj < 4; ++jj) x.v[jj] = x.v[jj] + vt[3 * 256 + 64 * jj] * ((y1.v[jj] * rstd1) * vt[0 * 256 + 64 * jj]);
            bool done = false;
            if (which) {
                Row16 y2;
                if (p < CTXL) { y2 = ld_row_bf16(SLAB + (size_t)(b * CTXL + p) * D, lane);
#pragma unroll
                    for (int k = 1; k < 4; ++k) { const Row16 sk = ld_row_bf16(SLAB + (size_t)k * 1024 * D + (size_t)(b * CTXL + p) * D, lane);
#pragma unroll
                        for (int jj = 0; jj < 4; ++jj) y2.v[jj] = y2.v[jj] + sk.v[jj]; } }
                else y2 = cvt_raw(q0.y2);
                const float rstd2 = 1.f / sqrtf(row_sumsq(y2) * (1.f / D) + EPS);
#pragma unroll
                for (int jj = 0; jj < 4; ++jj) x.v[jj] = x.v[jj] + vt[4 * 256 + 64 * jj] * ((y2.v[jj] * rstd2) * vt[1 * 256 + 64 * jj]);
                if (lastp) { st_row_f32(a->out + (size_t)(b * SEQ + (p - CTXL)) * D, x, lane); done = true; }
                else st_row_bf16(XB + (size_t)r * D, x, lane);
            }
            if (!done) {
                const float rs2 = 1.f / sqrtf(row_sumsq(x) * (1.f / D) + EPS); Row16 o;
#pragma unroll
                for (int jj = 0; jj < 4; ++jj) o.v[jj] = (x.v[jj] * rs2) * vt[2 * 256 + 64 * jj] * (vt[6 * 256 + 64 * jj] + 1.f) + vt[5 * 256 + 64 * jj];
                st_row_bf16(A1 + (size_t)r * D, o, lane);
            }
        }
        q0 = q1; q1 = q2;
    }
}
__device__ __forceinline__ void rowwise_post(int wv_, KA a, int layer, int which, LAS unsigned char* lds) {
    if (layer == 0) rowwise_body<true>(wv_, a, layer, which, lds); else rowwise_body<false>(wv_, a, layer, which, lds);
}

__device__ __forceinline__ void attn_phase_fast(int wv_, KA a, bool odd, char* lds_generic, bool skip_ctx_q = false) {
    const int G = gridDim.x, bx = blockIdx.x; const int vcu = (G % 8 == 0) ? (bx % 8) * (G / 8) + bx / 8 : bx;
    const int nvh = 8, nheavy = 4 * nvh * 32, ntot = nheavy + (skip_ctx_q ? 0 : 4 * nvh);
    unsigned char* ws = a->ws;
    const attn_body::bf16* P = (const attn_body::bf16*)(ws + WS_PH);
    for (int u = vcu; u < ntot; u += G) {
        int b, vh, panel;
        if (u < nheavy) { const int i = u >> 8, v = u & 255, xcd = v >> 5; b = xcd >> 1; vh = (xcd & 1) * (nvh >> 1) + i; panel = (v & 31) + 1; }
        else { const int lu = u - nheavy; b = lu / nvh; vh = lu % nvh; panel = 0; }
        const size_t row0 = (size_t)b * PB, qrow = row0 + 256 * panel; const int NT = panel == 0 ? CTXL / 64 : PB / 64;
        if (!odd) { const int kvh = vh >> 2;
            attn_body::attn_unit<8>(otid(), P + qrow * NP_EV + EGQ + vh * 64, NP_EV, P + row0 * NP_EV + EGK + kvh * 64, P + row0 * NP_EV + EGV + kvh * 64, NP_EV,
                                    (attn_body::bf16*)(ws + WS_A1) + qrow * D + 512 + vh * 64, D, NT, lds_generic); }
        else { const int hd = vh >> 1, c = vh & 1;
            attn_body::attn_unit128<8>(otid(), P + qrow * NP_OD + ODQ + hd * 128 + c * 64, NP_OD, P + row0 * NP_OD + ODK + hd * 128 + c * 64, P + row0 * NP_OD + ODV + hd * 128, NP_OD,
                                       (attn_body::bf16*)(ws + WS_Y) + qrow * D + hd * 256 + c * 128, D, NT, lds_generic); }
    }
}

constexpr size_t WS_UT = WS_Y, WS_S0T = WS_PH + 165 * MiB, WS_DEC = 504 * MiB;
constexpr int GQP = 144, GVP = 272, GIMG_OFF = 8 * (64 * GQP) + 2 * (64 * GVP) + 2048;
typedef short gbf16x8 __attribute__((ext_vector_type(8)));
typedef short gs16x4 __attribute__((ext_vector_type(4)));
typedef float gf32x4 __attribute__((ext_vector_type(4)));
__device__ __forceinline__ gs16x4 gtr(const LAS unsigned char* p) { return __builtin_bit_cast(gs16x4, __builtin_amdgcn_ds_read_tr16_b64_v4i16((LAS gs16x4*)p)); }
__device__ __forceinline__ gbf16x8 gcat(gs16x4 lo, gs16x4 hi) { return (gbf16x8){lo[0], lo[1], lo[2], lo[3], hi[0], hi[1], hi[2], hi[3]}; }
__device__ __forceinline__ float log_sigmoid_fast(float x) { return fminf(x, 0.f) - __logf(1.f + __expf(-fabsf(x))); }
__device__ __forceinline__ float rls(float v, int k) { return __builtin_bit_cast(float, __builtin_amdgcn_readlane(__builtin_bit_cast(int, v), k)); }

__device__ __forceinline__ void gla_prep_b(KA a, int j, const bf16* P, size_t row0, int head, int pdir, int role, int wave, int lane, LAS float* xch, float (&bv)[2][4][4], float (&tall)[4]) {
    const int g = lane >> 4, l15 = lane & 15; const gbf16x8 zero8 = {0, 0, 0, 0, 0, 0, 0, 0};
    gbf16x8 lrA[2];
#pragma unroll
    for (int tt = 0; tt < 2; ++tt) { lrA[tt] = zero8; if (g < 2) lrA[tt] = *(const gbf16x8*)(P + (row0 + 32 * role + 16 * tt + l15) * NP_EV + ELR + pdir * 16 + 8 * g); }
    gf32x4 gk[2][4];
#pragma unroll
    for (int dt = 0; dt < 4; ++dt) {
        unsigned hw[4] = {0u, 0u, 0u, 0u}, lw[4] = {0u, 0u, 0u, 0u};
        if (g < 2) {
#pragma unroll
            for (int e = 0; e < 8; ++e) { const float w = a->in[I_EVWLR][((size_t)(j * 2 + pdir) * 16 + 8 * g + e) * 256 + head * 64 + 16 * dt + l15];
                const unsigned h = f2bf(w), l = f2bf(w - __builtin_bit_cast(float, h << 16)); hw[e >> 1] |= h << (16 * (e & 1)); lw[e >> 1] |= l << (16 * (e & 1)); } }
        const gbf16x8 wh = __builtin_bit_cast(gbf16x8, (v4u){hw[0], hw[1], hw[2], hw[3]}), wlo = __builtin_bit_cast(gbf16x8, (v4u){lw[0], lw[1], lw[2], lw[3]});
        const float bl = a->in[I_EVBLR][(j * 2 + pdir) * 256 + head * 64 + 16 * dt + l15];
#pragma unroll
        for (int tt = 0; tt < 2; ++tt) { gf32x4 acc = (gf32x4){bl, bl, bl, bl};
            acc = __builtin_amdgcn_mfma_f32_16x16x32_bf16(lrA[tt], wh, acc, 0, 0, 0); acc = __builtin_amdgcn_mfma_f32_16x16x32_bf16(lrA[tt], wlo, acc, 0, 0, 0); gk[tt][dt] = acc; }
    }
    float tot[4];
#pragma unroll
    for (int dt = 0; dt < 4; ++dt) { float t2 = 0.f;
#pragma unroll
        for (int tt = 0; tt < 2; ++tt)
#pragma unroll
            for (int r = 0; r < 4; ++r) { const float x = gk[tt][dt][r]; const float e = __builtin_amdgcn_exp2f(-fabsf(x) * 1.4426950408889634f);
                const float la = (fminf(x, 0.f) - 0.6931471805599453f * __builtin_amdgcn_logf(1.f + e)) * (1.f / 16.f); gk[tt][dt][r] = la; t2 += la; }
        tot[dt] = sum_rows4(t2); }
    if (g == 0) {
#pragma unroll
        for (int dt = 0; dt < 4; ++dt) xch[wave * 64 + 16 * dt + l15] = tot[dt]; }
    gbf16x8 tri[2];
#pragma unroll
    for (int tt = 0; tt < 2; ++tt) { unsigned w[4] = {0u, 0u, 0u, 0u}; const int tl = 16 * tt + l15;
#pragma unroll
        for (int e = 0; e < 8; ++e) { const int tp = e < 4 ? 4 * g + e : 16 + 4 * g + (e - 4); const bool keep = pdir == 0 ? (tp <= tl) : (tp >= tl); w[e >> 1] |= keep ? (0x3F80u << (16 * (e & 1))) : 0u; }
        tri[tt] = __builtin_bit_cast(gbf16x8, (v4u){w[0], w[1], w[2], w[3]}); }
    gf32x4 bl2[2][4];
#pragma unroll
    for (int dt = 0; dt < 4; ++dt) { unsigned hw[4], lw[4];
#pragma unroll
        for (int e = 0; e < 8; e += 2) { const float x0 = gk[e >> 2][dt][e & 3], x1 = gk[e >> 2][dt][(e & 3) + 1];
            const unsigned h0 = f2bf(x0), h1 = f2bf(x1); hw[e >> 1] = h0 | (h1 << 16);
            lw[e >> 1] = f2bf(x0 - __builtin_bit_cast(float, h0 << 16)) | (f2bf(x1 - __builtin_bit_cast(float, h1 << 16)) << 16); }
        const gbf16x8 bh = __builtin_bit_cast(gbf16x8, (v4u){hw[0], hw[1], hw[2], hw[3]}), blo = __builtin_bit_cast(gbf16x8, (v4u){lw[0], lw[1], lw[2], lw[3]});
#pragma unroll
        for (int tt = 0; tt < 2; ++tt) { gf32x4 acc = (gf32x4){0.f, 0.f, 0.f, 0.f};
            acc = __builtin_amdgcn_mfma_f32_16x16x32_bf16(tri[tt], bh, acc, 0, 0, 0); acc = __builtin_amdgcn_mfma_f32_16x16x32_bf16(tri[tt], blo, acc, 0, 0, 0); bl2[tt][dt] = acc; } }
    __syncthreads();
    const bool need_other = pdir == 0 ? (role == 1) : (role == 0);
#pragma unroll
    for (int dt = 0; dt < 4; ++dt) { const float other = xch[(wave ^ 1) * 64 + 16 * dt + l15]; tall[dt] = tot[dt] + other; const float add = need_other ? other : 0.f;
#pragma unroll
        for (int tt = 0; tt < 2; ++tt)
#pragma unroll
            for (int r = 0; r < 4; ++r) bv[tt][dt][r] = bl2[tt][dt][r] + add; }
}
__device__ __forceinline__ void gla_state_phase(int wv_, KA a, int j, LAS unsigned char* lds) {
    const int tid = otid(), lane = tid & 63, wave = __builtin_amdgcn_readfirstlane(tid >> 6);
    const int hl = wave >> 2, dir = (wave >> 1) & 1, role = wave & 1, g = lane >> 4, l15 = lane & 15;
    unsigned char* ws = a->ws; const bf16* P = (const bf16*)(ws + WS_PH);
    LAS unsigned char* kimg = lds + (hl * 2 + dir) * (64 * GQP); LAS unsigned char* vimg = lds + 4 * (64 * GQP) + hl * (64 * GVP); LAS float* xch = (LAS float*)(lds + 4 * (64 * GQP) + 2 * (64 * GVP));
    for (int unit = blockIdx.x; unit < NB * 132 * 2; unit += gridDim.x) {
        const int b = unit / 264, rem = unit % 264, cidx = rem >> 1, hp = rem & 1, head = hp * 2 + hl; const size_t row0 = (size_t)b * PB + cidx * 64;
        const int chain = (b * 4 + head) * 2 + dir;
        __syncthreads();
        { v4u vv[4], kk[2];
#pragma unroll
            for (int it = 0; it < 4; ++it) { const int ch = tid + it * NTHR, hh = ch >> 10, t = (ch >> 4) & 63, c16 = ch & 15; vv[it] = *(const v4u*)(P + (row0 + t) * NP_EV + EVV + (hp * 2 + hh) * 128 + c16 * 8); }
#pragma unroll
            for (int it = 0; it < 2; ++it) { const int ch = tid + it * NTHR, hh = ch >> 9, t = (ch >> 3) & 63, c8 = ch & 7; kk[it] = *(const v4u*)(P + (row0 + t) * NP_EV + EK + (hp * 2 + hh) * 64 + c8 * 8); }
#pragma unroll
            for (int it = 0; it < 4; ++it) { const int ch = tid + it * NTHR, hh = ch >> 10, t = (ch >> 4) & 63, c16 = ch & 15; *(LAS v4u*)(lds + 4 * (64 * GQP) + hh * (64 * GVP) + t * GVP + c16 * 16) = vv[it]; }
#pragma unroll
            for (int it = 0; it < 2; ++it) { const int ch = tid + it * NTHR, hh = ch >> 9, t = (ch >> 3) & 63, c8 = ch & 7;
                *(LAS v4u*)(lds + (hh * 2) * (64 * GQP) + t * GQP + c8 * 16) = kk[it]; *(LAS v4u*)(lds + (hh * 2 + 1) * (64 * GQP) + t * GQP + c8 * 16) = kk[it]; } }
        float bv[2][4][4], tall[4];
        gla_prep_b(a, j, P, row0, head, dir, role, wave, lane, xch, bv, tall);
#pragma unroll
        for (int tt = 0; tt < 2; ++tt)
#pragma unroll
            for (int dt = 0; dt < 4; ++dt)
#pragma unroll
                for (int r = 0; r < 4; ++r) { const int t = 32 * role + 16 * tt + 4 * g + r, dk = 16 * dt + l15;
                    LAS bf16* kp = (LAS bf16*)(kimg + t * GQP + dk * 2);
                    *kp = (bf16)f2bf(bf2f(*kp) * __builtin_amdgcn_exp2f((tall[dt] - bv[tt][dt][r]) * 1.4426950408889634f)); }
        if (role == 0 && g == 0) {
#pragma unroll
            for (int dt = 0; dt < 4; ++dt) ((float*)(ws + WS_DEC))[((size_t)chain * 132 + cidx) * 64 + 16 * dt + l15] = __builtin_amdgcn_exp2f(tall[dt] * 1.4426950408889634f); }
        __syncthreads();
        gf32x4 acc[4][4];
#pragma unroll
        for (int x = 0; x < 4; ++x)
#pragma unroll
            for (int y = 0; y < 4; ++y) acc[x][y] = (gf32x4){0.f, 0.f, 0.f, 0.f};
        const int q = l15 >> 2, p4 = lane & 3;
#pragma unroll
        for (int ks = 0; ks < 2; ++ks) {
            gbf16x8 af[4], bfr[4];
#pragma unroll
            for (int x = 0; x < 4; ++x) { const LAS unsigned char* pa = kimg + (32 * ks + 8 * g + q) * GQP + (16 * x + 4 * p4) * 2; af[x] = gcat(gtr(pa), gtr(pa + 4 * GQP)); }
#pragma unroll
            for (int y = 0; y < 4; ++y) { const LAS unsigned char* pb = vimg + (32 * ks + 8 * g + q) * GVP + (64 * role + 16 * y + 4 * p4) * 2; bfr[y] = gcat(gtr(pb), gtr(pb + 4 * GVP)); }
#pragma unroll
            for (int x = 0; x < 4; ++x)
#pragma unroll
                for (int y = 0; y < 4; ++y) acc[x][y] = __builtin_amdgcn_mfma_f32_16x16x32_bf16(af[x], bfr[y], acc[x][y], 0, 0, 0);
        }
        bf16* UT = (bf16*)(ws + WS_UT) + ((size_t)chain * 132 + cidx) * 8192;
#pragma unroll
        for (int x = 0; x < 4; ++x)
#pragma unroll
            for (int y = 0; y < 4; ++y) { const int dv = 64 * role + 16 * y + l15, dk = 16 * x + 4 * g;
                *(unsigned long long*)(UT + dv * 64 + dk) = (unsigned long long)pk2(acc[x][y][0], acc[x][y][1]) | ((unsigned long long)pk2(acc[x][y][2], acc[x][y][3]) << 32); }
    }
}
__device__ __forceinline__ void gla_scan_phase(int wv_, KA a) {
    const int tid = otid(), lane = tid & 63, wave = tid >> 6;
    const int vt = (blockIdx.x + gridDim.x * wave) * 64 + lane;
    if (vt >= 32 * 1024) return;
    unsigned char* ws = a->ws;
    const int chain = vt >> 10, e = vt & 1023, dir = chain & 1;
    const bf16* UT = (const bf16*)(ws + WS_UT); bf16* S0T = (bf16*)(ws + WS_S0T); const float* DEC = (const float*)(ws + WS_DEC);
    float S[8];
#pragma unroll
    for (int i = 0; i < 8; ++i) S[i] = 0.f;
#pragma unroll 11
    for (int s = 0; s < 132; ++s) {
        const int cidx = dir == 0 ? s : (s < 4 ? 3 - s : 135 - s);
        const size_t off = ((size_t)chain * 132 + cidx) * 8192 + (size_t)e * 8;
        const v4u u = *(const v4u*)(UT + off);
        const f32x4 d0 = *(const f32x4*)(DEC + ((size_t)chain * 132 + cidx) * 64 + (e & 7) * 8), d1 = *(const f32x4*)(DEC + ((size_t)chain * 132 + cidx) * 64 + (e & 7) * 8 + 4);
        v4u o; o.x = pk2(S[0], S[1]); o.y = pk2(S[2], S[3]); o.z = pk2(S[4], S[5]); o.w = pk2(S[6], S[7]);
        *(v4u*)(S0T + off) = o;
        const unsigned uw[4] = {u.x, u.y, u.z, u.w}; const float dd[8] = {d0.x, d0.y, d0.z, d0.w, d1.x, d1.y, d1.z, d1.w};
#pragma unroll
        for (int i = 0; i < 8; ++i) { const float uv = __builtin_bit_cast(float, (i & 1) ? (uw[i >> 1] & 0xffff0000u) : (uw[i >> 1] << 16)); S[i] = S[i] * dd[i] + uv; }
    }
}
__device__ __forceinline__ void gla_output_phase(int wv_, KA a, int j, LAS unsigned char* lds, int skipmask = 0) {
    const int tid = otid(), lane = tid & 63, wave = __builtin_amdgcn_readfirstlane(tid >> 6);
    const int hl = wave >> 2, pdir = (wave >> 1) & 1, role = wave & 1, q4 = wave & 3, g = lane >> 4, l15 = lane & 15;
    unsigned char* ws = a->ws; const bf16* P = (const bf16*)(ws + WS_PH); bf16* MIX = (bf16*)(ws + WS_A1);
    LAS unsigned char* qimg0 = lds + (hl * 2) * (64 * GQP); LAS unsigned char* kimg0 = lds + (4 + hl * 2) * (64 * GQP); LAS unsigned char* vimg = lds + 8 * (64 * GQP) + hl * (64 * GVP);
    for (int unit = blockIdx.x; unit < NB * 132 * 2; unit += gridDim.x) {
        const int b = unit / 264, rem = unit % 264, cidx = rem >> 1, hp = rem & 1, head = hp * 2 + hl; const size_t row0 = (size_t)b * PB + cidx * 64;
        __syncthreads();
        gbf16x8 sfA[8][2], sfB[8][2];
        const bf16* S0f = (const bf16*)(ws + WS_S0T) + ((size_t)((b * 4 + head) * 2) * 132 + cidx) * 8192;
#pragma unroll
        for (int c = 0; c < 8; ++c)
#pragma unroll
            for (int ks = 0; ks < 2; ++ks) sfA[c][ks] = *(const gbf16x8*)(S0f + (16 * c + l15) * 64 + 32 * ks + 8 * g);
        { v4u vv[4], gg[4], qq2[2], kk[2];
#pragma unroll
            for (int it = 0; it < 4; ++it) { const int ch = tid + it * NTHR, hh = ch >> 10, t = (ch >> 4) & 63, c16 = ch & 15; const bf16* src = P + (row0 + t) * NP_EV + (hp * 2 + hh) * 128 + c16 * 8; vv[it] = *(const v4u*)(src + EVV); gg[it] = *(const v4u*)(src + EG); }
#pragma unroll
            for (int it = 0; it < 2; ++it) { const int ch = tid + it * NTHR, hh = ch >> 9, t = (ch >> 3) & 63, c8 = ch & 7; const bf16* src = P + (row0 + t) * NP_EV + (hp * 2 + hh) * 64 + c8 * 8; qq2[it] = *(const v4u*)(src + EQ); kk[it] = *(const v4u*)(src + EK); }
#pragma unroll
            for (int it = 0; it < 4; ++it) { const int ch = tid + it * NTHR, hh = ch >> 10, t = (ch >> 4) & 63, c16 = ch & 15;
                *(LAS v4u*)(lds + 8 * (64 * GQP) + hh * (64 * GVP) + t * GVP + c16 * 16) = vv[it]; *(LAS v4u*)(lds + GIMG_OFF + hh * (64 * GVP) + t * GVP + c16 * 16) = gg[it]; }
#pragma unroll
            for (int it = 0; it < 2; ++it) { const int ch = tid + it * NTHR, hh = ch >> 9, t = (ch >> 3) & 63, c8 = ch & 7;
                *(LAS v4u*)(lds + (hh * 2) * (64 * GQP) + t * GQP + c8 * 16) = qq2[it]; *(LAS v4u*)(lds + (hh * 2 + 1) * (64 * GQP) + t * GQP + c8 * 16) = qq2[it];
                *(LAS v4u*)(lds + (4 + hh * 2) * (64 * GQP) + t * GQP + c8 * 16) = kk[it]; *(LAS v4u*)(lds + (4 + hh * 2 + 1) * (64 * GQP) + t * GQP + c8 * 16) = kk[it]; } }
        {
            float bv[2][4][4], tall[4];
            gla_prep_b(a, j, P, row0, head, pdir, role, wave, lane, (LAS float*)(lds + 8 * (64 * GQP) + 2 * (64 * GVP)), bv, tall);
            LAS unsigned char* qi = qimg0 + pdir * (64 * GQP); LAS unsigned char* ki = kimg0 + pdir * (64 * GQP);
#pragma unroll
            for (int tt = 0; tt < 2; ++tt)
#pragma unroll
                for (int dt = 0; dt < 4; ++dt)
#pragma unroll
                    for (int r = 0; r < 4; ++r) { const int t = 32 * role + 16 * tt + 4 * g + r, dk = 16 * dt + l15;
                        const float e = __builtin_amdgcn_exp2f(bv[tt][dt][r] * 1.4426950408889634f);
                        LAS bf16* qp = (LAS bf16*)(qi + t * GQP + dk * 2); LAS bf16* kp = (LAS bf16*)(ki + t * GQP + dk * 2);
                        *qp = (bf16)f2bf(bf2f(*qp) * 0.125f * e);
                        *kp = (bf16)f2bf(bf2f(*kp) * __builtin_amdgcn_rcpf(e)); }
        }
        __syncthreads();
        gf32x4 o[8];
#pragma unroll
        for (int c = 0; c < 8; ++c) o[c] = (gf32x4){0.f, 0.f, 0.f, 0.f};
        const int qq = l15 >> 2, p4 = lane & 3;
#pragma unroll
        for (int c = 0; c < 8; ++c)
#pragma unroll
            for (int ks = 0; ks < 2; ++ks) sfB[c][ks] = *(const gbf16x8*)(S0f + (size_t)132 * 8192 + (16 * c + l15) * 64 + 32 * ks + 8 * g);
        if (!(skipmask & 2))
#pragma unroll
        for (int dir = 0; dir < 2; ++dir) {
            const LAS unsigned char* qimg = qimg0 + dir * (64 * GQP); const LAS unsigned char* kimg = kimg0 + dir * (64 * GQP);
            gbf16x8 qf[2];
#pragma unroll
            for (int ks = 0; ks < 2; ++ks) qf[ks] = *(const LAS gbf16x8*)(qimg + (16 * q4 + l15) * GQP + (32 * ks + 8 * g) * 2);
            gf32x4 st[4];
#pragma unroll
            for (int jt = 0; jt < 4; ++jt) { st[jt] = (gf32x4){0.f, 0.f, 0.f, 0.f};
#pragma unroll
                for (int ks = 0; ks < 2; ++ks) { const gbf16x8 kf = *(const LAS gbf16x8*)(kimg + (16 * jt + l15) * GQP + (32 * ks + 8 * g) * 2);
                    st[jt] = __builtin_amdgcn_mfma_f32_16x16x32_bf16(kf, qf[ks], st[jt], 0, 0, 0); }
                const int i = 16 * q4 + l15;
#pragma unroll
                for (int r = 0; r < 4; ++r) { const int jj = 16 * jt + 4 * g + r; const bool keep = dir == 0 ? (jj <= i) : (jj >= i); st[jt][r] = keep ? st[jt][r] : 0.f; } }
            gbf16x8 pa[2];
#pragma unroll
            for (int k2 = 0; k2 < 2; ++k2) { const unsigned w0 = pk2(st[2 * k2][0], st[2 * k2][1]), w1 = pk2(st[2 * k2][2], st[2 * k2][3]), w2 = pk2(st[2 * k2 + 1][0], st[2 * k2 + 1][1]), w3 = pk2(st[2 * k2 + 1][2], st[2 * k2 + 1][3]);
                pa[k2] = __builtin_bit_cast(gbf16x8, (v4u){w0, w1, w2, w3}); }
#pragma unroll
            for (int c = 0; c < 8; ++c) {
#pragma unroll
                for (int k2 = 0; k2 < 2; ++k2) { const LAS unsigned char* pv = vimg + (32 * k2 + 4 * g + qq) * GVP + (16 * c + 4 * p4) * 2;
                    const gbf16x8 vf = gcat(gtr(pv), gtr(pv + 16 * GVP));
                    o[c] = __builtin_amdgcn_mfma_f32_16x16x32_bf16(pa[k2], vf, o[c], 0, 0, 0); }
#pragma unroll
                for (int ks = 0; ks < 2; ++ks) o[c] = __builtin_amdgcn_mfma_f32_16x16x32_bf16(qf[ks], dir ? sfB[c][ks] : sfA[c][ks], o[c], 0, 0, 0);
            }
        }
        if (skipmask & 4) continue;
        float ss[4];
#pragma unroll
        for (int r = 0; r < 4; ++r) { float t2 = 0.f;
#pragma unroll
            for (int c = 0; c < 8; ++c) t2 += o[c][r] * o[c][r];
            t2 = sum16(t2);
            ss[r] = 1.f / sqrtf(t2 * (1.f / 128.f) + EPS); }
        LAS unsigned char* gimg = lds + GIMG_OFF + hl * (64 * GVP);
#pragma unroll
        for (int c = 0; c < 8; ++c) { const float gain = a->in[I_EVGLAG][j * 128 + 16 * c + l15];
#pragma unroll
            for (int r = 0; r < 4; ++r) { LAS bf16* gp = (LAS bf16*)(gimg + (16 * q4 + 4 * g + r) * GVP + (16 * c + l15) * 2);
                *gp = (bf16)f2bf(o[c][r] * ss[r] * gain * siluf(bf2f(*gp))); } }
        __syncthreads();
#pragma unroll
        for (int it = 0; it < 4; ++it) { const int ch = tid + it * NTHR, hh = ch >> 10, t = (ch >> 4) & 63, c16 = ch & 15;
            *(v4u*)(MIX + (row0 + t) * D + (hp * 2 + hh) * 128 + c16 * 8) = *(const LAS v4u*)(lds + GIMG_OFF + hh * (64 * GVP) + t * GVP + c16 * 16); }
    }
}

__device__ __forceinline__ void diff_out_phase(int wv_, KA a, int j, int layer) {
    const int tid_o = otid(), lane = tid_o & 63, wave = tid_o >> 6, gw = blockIdx.x * NWAVES + wave, NGW = gridDim.x * NWAVES;
    const bf16* O01 = (const bf16*)(a->ws + WS_Y); bf16* MIX = (bf16*)(a->ws + WS_A1);
    const float lam = ((const float*)(a->ws + WS_TAB))[8192 + j], post = 1.f - lam_init_of(layer);
    const int hd = lane >> 4, d8 = (lane & 15) * 8;
    float gn[8];
#pragma unroll
    for (int e = 0; e < 8; ++e) gn[e] = a->in[I_DIFFG][j * 128 + d8 + e] * post;
    for (int rb = gw; rb < R; rb += 4 * NGW) {
        v4u w0[4], w1[4];
#pragma unroll
        for (int k = 0; k < 4; ++k) { const int r = rb + k * NGW < R ? rb + k * NGW : rb; const bf16* o = O01 + (size_t)r * D + hd * 256 + d8; w0[k] = *(const v4u*)o; w1[k] = *(const v4u*)(o + 128); }
#pragma unroll
        for (int k = 0; k < 4; ++k) { const int r = rb + k * NGW;
            if (r >= R || (layer == DEPTH - 1 && row_cls(r) == 4)) continue;
            const unsigned a0[4] = {w0[k].x, w0[k].y, w0[k].z, w0[k].w}, a1[4] = {w1[k].x, w1[k].y, w1[k].z, w1[k].w};
            float v[8]; float ss = 0.f;
#pragma unroll
            for (int e = 0; e < 8; ++e) { const float x0 = __builtin_bit_cast(float, (e & 1) ? (a0[e >> 1] & 0xffff0000u) : (a0[e >> 1] << 16)), x1 = __builtin_bit_cast(float, (e & 1) ? (a1[e >> 1] & 0xffff0000u) : (a1[e >> 1] << 16));
                v[e] = x0 - lam * x1; ss += v[e] * v[e]; }
            ss = sum16(ss);
            const float rstd = 1.f / sqrtf(ss * (1.f / 128.f) + EPS);
            v4u ow; ow.x = pk2(v[0] * rstd * gn[0], v[1] * rstd * gn[1]); ow.y = pk2(v[2] * rstd * gn[2], v[3] * rstd * gn[3]); ow.z = pk2(v[4] * rstd * gn[4], v[5] * rstd * gn[5]); ow.w = pk2(v[6] * rstd * gn[6], v[7] * rstd * gn[7]);
            *(v4u*)(MIX + (size_t)r * D + 512 + hd * 128 + d8) = ow; }
    }
}

typedef float cf2 __attribute__((ext_vector_type(2)));
constexpr size_t WS_PT = WS_PH + 99 * MiB;
constexpr size_t WS_HYS = WS_A1;
constexpr float TWC[16] = {1.000000000e+00f, 9.807852804e-01f, 9.238795325e-01f, 8.314696123e-01f, 7.071067812e-01f, 5.555702330e-01f, 3.826834324e-01f, 1.950903220e-01f, 6.123233996e-17f, -1.950903220e-01f, -3.826834324e-01f, -5.555702330e-01f, -7.071067812e-01f, -8.314696123e-01f, -9.238795325e-01f, -9.807852804e-01f};
constexpr float TWS[16] = {0.000000000e+00f, 1.950903220e-01f, 3.826834324e-01f, 5.555702330e-01f, 7.071067812e-01f, 8.314696123e-01f, 9.238795325e-01f, 9.807852804e-01f, 1.000000000e+00f, 9.807852804e-01f, 9.238795325e-01f, 8.314696123e-01f, 7.071067812e-01f, 5.555702330e-01f, 3.826834324e-01f, 1.950903220e-01f};
__device__ __forceinline__ cf2 cmul(cf2 a, cf2 b) { return (cf2){a.x * b.x - a.y * b.y, a.x * b.y + a.y * b.x}; }
__device__ __forceinline__ cf2 cmulc(cf2 a, cf2 b) { return (cf2){a.x * b.x + a.y * b.y, a.y * b.x - a.x * b.y}; }
template <bool INV> __device__ __forceinline__ cf2 tw_mul(cf2 d, int ti) {
    if (ti == 0) return d;
    if (ti == 8) return INV ? (cf2){-d.y, d.x} : (cf2){d.y, -d.x};
    const float c = TWC[ti], s = TWS[ti];
    return INV ? (cf2){d.x * c - d.y * s, d.y * c + d.x * s} : (cf2){d.x * c + d.y * s, d.y * c - d.x * s};
}
template <int N, int H, bool INV> struct FftStage {
    static __device__ __forceinline__ void run(cf2 (&x)[N]) {
#pragma unroll
        for (int g = 0; g < N; g += 2 * H)
#pragma unroll
            for (int j = 0; j < H; ++j) { const cf2 a = x[g + j], b = x[g + j + H]; x[g + j] = a + b; x[g + j + H] = tw_mul<INV>(a - b, j * (16 / H)); }
        FftStage<N, H / 2, INV>::run(x);
    }
};
template <int N, bool INV> struct FftStage<N, 0, INV> { static __device__ __forceinline__ void run(cf2 (&)[N]) {} };
template <int N, bool INV> __device__ __forceinline__ void fft_reg(cf2 (&x)[N]) { FftStage<N, N / 2, INV>::run(x); }
__device__ __forceinline__ void fft32_half(cf2 (&x)[32]) {
#pragma unroll
    for (int j = 0; j < 16; ++j) x[j + 16] = tw_mul<false>(x[j], j);
    FftStage<32, 8, false>::run(x);
}
__host__ __device__ constexpr int br5(int i) { return ((i & 1) << 4) | ((i & 2) << 2) | (i & 4) | ((i & 8) >> 2) | ((i & 16) >> 4); }
__host__ __device__ constexpr int br4(int i) { return ((i & 1) << 3) | ((i & 2) << 1) | ((i & 4) >> 1) | ((i & 8) >> 3); }

#define HY_OPAQUE(w) asm volatile("" : "+v"(w.x), "+v"(w.y))
__device__ __forceinline__ void hy_p1_store(LAS cf2* buf, cf2 (&x)[32], int m, cf2 w1) {
    HY_OPAQUE(w1);
    const int base = 17 * (m >> 4) + (m & 15); cf2 pw = (cf2){1.f, 0.f};
#pragma unroll
    for (int k = 0; k < 32; ++k) { if (k) { pw = cmul(pw, w1); x[br5(k)] = cmul(x[br5(k)], pw); } buf[560 * k + base] = x[br5(k)]; }
}
__device__ __forceinline__ void hy_p2(LAS cf2* buf, int tid, cf2 w2) {
    HY_OPAQUE(w2);
    const int base = 560 * (tid >> 4) + (tid & 15); cf2 x[32];
#pragma unroll
    for (int n = 0; n < 32; ++n) x[n] = buf[base + 17 * n];
    fft_reg<32, false>(x);
    cf2 pw = (cf2){1.f, 0.f};
#pragma unroll
    for (int k = 0; k < 32; ++k) { if (k) { pw = cmul(pw, w2); x[br5(k)] = cmul(x[br5(k)], pw); } buf[base + 17 * k] = x[br5(k)]; }
}
template <int MODE> __device__ __forceinline__ void hy_p3(LAS cf2* buf, int tid, cf2* kf) {
#pragma unroll
    for (int i = 0; i < 2; ++i) {
        const int blk = tid + 512 * i, base = 560 * (blk >> 5) + 17 * (blk & 31); cf2 x[16];
#pragma unroll
        for (int n = 0; n < 16; ++n) x[n] = buf[base + n];
        fft_reg<16, false>(x);
        cf2* kp = kf + (size_t)(i * 16) * 512 + tid;
        if (MODE == 0) {
#pragma unroll
            for (int r = 0; r < 16; ++r) kp[r * 512] = x[r] * (1.f / 16384.f);
        } else {
            cf2 y[16];
#pragma unroll
            for (int r = 0; r < 16; ++r) x[r] = cmul(x[r], kp[r * 512]);
#pragma unroll
            for (int k = 0; k < 16; ++k) y[k] = x[br4(k)];
            fft_reg<16, true>(y);
#pragma unroll
            for (int r = 0; r < 16; ++r) buf[base + br4(r)] = y[r];
        }
    }
}
__device__ __forceinline__ void hy_ip2(LAS cf2* buf, int tid, cf2 w2) {
    HY_OPAQUE(w2);
    const int base = 560 * (tid >> 4) + (tid & 15); cf2 x[32]; cf2 pw = (cf2){1.f, 0.f};
#pragma unroll
    for (int k = 0; k < 32; ++k) { x[k] = buf[base + 17 * k]; if (k) { pw = cmulc(pw, w2); x[k] = cmul(x[k], pw); } }
    fft_reg<32, true>(x);
#pragma unroll
    for (int r = 0; r < 32; ++r) buf[base + 17 * br5(r)] = x[r];
}
__device__ __forceinline__ void hy_ip3(const LAS cf2* buf, cf2 (&x)[32], int m, cf2 w1) {
    HY_OPAQUE(w1);
    const int base = 17 * (m >> 4) + (m & 15); cf2 pw = (cf2){1.f, 0.f};
#pragma unroll
    for (int k = 0; k < 32; ++k) { x[k] = buf[560 * k + base]; if (k) { pw = cmulc(pw, w1); x[k] = cmul(x[k], pw); } }
    fft_reg<32, true>(x);
}
__device__ __forceinline__ float hy_sconv(const bf16* row, int L, int t, float w0, float w1, float w2, float cb) {
    float u0 = bf2f(row[t - 1]), u1 = bf2f(row[t]), u2 = bf2f(row[t + 1]); u0 = t > 0 ? u0 : 0.f; u2 = t + 1 < L ? u2 : 0.f;
    return u0 * w0 + u1 * w1 + u2 * w2 + cb;
}
__device__ __forceinline__ void hyena_fft_phase(int wv_, KA a, int j, bool do_ctx, LAS unsigned char* lds, bool dry = false, int skipmask = 0) {
    const int tid0 = otid();
    LAS cf2* buf = (LAS cf2*)lds;
    unsigned char* ws = a->ws;
    bf16* PT = (bf16*)(ws + WS_PT); const float* HF = (const float*)(ws + WS_HF);
    cf2* KF = (cf2*)(ws + WS_HYS + (size_t)blockIdx.x * 262144); float* Z1 = (float*)(ws + WS_HYS + (size_t)blockIdx.x * 262144 + 131072);
    const float* cw = a->in[I_ODCONVW] + (size_t)j * 3 * 1536; const float* cb = a->in[I_ODCONVB] + j * 1536; const float* hb = a->in[I_HYBIAS] + j * 1024;
    const float a1 = -6.283185307179586f * (float)tid0 * (1.f / 16384.f), a2 = -6.283185307179586f * (float)(tid0 & 15) * (1.f / 512.f);
    const cf2 w1 = (cf2){cosf(a1), sinf(a1)}, w2 = (cf2){cosf(a2), sinf(a2)};
    for (int c = blockIdx.x; c < 512; c += gridDim.x) {
#pragma unroll 1
        for (int o = 0; o < 2; ++o) {
            const float bias = hb[o * 512 + c];
            const int chg = 512 * (o + 1) + c;
            const float gw0 = cw[chg], gw1 = cw[1536 + chg], gw2 = cw[3072 + chg], gcb = cb[chg];
            if (!(skipmask & 1)) {
                int tid = tid0; asm volatile("" : "+v"(tid)); const int m = tid;
                const float* hf = HF + (size_t)(o * 1024 + c) * SEQ; const float* hbk = HF + (size_t)(o * 1024 + 512 + c) * SEQ;
                cf2 x[32];
#pragma unroll
                for (int n1 = 0; n1 < 32; ++n1) { float v;
                    if (n1 < 16) v = hf[512 * n1 + m]; else if (n1 == 16) v = m == 0 ? 0.f : hbk[8192 - m]; else v = hbk[16384 - 512 * n1 - m];
                    x[n1] = (cf2){v, 0.f}; }
                fft_reg<32, false>(x);
                hy_p1_store(buf, x, m, w1);
                __syncthreads(); hy_p2(buf, tid, w2); __syncthreads(); hy_p3<0>(buf, tid, KF); __syncthreads();
            }
#pragma unroll 1
            for (int pr = 0; pr < ((skipmask & 2) ? 0 : 2); ++pr) {
                int tid = tid0; asm volatile("" : "+v"(tid)); const int m = tid;
                cf2 xin[16];
                if (o == 0) { const float vw0 = cw[c], vw1 = cw[1536 + c], vw2 = cw[3072 + c], vcb = cb[c];
                    const bf16* r0 = PT + (size_t)c * R + (size_t)(2 * pr) * PB + CTXL; const bf16* r1 = r0 + PB;
#pragma unroll
                    for (int n1 = 0; n1 < 16; ++n1) xin[n1] = (cf2){hy_sconv(r0, SEQ, 512 * n1 + m, vw0, vw1, vw2, vcb), hy_sconv(r1, SEQ, 512 * n1 + m, vw0, vw1, vw2, vcb)}; }
                else {
#pragma unroll
                    for (int n1 = 0; n1 < 16; ++n1) xin[n1] = (cf2){Z1[(2 * pr) * SEQ + 512 * n1 + m], Z1[(2 * pr + 1) * SEQ + 512 * n1 + m]}; }
                cf2 x[32];
#pragma unroll
                for (int n1 = 0; n1 < 16; ++n1) x[n1] = xin[n1];
                fft32_half(x);
                hy_p1_store(buf, x, m, w1);
                __syncthreads(); hy_p2(buf, tid, w2); __syncthreads(); hy_p3<1>(buf, tid, KF); __syncthreads(); hy_ip2(buf, tid, w2); __syncthreads();
                hy_ip3(buf, x, m, w1);
                __syncthreads();
                const bf16* g0 = PT + (size_t)chg * R + (size_t)(2 * pr) * PB + CTXL; const bf16* g1 = g0 + PB;
#pragma unroll
                for (int i = 0; i < 32; ++i) { const int n1 = br5(i); if (n1 >= 16) continue; const int n = 512 * n1 + m;
                    const float z0 = hy_sconv(g0, SEQ, n, gw0, gw1, gw2, gcb) * (x[i].x + xin[n1].x * bias), z1 = hy_sconv(g1, SEQ, n, gw0, gw1, gw2, gcb) * (x[i].y + xin[n1].y * bias);
                    if (o == 0) { Z1[(2 * pr) * SEQ + n] = z0; Z1[(2 * pr + 1) * SEQ + n] = z1; }
                    else if (dry) { Z1[(2 * pr) * SEQ + n] = z0; Z1[(2 * pr + 1) * SEQ + n] = z1; }
                    else { bf16* o0 = PT + (size_t)c * R + (size_t)(2 * pr) * PB + CTXL; o0[n] = (bf16)f2bf(z0); o0[PB + n] = (bf16)f2bf(z1); } }
            }
        }
        if (do_ctx) {
            int tid = tid0; asm volatile("" : "+v"(tid));
            LAS float* uin = (LAS float*)lds;
            LAS float* hfl = uin + 3072;
            LAS float* z1c = hfl + 1024;
            const float* HFC = HF + (size_t)2048 * SEQ;
            __syncthreads();
            for (int idx = tid; idx < 3072; idx += NTHR) { const int k3 = idx >> 10, b = (idx >> 8) & 3, t = idx & 255, ch = 512 * k3 + c;
                uin[idx] = hy_sconv(PT + (size_t)ch * R + (size_t)b * PB, CTXL, t, cw[ch], cw[1536 + ch], cw[3072 + ch], cb[ch]); }
            for (int idx = tid; idx < 1024; idx += NTHR) hfl[idx] = HFC[(size_t)((idx >> 9) * 1024 + ((idx >> 8) & 1) * 512 + c) * CTXL + (idx & 255)];
            __syncthreads();
#pragma unroll 1
            for (int o = 0; o < 2; ++o) {
                const float bias = hb[o * 512 + c];
                float zz[2];
#pragma unroll
                for (int e = 0; e < 2; ++e) { const int oi = tid * 2 + e, b = oi >> 8, t = oi & 255;
                    const LAS float* in = o == 0 ? uin + b * 256 : z1c + b * 256; const LAS float* hfw = hfl + o * 512; const LAS float* hbw = hfw + 256;
                    float acc = 0.f;
                    for (int s = 0; s <= t; ++s) acc += hfw[t - s] * in[s];
                    for (int s = t + 1; s < 256; ++s) acc += hbw[s - t] * in[s];
                    zz[e] = uin[(1 + o) * 1024 + b * 256 + t] * (acc + in[t] * bias); }
                __syncthreads();
#pragma unroll
                for (int e = 0; e < 2; ++e) { const int oi = tid * 2 + e, b = oi >> 8, t = oi & 255;
                    if (o == 0 || dry) z1c[b * 256 + t] = zz[e]; else PT[(size_t)c * R + (size_t)b * PB + t] = (bf16)f2bf(zz[e]); }
                __syncthreads();
            }
        }
    }
}
__device__ __forceinline__ void hyena_transpose_phase(int wv_, KA a, LAS unsigned char* lds) {
    const int tid = otid();
    unsigned char* ws = a->ws; const bf16* PT = (const bf16*)(ws + WS_PT); bf16* MIX = (bf16*)(ws + WS_A1);
    constexpr int NT = 8 * (R / 64), TSZ = 64 * 66;
    for (int tb = blockIdx.x * 4; tb < NT; tb += gridDim.x * 4) {
        __syncthreads();
        v4u v[4];
#pragma unroll
        for (int k = 0; k < 4; ++k) { const int t = tb + k < NT ? tb + k : NT - 1; const int c0 = (t & 7) * 64, r0 = (t >> 3) * 64, cc = tid >> 3, rc = tid & 7;
            v[k] = *(const v4u*)(PT + (size_t)(c0 + cc) * R + r0 + rc * 8); }
#pragma unroll
        for (int k = 0; k < 4; ++k) { const int cc = tid >> 3, rc = tid & 7; LAS unsigned* d = (LAS unsigned*)((LAS bf16*)lds + k * TSZ + cc * 66 + rc * 8); d[0] = v[k].x; d[1] = v[k].y; d[2] = v[k].z; d[3] = v[k].w; }
        __syncthreads();
#pragma unroll
        for (int k = 0; k < 4; ++k) { if (tb + k >= NT) break; const int t = tb + k, c0 = (t & 7) * 64, r0 = (t >> 3) * 64, rr = tid >> 3, cch = tid & 7; const LAS bf16* tile = (const LAS bf16*)lds + k * TSZ; unsigned w[4];
#pragma unroll
            for (int e = 0; e < 4; ++e) w[e] = (unsigned)tile[(cch * 8 + 2 * e) * 66 + rr] | ((unsigned)tile[(cch * 8 + 2 * e + 1) * 66 + rr] << 16);
            *(v4u*)(MIX + (size_t)(r0 + rr) * D + c0 + cch * 8) = (v4u){w[0], w[1], w[2], w[3]}; }
    }
}

__device__ __forceinline__ void hyena_filter_phase(int wv_, KA a, int j) {
    typedef float f32x16_t __attribute__((ext_vector_type(16)));
    const int tid = otid(), lane = tid & 63, wave = tid >> 6, gw = blockIdx.x * NWAVES + wave, NGW = gridDim.x * NWAVES, l31 = lane & 31, h = lane >> 5;
    const float* w3 = a->in[I_FW3] + (size_t)j * 64 * 2048; unsigned char* ws = a->ws;
    const float da = logf(1e-2f) / 0.3f, db = logf(1e-2f) / 1.5f;
    for (int it = gw; it < 64 * 33; it += NGW) {
        const int ct = it & 63, tg = it >> 6; const bool isctx = tg == 32; const int L = isctx ? CTXL : SEQ;
        const float* hid = (const float*)(ws + WS_HID) + (isctx ? (size_t)(2 * SEQ + j * CTXL) * 64 : (size_t)(j * SEQ) * 64);
        float* HF = (float*)(ws + WS_HF) + (isctx ? (size_t)2048 * SEQ : 0);
        float aw[32];
#pragma unroll
        for (int sx = 0; sx < 32; ++sx) aw[sx] = w3[(size_t)(32 * h + sx) * 2048 + ct * 32 + l31];
        float dl[16];
#pragma unroll
        for (int r = 0; r < 16; ++r) { const int col = ct * 32 + (r & 3) + 8 * (r >> 2) + 4 * h; dl[r] = fabsf(da + (float)(col & 511) * ((db - da) / 511.f)); }
#pragma unroll 1
        for (int tt = 0; tt < 8; ++tt) {
            const int t0 = (isctx ? tt : 8 * tg + tt) * 32, t = t0 + l31;
            const f32x4* hr = (const f32x4*)(hid + (size_t)t * 64 + 32 * h);
            float bv[32];
#pragma unroll
            for (int q4 = 0; q4 < 8; ++q4) { const f32x4 v = hr[q4]; bv[4 * q4] = v.x; bv[4 * q4 + 1] = v.y; bv[4 * q4 + 2] = v.z; bv[4 * q4 + 3] = v.w; }
            f32x16_t acc = {};
#pragma unroll
            for (int sx = 0; sx < 32; ++sx) acc = __builtin_amdgcn_mfma_f32_32x32x2f32(aw[sx], bv[sx], acc, 0, 0, 0);
            const float tf = (float)t / (float)(L - 1);
#pragma unroll
            for (int r = 0; r < 16; ++r) { const int col = ct * 32 + (r & 3) + 8 * (r >> 2) + 4 * h; HF[(size_t)col * L + t] = acc[r] * __expf(-tf * dl[r]); }
        }
    }
}
__device__ __forceinline__ void tail_convert(int wv_, KA a, int l, int mask, LAS unsigned char* lds, int nunits) {
    const int G = (int)gridDim.x, bx = obx(); int first = nunits % G; if (first == 0 || G - first < 32) first = 0;
    if (bx < first) return;
    __syncthreads();
    convert_layer_weights(wv_, a, l, mask, lds, bx - first, G - first);
}
#ifndef PROBE_REPEAT
#define PROBE_REPEAT 0
#endif
#define PRB(id, stmt) do { if (PROBE_REPEAT == (id)) { stmt; __syncthreads(); } } while (0)
__global__ void __launch_bounds__(NTHR, 2) fwd_kernel(Args a_unused) {
    extern __shared__ __attribute__((aligned(16))) unsigned char lds_raw[];
    LAS unsigned char* lds = (LAS unsigned char*)lds_raw;
    volatile LAS unsigned* MISC = (volatile LAS unsigned*)(lds + LDS_MISC);
    const KA a0 = (KA)__builtin_amdgcn_kernarg_segment_ptr();
    if (threadIdx.x < 64) MISC[threadIdx.x] = 0u;
    const int wv_ = __builtin_amdgcn_readfirstlane(threadIdx.x >> 6);
    __syncthreads();
    const int lo = a0->ph_lo, hi = a0->ph_hi;
    XcdBarrier bar; bar.bar = (unsigned*)(a0->ws + WS_CTL) + CW_BAR; bar.x = 0; bar.st = MISC + 8;
    if (hi - lo > 1) bar = xcd_barrier_post((unsigned*)(a0->ws + WS_CTL) + CW_BAR, MISC + 8);
#define IN(k) (lo <= (k) && (k) < hi)
#define SEAM(k) do { if (IN((k) + 1)) { xcd_barrier(bar, wv_); if (PROBE_REPEAT == 20) xcd_barrier(bar, wv_); } } while (0)
    if (IN(0)) { PRB(13, p0a_prologue(wv_, ka_launder(a0), lds)); p0a_prologue(wv_, ka_launder(a0), lds); SEAM(0); }
    if (IN(1)) { PRB(14, p0b_first_norm(wv_, ka_launder(a0))); p0b_first_norm(wv_, ka_launder(a0)); SEAM(1); }
#pragma unroll 1
    for (int layer = 0; layer < DEPTH; ++layer) {
        const int pb = 2 + 9 * layer, j = layer >> 1; const bool odd = layer & 1; const int last = layer == DEPTH - 1;
        if (IN(pb + 0)) {
            const KA a = ka_launder(a0); unsigned char* ws = a->ws; const unsigned char* wl = ws + WS_W;
            if (odd) { hyena_filter_phase(wv_, ka_launder(a0), j); __syncthreads(); }
            if (odd) {
                pg8::Gemm g{nullptr, nullptr, R, NP_OD, D, 0}; pg8::DualOrder S;
                S.init(ws + WS_A1, wl + W_IN + (size_t)1536 * D * 2, R, 1536, wl + W_IN, ws + WS_A1, 1536, R, (int)gridDim.x, obx());
                pg8::EpiInProj E{(bf16*)(ws + WS_PH), NP_OD, (bf16*)(ws + WS_PT), R, (const float*)(ws + WS_TAB), nullptr, 1, C2};
                PRB(1, (pg8::gemm_phase<pg8::EpiInProj, pg8::DualOrder, true, true>(lds, g, S, E, otid())));
                pg8::gemm_phase<pg8::EpiInProj, pg8::DualOrder, true, true>(lds, g, S, E, otid());
            } else {
                pg8::Gemm g{(const bf16*)(ws + WS_A1), (const bf16*)(wl + W_IN), R, NP_EV, D, 0}; pg8::StaticOrder S; S.init(R, NP_EV, (int)gridDim.x, obx());
                pg8::EpiInProj E{(bf16*)(ws + WS_PH), NP_EV, nullptr, 0, (const float*)(ws + WS_TAB), a->in[I_EVQKG] + j * 128, 0, C2};
                PRB(1, (pg8::gemm_phase<pg8::EpiInProj, pg8::StaticOrder, true, true>(lds, g, S, E, otid())));
                pg8::gemm_phase<pg8::EpiInProj, pg8::StaticOrder, true, true>(lds, g, S, E, otid());
            }
            if (layer > 0) tail_convert(wv_, ka_launder(a0), layer, 8, lds, odd ? (R / 256) * 12 : (R / 256) * 10);
            SEAM(pb + 0);
        }
        if (IN(pb + 1)) {
            if (!odd) { PRB(2, gla_state_phase(wv_, ka_launder(a0), j, lds)); gla_state_phase(wv_, ka_launder(a0), j, lds); SEAM(pb + 1); }
        }
        if (IN(pb + 2)) {
            if (odd) { PRB(7, hyena_fft_phase(wv_, ka_launder(a0), j, layer != DEPTH - 1, lds, true)); PRB(71, hyena_fft_phase(wv_, ka_launder(a0), j, false, lds, true, 2)); PRB(72, hyena_fft_phase(wv_, ka_launder(a0), j, false, lds, true, 1)); hyena_fft_phase(wv_, ka_launder(a0), j, layer != DEPTH - 1, lds); __syncthreads(); PRB(6, attn_phase_fast(wv_, ka_launder(a0), true, (char*)lds_raw, last)); attn_phase_fast(wv_, ka_launder(a0), true, (char*)lds_raw, last); }
            else { PRB(4, gla_scan_phase(wv_, ka_launder(a0))); gla_scan_phase(wv_, ka_launder(a0)); __syncthreads(); PRB(5, attn_phase_fast(wv_, ka_launder(a0), false, (char*)lds_raw)); attn_phase_fast(wv_, ka_launder(a0), false, (char*)lds_raw); }
            SEAM(pb + 2);
        }
        if (IN(pb + 3)) {
            if (odd) { PRB(9, (diff_out_phase(wv_, ka_launder(a0), j, layer), hyena_transpose_phase(wv_, ka_launder(a0), lds))); diff_out_phase(wv_, ka_launder(a0), j, layer); hyena_transpose_phase(wv_, ka_launder(a0), lds); } else { PRB(8, gla_output_phase(wv_, ka_launder(a0), j, lds)); PRB(31, gla_output_phase(wv_, ka_launder(a0), j, lds, 1)); PRB(32, gla_output_phase(wv_, ka_launder(a0), j, lds, 2)); PRB(34, gla_output_phase(wv_, ka_launder(a0), j, lds, 4)); PRB(37, gla_output_phase(wv_, ka_launder(a0), j, lds, 7)); gla_output_phase(wv_, ka_launder(a0), j, lds); }
            SEAM(pb + 3);
        }
        if (IN(pb + 4)) {
            const KA a = ka_launder(a0); unsigned char* ws = a->ws; const unsigned char* wl = ws + WS_W;
            pg8::Gemm g{(const bf16*)(ws + WS_A1), (const bf16*)(wl + W_OUT), R, D, D, 0}; pg8::StaticOrder S; S.init(last ? NB * SEQ : R, D, (int)gridDim.x, obx(), last);
            pg8::EpiBf16<0> E{(bf16*)(ws + WS_Y), D};
            PRB(10, (pg8::gemm_phase<pg8::EpiBf16<0>, pg8::StaticOrder, true, true>(lds, g, S, E, otid())));
            pg8::gemm_phase<pg8::EpiBf16<0>, pg8::StaticOrder, true, true>(lds, g, S, E, otid());
            if (!last) tail_convert(wv_, ka_launder(a0), layer + 1, 1, lds, (R / 256) * 4);
            SEAM(pb + 4);
        }
        if (IN(pb + 5)) { PRB(15, rowwise_post(wv_, ka_launder(a0), layer, 0, lds)); rowwise_post(wv_, ka_launder(a0), layer, 0, lds); SEAM(pb + 5); }
        if (IN(pb + 6)) {
            const KA a = ka_launder(a0); unsigned char* ws = a->ws; const unsigned char* wl = ws + WS_W;
            pg8::Gemm g{(const bf16*)(ws + WS_A1), (const bf16*)(wl + W_1), R, DFF, D, 0}; pg8::StaticOrder S; S.init(last ? NB * SEQ : R, DFF, (int)gridDim.x, obx(), last);
            pg8::EpiBf16<2> E{(bf16*)(ws + WS_PH), DFF};
            PRB(11, (pg8::gemm_phase<pg8::EpiBf16<2>, pg8::StaticOrder, true, true>(lds, g, S, E, otid())));
            if (PROBE_REPEAT == 41) { pg8::EpiBf16<2> E2{(bf16*)(ws + WS_PH), DFF, 1}; pg8::gemm_phase<pg8::EpiBf16<2>, pg8::StaticOrder, true, true>(lds, g, S, E2, otid()); __syncthreads(); }
            pg8::gemm_phase<pg8::EpiBf16<2>, pg8::StaticOrder, true, true>(lds, g, S, E, otid());
            if (!last) tail_convert(wv_, ka_launder(a0), layer + 1, 2, lds, (R / 256) * 16);
            SEAM(pb + 6);
        }
        if (IN(pb + 7)) {
            const KA a = ka_launder(a0); unsigned char* ws = a->ws; const unsigned char* wl = ws + WS_W;
            { pg8::Gemm g{(const bf16*)(ws + WS_PH), (const bf16*)(wl + W_2), R, D, DFF, 0}; pg8::StaticOrder S; S.init(NB * SEQ, D, (int)gridDim.x, obx(), 1);
              pg8::EpiBf16<0> E{(bf16*)(ws + WS_A1), D};
              PRB(12, (pg8::gemm_phase<pg8::EpiBf16<0>, pg8::StaticOrder, true, true>(lds, g, S, E, otid())));
              pg8::gemm_phase<pg8::EpiBf16<0>, pg8::StaticOrder, true, true>(lds, g, S, E, otid()); }
            if (!last) { __syncthreads();
              pg8::Gemm g{(const bf16*)(ws + WS_PH), (const bf16*)(wl + W_2), 4 * 256, D, DFF / 4, DFF}; pg8::CtxSplitOrder<4, 4> S; S.init(DFF / 4, (int)gridDim.x, obx());
              pg8::EpiSlab E{(bf16*)(ws + WS_SLAB), D, (size_t)1024 * D};
              pg8::gemm_phase<pg8::EpiSlab, pg8::CtxSplitOrder<4, 4>, true, true>(lds, g, S, E, otid());
              tail_convert(wv_, ka_launder(a0), layer + 1, 4, lds, 64); }
            SEAM(pb + 7);
        }
        if (IN(pb + 8)) { rowwise_post(wv_, ka_launder(a0), layer, 1, lds); SEAM(pb + 8); }
    }
#undef IN
#undef SEAM
}

constexpr int N_PHASES = 2 + 9 * DEPTH;
#ifndef MK_ONE_LAUNCH
#define MK_ONE_LAUNCH 1
#endif
extern "C" void kernel_launch(void* const* d_in, const int* in_sizes, int n_in, void* d_out, int out_size, void* d_ws, size_t ws_size, hipStream_t stream) {
    static int grid = 0;
    if (grid == 0) {
        if (n_in != 27 || in_sizes[0] != NB * SEQ * D || out_size != NB * SEQ * D || ws_size < WS_END) { fprintf(stderr, "kernel_launch: unexpected shapes (n_in %d, in0 %d, out %d, ws %zu)\n", n_in, n_in > 0 ? in_sizes[0] : -1, out_size, ws_size); grid = -1; return; }
        int dev = 0, cus = 0;
        if (hipGetDevice(&dev) != hipSuccess || hipDeviceGetAttribute(&cus, hipDeviceAttributeMultiprocessorCount, dev) != hipSuccess) { grid = -1; return; }
        if (hipFuncSetAttribute((const void*)fwd_kernel, hipFuncAttributeMaxDynamicSharedMemorySize, LDS_BYTES) != hipSuccess) { fprintf(stderr, "kernel_launch: hipFuncSetAttribute failed\n"); grid = -1; return; }
        (void)hipGetLastError();
        grid = cus;
    }
    if (grid < 0) return;
    if (hipMemsetAsync((char*)d_ws + WS_CTL, 0, CTL_ZERO_BYTES, stream) != hipSuccess) return;
    Args a{};
    for (int i = 0; i < 27; ++i) a.in[i] = (const float*)d_in[i];
    a.out = (float*)d_out; a.ws = (unsigned char*)d_ws;
#if MK_ONE_LAUNCH
    a.ph_lo = 0; a.ph_hi = N_PHASES;
    hipLaunchKernelGGL(fwd_kernel, dim3(grid), dim3(NTHR), LDS_BYTES, stream, a);
#else
    for (int k = 0; k < N_PHASES; ++k) { a.ph_lo = k; a.ph_hi = k + 1; hipLaunchKernelGGL(fwd_kernel, dim3(grid), dim3(NTHR), LDS_BYTES, stream, a); }
#endif
}
```

```cpp
#include <hip/hip_runtime.h>
#include <cstdio>
#include <cstdint>
#include <hip/hip_bf16.h>
#include <cmath>

namespace pg8 {
#define PG8_LAS __attribute__((address_space(3)))
typedef unsigned short bf16_t;
typedef short bf16x8 __attribute__((ext_vector_type(8)));
typedef float f32x4 __attribute__((ext_vector_type(4)));
typedef unsigned u32x4 __attribute__((ext_vector_type(4)));
constexpr int BM = 256, BK = 64, HALF = 128, HTB = HALF * BK * 2  , STAGE_BYTES = 8 * HTB, NXCD = 8, WGM = 8;

__host__ __device__ __forceinline__ int lds_byte(int r, int c) { const int st = (r >> 4) * 2 + (c >> 5), rr = r & 15, cc = c & 31, ob = rr * 64 + cc * 2; return st * 1024 + (ob ^ (((ob >> 9) & 1) << 5)); }
__host__ __device__ __forceinline__ void stage_rc(int b, int& R, int& C) { const int st = b / 1024, sb = b % 1024, swz = sb ^ (((sb >> 9) & 1) << 5); R = (st >> 1) * 16 + swz / 64; C = (st & 1) * 32 + (swz % 64) / 2; }
__host__ __device__ __forceinline__ int perm32(int rho) { const int n = rho >> 4, i = rho & 15; return 8 * (i >> 2) + 4 * n + (i & 3); }

struct Unit { int pm, pn, kind; };
struct Gemm { const bf16_t* A; const bf16_t* Bt; int M, N, K; int ld; };

struct StaticOrder {
    int nM, nN, nwg, G, c, skip;
    __host__ __device__ void init(int M, int N, int G_, int c_, int skip_ = 0) { nM = M / BM; nN = N / BM; nwg = nM * nN; G = G_; c = c_; skip = skip_; }
    __host__ __device__ bool next(int i, Unit& u) const {
        const long L = (long)i * G + c; if (L >= nwg) return false;
        int wgid = (int)L; { const int q = nwg / NXCD, r = nwg % NXCD, xcd = wgid % NXCD, off = wgid / NXCD; wgid = (xcd < r ? xcd * (q + 1) : r * (q + 1) + (xcd - r) * q) + off; }
        const int nig = WGM * nN, gid = wgid / nig, fm = gid * WGM, gsz = (nM - fm) < WGM ? (nM - fm) : WGM;
        u.pm = fm + ((wgid % nig) % gsz); u.pn = (wgid % nig) / gsz; u.kind = 0; if (skip) u.pm += (u.pm >> 5) + 1; return true;
    }
    __device__ __forceinline__ const char* abase(const Gemm& g, const Unit& u, size_t tstep) const { return (const char*)g.A + (size_t)u.pm * tstep; }
    __device__ __forceinline__ const char* bbase(const Gemm& g, const Unit& u, size_t tstep) const { return (const char*)g.Bt + (size_t)u.pn * tstep; }
    __device__ __forceinline__ void a_ready(const Unit&) const {}
    __device__ __forceinline__ void done(const Unit&) const {}
};
struct DualOrder {
    StaticOrder s0, s1; const char *A0, *B0, *A1, *B1; int G, c;
    __device__ __forceinline__ void init(const void* a0, const void* b0, int M0, int N0, const void* a1, const void* b1, int M1, int N1, int G_, int c_) {
        s0.init(M0, N0, 1, 0); s1.init(M1, N1, 1, 0); A0 = (const char*)a0; B0 = (const char*)b0; A1 = (const char*)a1; B1 = (const char*)b1; G = G_; c = c_; }
    __device__ __forceinline__ bool next(int i, Unit& u) const {
        const int L = i * G + c;
        if (L < s0.nwg) { s0.next(L, u); u.kind = 0; return true; }
        if (L - s0.nwg < s1.nwg) { s1.next(L - s0.nwg, u); u.kind = 1; return true; }
        return false; }
    __device__ __forceinline__ const char* abase(const Gemm&, const Unit& u, size_t tstep) const { return (u.kind ? A1 : A0) + (size_t)u.pm * tstep; }
    __device__ __forceinline__ const char* bbase(const Gemm&, const Unit& u, size_t tstep) const { return (u.kind ? B1 : B0) + (size_t)u.pn * tstep; }
    __device__ __forceinline__ void a_ready(const Unit&) const {}
    __device__ __forceinline__ void done(const Unit&) const {}
};
template <int NN, int NS> struct CtxSplitOrder {
    int G, c; size_t kbytes;
    __device__ __forceinline__ void init(int Kslice, int G_, int c_) { G = G_; c = c_; kbytes = (size_t)Kslice * 2; }
    __device__ __forceinline__ bool next(int i, Unit& u) const { const int L = i * G + c; if (L >= 4 * NN * NS) return false; u.kind = L % NS; u.pn = (L / NS) % NN; u.pm = L / (NS * NN); return true; }
    __device__ __forceinline__ const char* abase(const Gemm& g, const Unit& u, size_t tstep) const { return (const char*)g.A + (size_t)(33 * u.pm) * tstep + (size_t)u.kind * kbytes; }
    __device__ __forceinline__ const char* bbase(const Gemm& g, const Unit& u, size_t tstep) const { return (const char*)g.Bt + (size_t)u.pn * tstep + (size_t)u.kind * kbytes; }
    __device__ __forceinline__ void a_ready(const Unit&) const {}
    __device__ __forceinline__ void done(const Unit&) const {}
};

__device__ __forceinline__ unsigned cvt_pk_bf16(float lo, float hi) { unsigned r; asm volatile("v_cvt_pk_bf16_f32 %0, %1, %2" : "=v"(r) : "v"(lo), "v"(hi)); return r; }
template <int ACT  > struct EpiBf16 {
    static constexpr bool PERM = true, AFTER_DRAIN = false;
    bf16_t* O; int ldc; int probe_nostore = 0;
    __device__ __forceinline__ void operator()(const f32x4 (&acc)[2][2][4][2], const Unit& u, int wr, int wc, int fr, int fq) const {
        if (probe_nostore && u.pm != 0x7fffffff) { float t = 0.f;
#pragma unroll
            for (int ai = 0; ai < 2; ++ai)
#pragma unroll
                for (int m = 0; m < 4; ++m)
#pragma unroll
                    for (int bj = 0; bj < 2; ++bj) t += acc[ai][bj][m][0][0] + acc[ai][bj][m][1][3];
            if (t == 1234.5678f) O[0] = 1; return; }
        const int row0 = u.pm * BM + wr * 64 + fr; const int col0 = u.pn * BM + wc * 32 + 8 * fq;
#pragma unroll
        for (int ai = 0; ai < 2; ++ai)
#pragma unroll
            for (int m = 0; m < 4; ++m) { bf16_t* rowp = O + (size_t)(row0 + ai * HALF + m * 16) * ldc + col0;
#pragma unroll
                for (int bj = 0; bj < 2; ++bj) { f32x4 v0 = acc[ai][bj][m][0], v1 = acc[ai][bj][m][1];
                    if (ACT == 2) {
#pragma unroll
                        for (int e = 0; e < 4; ++e) { const float a0 = fmaxf(v0[e], 0.f), a1 = fmaxf(v1[e], 0.f); v0[e] = a0 * a0; v1[e] = a1 * a1; } }
                    u32x4 w; w.x = cvt_pk_bf16(v0[0], v0[1]); w.y = cvt_pk_bf16(v0[2], v0[3]); w.z = cvt_pk_bf16(v1[0], v1[1]); w.w = cvt_pk_bf16(v1[2], v1[3]);
                    *(u32x4*)(rowp + bj * HALF) = w; } }
    }
};
struct EpiDual {
    static constexpr bool PERM = true, AFTER_DRAIN = false;
    bf16_t* O0; int ldc0; bf16_t* O1; int ldc1;
    __device__ __forceinline__ void operator()(const f32x4 (&acc)[2][2][4][2], const Unit& u, int wr, int wc, int fr, int fq) const {
        const EpiBf16<0> e{u.kind ? O1 : O0, u.kind ? ldc1 : ldc0}; e(acc, u, wr, wc, fr, fq);
    }
};
struct EpiInProj {
    static constexpr bool PERM = true, AFTER_DRAIN = false;
    bf16_t* O0; int ldc0; bf16_t* O1; int ldc1; const float* tab; const float* qkg; int odd; float qscale;
    __device__ __forceinline__ void operator()(const f32x4 (&acc)[2][2][4][2], const Unit& u, int wr, int wc, int fr, int fq) const {
        if (u.kind) { const EpiBf16<0> e{O1, ldc1}; e(acc, u, wr, wc, fr, fq); return; }
        const bool perm = !odd && u.pn >= 6 && u.pn <= 8;
        int mode = 0;
        if (odd) mode = u.pn < 2 ? 1 : (u.pn < 4 ? 2 : 0); else mode = (u.pn == 6 || u.pn == 7) ? 1 : ((u.pn == 8 && wc < 2) ? 2 : 0);
        const int pp = u.pm % 33; const bool rope = mode != 0 && pp != 0; const bool norm = mode != 0 && !odd;
        const int row0 = u.pm * BM + wr * 64 + fr;
        const int colb = u.pn * BM + (perm ? 64 * wc + 8 * fq : 32 * wc + 8 * fq), bjs = perm ? 32 : HALF;
        if (mode == 0) {
#pragma unroll
            for (int ai = 0; ai < 2; ++ai)
#pragma unroll
                for (int m = 0; m < 4; ++m) { bf16_t* rowp = O0 + (size_t)(row0 + ai * HALF + m * 16) * ldc0 + colb;
#pragma unroll
                    for (int bj = 0; bj < 2; ++bj) { const f32x4 v0 = acc[ai][bj][m][0], v1 = acc[ai][bj][m][1];
                        u32x4 w; w.x = cvt_pk_bf16(v0[0], v0[1]); w.y = cvt_pk_bf16(v0[2], v0[3]); w.z = cvt_pk_bf16(v1[0], v1[1]); w.w = cvt_pk_bf16(v1[2], v1[3]);
                        *(u32x4*)(rowp + bj * bjs) = w; } }
            return;
        }
        f32x4 G[2][2];
#pragma unroll
        for (int bj = 0; bj < 2; ++bj)
#pragma unroll
            for (int n = 0; n < 2; ++n) G[bj][n] = norm ? *(const f32x4*)(qkg + (mode == 2 ? 64 : 0) + 32 * bj + 8 * fq + 4 * n) : (f32x4){1.f, 1.f, 1.f, 1.f};
        const float sc = mode == 1 ? qscale : 1.f;
        const float* trow = tab + ((4 * (pp - 1) + wr) * 16 + 4 * fq) * 2;
        const float* tcol = tab + 4096 + (fr * 16 + 4 * fq) * 2;
        const f32x4 ID = (f32x4){1.f, 0.f, 1.f, 0.f};
        f32x4 TR[2][2];
#pragma unroll
        for (int ai = 0; ai < 2; ++ai) { TR[ai][0] = rope ? *(const f32x4*)(trow + ai * 64) : ID; TR[ai][1] = rope ? *(const f32x4*)(trow + ai * 64 + 4) : ID; }
        f32x4 TCn0 = rope ? *(const f32x4*)(tcol) : ID, TCn1 = rope ? *(const f32x4*)(tcol + 4) : ID;
#pragma unroll
        for (int m = 0; m < 4; ++m) {
            const f32x4 TC0 = TCn0, TC1 = TCn1;
            if (m < 3) { TCn0 = rope ? *(const f32x4*)(tcol + (m + 1) * 512) : ID; TCn1 = rope ? *(const f32x4*)(tcol + (m + 1) * 512 + 4) : ID; }
#pragma unroll
            for (int ai = 0; ai < 2; ++ai) {
                f32x4 v[2][2];
#pragma unroll
                for (int bj = 0; bj < 2; ++bj)
#pragma unroll
                    for (int n = 0; n < 2; ++n) v[bj][n] = acc[ai][bj][m][n];
                if (norm) { float ss = 0.f;
#pragma unroll
                    for (int bj = 0; bj < 2; ++bj)
#pragma unroll
                        for (int n = 0; n < 2; ++n) ss += (v[bj][n][0] * v[bj][n][0] + v[bj][n][1] * v[bj][n][1]) + (v[bj][n][2] * v[bj][n][2] + v[bj][n][3] * v[bj][n][3]);
                    { const unsigned u_ = __builtin_bit_cast(unsigned, ss); auto a_ = __builtin_amdgcn_permlane16_swap(u_, u_, false, false); ss = __builtin_bit_cast(float, (unsigned)a_[0]) + __builtin_bit_cast(float, (unsigned)a_[1]);
                      const unsigned w_ = __builtin_bit_cast(unsigned, ss); auto b_ = __builtin_amdgcn_permlane32_swap(w_, w_, false, false); ss = __builtin_bit_cast(float, (unsigned)b_[0]) + __builtin_bit_cast(float, (unsigned)b_[1]); }
                    const float rstd = 1.0f / sqrtf(ss * (1.f / 64.f) + 1e-6f);
#pragma unroll
                    for (int bj = 0; bj < 2; ++bj)
#pragma unroll
                        for (int n = 0; n < 2; ++n) v[bj][n] = (v[bj][n] * rstd) * G[bj][n]; }
                bf16_t* rowp = O0 + (size_t)(row0 + ai * HALF + m * 16) * ldc0 + colb;
#pragma unroll
                for (int bj = 0; bj < 2; ++bj) {
                    if (rope) {
                        const bool colang = odd ? (wc & 1) : (bj == 1);
                        const f32x4 T0 = colang ? TC0 : TR[ai][0], T1 = colang ? TC1 : TR[ai][1];
                        const f32x4 a0 = v[bj][0], a1 = v[bj][1];
                        v[bj][0] = (f32x4){a0[0] * T0[0] - a0[1] * T0[1], a0[0] * T0[1] + a0[1] * T0[0], a0[2] * T0[2] - a0[3] * T0[3], a0[2] * T0[3] + a0[3] * T0[2]};
                        v[bj][1] = (f32x4){a1[0] * T1[0] - a1[1] * T1[1], a1[0] * T1[1] + a1[1] * T1[0], a1[2] * T1[2] - a1[3] * T1[3], a1[2] * T1[3] + a1[3] * T1[2]};
                    }
                    const f32x4 x0 = v[bj][0] * sc, x1 = v[bj][1] * sc;
                    u32x4 w; w.x = cvt_pk_bf16(x0[0], x0[1]); w.y = cvt_pk_bf16(x0[2], x0[3]); w.z = cvt_pk_bf16(x1[0], x1[1]); w.w = cvt_pk_bf16(x1[2], x1[3]);
                    *(u32x4*)(rowp + bj * bjs) = w;
                }
            }
        }
    }
};
struct EpiSlab {
    static constexpr bool PERM = true, AFTER_DRAIN = false;
    bf16_t* O; int ldc; size_t slab;
    __device__ __forceinline__ void operator()(const f32x4 (&acc)[2][2][4][2], const Unit& u, int wr, int wc, int fr, int fq) const {
        const EpiBf16<0> e{O + (size_t)u.kind * slab, ldc}; e(acc, u, wr, wc, fr, fq);
    }
};

template <class Epi, class Sched, bool ALIGN_EPI = false, bool SP2 = false>
__device__ __forceinline__ void gemm_phase(PG8_LAS unsigned char* lds, const Gemm g, const Sched& S, const Epi& E, const int tid_in) {
    int tid_ = tid_in; asm volatile("" : "+v"(tid_));
    const int tid = tid_, wid = __builtin_amdgcn_readfirstlane(tid >> 6), lane = tid & 63, wr = wid >> 2, wc = wid & 3, fr = lane & 15, fq = lane >> 4;
    const int K = g.ld ? g.ld : g.K, nt = g.K / BK;
    unsigned voffA[2], voffB[2];
#pragma unroll
    for (int i = 0; i < 2; ++i) { int R, C; stage_rc(tid * 16 + i * 8192, R, C); const int Rb = Epi::PERM ? ((R & ~31) + perm32(R & 31)) : R;
        voffA[i] = (unsigned)(R * K + C) * 2u; voffB[i] = (unsigned)(Rb * K + C) * 2u; }
    const size_t kstep = (size_t)(BK * 2);
    const size_t hstep = (size_t)HALF * K * 2;
    const size_t tstep = 2 * hstep;
    const unsigned ldsw = (unsigned)wid * 1024u;
    const int aoff = lds_byte(wr * 64 + fr, fq * 8), boff = lds_byte(wc * 32 + fr, fq * 8);
#define PG8_SA(b, h) (((b) * 2 + (h)) * HTB)
#define PG8_SB(b, h) ((4 + (b) * 2 + (h)) * HTB)
#define PG8_STAGE(bufoff, gbase, voff) do { _Pragma("unroll") for (int _i = 0; _i < 2; ++_i) \
        __builtin_amdgcn_global_load_lds((const unsigned*)((const char*)(gbase) + (voff)[_i]), (PG8_LAS unsigned*)(lds + (bufoff) + ldsw + _i * 8192), 16, 0, 0); } while (0)
#define PG8_LDA(dst, b, h) do { _Pragma("unroll") for (int m = 0; m < 4; ++m) _Pragma("unroll") for (int k = 0; k < 2; ++k) dst[m][k] = *(const PG8_LAS bf16x8*)(lds + PG8_SA(b, h) + aoff + m * 2048 + k * 1024); } while (0)
#define PG8_LDB(dst, b, h) do { _Pragma("unroll") for (int n = 0; n < 2; ++n) _Pragma("unroll") for (int k = 0; k < 2; ++k) dst[n][k] = *(const PG8_LAS bf16x8*)(lds + PG8_SB(b, h) + boff + n * 2048 + k * 1024); } while (0)
#define PG8_MMA(ai, bj, At, Bt) do { __builtin_amdgcn_s_setprio(1); _Pragma("unroll") for (int m = 0; m < 4; ++m) _Pragma("unroll") for (int n = 0; n < 2; ++n) _Pragma("unroll") for (int k = 0; k < 2; ++k) \
        acc[ai][bj][m][n] = __builtin_amdgcn_mfma_f32_16x16x32_bf16(Bt[n][k], At[m][k], acc[ai][bj][m][n], 0, 0, 0); __builtin_amdgcn_s_setprio(0); } while (0)
#define PG8_WAIT_V(n) asm volatile("s_waitcnt vmcnt(" #n ")" ::: "memory")
#define PG8_WAIT_L(n) asm volatile("s_waitcnt lgkmcnt(" #n ")" ::: "memory")
#define PG8_BAR __builtin_amdgcn_s_barrier()
#define PG8_SCHED __builtin_amdgcn_sched_barrier(0)
    Unit cur, nxt; int ui = 0;
    if (!S.next(0, cur)) return;
    f32x4 acc[2][2][4][2];
#pragma unroll
    for (int a = 0; a < 2; ++a)
#pragma unroll
        for (int b = 0; b < 2; ++b)
#pragma unroll
            for (int m = 0; m < 4; ++m)
#pragma unroll
                for (int n = 0; n < 2; ++n) acc[a][b][m][n] = (f32x4){0.f, 0.f, 0.f, 0.f};
    bf16x8 At[4][2], B0[2][2], B1[2][2];
    const char* cA = S.abase(g, cur, tstep); const char* cB = S.bbase(g, cur, tstep);
    S.a_ready(cur);
    if constexpr (SP2) {
        PG8_STAGE(PG8_SB(0, 0), cB, voffB); PG8_STAGE(PG8_SB(0, 1), cB + hstep, voffB); PG8_STAGE(PG8_SA(0, 0), cA, voffA); PG8_STAGE(PG8_SA(0, 1), cA + hstep, voffA);
        if (wr == 1) PG8_BAR;
        PG8_WAIT_V(2); PG8_BAR;
        PG8_STAGE(PG8_SB(1, 0), cB + kstep, voffB); PG8_STAGE(PG8_SA(1, 0), cA + kstep, voffA); PG8_STAGE(PG8_SB(1, 1), cB + hstep + kstep, voffB);
        PG8_WAIT_V(6); PG8_BAR;
    } else {
        PG8_STAGE(PG8_SB(0, 0), cB, voffB); PG8_STAGE(PG8_SA(0, 0), cA, voffA); PG8_STAGE(PG8_SB(0, 1), cB + hstep, voffB); PG8_STAGE(PG8_SA(0, 1), cA + hstep, voffA);
        if (wr == 1) PG8_BAR;
        PG8_WAIT_V(4); PG8_BAR;
        PG8_STAGE(PG8_SB(1, 0), cB + kstep, voffB); PG8_STAGE(PG8_SA(1, 0), cA + kstep, voffA); PG8_STAGE(PG8_SB(1, 1), cB + hstep + kstep, voffB);
        PG8_WAIT_V(6); PG8_BAR;
    }
    for (;;) {
        const bool has_next = S.next(ui + 1, nxt);
        const char* nA = has_next ? S.abase(g, nxt, tstep) : cA; const char* nB = has_next ? S.bbase(g, nxt, tstep) : cB;
        for (int t = 0; t < nt; t += 2) {
            const bool last = (t == nt - 2);
            const char* a1 = cA + (size_t)(t + 1) * kstep;
            const char* a2 = last ? nA : cA + (size_t)(t + 2) * kstep; const char* b2 = last ? nB : cB + (size_t)(t + 2) * kstep;
            const char* a3 = a2 + kstep; const char* b3 = b2 + kstep;
            if (last && has_next) S.a_ready(nxt);
            if constexpr (SP2) {
            PG8_LDB(B0, 0, 0); PG8_LDB(B1, 0, 1); PG8_SCHED; PG8_LDA(At, 0, 0); PG8_STAGE(PG8_SA(1, 1), a1 + hstep, voffA);
            PG8_WAIT_V(8); PG8_WAIT_L(0); PG8_BAR; PG8_MMA(0, 0, At, B0); PG8_MMA(0, 1, At, B1); PG8_BAR; PG8_SCHED;
            PG8_LDA(At, 0, 1); PG8_STAGE(PG8_SB(0, 0), b2, voffB); PG8_STAGE(PG8_SB(0, 1), b2 + hstep, voffB); PG8_STAGE(PG8_SA(0, 0), a2, voffA);
            PG8_WAIT_V(8); PG8_WAIT_L(0); PG8_BAR; PG8_MMA(1, 0, At, B0); PG8_MMA(1, 1, At, B1); PG8_BAR; PG8_SCHED;
            PG8_LDB(B0, 1, 0); PG8_LDB(B1, 1, 1); PG8_SCHED; PG8_LDA(At, 1, 0); PG8_STAGE(PG8_SA(0, 1), a2 + hstep, voffA);
            PG8_WAIT_V(8); PG8_WAIT_L(0); PG8_BAR; PG8_MMA(0, 0, At, B0); PG8_MMA(0, 1, At, B1); PG8_BAR; PG8_SCHED;
            PG8_LDA(At, 1, 1); PG8_STAGE(PG8_SB(1, 0), b3, voffB); PG8_STAGE(PG8_SB(1, 1), b3 + hstep, voffB); PG8_STAGE(PG8_SA(1, 0), a3, voffA);
            PG8_WAIT_V(8); PG8_WAIT_L(0); PG8_BAR; PG8_MMA(1, 0, At, B0); PG8_MMA(1, 1, At, B1); PG8_BAR; PG8_SCHED;
            } else {
            PG8_LDB(B0, 0, 0); PG8_SCHED; PG8_LDA(At, 0, 0); PG8_STAGE(PG8_SA(1, 1), a1 + hstep, voffA);
            PG8_WAIT_L(8); PG8_BAR; PG8_WAIT_L(0); PG8_MMA(0, 0, At, B0); PG8_BAR; PG8_SCHED;
            PG8_LDB(B1, 0, 1); PG8_STAGE(PG8_SB(0, 0), b2, voffB);
            PG8_BAR; PG8_WAIT_L(0); PG8_MMA(0, 1, At, B1); PG8_BAR;
            PG8_LDA(At, 0, 1); PG8_STAGE(PG8_SA(0, 0), a2, voffA);
            PG8_BAR; PG8_WAIT_L(0); PG8_MMA(1, 0, At, B0); PG8_BAR; PG8_SCHED;
            PG8_STAGE(PG8_SB(0, 1), b2 + hstep, voffB);
            PG8_WAIT_V(6); PG8_BAR; PG8_MMA(1, 1, At, B1); PG8_BAR;
            PG8_LDB(B0, 1, 0); PG8_SCHED; PG8_LDA(At, 1, 0); PG8_STAGE(PG8_SA(0, 1), a2 + hstep, voffA);
            PG8_WAIT_L(8); PG8_BAR; PG8_WAIT_L(0); PG8_MMA(0, 0, At, B0); PG8_BAR; PG8_SCHED;
            PG8_LDB(B1, 1, 1); PG8_STAGE(PG8_SB(1, 0), b3, voffB);
            PG8_BAR; PG8_WAIT_L(0); PG8_MMA(0, 1, At, B1); PG8_BAR;
            PG8_LDA(At, 1, 1); PG8_STAGE(PG8_SA(1, 0), a3, voffA);
            PG8_BAR; PG8_WAIT_L(0); PG8_MMA(1, 0, At, B0); PG8_BAR; PG8_SCHED;
            PG8_STAGE(PG8_SB(1, 1), b3 + hstep, voffB);
            PG8_WAIT_V(6); PG8_BAR; PG8_MMA(1, 1, At, B1); PG8_BAR;
            }
        }
        if constexpr (ALIGN_EPI) { if (wr == 0) PG8_BAR; }
        if constexpr (!Epi::AFTER_DRAIN) { E(acc, cur, wr, wc, fr, fq); S.done(cur); }
        if (!has_next) break;
#pragma unroll
        for (int a = 0; a < 2; ++a)
#pragma unroll
            for (int b = 0; b < 2; ++b)
#pragma unroll
                for (int m = 0; m < 4; ++m)
#pragma unroll
                    for (int n = 0; n < 2; ++n) acc[a][b][m][n] = (f32x4){0.f, 0.f, 0.f, 0.f};
        cur = nxt; cA = nA; cB = nB; ++ui;
        if constexpr (ALIGN_EPI) { if (wr == 1) PG8_BAR; }
    }
    PG8_WAIT_V(0);
    if constexpr (!ALIGN_EPI) { if (wr == 0) PG8_BAR; }
    PG8_BAR;
    if constexpr (Epi::AFTER_DRAIN) { E.fused(acc, cur, wr, wc, fr, fq, lds, wid, lane); S.done(cur); }
#undef PG8_SA
#undef PG8_SB
#undef PG8_STAGE
#undef PG8_LDA
#undef PG8_LDB
#undef PG8_MMA
#undef PG8_WAIT_V
#undef PG8_WAIT_L
#undef PG8_BAR
#undef PG8_SCHED
}
}

#define GAS __attribute__((address_space(1)))
#define LAS __attribute__((address_space(3)))
typedef unsigned short bf16;
typedef unsigned v4u __attribute__((ext_vector_type(4)));
typedef float f32x4 __attribute__((ext_vector_type(4)));
typedef short bf16x8 __attribute__((ext_vector_type(8)));
typedef GAS unsigned gu32;
typedef GAS unsigned long long gu64;
#define RLX_AGENT __ATOMIC_RELAXED, __HIP_MEMORY_SCOPE_AGENT
#define LDS_WAIT() asm volatile("s_waitcnt lgkmcnt(0)" ::: "memory")
#define VM_WAIT() asm volatile("s_waitcnt vmcnt(0)" ::: "memory")
__device__ __forceinline__ unsigned long long rt() { return __builtin_amdgcn_s_memrealtime(); }
typedef float hw_f32x2 __attribute__((ext_vector_type(2))); typedef __bf16 hw_bf16x2 __attribute__((ext_vector_type(2)));
__device__ __forceinline__ unsigned pk2(float lo, float hi) { const hw_f32x2 v = {lo, hi}; return __builtin_bit_cast(unsigned, __builtin_convertvector(v, hw_bf16x2)); }
__device__ __forceinline__ unsigned f2bf(float f) { return pk2(f, 0.f) & 0xffffu; }

#define XB_TMO      128
#define XB_XCNT(j)  (256  + 64 * (j))
#define XB_XSUB(j)  (1280 + 64 * (j))
#define XB_XGEN(j)  (2304 + 64 * (j))
#define XB_TOP      3328
#define XB_TOPGEN   3392
#define XCD_BAR_WORDS 3456
#define XB_SPIN_CAP (1u << 21)

__device__ __forceinline__ unsigned xb_ld(unsigned* p)              { return __hip_atomic_load(p, __ATOMIC_RELAXED, __HIP_MEMORY_SCOPE_AGENT); }
__device__ __forceinline__ unsigned xb_add(unsigned* p, unsigned v) { return __hip_atomic_fetch_add(p, v, __ATOMIC_RELAXED, __HIP_MEMORY_SCOPE_AGENT); }
__device__ __forceinline__ unsigned xb_xcc_id() { return (unsigned)__builtin_amdgcn_s_getreg((3 << 11) | 20) & 0xFu; }
#define XB_SPIN(cond, bar) do { unsigned _sp = 0; while (cond) { __builtin_amdgcn_s_sleep(1); \
    if ((++_sp & 255u) == 0u) { if (xb_ld(&(bar)[XB_TMO])) break; if (_sp > XB_SPIN_CAP) { atomicAdd(&(bar)[XB_TMO], 1u); break; } } } } while (0)

struct XcdBarrier {
    unsigned* bar; unsigned x;
    volatile LAS unsigned* st;
};

__device__ __forceinline__ XcdBarrier xcd_barrier_post(unsigned* bar, volatile LAS unsigned* st) {
    XcdBarrier b; b.bar = bar; b.x = xb_xcc_id(); b.st = st;
    if (threadIdx.x == 0) (void)xb_add(&bar[XB_XCNT(b.x)], 1u);
    return b;
}
__device__ __forceinline__ void xcd_barrier_complete(unsigned* bar, unsigned x, unsigned& nloc, unsigned& nx) {
    const unsigned G = gridDim.x * gridDim.y * gridDim.z;
    unsigned sum, cnt, mine, sp = 0u;
    for (;;) {
        sum = 0u; cnt = 0u; mine = 0u;
#pragma unroll
        for (unsigned j = 0; j < 16; ++j) { const unsigned c = xb_ld(&bar[XB_XCNT(j)]); sum += c; cnt += (c > 0u) ? 1u : 0u; mine = (j == x) ? c : mine; }
        if (sum == G) break;
        __builtin_amdgcn_s_sleep(1);
        if ((++sp & 255u) == 0u) { if (xb_ld(&bar[XB_TMO])) break; if (sp > XB_SPIN_CAP) { atomicAdd(&bar[XB_TMO], 1u); break; } }
    }
    nloc = mine > 0u ? mine : 1u; nx = cnt > 0u ? cnt : 1u;
}

__device__ __forceinline__ void xcd_barrier(const XcdBarrier& b, const int wv) {
    asm volatile("s_waitcnt vmcnt(0)" ::: "memory");
    __syncthreads();
    int xb_lane; asm volatile("v_mbcnt_lo_u32_b32 %0, -1, 0\n\tv_mbcnt_hi_u32_b32 %0, -1, %0" : "=v"(xb_lane));
    if (wv == 0 && xb_lane == 0) {
        unsigned* bar = b.bar;
        __builtin_amdgcn_s_waitcnt(0);
        unsigned nloc = b.st[0], nx = b.st[1];
        if (nloc == 0u) { xcd_barrier_complete(bar, b.x, nloc, nx); b.st[0] = nloc; b.st[1] = nx; }
        const unsigned old = xb_add(&bar[XB_XSUB(b.x)], 1u);
        const unsigned gen = old / nloc;
        if (old + 1u == (gen + 1u) * nloc) {
            __builtin_amdgcn_fence(__ATOMIC_RELEASE, "agent");
            asm volatile("s_waitcnt vmcnt(0)" ::: "memory");
            const unsigned og = xb_add(&bar[XB_TOP], 1u);
            const unsigned tg = og / nx;
            if (og + 1u == (tg + 1u) * nx) xb_add(&bar[XB_TOPGEN], 1u);
            else XB_SPIN(xb_ld(&bar[XB_TOPGEN]) == tg, bar);
            __builtin_amdgcn_fence(__ATOMIC_ACQUIRE, "agent");
            xb_add(&bar[XB_XGEN(b.x)], 1u);
            asm volatile("s_waitcnt vmcnt(0)" ::: "memory");
        } else {
            XB_SPIN(xb_ld(&bar[XB_XGEN(b.x)]) == gen, bar);
            __builtin_amdgcn_fence(__ATOMIC_ACQUIRE, "agent");
            asm volatile("s_waitcnt vmcnt(0)" ::: "memory");
        }
    }
    __syncthreads();
}

#include <hip/hip_bf16.h>
#include <cmath>
namespace attn_body {
using bf16=__hip_bfloat16;
using bf16x8=__attribute__((ext_vector_type(8)))short;
using s16x4=__attribute__((ext_vector_type(4)))short;
using f32x16=__attribute__((ext_vector_type(16)))float;
using u32x4=__attribute__((ext_vector_type(4)))unsigned;
constexpr int D=64;
constexpr int NW=8,QBLK=32,QB=QBLK*NW,KVBLK=64;
constexpr int ATTN_UNIT_ROWS=QB;
__device__ __forceinline__ int crow(int r,int hi){return (r&3)+8*(r>>2)+4*hi;}
#define SBAR() __builtin_amdgcn_sched_barrier(0)
constexpr int NSLOT=3, SLOTB=8192;
constexpr int LDS_K=0, LDS_V=NSLOT*SLOTB, LDS_WS=2*NSLOT*SLOTB, LDS_OST=LDS_WS+NW*64*4, LDS_BYTES=LDS_OST+NW*4096;
constexpr float C2=0.125f*1.4426950408889634f;
__device__ __forceinline__ void glds16(const void*gsrc,unsigned lds_dst){unsigned keep;
  asm volatile("s_mov_b32 %0, m0\n\ts_mov_b32 m0, %2\n\ts_nop 0\n\tglobal_load_lds_dwordx4 %1, off\n\ts_mov_b32 m0, %0":"=&s"(keep):"v"(gsrc),"s"(lds_dst):"memory");}
__device__ __forceinline__ float max3f(float a,float b,float c){float r;asm("v_max3_f32 %0, %1, %2, %3":"=v"(r):"v"(a),"v"(b),"v"(c));return r;}
__device__ __forceinline__ float max2f(float a,float b){float r;asm("v_max_f32_e32 %0, %1, %2":"=v"(r):"v"(a),"v"(b));return r;}
__device__ __forceinline__ float fadd_s(float a,float b){float r;asm("v_add_f32_e32 %0, %1, %2":"=v"(r):"v"(a),"v"(b));return r;}
__device__ __forceinline__ float fsub_s(float a,float b){float r;asm("v_sub_f32_e32 %0, %1, %2":"=v"(r):"v"(a),"v"(b));return r;}
typedef float f32x2_t __attribute__((ext_vector_type(2))); typedef __bf16 bf16x2_t __attribute__((ext_vector_type(2)));
__device__ __forceinline__ unsigned cvtpk_s(float lo,float hi){f32x2_t v={lo,hi};bf16x2_t b=__builtin_convertvector(v,bf16x2_t);return __builtin_bit_cast(unsigned,b);}
#define WAIT_BAR(N) asm volatile("s_waitcnt vmcnt(" #N ") lgkmcnt(0)\n\ts_barrier":::"memory")

__device__ __forceinline__ void qkt(f32x16&p0,f32x16&p1,const char*Kslot,const bf16x8*qr,const f32x16&negm,int r32,int hi){
  const char*kb=Kslot+hi*1024+r32*16;
  #pragma unroll
  for(int d0=0;d0<4;++d0){
    const bf16x8 b0=*reinterpret_cast<const bf16x8*>(kb+d0*2048);
    const bf16x8 b1=*reinterpret_cast<const bf16x8*>(kb+d0*2048+512);
    if(d0==0){p0=__builtin_amdgcn_mfma_f32_32x32x16_bf16(b0,qr[0],negm,0,0,0);p1=__builtin_amdgcn_mfma_f32_32x32x16_bf16(b1,qr[0],negm,0,0,0);}
    else{p0=__builtin_amdgcn_mfma_f32_32x32x16_bf16(b0,qr[d0],p0,0,0,0);p1=__builtin_amdgcn_mfma_f32_32x32x16_bf16(b1,qr[d0],p1,0,0,0);}}
}
typedef __attribute__((address_space(3))) const char* lds_cptr;
typedef short v4i16_t __attribute__((ext_vector_type(4)));
__device__ __forceinline__ void kload8(bf16x8*kf,lds_cptr kp){
  kf[0]=*(const __attribute__((address_space(3))) bf16x8*)(kp);      kf[1]=*(const __attribute__((address_space(3))) bf16x8*)(kp+512);
  kf[2]=*(const __attribute__((address_space(3))) bf16x8*)(kp+2048); kf[3]=*(const __attribute__((address_space(3))) bf16x8*)(kp+2560);
  kf[4]=*(const __attribute__((address_space(3))) bf16x8*)(kp+4096); kf[5]=*(const __attribute__((address_space(3))) bf16x8*)(kp+4608);
  kf[6]=*(const __attribute__((address_space(3))) bf16x8*)(kp+6144); kf[7]=*(const __attribute__((address_space(3))) bf16x8*)(kp+6656);
}
__device__ __forceinline__ void kload2(bf16x8*kf,lds_cptr kp,int j){ kf[2*j]=*(const __attribute__((address_space(3))) bf16x8*)(kp+j*2048); kf[2*j+1]=*(const __attribute__((address_space(3))) bf16x8*)(kp+j*2048+512); }
__device__ __forceinline__ s16x4 vtr(lds_cptr p){ return __builtin_bit_cast(s16x4,__builtin_amdgcn_ds_read_tr16_b64_v4i16((__attribute__((address_space(3))) v4i16_t*)p)); }
__device__ __forceinline__ float rowmax(const f32x16&p0,const f32x16&p1){
  float a=max3f(p0[0],p0[1],p1[0]),b=max3f(p0[2],p0[3],p1[1]);a=max3f(a,p1[2],p1[3]);
  #pragma unroll
  for(int r=4;r<16;r+=4){a=max3f(a,p0[r],p0[r+1]);b=max3f(b,p0[r+2],p0[r+3]);a=max3f(a,p1[r],p1[r+1]);b=max3f(b,p1[r+2],p1[r+3]);}
  const float m=max2f(a,b);
  auto rr=__builtin_amdgcn_permlane32_swap(__float_as_uint(m),__float_as_uint(m),false,false);
  return max2f(__uint_as_float(rr[0]),__uint_as_float(rr[1]));
}
__device__ __forceinline__ void pv(f32x16*o,int vb,bf16x8 pa0,bf16x8 pa1,bf16x8 pa2,bf16x8 pa3){
  #pragma unroll
  for(int d0=0;d0<2;++d0){s16x4 lo[4],hi[4];
    #pragma unroll
    for(int ks=0;ks<4;++ks){
      asm volatile("ds_read_b64_tr_b16 %0,%1 offset:%c2":"=&v"(lo[ks]):"v"(vb),"i"(d0*4096+ks*1024):"memory");
      asm volatile("ds_read_b64_tr_b16 %0,%1 offset:%c2":"=&v"(hi[ks]):"v"(vb),"i"(d0*4096+ks*1024+512):"memory");}
    asm volatile("s_waitcnt lgkmcnt(0)":::"memory");SBAR();
    #define PK(k) (bf16x8){lo[k][0],lo[k][1],lo[k][2],lo[k][3],hi[k][0],hi[k][1],hi[k][2],hi[k][3]}
    o[d0]=__builtin_amdgcn_mfma_f32_32x32x16_bf16(pa0,PK(0),o[d0],0,0,0);
    o[d0]=__builtin_amdgcn_mfma_f32_32x32x16_bf16(pa1,PK(1),o[d0],0,0,0);
    o[d0]=__builtin_amdgcn_mfma_f32_32x32x16_bf16(pa2,PK(2),o[d0],0,0,0);
    o[d0]=__builtin_amdgcn_mfma_f32_32x32x16_bf16(pa3,PK(3),o[d0],0,0,0);
    #undef PK
  }
}

#ifndef ATTN_STORE16
#define ATTN_STORE16(p,v) (*(u32x4*)(p)=(v))
#endif
template<int THRL> __device__ __forceinline__ void attn_unit(const int tid_in,const bf16*Qu,int qpitch,const bf16*__restrict__ Kh,const bf16*__restrict__ Vh,int kvpitch,bf16*Ou,int opitch,const int NT,char*shm){
  int tid_=tid_in; asm volatile("":"+v"(tid_));
  const int tid=tid_,lane=tid&63,r32=lane&31,hi=lane>>5; const int wid=__builtin_amdgcn_readfirstlane(tid>>6);
  const bf16*Qw=Qu+(long)(wid*QBLK)*qpitch;
  const unsigned lds0=(unsigned)(uintptr_t)shm;
  float*wsf=(float*)(shm+LDS_WS)+wid*64;
  const bf16*ksrc=Kh+(long)lane*kvpitch+wid*8;
  const bf16*vsrc=Vh+(long)(16*(wid&3)+(lane>>2))*kvpitch+(wid>>2)*32+(lane&3)*8;
  const unsigned kdst=lds0+LDS_K+wid*1024, vdst=lds0+LDS_V+wid*1024;
  #define DMA_K(t,slot) glds16(ksrc+(long)(t)*KVBLK*kvpitch,(unsigned)__builtin_amdgcn_readfirstlane(kdst+(slot)))
  #define DMA_V(t,slot) glds16(vsrc+(long)(t)*KVBLK*kvpitch,(unsigned)__builtin_amdgcn_readfirstlane(vdst+(slot)))
  const int vb0=(int)(lds0+LDS_V)+((lane>>4)&1)*32+(lane&3)*8+(4*hi+((lane&15)>>2))*64;
  const char*Kbase=shm+LDS_K; bf16x8 kf[8];
  const lds_cptr shm3=(lds_cptr)shm; const lds_cptr kp0=shm3+LDS_K+hi*1024+r32*16; const lds_cptr vp0=shm3+LDS_V+((lane>>4)&1)*32+(lane&3)*8+(4*hi+((lane&15)>>2))*64;
  DMA_K(0,0);DMA_V(0,0);DMA_K(1,SLOTB);
  bf16x8 qr[4];
  #pragma unroll
  for(int d0=0;d0<4;++d0)qr[d0]=*reinterpret_cast<const bf16x8*>(&Qw[(long)r32*qpitch+d0*16+hi*8]);
  float mhat=0.f,l_reg=0.f;f32x16 o[2];o[0]=f32x16{};o[1]=f32x16{};f32x16 negm=f32x16{};asm volatile("":"+v"(negm));
  #define CMASK(P0,P1,t) do{}while(0)
  bool resc=false;
  #define START(P0,P1) do{ const float rm=rowmax(P0,P1); resc=false; \
    { const float dl=rm; mhat=fadd_s(mhat,dl); \
      _Pragma("unroll") for(int r=0;r<16;++r){P0[r]=fsub_s(P0[r],dl);P1[r]=fsub_s(P1[r],dl);} \
      _Pragma("unroll") for(int r=0;r<16;++r)negm[r]=-mhat; asm volatile("":"+v"(negm)); } \
    _Pragma("unroll") for(int r=0;r<16;++r)P0[r]=__builtin_amdgcn_exp2f(P0[r]); }while(0)
  #define RESC() do{ if(resc){ asm volatile("s_waitcnt lgkmcnt(0)":::"memory"); \
      _Pragma("unroll") for(int d_=0;d_<2;++d_) _Pragma("unroll") for(int r=0;r<16;++r)o[d_][r]*=wsf[crow(r,hi)]; } }while(0)
  f32x16 pA0,pA1,pB0,pB1;
  int sl_prev=0,sl_cur=0,sl_next=SLOTB;
  #define ROT() do{sl_prev=sl_cur;sl_cur=sl_next;sl_next=(sl_next==(NSLOT-1)*SLOTB)?0:sl_next+SLOTB;}while(0)
  DMA_K(2,2*SLOTB);
  WAIT_BAR(3);
  qkt(pA0,pA1,Kbase,qr,negm,r32,hi);asm volatile("s_nop 15\n\ts_nop 7":"+v"(pA0),"+v"(pA1));CMASK(pA0,pA1,0);
  START(pA0,pA1);
  _Pragma("unroll") for(int r=0;r<16;++r)pA1[r]=__builtin_amdgcn_exp2f(pA1[r]);
  WAIT_BAR(0);
  DMA_K(3,0);DMA_V(1,SLOTB);
  ROT();
  kload8(kf,kp0+sl_cur);
  WAIT_BAR(2);
  s16x4 vlo[8],vhi[8]; u32x4 pw0,pw1,pw2,pw3;
  #define PKW(P,B) cvtpk_s(P[B],P[B+1])
  #define PAF(k) __builtin_bit_cast(bf16x8,pw##k)
  #define VFR(i) (bf16x8){vlo[i][0],vlo[i][1],vlo[i][2],vlo[i][3],vhi[i][0],vhi[i][1],vhi[i][2],vhi[i][3]}
  #define PIN(x) asm volatile("":"+v"(x))
  #define MX3(a,b,c) __builtin_fmaxf(__builtin_fmaxf((a),(b)),(c))
  #define GAPA(MF,A0,A1,A2,A3,W0,W1,PW) do{ MF; sacc+=A0; sacc+=A1; sacc+=A2; sacc+=A3; PIN(sacc); W0; W1; PIN(PW); SBAR(); }while(0)
  #define EX(v) __builtin_amdgcn_exp2f(v)
  #define GAPB(MF,X,B) do{ MF; X[B]=EX(X[B]); X[B+1]=EX(X[B+1]); X[B+2]=EX(X[B+2]); X[B+3]=EX(X[B+3]); PIN(X); SBAR(); }while(0)
  #define VRD(i) do{ vlo[i]=vtr(vp_+(((i)>>2)*4096+((i)&3)*1024)); vhi[i]=vtr(vp_+(((i)>>2)*4096+((i)&3)*1024+512)); }while(0)
  #define KRD(G,j) do{ if(G){ kload2(kf,kp0+sl_next,j); SBAR(); } }while(0)
  #define STEP(C0,C1,P0,P1,t,GK,GV,GL) do{ SBAR(); \
    const lds_cptr vp_=vp0+sl_prev; \
    VRD(0); SBAR(); float sacc=(P0[0]+P0[1]); \
    GAPA(C0=__builtin_amdgcn_mfma_f32_32x32x16_bf16(kf[0],qr[0],negm,0,0,0), P0[2],P0[3],P0[4],P0[5],     pw0[0]=PKW(P0,0), pw0[1]=PKW(P0,2), pw0); \
    VRD(4); SBAR(); GAPA(C1=__builtin_amdgcn_mfma_f32_32x32x16_bf16(kf[1],qr[0],negm,0,0,0), P0[6],P0[7],P0[8],P0[9],     pw0[2]=PKW(P0,4), pw0[3]=PKW(P0,6), pw0); \
    VRD(1); SBAR(); GAPA(C0=__builtin_amdgcn_mfma_f32_32x32x16_bf16(kf[2],qr[1],C0,0,0,0),   P0[10],P0[11],P0[12],P0[13], pw1[0]=PKW(P0,8), pw1[1]=PKW(P0,10), pw1); \
    VRD(5); SBAR(); GAPA(C1=__builtin_amdgcn_mfma_f32_32x32x16_bf16(kf[3],qr[1],C1,0,0,0),   P0[14],P0[15],P1[0],P1[1],   pw1[2]=PKW(P0,12),pw1[3]=PKW(P0,14), pw1); \
    VRD(2); SBAR(); GAPA(C0=__builtin_amdgcn_mfma_f32_32x32x16_bf16(kf[4],qr[2],C0,0,0,0),   P1[2],P1[3],P1[4],P1[5],     pw2[0]=PKW(P1,0), pw2[1]=PKW(P1,2), pw2); \
    VRD(6); SBAR(); GAPA(C1=__builtin_amdgcn_mfma_f32_32x32x16_bf16(kf[5],qr[2],C1,0,0,0),   P1[6],P1[7],P1[8],P1[9],     pw2[2]=PKW(P1,4), pw2[3]=PKW(P1,6), pw2); \
    VRD(3); SBAR(); GAPA(C0=__builtin_amdgcn_mfma_f32_32x32x16_bf16(kf[6],qr[3],C0,0,0,0),   P1[10],P1[11],P1[12],P1[13], pw3[0]=PKW(P1,8), pw3[1]=PKW(P1,10), pw3); \
    VRD(7); SBAR(); GAPA(C1=__builtin_amdgcn_mfma_f32_32x32x16_bf16(kf[7],qr[3],C1,0,0,0),   P1[14],P1[15],0.f,0.f,       pw3[2]=PKW(P1,12),pw3[3]=PKW(P1,14), pw3); \
    l_reg+=sacc; \
    if(GK){DMA_K((t)+3,sl_cur);} if(GV){DMA_V((t)+1,sl_next);} \
    CMASK(C0,C1,t); \
    { float a=MX3(C0[0],C0[1],C1[0]),b=MX3(C0[2],C0[3],C1[1]); a=MX3(a,C1[2],C1[3]); \
      _Pragma("unroll") for(int r=4;r<16;r+=4){a=MX3(a,C0[r],C0[r+1]);b=MX3(b,C0[r+2],C0[r+3]);a=MX3(a,C1[r],C1[r+1]);b=MX3(b,C1[r+2],C1[r+3]);} \
      float rm=__builtin_fmaxf(a,b); { auto rr=__builtin_amdgcn_permlane32_swap(__float_as_uint(rm),__float_as_uint(rm),false,false); rm=__builtin_fmaxf(__uint_as_float(rr[0]),__uint_as_float(rr[1])); } \
      resc=false; \
      if(__builtin_expect(__any(rm>(float)THRL),0)){ const float dl=__builtin_fmaxf(rm,0.f); mhat+=dl; \
        _Pragma("unroll") for(int r=0;r<16;++r){C0[r]-=dl;C1[r]-=dl;} \
        _Pragma("unroll") for(int r=0;r<16;++r)negm[r]=-mhat; asm volatile("":"+v"(negm)); \
        const float f=__builtin_amdgcn_exp2f(-dl); l_reg*=f; if(hi==0)wsf[r32]=f; resc=true; } } \
    SBAR(); \
    GAPB(o[0]=__builtin_amdgcn_mfma_f32_32x32x16_bf16(PAF(0),VFR(0),o[0],0,0,0), C0,0); \
    GAPB(o[1]=__builtin_amdgcn_mfma_f32_32x32x16_bf16(PAF(0),VFR(4),o[1],0,0,0), C0,4); \
    KRD(GL,0); GAPB(o[0]=__builtin_amdgcn_mfma_f32_32x32x16_bf16(PAF(1),VFR(1),o[0],0,0,0), C0,8); \
    KRD(GL,1); GAPB(o[1]=__builtin_amdgcn_mfma_f32_32x32x16_bf16(PAF(1),VFR(5),o[1],0,0,0), C0,12); \
    KRD(GL,2); GAPB(o[0]=__builtin_amdgcn_mfma_f32_32x32x16_bf16(PAF(2),VFR(2),o[0],0,0,0), C1,0); \
    KRD(GL,3); GAPB(o[1]=__builtin_amdgcn_mfma_f32_32x32x16_bf16(PAF(2),VFR(6),o[1],0,0,0), C1,4); \
    GAPB(o[0]=__builtin_amdgcn_mfma_f32_32x32x16_bf16(PAF(3),VFR(3),o[0],0,0,0), C1,8); \
    GAPB(o[1]=__builtin_amdgcn_mfma_f32_32x32x16_bf16(PAF(3),VFR(7),o[1],0,0,0), C1,12); \
    }while(0)
  int t=1;
  #undef CMASK
  #define CMASK(P0,P1,t) do{}while(0)
  for(;t+5<NT;t+=2){
    STEP(pB0,pB1,pA0,pA1,t,true,true,true);     WAIT_BAR(2); RESC(); ROT();
    STEP(pA0,pA1,pB0,pB1,t+1,true,true,true);   WAIT_BAR(2); RESC(); ROT();
  }
  #undef CMASK
  #define CMASK(P0,P1,t) do{}while(0)
  #define ENDW(tt) do{ if((tt)+3<NT){WAIT_BAR(2);} else if((tt)+2<NT){WAIT_BAR(1);} else {WAIT_BAR(0);} }while(0)
  for(;t+1<NT;t+=2){
    STEP(pB0,pB1,pA0,pA1,t,(t+3<NT),(t+1<NT),(t+1<NT));       ENDW(t);   RESC(); ROT();
    STEP(pA0,pA1,pB0,pB1,t+1,(t+4<NT),(t+2<NT),(t+2<NT));     ENDW(t+1); RESC(); ROT();
  }
  STEP(pB0,pB1,pA0,pA1,NT-1,false,false,false); RESC();
  { float sacc=pB0[0]+pB0[1]; _Pragma("unroll") for(int r=2;r<16;++r)sacc+=pB0[r]; _Pragma("unroll") for(int r=0;r<16;++r)sacc+=pB1[r]; l_reg+=sacc;
    pw0=(u32x4){PKW(pB0,0),PKW(pB0,2),PKW(pB0,4),PKW(pB0,6)};pw1=(u32x4){PKW(pB0,8),PKW(pB0,10),PKW(pB0,12),PKW(pB0,14)};pw2=(u32x4){PKW(pB1,0),PKW(pB1,2),PKW(pB1,4),PKW(pB1,6)};pw3=(u32x4){PKW(pB1,8),PKW(pB1,10),PKW(pB1,12),PKW(pB1,14)};
    SBAR(); pv(o,vb0+sl_cur,PAF(0),PAF(1),PAF(2),PAF(3)); }
  #undef PKW
  #undef PAF
  #undef VFR
  #undef PIN
  #undef MX3
  #undef GAPA
  #undef GAPB
  #undef EX
  #undef VRD
  #undef KRD
  #undef STEP
  #undef ENDW
  {auto rr=__builtin_amdgcn_permlane32_swap(__float_as_uint(l_reg),__float_as_uint(l_reg),false,false);l_reg=__uint_as_float(rr[0])+__uint_as_float(rr[1]);}
  if(hi==0)wsf[32+r32]=l_reg;asm volatile("s_waitcnt lgkmcnt(0)":::"memory");
  float rli[16];
  #pragma unroll
  for(int r=0;r<16;++r)rli[r]=__builtin_amdgcn_rcpf(wsf[32+crow(r,hi)]);
  bf16*Ow=Ou+(long)(wid*QBLK)*opitch;
  { bf16*stg=(bf16*)(shm+LDS_OST)+wid*2048;
    #pragma unroll
    for(int r=0;r<16;++r){const int orow=crow(r,hi);
      #pragma unroll
      for(int d0=0;d0<2;++d0)stg[orow*64+d0*32+r32]=__float2bfloat16(o[d0][r]*rli[r]);}
    asm volatile("s_waitcnt lgkmcnt(0)":::"memory");
    #pragma unroll
    for(int i=0;i<4;++i){const int row=i*8+(lane>>3),ch=lane&7; const u32x4 v=*(const u32x4*)(stg+row*64+ch*8); ATTN_STORE16(Ow+(long)row*opitch+ch*8,v);} }
  asm volatile("s_waitcnt lgkmcnt(0)\n\ts_barrier":::"memory");
  #undef DMA_K
  #undef DMA_V
  #undef CMASK
  #undef START
  #undef RESC
  #undef ROT
}
__device__ __forceinline__ void pv128(f32x16*o,int vb,bf16x8 pa0,bf16x8 pa1,bf16x8 pa2,bf16x8 pa3){
  #pragma unroll
  for(int d0=0;d0<4;++d0){s16x4 lo[4],hi[4];
    #pragma unroll
    for(int ks=0;ks<4;++ks){
      asm volatile("ds_read_b64_tr_b16 %0,%1 offset:%c2":"=&v"(lo[ks]):"v"(vb),"i"(d0*4096+ks*1024):"memory");
      asm volatile("ds_read_b64_tr_b16 %0,%1 offset:%c2":"=&v"(hi[ks]):"v"(vb),"i"(d0*4096+ks*1024+512):"memory");}
    asm volatile("s_waitcnt lgkmcnt(0)":::"memory");SBAR();
    #define PK(k) (bf16x8){lo[k][0],lo[k][1],lo[k][2],lo[k][3],hi[k][0],hi[k][1],hi[k][2],hi[k][3]}
    o[d0]=__builtin_amdgcn_mfma_f32_32x32x16_bf16(pa0,PK(0),o[d0],0,0,0);
    o[d0]=__builtin_amdgcn_mfma_f32_32x32x16_bf16(pa1,PK(1),o[d0],0,0,0);
    o[d0]=__builtin_amdgcn_mfma_f32_32x32x16_bf16(pa2,PK(2),o[d0],0,0,0);
    o[d0]=__builtin_amdgcn_mfma_f32_32x32x16_bf16(pa3,PK(3),o[d0],0,0,0);
    #undef PK
  }
}
constexpr int LDS_V128=NSLOT*SLOTB, LDS_WS128=LDS_V128+NSLOT*2*SLOTB, LDS_OST128=LDS_WS128+NW*64*4, LDS_BYTES128=LDS_OST128+NW*8192;
template<int THRL> __device__ __forceinline__ void attn_unit128(const int tid_in,const bf16*Qu,int qpitch,const bf16*__restrict__ Kh,const bf16*__restrict__ Vh,int kvpitch,bf16*Ou,int opitch,const int NT,char*shm){
  int tid_=tid_in; asm volatile("":"+v"(tid_));
  const int tid=tid_,lane=tid&63,r32=lane&31,hi=lane>>5; const int wid=__builtin_amdgcn_readfirstlane(tid>>6);
  const bf16*Qw=Qu+(long)(wid*QBLK)*qpitch;
  const unsigned lds0=(unsigned)(uintptr_t)shm;
  float*wsf=(float*)(shm+LDS_WS128)+wid*64;
  const bf16*ksrc=Kh+(long)lane*kvpitch+wid*8;
  const bf16*vsrc=Vh+(long)(16*(wid&3)+(lane>>2))*kvpitch+(wid>>2)*32+(lane&3)*8;
  const unsigned kdst=lds0+LDS_K+wid*1024, vdst=lds0+LDS_V128+wid*1024;
  #define DMA_K(t,slot) glds16(ksrc+(long)(t)*KVBLK*kvpitch,(unsigned)__builtin_amdgcn_readfirstlane(kdst+(slot)))
  #define DMA_V(t,slot) do{ glds16(vsrc+(long)(t)*KVBLK*kvpitch,(unsigned)__builtin_amdgcn_readfirstlane(vdst+2*(slot))); glds16(vsrc+(long)(t)*KVBLK*kvpitch+64,(unsigned)__builtin_amdgcn_readfirstlane(vdst+8192+2*(slot))); }while(0)
  const int vb0=(int)(lds0+LDS_V128)+((lane>>4)&1)*32+(lane&3)*8+(4*hi+((lane&15)>>2))*64;
  const char*Kbase=shm+LDS_K; bf16x8 kf[8];
  const lds_cptr shm3=(lds_cptr)shm; const lds_cptr kp0=shm3+LDS_K+hi*1024+r32*16; const lds_cptr vp0=shm3+LDS_V128+((lane>>4)&1)*32+(lane&3)*8+(4*hi+((lane&15)>>2))*64;
  DMA_K(0,0);DMA_V(0,0);DMA_K(1,SLOTB);
  bf16x8 qr[4];
  #pragma unroll
  for(int d0=0;d0<4;++d0)qr[d0]=*reinterpret_cast<const bf16x8*>(&Qw[(long)r32*qpitch+d0*16+hi*8]);
  float mhat=0.f,l_reg=0.f;f32x16 o[4];o[0]=f32x16{};o[1]=f32x16{};o[2]=f32x16{};o[3]=f32x16{};f32x16 negm=f32x16{};asm volatile("":"+v"(negm));
  #define CMASK(P0,P1,t) do{}while(0)
  bool resc=false;
  #define START(P0,P1) do{ const float rm=rowmax(P0,P1); resc=false; \
    { const float dl=rm; mhat=fadd_s(mhat,dl); \
      _Pragma("unroll") for(int r=0;r<16;++r){P0[r]=fsub_s(P0[r],dl);P1[r]=fsub_s(P1[r],dl);} \
      _Pragma("unroll") for(int r=0;r<16;++r)negm[r]=-mhat; asm volatile("":"+v"(negm)); } \
    _Pragma("unroll") for(int r=0;r<16;++r)P0[r]=__builtin_amdgcn_exp2f(P0[r]); }while(0)
  #define RESC() do{ if(resc){ asm volatile("s_waitcnt lgkmcnt(0)":::"memory"); \
      _Pragma("unroll") for(int d_=0;d_<4;++d_) _Pragma("unroll") for(int r=0;r<16;++r)o[d_][r]*=wsf[crow(r,hi)]; } }while(0)
  f32x16 pA0,pA1,pB0,pB1;
  int sl_prev=0,sl_cur=0,sl_next=SLOTB;
  #define ROT() do{sl_prev=sl_cur;sl_cur=sl_next;sl_next=(sl_next==(NSLOT-1)*SLOTB)?0:sl_next+SLOTB;}while(0)
  DMA_K(2,2*SLOTB);
  WAIT_BAR(4);
  qkt(pA0,pA1,Kbase,qr,negm,r32,hi);asm volatile("s_nop 15\n\ts_nop 7":"+v"(pA0),"+v"(pA1));CMASK(pA0,pA1,0);
  START(pA0,pA1);
  _Pragma("unroll") for(int r=0;r<16;++r)pA1[r]=__builtin_amdgcn_exp2f(pA1[r]);
  WAIT_BAR(0);
  DMA_K(3,0);DMA_V(1,SLOTB);
  ROT();
  kload8(kf,kp0+sl_cur);
  WAIT_BAR(3);
  s16x4 vbl[3],vbh[3]; u32x4 pw0,pw1,pw2,pw3;
  #define PKW(P,B) cvtpk_s(P[B],P[B+1])
  #define PAF(k) __builtin_bit_cast(bf16x8,pw##k)
  #define VFB(s) (bf16x8){vbl[s][0],vbl[s][1],vbl[s][2],vbl[s][3],vbh[s][0],vbh[s][1],vbh[s][2],vbh[s][3]}
  #define PIN(x) asm volatile("":"+v"(x))
  #define MX3(a,b,c) __builtin_fmaxf(__builtin_fmaxf((a),(b)),(c))
  #define GAPA(MF,A0,A1,A2,A3,W0,W1,PW) do{ MF; sacc+=A0; sacc+=A1; sacc+=A2; sacc+=A3; PIN(sacc); W0; W1; PIN(PW); SBAR(); }while(0)
  #define EX(v) __builtin_amdgcn_exp2f(v)
  #define VRD3(s,i) do{ vbl[s]=vtr(vp_+(((i)&3)*4096+((i)>>2)*1024)); vbh[s]=vtr(vp_+(((i)&3)*4096+((i)>>2)*1024+512)); }while(0)
  #define GAPB(i,X,B) do{ o[(i)&3]=__builtin_amdgcn_mfma_f32_32x32x16_bf16(PAFI((i)>>2),VFB((i)%3),o[(i)&3],0,0,0); if((i)+2<16){VRD3(((i)+2)%3,(i)+2);} X[B]=EX(X[B]); X[B+1]=EX(X[B+1]); PIN(X); SBAR(); }while(0)
  #define PAFI(k) ((k)==0?PAF(0):(k)==1?PAF(1):(k)==2?PAF(2):PAF(3))
  #define KRD(G,j) do{ if(G){ kload2(kf,kp0+sl_next,j); SBAR(); } }while(0)
  #define STEP(C0,C1,P0,P1,t,GK,GV,GL) do{ SBAR(); \
    const lds_cptr vp_=vp0+2*sl_prev; \
    float sacc=(P0[0]+P0[1]); \
    GAPA(C0=__builtin_amdgcn_mfma_f32_32x32x16_bf16(kf[0],qr[0],negm,0,0,0), P0[2],P0[3],P0[4],P0[5],     pw0[0]=PKW(P0,0), pw0[1]=PKW(P0,2), pw0); \
    GAPA(C1=__builtin_amdgcn_mfma_f32_32x32x16_bf16(kf[1],qr[0],negm,0,0,0), P0[6],P0[7],P0[8],P0[9],     pw0[2]=PKW(P0,4), pw0[3]=PKW(P0,6), pw0); \
    GAPA(C0=__builtin_amdgcn_mfma_f32_32x32x16_bf16(kf[2],qr[1],C0,0,0,0),   P0[10],P0[11],P0[12],P0[13], pw1[0]=PKW(P0,8), pw1[1]=PKW(P0,10), pw1); \
    GAPA(C1=__builtin_amdgcn_mfma_f32_32x32x16_bf16(kf[3],qr[1],C1,0,0,0),   P0[14],P0[15],P1[0],P1[1],   pw1[2]=PKW(P0,12),pw1[3]=PKW(P0,14), pw1); \
    GAPA(C0=__builtin_amdgcn_mfma_f32_32x32x16_bf16(kf[4],qr[2],C0,0,0,0),   P1[2],P1[3],P1[4],P1[5],     pw2[0]=PKW(P1,0), pw2[1]=PKW(P1,2), pw2); \
    GAPA(C1=__builtin_amdgcn_mfma_f32_32x32x16_bf16(kf[5],qr[2],C1,0,0,0),   P1[6],P1[7],P1[8],P1[9],     pw2[2]=PKW(P1,4), pw2[3]=PKW(P1,6), pw2); \
    VRD3(0,0); SBAR(); GAPA(C0=__builtin_amdgcn_mfma_f32_32x32x16_bf16(kf[6],qr[3],C0,0,0,0),   P1[10],P1[11],P1[12],P1[13], pw3[0]=PKW(P1,8), pw3[1]=PKW(P1,10), pw3); \
    VRD3(1,1); SBAR(); GAPA(C1=__builtin_amdgcn_mfma_f32_32x32x16_bf16(kf[7],qr[3],C1,0,0,0),   P1[14],P1[15],0.f,0.f,       pw3[2]=PKW(P1,12),pw3[3]=PKW(P1,14), pw3); \
    l_reg+=sacc; \
    if(GK){DMA_K((t)+3,sl_cur);} if(GV){DMA_V((t)+1,sl_next);} \
    { float a=MX3(C0[0],C0[1],C1[0]),b=MX3(C0[2],C0[3],C1[1]); a=MX3(a,C1[2],C1[3]); \
      _Pragma("unroll") for(int r=4;r<16;r+=4){a=MX3(a,C0[r],C0[r+1]);b=MX3(b,C0[r+2],C0[r+3]);a=MX3(a,C1[r],C1[r+1]);b=MX3(b,C1[r+2],C1[r+3]);} \
      float rm=__builtin_fmaxf(a,b); { auto rr=__builtin_amdgcn_permlane32_swap(__float_as_uint(rm),__float_as_uint(rm),false,false); rm=__builtin_fmaxf(__uint_as_float(rr[0]),__uint_as_float(rr[1])); } \
      resc=false; \
      if(__builtin_expect(__any(rm>(float)THRL),0)){ const float dl=__builtin_fmaxf(rm,0.f); mhat+=dl; \
        _Pragma("unroll") for(int r=0;r<16;++r){C0[r]-=dl;C1[r]-=dl;} \
        _Pragma("unroll") for(int r=0;r<16;++r)negm[r]=-mhat; asm volatile("":"+v"(negm)); \
        const float f=__builtin_amdgcn_exp2f(-dl); l_reg*=f; if(hi==0)wsf[r32]=f; resc=true; } } \
    SBAR(); \
    GAPB(0,C0,0); GAPB(1,C0,2); GAPB(2,C0,4); GAPB(3,C0,6); \
    KRD(GL,0); GAPB(4,C0,8); GAPB(5,C0,10); KRD(GL,1); GAPB(6,C0,12); GAPB(7,C0,14); \
    KRD(GL,2); GAPB(8,C1,0); GAPB(9,C1,2); KRD(GL,3); GAPB(10,C1,4); GAPB(11,C1,6); \
    GAPB(12,C1,8); GAPB(13,C1,10); GAPB(14,C1,12); GAPB(15,C1,14); \
    }while(0)
  int t=1;
  #undef CMASK
  #define CMASK(P0,P1,t) do{}while(0)
  for(;t+5<NT;t+=2){
    STEP(pB0,pB1,pA0,pA1,t,true,true,true);     WAIT_BAR(3); RESC(); ROT();
    STEP(pA0,pA1,pB0,pB1,t+1,true,true,true);   WAIT_BAR(3); RESC(); ROT();
  }
  #undef CMASK
  #define CMASK(P0,P1,t) do{}while(0)
  #define ENDW(tt) do{ if((tt)+3<NT){WAIT_BAR(3);} else if((tt)+2<NT){WAIT_BAR(2);} else {WAIT_BAR(0);} }while(0)
  for(;t+1<NT;t+=2){
    STEP(pB0,pB1,pA0,pA1,t,(t+3<NT),(t+1<NT),(t+1<NT));       ENDW(t);   RESC(); ROT();
    STEP(pA0,pA1,pB0,pB1,t+1,(t+4<NT),(t+2<NT),(t+2<NT));     ENDW(t+1); RESC(); ROT();
  }
  STEP(pB0,pB1,pA0,pA1,NT-1,false,false,false); RESC();
  { float sacc=pB0[0]+pB0[1]; _Pragma("unroll") for(int r=2;r<16;++r)sacc+=pB0[r]; _Pragma("unroll") for(int r=0;r<16;++r)sacc+=pB1[r]; l_reg+=sacc;
    pw0=(u32x4){PKW(pB0,0),PKW(pB0,2),PKW(pB0,4),PKW(pB0,6)};pw1=(u32x4){PKW(pB0,8),PKW(pB0,10),PKW(pB0,12),PKW(pB0,14)};pw2=(u32x4){PKW(pB1,0),PKW(pB1,2),PKW(pB1,4),PKW(pB1,6)};pw3=(u32x4){PKW(pB1,8),PKW(pB1,10),PKW(pB1,12),PKW(pB1,14)};
    SBAR(); pv128(o,vb0+2*sl_cur,PAF(0),PAF(1),PAF(2),PAF(3)); }
  #undef PKW
  #undef PAF
  #undef VFB
  #undef VRD3
  #undef PAFI
  #undef PIN
  #undef MX3
  #undef GAPA
  #undef GAPB
  #undef EX
  #undef KRD
  #undef STEP
  #undef ENDW
  {auto rr=__builtin_amdgcn_permlane32_swap(__float_as_uint(l_reg),__float_as_uint(l_reg),false,false);l_reg=__uint_as_float(rr[0])+__uint_as_float(rr[1]);}
  if(hi==0)wsf[32+r32]=l_reg;asm volatile("s_waitcnt lgkmcnt(0)":::"memory");
  float rli[16];
  #pragma unroll
  for(int r=0;r<16;++r)rli[r]=__builtin_amdgcn_rcpf(wsf[32+crow(r,hi)]);
  bf16*Ow=Ou+(long)(wid*QBLK)*opitch;
  { bf16*stg=(bf16*)(shm+LDS_OST128)+wid*4096;
    #pragma unroll
    for(int r=0;r<16;++r){const int orow=crow(r,hi);
      #pragma unroll
      for(int d0=0;d0<4;++d0)stg[orow*128+d0*32+r32]=__float2bfloat16(o[d0][r]*rli[r]);}
    asm volatile("s_waitcnt lgkmcnt(0)":::"memory");
    #pragma unroll
    for(int i=0;i<8;++i){const int row=i*4+(lane>>4),ch=lane&15; const u32x4 v=*(const u32x4*)(stg+row*128+ch*8); ATTN_STORE16(Ow+(long)row*opitch+ch*8,v);} }
  asm volatile("s_waitcnt lgkmcnt(0)\n\ts_barrier":::"memory");
  #undef DMA_K
  #undef DMA_V
  #undef CMASK
  #undef START
  #undef RESC
  #undef ROT
}
constexpr int ATTN_LDS_BYTES=LDS_BYTES;
#undef SBAR
#undef WAIT_BAR
}

constexpr int NB = 4, SEQ = 8192, CTXL = 256, PB = SEQ + CTXL, R = NB * PB, D = 1024, DFF = 4096, DEPTH = 4;
constexpr int NP_EV = 2560, NP_OD = 1536;
constexpr float EPS = 1e-6f;
constexpr float C2 = 0.125f * 1.4426950408889634f;
constexpr int EQ = 0, EK = 256, EVV = 512, EG = 1024, EGQ = 1536, EGK = 2048, EGV = 2176, ELR = 2304;
constexpr int ODQ = 0, ODK = 512, ODV = 1024;
constexpr int NWAVES = 8, NTHR = 512;
constexpr int LDS_BYTES = 163840, LDS_MISC = 163840 - 256;

constexpr size_t MiB = 1u << 20;
constexpr size_t WS_CTL = 0, CTL_ZERO_BYTES = 1 * MiB;
constexpr size_t WS_MOD = 1 * MiB;
constexpr size_t WS_TAB = 2 * MiB;
constexpr size_t WS_HID = 3 * MiB;
constexpr size_t WS_XB = 36 * MiB;
constexpr size_t WS_W = 12 * MiB, W_IN = 0, W_OUT = 6 * MiB, W_1 = 8 * MiB, W_2 = 16 * MiB;
constexpr size_t WS_A1 = 108 * MiB;
constexpr size_t WS_Y = 174 * MiB;
constexpr size_t WS_PH = 240 * MiB;
constexpr size_t WS_OGLA = WS_PH + 165 * MiB;
constexpr size_t WS_HF = WS_PH + 198 * MiB;
constexpr size_t WS_SLAB = 504 * MiB;
constexpr size_t WS_END = 512 * MiB;
constexpr int CW_BAR = 4096;

struct Args { const float* in[27]; float* out; unsigned char* ws; int ph_lo, ph_hi; };
enum { I_X = 0, I_C, I_CTX, I_CCTX, I_WADA, I_BADA, I_NORMG, I_W1, I_W2, I_EVWIN, I_EVWLR, I_EVBLR, I_EVGLAG, I_EVQKG, I_EVWOUT,
       I_ODWIN, I_ODCONVW, I_ODCONVB, I_FW1, I_FB1, I_FW2, I_FB2, I_FW3, I_HYBIAS, I_LAM, I_DIFFG, I_ODWOUT };

typedef const __attribute__((address_space(4))) Args* KA;
__device__ __forceinline__ KA ka_launder(KA a) { asm volatile("" : "+s"(a)); return a; }
__device__ __forceinline__ int otid_(int wv) { int l; asm volatile("v_mbcnt_lo_u32_b32 %0, -1, 0\n\tv_mbcnt_hi_u32_b32 %0, -1, %0" : "=v"(l)); return (wv << 6) | l; }
#define otid() otid_(wv_)
__device__ __forceinline__ int obx() { int b = blockIdx.x; asm volatile("" : "+s"(b)); return b; }
__device__ __forceinline__ float bf2f(bf16 v) { return __builtin_bit_cast(float, (unsigned)v << 16); }
template <int CTRL> __device__ __forceinline__ float dpp_mov(float v) { return __builtin_bit_cast(float, __builtin_amdgcn_update_dpp(0, __builtin_bit_cast(int, v), CTRL, 0xF, 0xF, false)); }
__device__ __forceinline__ float sum16(float v) {
    v += dpp_mov<0xB1>(v);
    v += dpp_mov<0x4E>(v);
    v += dpp_mov<0x141>(v);
    v += dpp_mov<0x140>(v);
    return v;
}
__device__ __forceinline__ float sum_rows4(float v) {
    const unsigned u = __builtin_bit_cast(unsigned, v);
    auto a = __builtin_amdgcn_permlane16_swap(u, u, false, false);
    const float w = __builtin_bit_cast(float, (unsigned)a[0]) + __builtin_bit_cast(float, (unsigned)a[1]);
    const unsigned uw = __builtin_bit_cast(unsigned, w);
    auto b = __builtin_amdgcn_permlane32_swap(uw, uw, false, false);
    return __builtin_bit_cast(float, (unsigned)b[0]) + __builtin_bit_cast(float, (unsigned)b[1]);
}
__device__ __forceinline__ float wave_sum(float v) { return sum_rows4(sum16(v)); }
__device__ __forceinline__ float rl(float v, int k) { return __builtin_bit_cast(float, __builtin_amdgcn_readlane(__builtin_bit_cast(int, v), k)); }
__device__ __forceinline__ float siluf(float v) { return v / (1.f + __expf(-v)); }
__device__ __forceinline__ float lam_init_of(int layer) { return 0.8f - 0.6f * expf(-0.3f * (float)layer); }
__device__ __forceinline__ const float* xin_ptr(KA a, int r) {
    const int b = r / PB, p = r - b * PB;
    return p < CTXL ? a->in[I_CTX] + (size_t)(b * CTXL + p) * D : a->in[I_X] + (size_t)(b * SEQ + (p - CTXL)) * D;
}
__device__ __forceinline__ int row_cls(int r) { const int b = r / PB, p = r - b * PB; return p < CTXL ? 4 : b; }

__device__ __forceinline__ void transpose_item(const float* W, int K, int N, int src_n0, bf16* WT, int dst_n0, int k0, LAS float* scr, int lane) {
    if (src_n0 < 0) {
#pragma unroll
        for (int j = 0; j < 4; ++j) { const int n = (lane >> 3) + 8 * j; *(GAS v4u*)(WT + (size_t)(dst_n0 + n) * K + k0 + 8 * (lane & 7)) = (v4u){0u, 0u, 0u, 0u}; }
        return;
    }
#pragma unroll 8
    for (int i = 0; i < 32; ++i) { const int kk = 2 * i + (lane >> 5); scr[kk * 33 + (lane & 31)] = W[(size_t)(k0 + kk) * N + src_n0 + (lane & 31)]; }
    LDS_WAIT(); asm volatile("" ::: "memory");
    const int c = lane & 7;
#pragma unroll
    for (int j = 0; j < 4; ++j) { const int n = (lane >> 3) + 8 * j; const LAS float* s = scr + (8 * c) * 33 + n;
        v4u o; o.x = pk2(s[0 * 33], s[1 * 33]); o.y = pk2(s[2 * 33], s[3 * 33]); o.z = pk2(s[4 * 33], s[5 * 33]); o.w = pk2(s[6 * 33], s[7 * 33]);
        *(GAS v4u*)(WT + (size_t)(dst_n0 + n) * K + k0 + 8 * c) = o; }
    LDS_WAIT(); asm volatile("" ::: "memory");
}
__device__ __forceinline__ int ev_src_col(int j) {
    if (j < 1536) return j;
    if (j < 2304) { const int tile = j >> 8, pb = (j & 255) >> 5, bj = pb >> 2, wc = pb & 3;
        return (tile << 8) + (2 * wc + bj) * 32 + 32; }
    if (j < 2336) return j - 768; return -1;
}
__device__ __forceinline__ void convert_layer_weights(int wv_, KA a, int l, int mask, LAS unsigned char* lds, int rank, int nranks) {
    const int tid = otid(), lane = tid & 63, wave = __builtin_amdgcn_readfirstlane(tid >> 6);
    const int gw = rank * NWAVES + wave, NGW = nranks * NWAVES;
    LAS float* scr = (LAS float*)(lds + 49152 + wave * 8448);
    const int odd = l & 1, pr = l >> 1; unsigned char* wl = a->ws + WS_W;
    const int n_in = (mask & 1) ? (odd ? 16 * 96 : 16 * 80) : 0, n_o = (mask & 2) ? 16 * 32 : 0, n_1 = (mask & 4) ? 16 * 128 : 0, n_2 = (mask & 8) ? 64 * 32 : 0;
    for (int it = gw; it < n_in + n_o + n_1 + n_2; it += NGW) {
        int r = it;
        if (r < n_in) { const int nblk = odd ? 96 : 80, kb = r / nblk, nb = r % nblk;
            if (odd) transpose_item(a->in[I_ODWIN] + (size_t)pr * 1024 * 3072, 1024, 3072, nb * 32, (bf16*)(wl + W_IN), nb * 32, kb * 64, scr, lane);
            else     transpose_item(a->in[I_EVWIN] + (size_t)pr * 1024 * 2336, 1024, 2336, ev_src_col(nb * 32), (bf16*)(wl + W_IN), nb * 32, kb * 64, scr, lane);
            continue; }
        r -= n_in;
        if (r < n_o) { const int kb = r / 32, nb = r % 32; transpose_item((odd ? a->in[I_ODWOUT] : a->in[I_EVWOUT]) + (size_t)pr * 1024 * 1024, 1024, 1024, nb * 32, (bf16*)(wl + W_OUT), nb * 32, kb * 64, scr, lane); continue; }
        r -= n_o;
        if (r < n_1) { const int kb = r / 128, nb = r % 128; transpose_item(a->in[I_W1] + (size_t)l * 1024 * 4096, 1024, 4096, nb * 32, (bf16*)(wl + W_1), nb * 32, kb * 64, scr, lane); continue; }
        r -= n_1;
        { const int kb = r / 32, nb = r % 32; transpose_item(a->in[I_W2] + (size_t)l * 4096 * 1024, 4096, 1024, nb * 32, (bf16*)(wl + W_2), nb * 32, kb * 64, scr, lane); }
    }
}
__device__ __forceinline__ void p0a_prologue(int wv_, KA a, LAS unsigned char* lds) {
    const int tid = otid(), lane = tid & 63, wave = __builtin_amdgcn_readfirstlane(tid >> 6);
    const int gw = blockIdx.x * NWAVES + wave, NGW = gridDim.x * NWAVES;
    LAS float* sc = (LAS float*)lds;
    LAS float* red = (LAS float*)(lds + 20480);
    for (int i = tid; i < 5 * 1024; i += NTHR) { const int cls = i >> 10, k = i & 1023; const float v = cls < 4 ? a->in[I_C][cls * 1024 + k] : a->in[I_CCTX][k]; sc[i] = v / (1.f + expf(-v)); }
    __syncthreads();
    float* MOD = (float*)(a->ws + WS_MOD);
    for (int item = blockIdx.x; item < 4 * 48; item += gridDim.x) {
        const int l = item / 48, nb = item % 48;
        const float* W = a->in[I_WADA] + (size_t)l * 1024 * 6144 + nb * 128 + lane * 2;
        float acc[5][2];
#pragma unroll
        for (int c = 0; c < 5; ++c) { acc[c][0] = 0.f; acc[c][1] = 0.f; }
#pragma unroll 4
        for (int kk = 0; kk < 128; ++kk) { const int k = wave * 128 + kk; const float2 w = *(const float2*)(W + (size_t)k * 6144);
#pragma unroll
            for (int c = 0; c < 5; ++c) { const float s = sc[c * 1024 + k]; acc[c][0] += s * w.x; acc[c][1] += s * w.y; } }
#pragma unroll
        for (int c = 0; c < 5; ++c) { red[(wave * 5 + c) * 128 + lane * 2] = acc[c][0]; red[(wave * 5 + c) * 128 + lane * 2 + 1] = acc[c][1]; }
        __syncthreads();
        for (int o = tid; o < 640; o += NTHR) { const int c = o >> 7, cc = o & 127; float s = a->in[I_BADA][l * 6144 + nb * 128 + cc];
#pragma unroll
            for (int w = 0; w < 8; ++w) s += red[(w * 5 + c) * 128 + cc];
            MOD[(size_t)(l * 5 + c) * 6144 + nb * 128 + cc] = s; }
        __syncthreads();
    }
    convert_layer_weights(wv_, a, 0, 15, lds, blockIdx.x, gridDim.x);
    {
        float* tab = (float*)(a->ws + WS_TAB);
        const int gt = blockIdx.x * NTHR + tid;
        if (gt < 3072) { const int pos = gt < 2048 ? gt / 16 : (gt - 2048) / 16, i = gt & 15;
            const float inv = powf(10000.f, -(float)i / 16.f), ang = (float)pos * inv;
            tab[gt * 2] = cosf(ang); tab[gt * 2 + 1] = sinf(ang); }
        if (gw == NGW - 1) {
#pragma unroll
            for (int j = 0; j < 2; ++j) { const float* lp = a->in[I_LAM] + j * 256;
                const float s1 = wave_sum(lp[lane] * lp[64 + lane]), s2 = wave_sum(lp[128 + lane] * lp[192 + lane]);
                if (lane == 0) tab[8192 + j] = expf(s1) - expf(s2) + lam_init_of(2 * j + 1); }
        }
    }
    for (int it = gw; it < 2 * PB; it += NGW) {
        const int j = it / PB, q = it % PB; const bool isctx = q >= SEQ; const int pos = isctx ? q - SEQ : q, L = isctx ? CTXL : SEQ;
        const float t = (float)pos / (float)(L - 1), w = 2.f * 3.14159265358979323846f * (float)pos / (float)L;
        float z = 0.f;
        if (lane == 0) z = t;
        else if (lane <= 16) { const float band = 1e-4f + (float)(lane - 1) * ((15.f - 1e-4f) / 15.f); z = cosf(w * band); }
        else if (lane <= 32) { const float band = 1e-4f + (float)(lane - 17) * ((15.f - 1e-4f) / 15.f); z = -sinf(w * band); }
        const float* w1 = a->in[I_FW1] + j * 33 * 64; const float* w2 = a->in[I_FW2] + j * 64 * 64;
        float h1 = a->in[I_FB1][j * 64 + lane];
#pragma unroll
        for (int e = 0; e < 33; ++e) h1 += rl(z, e) * w1[e * 64 + lane];
        h1 = sinf(h1);
        float h2 = a->in[I_FB2][j * 64 + lane];
#pragma unroll
        for (int e = 0; e < 64; ++e) h2 += rl(h1, e) * w2[e * 64 + lane];
        h2 = sinf(h2);
        float* HID = (float*)(a->ws + WS_HID) + (isctx ? (size_t)(2 * SEQ + j * CTXL + pos) * 64 : (size_t)(j * SEQ + pos) * 64);
        HID[lane] = h2;
    }
}

struct Row16 { f32x4 v[4]; };
__device__ __forceinline__ Row16 ld_row_f32(const float* p, int lane) { Row16 r; const GAS f32x4* q = (const GAS f32x4*)p + lane;
#pragma unroll
    for (int j = 0; j < 4; ++j) r.v[j] = q[64 * j];
    return r; }
__device__ __forceinline__ Row16 ld_row_bf16(const bf16* p, int lane) { Row16 r; const GAS unsigned long long* q = (const GAS unsigned long long*)p + lane;
#pragma unroll
    for (int j = 0; j < 4; ++j) { const unsigned long long w = q[64 * j]; const unsigned lo = (unsigned)w, hi = (unsigned)(w >> 32);
        r.v[j] = (f32x4){__builtin_bit_cast(float, lo << 16), __builtin_bit_cast(float, lo & 0xffff0000u), __builtin_bit_cast(float, hi << 16), __builtin_bit_cast(float, hi & 0xffff0000u)}; }
    return r; }
__device__ __forceinline__ void st_row_f32(float* p, const Row16& r, int lane) { GAS f32x4* q = (GAS f32x4*)p + lane;
#pragma unroll
    for (int j = 0; j < 4; ++j) q[64 * j] = r.v[j]; }
__device__ __forceinline__ void st_row_bf16(bf16* p, const Row16& r, int lane) { GAS unsigned long long* q = (GAS unsigned long long*)p + lane;
#pragma unroll
    for (int j = 0; j < 4; ++j) q[64 * j] = (unsigned long long)pk2(r.v[j].x, r.v[j].y) | ((unsigned long long)pk2(r.v[j].z, r.v[j].w) << 32); }
__device__ __forceinline__ float row_sumsq(const Row16& r) { float s = 0.f;
#pragma unroll
    for (int j = 0; j < 4; ++j) s += (r.v[j].x * r.v[j].x + r.v[j].y * r.v[j].y) + (r.v[j].z * r.v[j].z + r.v[j].w * r.v[j].w);
    return wave_sum(s); }
__device__ __forceinline__ void norm_mod_store(const Row16& x, const float* g, const float* shift, const float* scale, bf16* dst, int lane) {
    const float rstd = 1.f / sqrtf(row_sumsq(x) * (1.f / D) + EPS);
    const Row16 G = ld_row_f32(g, lane), SH = ld_row_f32(shift, lane), SC = ld_row_f32(scale, lane); Row16 o;
#pragma unroll
    for (int j = 0; j < 4; ++j) o.v[j] = (x.v[j] * rstd) * G.v[j] * (SC.v[j] + 1.f) + SH.v[j];
    st_row_bf16(dst, o, lane);
}
__device__ __forceinline__ void p0b_first_norm(int wv_, KA a) {
    const int tid_o = otid(), lane = tid_o & 63, wave = tid_o >> 6, gw = blockIdx.x * NWAVES + wave, NGW = gridDim.x * NWAVES;
    const float* MOD = (const float*)(a->ws + WS_MOD); bf16* A1 = (bf16*)(a->ws + WS_A1);
    for (int rb = gw; rb < R; rb += 2 * NGW) {
        const int r2 = rb + NGW < R ? rb + NGW : rb;
        const Row16 xa = ld_row_f32(xin_ptr(a, rb), lane), xb = ld_row_f32(xin_ptr(a, r2), lane);
        { const float* m = MOD + (size_t)(0 * 5 + row_cls(rb)) * 6144; norm_mod_store(xa, a->in[I_NORMG] + 0, m + 0, m + 1024, A1 + (size_t)rb * D, lane); }
        if (rb + NGW < R) { const float* m = MOD + (size_t)(0 * 5 + row_cls(r2)) * 6144; norm_mod_store(xb, a->in[I_NORMG] + 0, m + 0, m + 1024, A1 + (size_t)r2 * D, lane); }
    }
}
typedef unsigned long long u64_t;
template <bool FIRST> struct RawRow { u64_t xb[FIRST ? 1 : 4]; f32x4 xf[FIRST ? 4 : 1]; u64_t y1[4], y2[4]; };
__device__ __forceinline__ Row16 cvt_raw(const u64_t (&q)[4]) { Row16 r;
#pragma unroll
    for (int j = 0; j < 4; ++j) { const unsigned lo = (unsigned)q[j], hi = (unsigned)(q[j] >> 32);
        r.v[j] = (f32x4){__builtin_bit_cast(float, lo << 16), __builtin_bit_cast(float, lo & 0xffff0000u), __builtin_bit_cast(float, hi << 16), __builtin_bit_cast(float, hi & 0xffff0000u)}; }
    return r; }
template <bool FIRST> __device__ __forceinline__ void rowwise_body(int wv_, KA a, int layer, int which, LAS unsigned char* lds) {
    const int tid = otid(), lane = tid & 63, wave = tid >> 6, gw = blockIdx.x * NWAVES + wave;
    const float* MOD = (const float*)(a->ws + WS_MOD); bf16* A1 = (bf16*)(a->ws + WS_A1); const bf16* Y = (const bf16*)(a->ws + WS_Y); const bf16* SLAB = (const bf16*)(a->ws + WS_SLAB);
    bf16* XB = (bf16*)(a->ws + WS_XB);
    const float* ng = a->in[I_NORMG] + (size_t)layer * 4 * D;
    const bool lastl = layer == DEPTH - 1, lastp = lastl && which == 1;
    constexpr int RPW = 17;
    const int rbl = blockIdx.x * (NWAVES * RPW), rbh = rbl + NWAVES * RPW - 1;
    const int clsA = row_cls(rbl < R ? rbl : R - 1), clsB = row_cls(rbh < R ? rbh : R - 1);
    LAS f32x4* vec = (LAS f32x4*)lds;
    for (int idx = tid; idx < 2 * 7 * 256; idx += NTHR) { const int c = idx / (7 * 256), v = (idx >> 8) % 7, q = idx & 255, cls = c ? clsB : clsA;
        const float* m = MOD + (size_t)(layer * 5 + cls) * 6144; const float* m2 = MOD + (size_t)((lastp || !which ? layer : layer + 1) * 5 + cls) * 6144;
        const float* src = v == 0 ? ng + 1 * D : v == 1 ? ng + 3 * D : v == 2 ? (which ? ng + 4 * D : ng + 2 * D) : v == 3 ? m + 2 * 1024 : v == 4 ? m + 5 * 1024 : v == 5 ? (which ? m2 + 0 : m + 3 * 1024) : (which ? m2 + 1024 : m + 4 * 1024);
        vec[idx] = *(const f32x4*)(src + 4 * q); }
    __syncthreads();
    const int r0 = gw * RPW, r1 = r0 + RPW < R ? r0 + RPW : R;
    if (r0 >= R) return;
    auto load_raw = [&](RawRow<FIRST>& q, int r) {
        if constexpr (FIRST) { const GAS f32x4* xp = (const GAS f32x4*)xin_ptr(a, r) + lane;
#pragma unroll
            for (int j = 0; j < 4; ++j) q.xf[j] = xp[64 * j]; }
        else { const GAS u64_t* xp = (const GAS u64_t*)(XB + (size_t)r * D) + lane;
#pragma unroll
            for (int j = 0; j < 4; ++j) q.xb[j] = xp[64 * j]; }
        const GAS u64_t* yp = (const GAS u64_t*)(Y + (size_t)r * D) + lane;
#pragma unroll
        for (int j = 0; j < 4; ++j) q.y1[j] = yp[64 * j];
        if (which) { const GAS u64_t* zp = (const GAS u64_t*)(A1 + (size_t)r * D) + lane;
#pragma unroll
            for (int j = 0; j < 4; ++j) q.y2[j] = zp[64 * j]; } };
    RawRow<FIRST> q0, q1, q2;
    load_raw(q0, r0); q1 = q0; q2 = q0;
    if (r0 + 1 < r1) load_raw(q1, r0 + 1);
    for (int r = r0; r < r1; ++r) {
        if (r + 2 < r1) load_raw(q2, r + 2);
        const int b = r / PB, p = r - b * PB, cls = p < CTXL ? 4 : b;
        if (!(lastl && cls == 4)) {
            const LAS f32x4* vt = vec + (cls == clsA ? 0 : 7 * 256) + lane;
            Row16 x;
            if constexpr (FIRST) {
#pragma unroll
                for (int jj = 0; jj < 4; ++jj) x.v[jj] = q0.xf[jj]; }
            else x = cvt_raw(q0.xb);
            const Row16 y1 = cvt_raw(q0.y1);
            const float rstd1 = 1.f / sqrtf(row_sumsq(y1) * (1.f / D) + EPS);
#pragma unroll
            for (int jj = 0; jj < 4; ++jj) x.v[jj] = x.v[jj] + vt[3 * 256 + 64 * jj] * ((y1.v[jj] * rstd1) * vt[0 * 256 + 64 * jj]);
            bool done = false;
            if (which) {
                Row16 y2;
                if (p < CTXL) { y2 = ld_row_bf16(SLAB + (size_t)(b * CTXL + p) * D, lane);
#pragma unroll
                    for (int k = 1; k < 4; ++k) { const Row16 sk = ld_row_bf16(SLAB + (size_t)k * 1024 * D + (size_t)(b * CTXL + p) * D, lane);
#pragma unroll
                        for (int jj = 0; jj < 4; ++jj) y2.v[jj] = y2.v[jj] + sk.v[jj]; } }
                else y2 = cvt_raw(q0.y2);
                const float rstd2 = 1.f / sqrtf(row_sumsq(y2) * (1.f / D) + EPS);
#pragma unroll
                for (int jj = 0; jj < 4; ++jj) x.v[jj] = x.v[jj] + vt[4 * 256 + 64 * jj] * ((y2.v[jj] * rstd2) * vt[1 * 256 + 64 * jj]);
                if (lastp) { st_row_f32(a->out + (size_t)(b * SEQ + (p - CTXL)) * D, x, lane); done = true; }
                else st_row_bf16(XB + (size_t)r * D, x, lane);
            }
            if (!done) {
                const float rs2 = 1.f / sqrtf(row_sumsq(x) * (1.f / D) + EPS); Row16 o;
#pragma unroll
                for (int jj = 0; jj < 4; ++jj) o.v[jj] = (x.v[jj] * rs2) * vt[2 * 256 + 64 * jj] * (vt[6 * 256 + 64 * jj] + 1.f) + vt[5 * 256 + 64 * jj];
                st_row_bf16(A1 + (size_t)r * D, o, lane);
            }
        }
        q0 = q1; q1 = q2;
    }
}
__device__ __forceinline__ void rowwise_post(int wv_, KA a, int layer, int which, LAS unsigned char* lds) {
    if (layer == 0) rowwise_body<true>(wv_, a, layer, which, lds); else rowwise_body<false>(wv_, a, layer, which, lds);
}

__device__ __forceinline__ void attn_phase_fast(int wv_, KA a, bool odd, char* lds_generic, bool skip_ctx_q = false) {
    const int G = gridDim.x, bx = blockIdx.x; const int vcu = (G % 8 == 0) ? (bx % 8) * (G / 8) + bx / 8 : bx;
    const int nvh = 8, nheavy = 4 * nvh * 32, ntot = nheavy + (skip_ctx_q ? 0 : 4 * nvh);
    unsigned char* ws = a->ws;
    const attn_body::bf16* P = (const attn_body::bf16*)(ws + WS_PH);
    for (int u = vcu; u < ntot; u += G) {
        int b, vh, panel;
        if (u < nheavy) { const int i = u >> 8, v = u & 255, xcd = v >> 5; b = xcd >> 1; vh = (xcd & 1) * (nvh >> 1) + i; panel = (v & 31) + 1; }
        else { const int lu = u - nheavy; b = lu / nvh; vh = lu % nvh; panel = 0; }
        const size_t row0 = (size_t)b * PB, qrow = row0 + 256 * panel; const int NT = panel == 0 ? CTXL / 64 : PB / 64;
        if (!odd) { const int kvh = vh >> 2;
            attn_body::attn_unit<8>(otid(), P + qrow * NP_EV + EGQ + vh * 64, NP_EV, P + row0 * NP_EV + EGK + kvh * 64, P + row0 * NP_EV + EGV + kvh * 64, NP_EV,
                                    (attn_body::bf16*)(ws + WS_A1) + qrow * D + 512 + vh * 64, D, NT, lds_generic); }
        else { const int hd = vh >> 1, c = vh & 1;
            attn_body::attn_unit128<8>(otid(), P + qrow * NP_OD + ODQ + hd * 128 + c * 64, NP_OD, P + row0 * NP_OD + ODK + hd * 128 + c * 64, P + row0 * NP_OD + ODV + hd * 128, NP_OD,
                                       (attn_body::bf16*)(ws + WS_Y) + qrow * D + hd * 256 + c * 128, D, NT, lds_generic); }
    }
}

constexpr size_t WS_UT = WS_Y, WS_S0T = WS_PH + 165 * MiB, WS_DEC = 504 * MiB;
constexpr int GQP = 144, GVP = 272, GIMG_OFF = 8 * (64 * GQP) + 2 * (64 * GVP) + 2048;
typedef short gbf16x8 __attribute__((ext_vector_type(8)));
typedef short gs16x4 __attribute__((ext_vector_type(4)));
typedef float gf32x4 __attribute__((ext_vector_type(4)));
__device__ __forceinline__ gs16x4 gtr(const LAS unsigned char* p) { return __builtin_bit_cast(gs16x4, __builtin_amdgcn_ds_read_tr16_b64_v4i16((LAS gs16x4*)p)); }
__device__ __forceinline__ gbf16x8 gcat(gs16x4 lo, gs16x4 hi) { return (gbf16x8){lo[0], lo[1], lo[2], lo[3], hi[0], hi[1], hi[2], hi[3]}; }
__device__ __forceinline__ float log_sigmoid_fast(float x) { return fminf(x, 0.f) - __logf(1.f + __expf(-fabsf(x))); }
__device__ __forceinline__ float rls(float v, int k) { return __builtin_bit_cast(float, __builtin_amdgcn_readlane(__builtin_bit_cast(int, v), k)); }

__device__ __forceinline__ void gla_prep_b(KA a, int j, const bf16* P, size_t row0, int head, int pdir, int role, int wave, int lane, LAS float* xch, float (&bv)[2][4][4], float (&tall)[4]) {
    const int g = lane >> 4, l15 = lane & 15; const gbf16x8 zero8 = {0, 0, 0, 0, 0, 0, 0, 0};
    gbf16x8 lrA[2];
#pragma unroll
    for (int tt = 0; tt < 2; ++tt) { lrA[tt] = zero8; if (g < 2) lrA[tt] = *(const gbf16x8*)(P + (row0 + 32 * role + 16 * tt + l15) * NP_EV + ELR + pdir * 16 + 8 * g); }
    gf32x4 gk[2][4];
#pragma unroll
    for (int dt = 0; dt < 4; ++dt) {
        unsigned hw[4] = {0u, 0u, 0u, 0u}, lw[4] = {0u, 0u, 0u, 0u};
        if (g < 2) {
#pragma unroll
            for (int e = 0; e < 8; ++e) { const float w = a->in[I_EVWLR][((size_t)(j * 2 + pdir) * 16 + 8 * g + e) * 256 + head * 64 + 16 * dt + l15];
                const unsigned h = f2bf(w), l = f2bf(w - __builtin_bit_cast(float, h << 16)); hw[e >> 1] |= h << (16 * (e & 1)); lw[e >> 1] |= l << (16 * (e & 1)); } }
        const gbf16x8 wh = __builtin_bit_cast(gbf16x8, (v4u){hw[0], hw[1], hw[2], hw[3]}), wlo = __builtin_bit_cast(gbf16x8, (v4u){lw[0], lw[1], lw[2], lw[3]});
        const float bl = a->in[I_EVBLR][(j * 2 + pdir) * 256 + head * 64 + 16 * dt + l15];
#pragma unroll
        for (int tt = 0; tt < 2; ++tt) { gf32x4 acc = (gf32x4){bl, bl, bl, bl};
            acc = __builtin_amdgcn_mfma_f32_16x16x32_bf16(lrA[tt], wh, acc, 0, 0, 0); acc = __builtin_amdgcn_mfma_f32_16x16x32_bf16(lrA[tt], wlo, acc, 0, 0, 0); gk[tt][dt] = acc; }
    }
    float tot[4];
#pragma unroll
    for (int dt = 0; dt < 4; ++dt) { float t2 = 0.f;
#pragma unroll
        for (int tt = 0; tt < 2; ++tt)
#pragma unroll
            for (int r = 0; r < 4; ++r) { const float x = gk[tt][dt][r]; const float e = __builtin_amdgcn_exp2f(-fabsf(x) * 1.4426950408889634f);
                const float la = (fminf(x, 0.f) - 0.6931471805599453f * __builtin_amdgcn_logf(1.f + e)) * (1.f / 16.f); gk[tt][dt][r] = la; t2 += la; }
        tot[dt] = sum_rows4(t2); }
    if (g == 0) {
#pragma unroll
        for (int dt = 0; dt < 4; ++dt) xch[wave * 64 + 16 * dt + l15] = tot[dt]; }
    gbf16x8 tri[2];
#pragma unroll
    for (int tt = 0; tt < 2; ++tt) { unsigned w[4] = {0u, 0u, 0u, 0u}; const int tl = 16 * tt + l15;
#pragma unroll
        for (int e = 0; e < 8; ++e) { const int tp = e < 4 ? 4 * g + e : 16 + 4 * g + (e - 4); const bool keep = pdir == 0 ? (tp <= tl) : (tp >= tl); w[e >> 1] |= keep ? (0x3F80u << (16 * (e & 1))) : 0u; }
        tri[tt] = __builtin_bit_cast(gbf16x8, (v4u){w[0], w[1], w[2], w[3]}); }
    gf32x4 bl2[2][4];
#pragma unroll
    for (int dt = 0; dt < 4; ++dt) { unsigned hw[4], lw[4];
#pragma unroll
        for (int e = 0; e < 8; e += 2) { const float x0 = gk[e >> 2][dt][e & 3], x1 = gk[e >> 2][dt][(e & 3) + 1];
            const unsigned h0 = f2bf(x0), h1 = f2bf(x1); hw[e >> 1] = h0 | (h1 << 16);
            lw[e >> 1] = f2bf(x0 - __builtin_bit_cast(float, h0 << 16)) | (f2bf(x1 - __builtin_bit_cast(float, h1 << 16)) << 16); }
        const gbf16x8 bh = __builtin_bit_cast(gbf16x8, (v4u){hw[0], hw[1], hw[2], hw[3]}), blo = __builtin_bit_cast(gbf16x8, (v4u){lw[0], lw[1], lw[2], lw[3]});
#pragma unroll
        for (int tt = 0; tt < 2; ++tt) { gf32x4 acc = (gf32x4){0.f, 0.f, 0.f, 0.f};
            acc = __builtin_amdgcn_mfma_f32_16x16x32_bf16(tri[tt], bh, acc, 0, 0, 0); acc = __builtin_amdgcn_mfma_f32_16x16x32_bf16(tri[tt], blo, acc, 0, 0, 0); bl2[tt][dt] = acc; } }
    __syncthreads();
    const bool need_other = pdir == 0 ? (role == 1) : (role == 0);
#pragma unroll
    for (int dt = 0; dt < 4; ++dt) { const float other = xch[(wave ^ 1) * 64 + 16 * dt + l15]; tall[dt] = tot[dt] + other; const float add = need_other ? other : 0.f;
#pragma unroll
        for (int tt = 0; tt < 2; ++tt)
#pragma unroll
            for (int r = 0; r < 4; ++r) bv[tt][dt][r] = bl2[tt][dt][r] + add; }
}
__device__ __forceinline__ void gla_state_phase(int wv_, KA a, int j, LAS unsigned char* lds) {
    const int tid = otid(), lane = tid & 63, wave = __builtin_amdgcn_readfirstlane(tid >> 6);
    const int hl = wave >> 2, dir = (wave >> 1) & 1, role = wave & 1, g = lane >> 4, l15 = lane & 15;
    unsigned char* ws = a->ws; const bf16* P = (const bf16*)(ws + WS_PH);
    LAS unsigned char* kimg = lds + (hl * 2 + dir) * (64 * GQP); LAS unsigned char* vimg = lds + 4 * (64 * GQP) + hl * (64 * GVP); LAS float* xch = (LAS float*)(lds + 4 * (64 * GQP) + 2 * (64 * GVP));
    for (int unit = blockIdx.x; unit < NB * 132 * 2; unit += gridDim.x) {
        const int b = unit / 264, rem = unit % 264, cidx = rem >> 1, hp = rem & 1, head = hp * 2 + hl; const size_t row0 = (size_t)b * PB + cidx * 64;
        const int chain = (b * 4 + head) * 2 + dir;
        __syncthreads();
        { v4u vv[4], kk[2];
#pragma unroll
            for (int it = 0; it < 4; ++it) { const int ch = tid + it * NTHR, hh = ch >> 10, t = (ch >> 4) & 63, c16 = ch & 15; vv[it] = *(const v4u*)(P + (row0 + t) * NP_EV + EVV + (hp * 2 + hh) * 128 + c16 * 8); }
#pragma unroll
            for (int it = 0; it < 2; ++it) { const int ch = tid + it * NTHR, hh = ch >> 9, t = (ch >> 3) & 63, c8 = ch & 7; kk[it] = *(const v4u*)(P + (row0 + t) * NP_EV + EK + (hp * 2 + hh) * 64 + c8 * 8); }
#pragma unroll
            for (int it = 0; it < 4; ++it) { const int ch = tid + it * NTHR, hh = ch >> 10, t = (ch >> 4) & 63, c16 = ch & 15; *(LAS v4u*)(lds + 4 * (64 * GQP) + hh * (64 * GVP) + t * GVP + c16 * 16) = vv[it]; }
#pragma unroll
            for (int it = 0; it < 2; ++it) { const int ch = tid + it * NTHR, hh = ch >> 9, t = (ch >> 3) & 63, c8 = ch & 7;
                *(LAS v4u*)(lds + (hh * 2) * (64 * GQP) + t * GQP + c8 * 16) = kk[it]; *(LAS v4u*)(lds + (hh * 2 + 1) * (64 * GQP) + t * GQP + c8 * 16) = kk[it]; } }
        float bv[2][4][4], tall[4];
        gla_prep_b(a, j, P, row0, head, dir, role, wave, lane, xch, bv, tall);
#pragma unroll
        for (int tt = 0; tt < 2; ++tt)
#pragma unroll
            for (int dt = 0; dt < 4; ++dt)
#pragma unroll
                for (int r = 0; r < 4; ++r) { const int t = 32 * role + 16 * tt + 4 * g + r, dk = 16 * dt + l15;
                    LAS bf16* kp = (LAS bf16*)(kimg + t * GQP + dk * 2);
                    *kp = (bf16)f2bf(bf2f(*kp) * __builtin_amdgcn_exp2f((tall[dt] - bv[tt][dt][r]) * 1.4426950408889634f)); }
        if (role == 0 && g == 0) {
#pragma unroll
            for (int dt = 0; dt < 4; ++dt) ((float*)(ws + WS_DEC))[((size_t)chain * 132 + cidx) * 64 + 16 * dt + l15] = __builtin_amdgcn_exp2f(tall[dt] * 1.4426950408889634f); }
        __syncthreads();
        gf32x4 acc[4][4];
#pragma unroll
        for (int x = 0; x < 4; ++x)
#pragma unroll
            for (int y = 0; y < 4; ++y) acc[x][y] = (gf32x4){0.f, 0.f, 0.f, 0.f};
        const int q = l15 >> 2, p4 = lane & 3;
#pragma unroll
        for (int ks = 0; ks < 2; ++ks) {
            gbf16x8 af[4], bfr[4];
#pragma unroll
            for (int x = 0; x < 4; ++x) { const LAS unsigned char* pa = kimg + (32 * ks + 8 * g + q) * GQP + (16 * x + 4 * p4) * 2; af[x] = gcat(gtr(pa), gtr(pa + 4 * GQP)); }
#pragma unroll
            for (int y = 0; y < 4; ++y) { const LAS unsigned char* pb = vimg + (32 * ks + 8 * g + q) * GVP + (64 * role + 16 * y + 4 * p4) * 2; bfr[y] = gcat(gtr(pb), gtr(pb + 4 * GVP)); }
#pragma unroll
            for (int x = 0; x < 4; ++x)
#pragma unroll
                for (int y = 0; y < 4; ++y) acc[x][y] = __builtin_amdgcn_mfma_f32_16x16x32_bf16(af[x], bfr[y], acc[x][y], 0, 0, 0);
        }
        bf16* UT = (bf16*)(ws + WS_UT) + ((size_t)chain * 132 + cidx) * 8192;
#pragma unroll
        for (int x = 0; x < 4; ++x)
#pragma unroll
            for (int y = 0; y < 4; ++y) { const int dv = 64 * role + 16 * y + l15, dk = 16 * x + 4 * g;
                *(unsigned long long*)(UT + dv * 64 + dk) = (unsigned long long)pk2(acc[x][y][0], acc[x][y][1]) | ((unsigned long long)pk2(acc[x][y][2], acc[x][y][3]) << 32); }
    }
}
__device__ __forceinline__ void gla_scan_phase(int wv_, KA a) {
    const int tid = otid(), lane = tid & 63, wave = tid >> 6;
    const int vt = (blockIdx.x + gridDim.x * wave) * 64 + lane;
    if (vt >= 32 * 1024) return;
    unsigned char* ws = a->ws;
    const int chain = vt >> 10, e = vt & 1023, dir = chain & 1;
    const bf16* UT = (const bf16*)(ws + WS_UT); bf16* S0T = (bf16*)(ws + WS_S0T); const float* DEC = (const float*)(ws + WS_DEC);
    float S[8];
#pragma unroll
    for (int i = 0; i < 8; ++i) S[i] = 0.f;
#pragma unroll 11
    for (int s = 0; s < 132; ++s) {
        const int cidx = dir == 0 ? s : (s < 4 ? 3 - s : 135 - s);
        const size_t off = ((size_t)chain * 132 + cidx) * 8192 + (size_t)e * 8;
        const v4u u = *(const v4u*)(UT + off);
        const f32x4 d0 = *(const f32x4*)(DEC + ((size_t)chain * 132 + cidx) * 64 + (e & 7) * 8), d1 = *(const f32x4*)(DEC + ((size_t)chain * 132 + cidx) * 64 + (e & 7) * 8 + 4);
        v4u o; o.x = pk2(S[0], S[1]); o.y = pk2(S[2], S[3]); o.z = pk2(S[4], S[5]); o.w = pk2(S[6], S[7]);
        *(v4u*)(S0T + off) = o;
        const unsigned uw[4] = {u.x, u.y, u.z, u.w}; const float dd[8] = {d0.x, d0.y, d0.z, d0.w, d1.x, d1.y, d1.z, d1.w};
#pragma unroll
        for (int i = 0; i < 8; ++i) { const float uv = __builtin_bit_cast(float, (i & 1) ? (uw[i >> 1] & 0xffff0000u) : (uw[i >> 1] << 16)); S[i] = S[i] * dd[i] + uv; }
    }
}
__device__ __forceinline__ void gla_output_phase(int wv_, KA a, int j, LAS unsigned char* lds, int skipmask = 0) {
    const int tid = otid(), lane = tid & 63, wave = __builtin_amdgcn_readfirstlane(tid >> 6);
    const int hl = wave >> 2, pdir = (wave >> 1) & 1, role = wave & 1, q4 = wave & 3, g = lane >> 4, l15 = lane & 15;
    unsigned char* ws = a->ws; const bf16* P = (const bf16*)(ws + WS_PH); bf16* MIX = (bf16*)(ws + WS_A1);
    LAS unsigned char* qimg0 = lds + (hl * 2) * (64 * GQP); LAS unsigned char* kimg0 = lds + (4 + hl * 2) * (64 * GQP); LAS unsigned char* vimg = lds + 8 * (64 * GQP) + hl * (64 * GVP);
    for (int unit = blockIdx.x; unit < NB * 132 * 2; unit += gridDim.x) {
        const int b = unit / 264, rem = unit % 264, cidx = rem >> 1, hp = rem & 1, head = hp * 2 + hl; const size_t row0 = (size_t)b * PB + cidx * 64;
        __syncthreads();
        gbf16x8 sfA[8][2], sfB[8][2];
        const bf16* S0f = (const bf16*)(ws + WS_S0T) + ((size_t)((b * 4 + head) * 2) * 132 + cidx) * 8192;
#pragma unroll
        for (int c = 0; c < 8; ++c)
#pragma unroll
            for (int ks = 0; ks < 2; ++ks) sfA[c][ks] = *(const gbf16x8*)(S0f + (16 * c + l15) * 64 + 32 * ks + 8 * g);
        { v4u vv[4], gg[4], qq2[2], kk[2];
#pragma unroll
            for (int it = 0; it < 4; ++it) { const int ch = tid + it * NTHR, hh = ch >> 10, t = (ch >> 4) & 63, c16 = ch & 15; const bf16* src = P + (row0 + t) * NP_EV + (hp * 2 + hh) * 128 + c16 * 8; vv[it] = *(const v4u*)(src + EVV); gg[it] = *(const v4u*)(src + EG); }
#pragma unroll
            for (int it = 0; it < 2; ++it) { const int ch = tid + it * NTHR, hh = ch >> 9, t = (ch >> 3) & 63, c8 = ch & 7; const bf16* src = P + (row0 + t) * NP_EV + (hp * 2 + hh) * 64 + c8 * 8; qq2[it] = *(const v4u*)(src + EQ); kk[it] = *(const v4u*)(src + EK); }
#pragma unroll
            for (int it = 0; it < 4; ++it) { const int ch = tid + it * NTHR, hh = ch >> 10, t = (ch >> 4) & 63, c16 = ch & 15;
                *(LAS v4u*)(lds + 8 * (64 * GQP) + hh * (64 * GVP) + t * GVP + c16 * 16) = vv[it]; *(LAS v4u*)(lds + GIMG_OFF + hh * (64 * GVP) + t * GVP + c16 * 16) = gg[it]; }
#pragma unroll
            for (int it = 0; it < 2; ++it) { const int ch = tid + it * NTHR, hh = ch >> 9, t = (ch >> 3) & 63, c8 = ch & 7;
                *(LAS v4u*)(lds + (hh * 2) * (64 * GQP) + t * GQP + c8 * 16) = qq2[it]; *(LAS v4u*)(lds + (hh * 2 + 1) * (64 * GQP) + t * GQP + c8 * 16) = qq2[it];
                *(LAS v4u*)(lds + (4 + hh * 2) * (64 * GQP) + t * GQP + c8 * 16) = kk[it]; *(LAS v4u*)(lds + (4 + hh * 2 + 1) * (64 * GQP) + t * GQP + c8 * 16) = kk[it]; } }
        {
            float bv[2][4][4], tall[4];
            gla_prep_b(a, j, P, row0, head, pdir, role, wave, lane, (LAS float*)(lds + 8 * (64 * GQP) + 2 * (64 * GVP)), bv, tall);
            LAS unsigned char* qi = qimg0 + pdir * (64 * GQP); LAS unsigned char* ki = kimg0 + pdir * (64 * GQP);
#pragma unroll
            for (int tt = 0; tt < 2; ++tt)
#pragma unroll
                for (int dt = 0; dt < 4; ++dt)
#pragma unroll
                    for (int r = 0; r < 4; ++r) { const int t = 32 * role + 16 * tt + 4 * g + r, dk = 16 * dt + l15;
                        const float e = __builtin_amdgcn_exp2f(bv[tt][dt][r] * 1.4426950408889634f);
                        LAS bf16* qp = (LAS bf16*)(qi + t * GQP + dk * 2); LAS bf16* kp = (LAS bf16*)(ki + t * GQP + dk * 2);
                        *qp = (bf16)f2bf(bf2f(*qp) * 0.125f * e);
                        *kp = (bf16)f2bf(bf2f(*kp) * __builtin_amdgcn_rcpf(e)); }
        }
        __syncthreads();
        gf32x4 o[8];
#pragma unroll
        for (int c = 0; c < 8; ++c) o[c] = (gf32x4){0.f, 0.f, 0.f, 0.f};
        const int qq = l15 >> 2, p4 = lane & 3;
#pragma unroll
        for (int c = 0; c < 8; ++c)
#pragma unroll
            for (int ks = 0; ks < 2; ++ks) sfB[c][ks] = *(const gbf16x8*)(S0f + (size_t)132 * 8192 + (16 * c + l15) * 64 + 32 * ks + 8 * g);
        if (!(skipmask & 2))
#pragma unroll
        for (int dir = 0; dir < 2; ++dir) {
            const LAS unsigned char* qimg = qimg0 + dir * (64 * GQP); const LAS unsigned char* kimg = kimg0 + dir * (64 * GQP);
            gbf16x8 qf[2];
#pragma unroll
            for (int ks = 0; ks < 2; ++ks) qf[ks] = *(const LAS gbf16x8*)(qimg + (16 * q4 + l15) * GQP + (32 * ks + 8 * g) * 2);
            gf32x4 st[4];
#pragma unroll
            for (int jt = 0; jt < 4; ++jt) { st[jt] = (gf32x4){0.f, 0.f, 0.f, 0.f};
#pragma unroll
                for (int ks = 0; ks < 2; ++ks) { const gbf16x8 kf = *(const LAS gbf16x8*)(kimg + (16 * jt + l15) * GQP + (32 * ks + 8 * g) * 2);
                    st[jt] = __builtin_amdgcn_mfma_f32_16x16x32_bf16(kf, qf[ks], st[jt], 0, 0, 0); }
                const int i = 16 * q4 + l15;
#pragma unroll
                for (int r = 0; r < 4; ++r) { const int jj = 16 * jt + 4 * g + r; const bool keep = dir == 0 ? (jj <= i) : (jj >= i); st[jt][r] = keep ? st[jt][r] : 0.f; } }
            gbf16x8 pa[2];
#pragma unroll
            for (int k2 = 0; k2 < 2; ++k2) { const unsigned w0 = pk2(st[2 * k2][0], st[2 * k2][1]), w1 = pk2(st[2 * k2][2], st[2 * k2][3]), w2 = pk2(st[2 * k2 + 1][0], st[2 * k2 + 1][1]), w3 = pk2(st[2 * k2 + 1][2], st[2 * k2 + 1][3]);
                pa[k2] = __builtin_bit_cast(gbf16x8, (v4u){w0, w1, w2, w3}); }
#pragma unroll
            for (int c = 0; c < 8; ++c) {
#pragma unroll
                for (int k2 = 0; k2 < 2; ++k2) { const LAS unsigned char* pv = vimg + (32 * k2 + 4 * g + qq) * GVP + (16 * c + 4 * p4) * 2;
                    const gbf16x8 vf = gcat(gtr(pv), gtr(pv + 16 * GVP));
                    o[c] = __builtin_amdgcn_mfma_f32_16x16x32_bf16(pa[k2], vf, o[c], 0, 0, 0); }
#pragma unroll
                for (int ks = 0; ks < 2; ++ks) o[c] = __builtin_amdgcn_mfma_f32_16x16x32_bf16(qf[ks], dir ? sfB[c][ks] : sfA[c][ks], o[c], 0, 0, 0);
            }
        }
        if (skipmask & 4) continue;
        float ss[4];
#pragma unroll
        for (int r = 0; r < 4; ++r) { float t2 = 0.f;
#pragma unroll
            for (int c = 0; c < 8; ++c) t2 += o[c][r] * o[c][r];
            t2 = sum16(t2);
            ss[r] = 1.f / sqrtf(t2 * (1.f / 128.f) + EPS); }
        LAS unsigned char* gimg = lds + GIMG_OFF + hl * (64 * GVP);
#pragma unroll
        for (int c = 0; c < 8; ++c) { const float gain = a->in[I_EVGLAG][j * 128 + 16 * c + l15];
#pragma unroll
            for (int r = 0; r < 4; ++r) { LAS bf16* gp = (LAS bf16*)(gimg + (16 * q4 + 4 * g + r) * GVP + (16 * c + l15) * 2);
                *gp = (bf16)f2bf(o[c][r] * ss[r] * gain * siluf(bf2f(*gp))); } }
        __syncthreads();
#pragma unroll
        for (int it = 0; it < 4; ++it) { const int ch = tid + it * NTHR, hh = ch >> 10, t = (ch >> 4) & 63, c16 = ch & 15;
            *(v4u*)(MIX + (row0 + t) * D + (hp * 2 + hh) * 128 + c16 * 8) = *(const LAS v4u*)(lds + GIMG_OFF + hh * (64 * GVP) + t * GVP + c16 * 16); }
    }
}

__device__ __forceinline__ void diff_out_phase(int wv_, KA a, int j, int layer) {
    const int tid_o = otid(), lane = tid_o & 63, wave = tid_o >> 6, gw = blockIdx.x * NWAVES + wave, NGW = gridDim.x * NWAVES;
    const bf16* O01 = (const bf16*)(a->ws + WS_Y); bf16* MIX = (bf16*)(a->ws + WS_A1);
    const float lam = ((const float*)(a->ws + WS_TAB))[8192 + j], post = 1.f - lam_init_of(layer);
    const int hd = lane >> 4, d8 = (lane & 15) * 8;
    float gn[8];
#pragma unroll
    for (int e = 0; e < 8; ++e) gn[e] = a->in[I_DIFFG][j * 128 + d8 + e] * post;
    for (int rb = gw; rb < R; rb += 4 * NGW) {
        v4u w0[4], w1[4];
#pragma unroll
        for (int k = 0; k < 4; ++k) { const int r = rb + k * NGW < R ? rb + k * NGW : rb; const bf16* o = O01 + (size_t)r * D + hd * 256 + d8; w0[k] = *(const v4u*)o; w1[k] = *(const v4u*)(o + 128); }
#pragma unroll
        for (int k = 0; k < 4; ++k) { const int r = rb + k * NGW;
            if (r >= R || (layer == DEPTH - 1 && row_cls(r) == 4)) continue;
            const unsigned a0[4] = {w0[k].x, w0[k].y, w0[k].z, w0[k].w}, a1[4] = {w1[k].x, w1[k].y, w1[k].z, w1[k].w};
            float v[8]; float ss = 0.f;
#pragma unroll
            for (int e = 0; e < 8; ++e) { const float x0 = __builtin_bit_cast(float, (e & 1) ? (a0[e >> 1] & 0xffff0000u) : (a0[e >> 1] << 16)), x1 = __builtin_bit_cast(float, (e & 1) ? (a1[e >> 1] & 0xffff0000u) : (a1[e >> 1] << 16));
                v[e] = x0 - lam * x1; ss += v[e] * v[e]; }
            ss = sum16(ss);
            const float rstd = 1.f / sqrtf(ss * (1.f / 128.f) + EPS);
            v4u ow; ow.x = pk2(v[0] * rstd * gn[0], v[1] * rstd * gn[1]); ow.y = pk2(v[2] * rstd * gn[2], v[3] * rstd * gn[3]); ow.z = pk2(v[4] * rstd * gn[4], v[5] * rstd * gn[5]); ow.w = pk2(v[6] * rstd * gn[6], v[7] * rstd * gn[7]);
            *(v4u*)(MIX + (size_t)r * D + 512 + hd * 128 + d8) = ow; }
    }
}

typedef float cf2 __attribute__((ext_vector_type(2)));
constexpr size_t WS_PT = WS_PH + 99 * MiB;
constexpr size_t WS_HYS = WS_A1;
constexpr float TWC[16] = {1.000000000e+00f, 9.807852804e-01f, 9.238795325e-01f, 8.314696123e-01f, 7.071067812e-01f, 5.555702330e-01f, 3.826834324e-01f, 1.950903220e-01f, 6.123233996e-17f, -1.950903220e-01f, -3.826834324e-01f, -5.555702330e-01f, -7.071067812e-01f, -8.314696123e-01f, -9.238795325e-01f, -9.807852804e-01f};
constexpr float TWS[16] = {0.000000000e+00f, 1.950903220e-01f, 3.826834324e-01f, 5.555702330e-01f, 7.071067812e-01f, 8.314696123e-01f, 9.238795325e-01f, 9.807852804e-01f, 1.000000000e+00f, 9.807852804e-01f, 9.238795325e-01f, 8.314696123e-01f, 7.071067812e-01f, 5.555702330e-01f, 3.826834324e-01f, 1.950903220e-01f};
__device__ __forceinline__ cf2 cmul(cf2 a, cf2 b) { return (cf2){a.x * b.x - a.y * b.y, a.x * b.y + a.y * b.x}; }
__device__ __forceinline__ cf2 cmulc(cf2 a, cf2 b) { return (cf2){a.x * b.x + a.y * b.y, a.y * b.x - a.x * b.y}; }
template <bool INV> __device__ __forceinline__ cf2 tw_mul(cf2 d, int ti) {
    if (ti == 0) return d;
    if (ti == 8) return INV ? (cf2){-d.y, d.x} : (cf2){d.y, -d.x};
    const float c = TWC[ti], s = TWS[ti];
    return INV ? (cf2){d.x * c - d.y * s, d.y * c + d.x * s} : (cf2){d.x * c + d.y * s, d.y * c - d.x * s};
}
template <int N, int H, bool INV> struct FftStage {
    static __device__ __forceinline__ void run(cf2 (&x)[N]) {
#pragma unroll
        for (int g = 0; g < N; g += 2 * H)
#pragma unroll
            for (int j = 0; j < H; ++j) { const cf2 a = x[g + j], b = x[g + j + H]; x[g + j] = a + b; x[g + j + H] = tw_mul<INV>(a - b, j * (16 / H)); }
        FftStage<N, H / 2, INV>::run(x);
    }
};
template <int N, bool INV> struct FftStage<N, 0, INV> { static __device__ __forceinline__ void run(cf2 (&)[N]) {} };
template <int N, bool INV> __device__ __forceinline__ void fft_reg(cf2 (&x)[N]) { FftStage<N, N / 2, INV>::run(x); }
__device__ __forceinline__ void fft32_half(cf2 (&x)[32]) {
#pragma unroll
    for (int j = 0; j < 16; ++j) x[j + 16] = tw_mul<false>(x[j], j);
    FftStage<32, 8, false>::run(x);
}
__host__ __device__ constexpr int br5(int i) { return ((i & 1) << 4) | ((i & 2) << 2) | (i & 4) | ((i & 8) >> 2) | ((i & 16) >> 4); }
__host__ __device__ constexpr int br4(int i) { return ((i & 1) << 3) | ((i & 2) << 1) | ((i & 4) >> 1) | ((i & 8) >> 3); }

#define HY_OPAQUE(w) asm volatile("" : "+v"(w.x), "+v"(w.y))
__device__ __forceinline__ void hy_p1_store(LAS cf2* buf, cf2 (&x)[32], int m, cf2 w1) {
    HY_OPAQUE(w1);
    const int base = 17 * (m >> 4) + (m & 15); cf2 pw = (cf2){1.f, 0.f};
#pragma unroll
    for (int k = 0; k < 32; ++k) { if (k) { pw = cmul(pw, w1); x[br5(k)] = cmul(x[br5(k)], pw); } buf[560 * k + base] = x[br5(k)]; }
}
__device__ __forceinline__ void hy_p2(LAS cf2* buf, int tid, cf2 w2) {
    HY_OPAQUE(w2);
    const int base = 560 * (tid >> 4) + (tid & 15); cf2 x[32];
#pragma unroll
    for (int n = 0; n < 32; ++n) x[n] = buf[base + 17 * n];
    fft_reg<32, false>(x);
    cf2 pw = (cf2){1.f, 0.f};
#pragma unroll
    for (int k = 0; k < 32; ++k) { if (k) { pw = cmul(pw, w2); x[br5(k)] = cmul(x[br5(k)], pw); } buf[base + 17 * k] = x[br5(k)]; }
}
template <int MODE> __device__ __forceinline__ void hy_p3(LAS cf2* buf, int tid, cf2* kf) {
#pragma unroll
    for (int i = 0; i < 2; ++i) {
        const int blk = tid + 512 * i, base = 560 * (blk >> 5) + 17 * (blk & 31); cf2 x[16];
#pragma unroll
        for (int n = 0; n < 16; ++n) x[n] = buf[base + n];
        fft_reg<16, false>(x);
        cf2* kp = kf + (size_t)(i * 16) * 512 + tid;
        if (MODE == 0) {
#pragma unroll
            for (int r = 0; r < 16; ++r) kp[r * 512] = x[r] * (1.f / 16384.f);
        } else {
            cf2 y[16];
#pragma unroll
            for (int r = 0; r < 16; ++r) x[r] = cmul(x[r], kp[r * 512]);
#pragma unroll
            for (int k = 0; k < 16; ++k) y[k] = x[br4(k)];
            fft_reg<16, true>(y);
#pragma unroll
            for (int r = 0; r < 16; ++r) buf[base + br4(r)] = y[r];
        }
    }
}
__device__ __forceinline__ void hy_ip2(LAS cf2* buf, int tid, cf2 w2) {
    HY_OPAQUE(w2);
    const int base = 560 * (tid >> 4) + (tid & 15); cf2 x[32]; cf2 pw = (cf2){1.f, 0.f};
#pragma unroll
    for (int k = 0; k < 32; ++k) { x[k] = buf[base + 17 * k]; if (k) { pw = cmulc(pw, w2); x[k] = cmul(x[k], pw); } }
    fft_reg<32, true>(x);
#pragma unroll
    for (int r = 0; r < 32; ++r) buf[base + 17 * br5(r)] = x[r];
}
__device__ __forceinline__ void hy_ip3(const LAS cf2* buf, cf2 (&x)[32], int m, cf2 w1) {
    HY_OPAQUE(w1);
    const int base = 17 * (m >> 4) + (m & 15); cf2 pw = (cf2){1.f, 0.f};
#pragma unroll
    for (int k = 0; k < 32; ++k) { x[k] = buf[560 * k + base]; if (k) { pw = cmulc(pw, w1); x[k] = cmul(x[k], pw); } }
    fft_reg<32, true>(x);
}
__device__ __forceinline__ float hy_sconv(const bf16* row, int L, int t, float w0, float w1, float w2, float cb) {
    float u0 = bf2f(row[t - 1]), u1 = bf2f(row[t]), u2 = bf2f(row[t + 1]); u0 = t > 0 ? u0 : 0.f; u2 = t + 1 < L ? u2 : 0.f;
    return u0 * w0 + u1 * w1 + u2 * w2 + cb;
}
__device__ __forceinline__ void hyena_fft_phase(int wv_, KA a, int j, bool do_ctx, LAS unsigned char* lds, bool dry = false, int skipmask = 0) {
    const int tid0 = otid();
    LAS cf2* buf = (LAS cf2*)lds;
    unsigned char* ws = a->ws;
    bf16* PT = (bf16*)(ws + WS_PT); const float* HF = (const float*)(ws + WS_HF);
    cf2* KF = (cf2*)(ws + WS_HYS + (size_t)blockIdx.x * 262144); float* Z1 = (float*)(ws + WS_HYS + (size_t)blockIdx.x * 262144 + 131072);
    const float* cw = a->in[I_ODCONVW] + (size_t)j * 3 * 1536; const float* cb = a->in[I_ODCONVB] + j * 1536; const float* hb = a->in[I_HYBIAS] + j * 1024;
    const float a1 = -6.283185307179586f * (float)tid0 * (1.f / 16384.f), a2 = -6.283185307179586f * (float)(tid0 & 15) * (1.f / 512.f);
    const cf2 w1 = (cf2){cosf(a1), sinf(a1)}, w2 = (cf2){cosf(a2), sinf(a2)};
    for (int c = blockIdx.x; c < 512; c += gridDim.x) {
#pragma unroll 1
        for (int o = 0; o < 2; ++o) {
            const float bias = hb[o * 512 + c];
            const int chg = 512 * (o + 1) + c;
            const float gw0 = cw[chg], gw1 = cw[1536 + chg], gw2 = cw[3072 + chg], gcb = cb[chg];
            if (!(skipmask & 1)) {
                int tid = tid0; asm volatile("" : "+v"(tid)); const int m = tid;
                const float* hf = HF + (size_t)(o * 1024 + c) * SEQ; const float* hbk = HF + (size_t)(o * 1024 + 512 + c) * SEQ;
                cf2 x[32];
#pragma unroll
                for (int n1 = 0; n1 < 32; ++n1) { float v;
                    if (n1 < 16) v = hf[512 * n1 + m]; else if (n1 == 16) v = m == 0 ? 0.f : hbk[8192 - m]; else v = hbk[16384 - 512 * n1 - m];
                    x[n1] = (cf2){v, 0.f}; }
                fft_reg<32, false>(x);
                hy_p1_store(buf, x, m, w1);
                __syncthreads(); hy_p2(buf, tid, w2); __syncthreads(); hy_p3<0>(buf, tid, KF); __syncthreads();
            }
#pragma unroll 1
            for (int pr = 0; pr < ((skipmask & 2) ? 0 : 2); ++pr) {
                int tid = tid0; asm volatile("" : "+v"(tid)); const int m = tid;
                cf2 xin[16];
                if (o == 0) { const float vw0 = cw[c], vw1 = cw[1536 + c], vw2 = cw[3072 + c], vcb = cb[c];
                    const bf16* r0 = PT + (size_t)c * R + (size_t)(2 * pr) * PB + CTXL; const bf16* r1 = r0 + PB;
#pragma unroll
                    for (int n1 = 0; n1 < 16; ++n1) xin[n1] = (cf2){hy_sconv(r0, SEQ, 512 * n1 + m, vw0, vw1, vw2, vcb), hy_sconv(r1, SEQ, 512 * n1 + m, vw0, vw1, vw2, vcb)}; }
                else {
#pragma unroll
                    for (int n1 = 0; n1 < 16; ++n1) xin[n1] = (cf2){Z1[(2 * pr) * SEQ + 512 * n1 + m], Z1[(2 * pr + 1) * SEQ + 512 * n1 + m]}; }
                cf2 x[32];
#pragma unroll
                for (int n1 = 0; n1 < 16; ++n1) x[n1] = xin[n1];
                fft32_half(x);
                hy_p1_store(buf, x, m, w1);
                __syncthreads(); hy_p2(buf, tid, w2); __syncthreads(); hy_p3<1>(buf, tid, KF); __syncthreads(); hy_ip2(buf, tid, w2); __syncthreads();
                hy_ip3(buf, x, m, w1);
                __syncthreads();
                const bf16* g0 = PT + (size_t)chg * R + (size_t)(2 * pr) * PB + CTXL; const bf16* g1 = g0 + PB;
#pragma unroll
                for (int i = 0; i < 32; ++i) { const int n1 = br5(i); if (n1 >= 16) continue; const int n = 512 * n1 + m;
                    const float z0 = hy_sconv(g0, SEQ, n, gw0, gw1, gw2, gcb) * (x[i].x + xin[n1].x * bias), z1 = hy_sconv(g1, SEQ, n, gw0, gw1, gw2, gcb) * (x[i].y + xin[n1].y * bias);
                    if (o == 0) { Z1[(2 * pr) * SEQ + n] = z0; Z1[(2 * pr + 1) * SEQ + n] = z1; }
                    else if (dry) { Z1[(2 * pr) * SEQ + n] = z0; Z1[(2 * pr + 1) * SEQ + n] = z1; }
                    else { bf16* o0 = PT + (size_t)c * R + (size_t)(2 * pr) * PB + CTXL; o0[n] = (bf16)f2bf(z0); o0[PB + n] = (bf16)f2bf(z1); } }
            }
        }
        if (do_ctx) {
            int tid = tid0; asm volatile("" : "+v"(tid));
            LAS float* uin = (LAS float*)lds;
            LAS float* hfl = uin + 3072;
            LAS float* z1c = hfl + 1024;
            const float* HFC = HF + (size_t)2048 * SEQ;
            __syncthreads();
            for (int idx = tid; idx < 3072; idx += NTHR) { const int k3 = idx >> 10, b = (idx >> 8) & 3, t = idx & 255, ch = 512 * k3 + c;
                uin[idx] = hy_sconv(PT + (size_t)ch * R + (size_t)b * PB, CTXL, t, cw[ch], cw[1536 + ch], cw[3072 + ch], cb[ch]); }
            for (int idx = tid; idx < 1024; idx += NTHR) hfl[idx] = HFC[(size_t)((idx >> 9) * 1024 + ((idx >> 8) & 1) * 512 + c) * CTXL + (idx & 255)];
            __syncthreads();
#pragma unroll 1
            for (int o = 0; o < 2; ++o) {
                const float bias = hb[o * 512 + c];
                float zz[2];
#pragma unroll
                for (int e = 0; e < 2; ++e) { const int oi = tid * 2 + e, b = oi >> 8, t = oi & 255;
                    const LAS float* in = o == 0 ? uin + b * 256 : z1c + b * 256; const LAS float* hfw = hfl + o * 512; const LAS float* hbw = hfw + 256;
                    float acc = 0.f;
                    for (int s = 0; s <= t; ++s) acc += hfw[t - s] * in[s];
                    for (int s = t + 1; s < 256; ++s) acc += hbw[s - t] * in[s];
                    zz[e] = uin[(1 + o) * 1024 + b * 256 + t] * (acc + in[t] * bias); }
                __syncthreads();
#pragma unroll
                for (int e = 0; e < 2; ++e) { const int oi = tid * 2 + e, b = oi >> 8, t = oi & 255;
                    if (o == 0 || dry) z1c[b * 256 + t] = zz[e]; else PT[(size_t)c * R + (size_t)b * PB + t] = (bf16)f2bf(zz[e]); }
                __syncthreads();
            }
        }
    }
}
__device__ __forceinline__ void hyena_transpose_phase(int wv_, KA a, LAS unsigned char* lds) {
    const int tid = otid();
    unsigned char* ws = a->ws; const bf16* PT = (const bf16*)(ws + WS_PT); bf16* MIX = (bf16*)(ws + WS_A1);
    constexpr int NT = 8 * (R / 64), TSZ = 64 * 66;
    for (int tb = blockIdx.x * 4; tb < NT; tb += gridDim.x * 4) {
        __syncthreads();
        v4u v[4];
#pragma unroll
        for (int k = 0; k < 4; ++k) { const int t = tb + k < NT ? tb + k : NT - 1; const int c0 = (t & 7) * 64, r0 = (t >> 3) * 64, cc = tid >> 3, rc = tid & 7;
            v[k] = *(const v4u*)(PT + (size_t)(c0 + cc) * R + r0 + rc * 8); }
#pragma unroll
        for (int k = 0; k < 4; ++k) { const int cc = tid >> 3, rc = tid & 7; LAS unsigned* d = (LAS unsigned*)((LAS bf16*)lds + k * TSZ + cc * 66 + rc * 8); d[0] = v[k].x; d[1] = v[k].y; d[2] = v[k].z; d[3] = v[k].w; }
        __syncthreads();
#pragma unroll
        for (int k = 0; k < 4; ++k) { if (tb + k >= NT) break; const int t = tb + k, c0 = (t & 7) * 64, r0 = (t >> 3) * 64, rr = tid >> 3, cch = tid & 7; const LAS bf16* tile = (const LAS bf16*)lds + k * TSZ; unsigned w[4];
#pragma unroll
            for (int e = 0; e < 4; ++e) w[e] = (unsigned)tile[(cch * 8 + 2 * e) * 66 + rr] | ((unsigned)tile[(cch * 8 + 2 * e + 1) * 66 + rr] << 16);
            *(v4u*)(MIX + (size_t)(r0 + rr) * D + c0 + cch * 8) = (v4u){w[0], w[1], w[2], w[3]}; }
    }
}

__device__ __forceinline__ void hf_split(const float (&x)[8], gbf16x8& hi, gbf16x8& lo) {
    unsigned hw[4], lw[4];
#pragma unroll
    for (int e = 0; e < 4; ++e) { const unsigned w = pk2(x[2 * e], x[2 * e + 1]); hw[e] = w;
        lw[e] = pk2(x[2 * e] - __builtin_bit_cast(float, w << 16), x[2 * e + 1] - __builtin_bit_cast(float, w & 0xffff0000u)); }
    hi = __builtin_bit_cast(gbf16x8, (v4u){hw[0], hw[1], hw[2], hw[3]}); lo = __builtin_bit_cast(gbf16x8, (v4u){lw[0], lw[1], lw[2], lw[3]});
}
__device__ __forceinline__ void hyena_filter_phase(int wv_, KA a, int j) {
    typedef float f32x16_t __attribute__((ext_vector_type(16)));
    const int tid = otid(), lane = tid & 63, wave = tid >> 6, gw = blockIdx.x * NWAVES + wave, NGW = gridDim.x * NWAVES, l31 = lane & 31, h = lane >> 5;
    const float* w3 = a->in[I_FW3] + (size_t)j * 64 * 2048; unsigned char* ws = a->ws;
    const float da = logf(1e-2f) / 0.3f, db = logf(1e-2f) / 1.5f;
    for (int it = gw; it < 2048 + 512; it += NGW) {
        const bool isctx = it >= 2048; const int rr = isctx ? it - 2048 : it, ct = rr & 63, tg = rr >> 6; const int L = isctx ? CTXL : SEQ, tile0 = isctx ? tg : 8 * tg, nt = isctx ? 1 : 8;
        const float* hid = (const float*)(ws + WS_HID) + (isctx ? (size_t)(2 * SEQ + j * CTXL) * 64 : (size_t)(j * SEQ) * 64);
        float* HF = (float*)(ws + WS_HF) + (isctx ? (size_t)2048 * SEQ : 0);
        gbf16x8 ah[4], al[4];
#pragma unroll
        for (int q = 0; q < 4; ++q) { float x[8];
#pragma unroll
            for (int e = 0; e < 8; ++e) x[e] = w3[(size_t)(32 * h + 8 * q + e) * 2048 + ct * 32 + l31];
            hf_split(x, ah[q], al[q]); }
        float dl[16];
#pragma unroll
        for (int r = 0; r < 16; ++r) { const int col = ct * 32 + (r & 3) + 8 * (r >> 2) + 4 * h; dl[r] = fabsf(da + (float)(col & 511) * ((db - da) / 511.f)); }
        f32x4 nx[8];
        { const f32x4* hr = (const f32x4*)(hid + (size_t)(tile0 * 32 + l31) * 64 + 32 * h);
#pragma unroll
          for (int q4 = 0; q4 < 8; ++q4) nx[q4] = hr[q4]; }
#pragma unroll 1
        for (int tt = 0; tt < nt; ++tt) {
            const int t = (tile0 + tt) * 32 + l31;
            f32x4 cur[8];
#pragma unroll
            for (int q4 = 0; q4 < 8; ++q4) cur[q4] = nx[q4];
            if (tt + 1 < nt) { const f32x4* hr = (const f32x4*)(hid + (size_t)(t + 32) * 64 + 32 * h);
#pragma unroll
                for (int q4 = 0; q4 < 8; ++q4) nx[q4] = hr[q4]; }
            f32x16_t acc = {};
#pragma unroll
            for (int q = 0; q < 4; ++q) { const float x[8] = {cur[2 * q].x, cur[2 * q].y, cur[2 * q].z, cur[2 * q].w, cur[2 * q + 1].x, cur[2 * q + 1].y, cur[2 * q + 1].z, cur[2 * q + 1].w};
                gbf16x8 bh, bl; hf_split(x, bh, bl);
                acc = __builtin_amdgcn_mfma_f32_32x32x16_bf16(ah[q], bh, acc, 0, 0, 0); acc = __builtin_amdgcn_mfma_f32_32x32x16_bf16(ah[q], bl, acc, 0, 0, 0); acc = __builtin_amdgcn_mfma_f32_32x32x16_bf16(al[q], bh, acc, 0, 0, 0); }
            const float tf = (float)t / (float)(L - 1);
#pragma unroll
            for (int r = 0; r < 16; ++r) { const int col = ct * 32 + (r & 3) + 8 * (r >> 2) + 4 * h; HF[(size_t)col * L + t] = acc[r] * __expf(-tf * dl[r]); }
        }
    }
}
__device__ __forceinline__ void tail_convert(int wv_, KA a, int l, int mask, LAS unsigned char* lds, int nunits) {
    const int G = (int)gridDim.x, bx = obx(); int first = nunits % G; if (first == 0 || G - first < 32) first = 0;
    if (bx < first) return;
    __syncthreads();
    convert_layer_weights(wv_, a, l, mask, lds, bx - first, G - first);
}
#ifndef PROBE_REPEAT
#define PROBE_REPEAT 0
#endif
#define PRB(id, stmt) do { if (PROBE_REPEAT == (id)) { stmt; __syncthreads(); } } while (0)
__global__ void __launch_bounds__(NTHR, 2) fwd_kernel(Args a_unused) {
    extern __shared__ __attribute__((aligned(16))) unsigned char lds_raw[];
    LAS unsigned char* lds = (LAS unsigned char*)lds_raw;
    volatile LAS unsigned* MISC = (volatile LAS unsigned*)(lds + LDS_MISC);
    const KA a0 = (KA)__builtin_amdgcn_kernarg_segment_ptr();
    if (threadIdx.x < 64) MISC[threadIdx.x] = 0u;
    const int wv_ = __builtin_amdgcn_readfirstlane(threadIdx.x >> 6);
    __syncthreads();
    const int lo = a0->ph_lo, hi = a0->ph_hi;
    XcdBarrier bar; bar.bar = (unsigned*)(a0->ws + WS_CTL) + CW_BAR; bar.x = 0; bar.st = MISC + 8;
    if (hi - lo > 1) bar = xcd_barrier_post((unsigned*)(a0->ws + WS_CTL) + CW_BAR, MISC + 8);
#define IN(k) (lo <= (k) && (k) < hi)
#define SEAM(k) do { if (IN((k) + 1)) { xcd_barrier(bar, wv_); if (PROBE_REPEAT == 20) xcd_barrier(bar, wv_); } } while (0)
    if (IN(0)) { PRB(13, p0a_prologue(wv_, ka_launder(a0), lds)); p0a_prologue(wv_, ka_launder(a0), lds); SEAM(0); }
    if (IN(1)) { PRB(14, p0b_first_norm(wv_, ka_launder(a0))); p0b_first_norm(wv_, ka_launder(a0)); SEAM(1); }
#pragma unroll 1
    for (int layer = 0; layer < DEPTH; ++layer) {
        const int pb = 2 + 9 * layer, j = layer >> 1; const bool odd = layer & 1; const int last = layer == DEPTH - 1;
        if (IN(pb + 0)) {
            const KA a = ka_launder(a0); unsigned char* ws = a->ws; const unsigned char* wl = ws + WS_W;
            if (odd) { hyena_filter_phase(wv_, ka_launder(a0), j); __syncthreads(); }
            if (odd) {
                pg8::Gemm g{nullptr, nullptr, R, NP_OD, D, 0}; pg8::DualOrder S;
                S.init(ws + WS_A1, wl + W_IN + (size_t)1536 * D * 2, R, 1536, wl + W_IN, ws + WS_A1, 1536, R, (int)gridDim.x, obx());
                pg8::EpiInProj E{(bf16*)(ws + WS_PH), NP_OD, (bf16*)(ws + WS_PT), R, (const float*)(ws + WS_TAB), nullptr, 1, C2};
                PRB(1, (pg8::gemm_phase<pg8::EpiInProj, pg8::DualOrder, true, true>(lds, g, S, E, otid())));
                pg8::gemm_phase<pg8::EpiInProj, pg8::DualOrder, true, true>(lds, g, S, E, otid());
            } else {
                pg8::Gemm g{(const bf16*)(ws + WS_A1), (const bf16*)(wl + W_IN), R, NP_EV, D, 0}; pg8::StaticOrder S; S.init(R, NP_EV, (int)gridDim.x, obx());
                pg8::EpiInProj E{(bf16*)(ws + WS_PH), NP_EV, nullptr, 0, (const float*)(ws + WS_TAB), a->in[I_EVQKG] + j * 128, 0, C2};
                PRB(1, (pg8::gemm_phase<pg8::EpiInProj, pg8::StaticOrder, true, true>(lds, g, S, E, otid())));
                pg8::gemm_phase<pg8::EpiInProj, pg8::StaticOrder, true, true>(lds, g, S, E, otid());
            }
            if (layer > 0) tail_convert(wv_, ka_launder(a0), layer, 8, lds, odd ? (R / 256) * 12 : (R / 256) * 10);
            SEAM(pb + 0);
        }
        if (IN(pb + 1)) {
            if (!odd) { PRB(2, gla_state_phase(wv_, ka_launder(a0), j, lds)); gla_state_phase(wv_, ka_launder(a0), j, lds); SEAM(pb + 1); }
        }
        if (IN(pb + 2)) {
            if (odd) { PRB(7, hyena_fft_phase(wv_, ka_launder(a0), j, layer != DEPTH - 1, lds, true)); PRB(71, hyena_fft_phase(wv_, ka_launder(a0), j, false, lds, true, 2)); PRB(72, hyena_fft_phase(wv_, ka_launder(a0), j, false, lds, true, 1)); hyena_fft_phase(wv_, ka_launder(a0), j, layer != DEPTH - 1, lds); __syncthreads(); PRB(6, attn_phase_fast(wv_, ka_launder(a0), true, (char*)lds_raw, last)); attn_phase_fast(wv_, ka_launder(a0), true, (char*)lds_raw, last); }
            else { PRB(4, gla_scan_phase(wv_, ka_launder(a0))); gla_scan_phase(wv_, ka_launder(a0)); __syncthreads(); PRB(5, attn_phase_fast(wv_, ka_launder(a0), false, (char*)lds_raw)); attn_phase_fast(wv_, ka_launder(a0), false, (char*)lds_raw); }
            SEAM(pb + 2);
        }
        if (IN(pb + 3)) {
            if (odd) { PRB(9, (diff_out_phase(wv_, ka_launder(a0), j, layer), hyena_transpose_phase(wv_, ka_launder(a0), lds))); diff_out_phase(wv_, ka_launder(a0), j, layer); hyena_transpose_phase(wv_, ka_launder(a0), lds); } else { PRB(8, gla_output_phase(wv_, ka_launder(a0), j, lds)); PRB(31, gla_output_phase(wv_, ka_launder(a0), j, lds, 1)); PRB(32, gla_output_phase(wv_, ka_launder(a0), j, lds, 2)); PRB(34, gla_output_phase(wv_, ka_launder(a0), j, lds, 4)); PRB(37, gla_output_phase(wv_, ka_launder(a0), j, lds, 7)); gla_output_phase(wv_, ka_launder(a0), j, lds); }
            SEAM(pb + 3);
        }
        if (IN(pb + 4)) {
            const KA a = ka_launder(a0); unsigned char* ws = a->ws; const unsigned char* wl = ws + WS_W;
            pg8::Gemm g{(const bf16*)(ws + WS_A1), (const bf16*)(wl + W_OUT), R, D, D, 0}; pg8::StaticOrder S; S.init(last ? NB * SEQ : R, D, (int)gridDim.x, obx(), last);
            pg8::EpiBf16<0> E{(bf16*)(ws + WS_Y), D};
            PRB(10, (pg8::gemm_phase<pg8::EpiBf16<0>, pg8::StaticOrder, true, true>(lds, g, S, E, otid())));
            pg8::gemm_phase<pg8::EpiBf16<0>, pg8::StaticOrder, true, true>(lds, g, S, E, otid());
            if (!last) tail_convert(wv_, ka_launder(a0), layer + 1, 1, lds, (R / 256) * 4);
            SEAM(pb + 4);
        }
        if (IN(pb + 5)) { PRB(15, rowwise_post(wv_, ka_launder(a0), layer, 0, lds)); rowwise_post(wv_, ka_launder(a0), layer, 0, lds); SEAM(pb + 5); }
        if (IN(pb + 6)) {
            const KA a = ka_launder(a0); unsigned char* ws = a->ws; const unsigned char* wl = ws + WS_W;
            pg8::Gemm g{(const bf16*)(ws + WS_A1), (const bf16*)(wl + W_1), R, DFF, D, 0}; pg8::StaticOrder S; S.init(last ? NB * SEQ : R, DFF, (int)gridDim.x, obx(), last);
            pg8::EpiBf16<2> E{(bf16*)(ws + WS_PH), DFF};
            PRB(11, (pg8::gemm_phase<pg8::EpiBf16<2>, pg8::StaticOrder, true, true>(lds, g, S, E, otid())));
            if (PROBE_REPEAT == 41) { pg8::EpiBf16<2> E2{(bf16*)(ws + WS_PH), DFF, 1}; pg8::gemm_phase<pg8::EpiBf16<2>, pg8::StaticOrder, true, true>(lds, g, S, E2, otid()); __syncthreads(); }
            pg8::gemm_phase<pg8::EpiBf16<2>, pg8::StaticOrder, true, true>(lds, g, S, E, otid());
            if (!last) tail_convert(wv_, ka_launder(a0), layer + 1, 2, lds, (R / 256) * 16);
            SEAM(pb + 6);
        }
        if (IN(pb + 7)) {
            const KA a = ka_launder(a0); unsigned char* ws = a->ws; const unsigned char* wl = ws + WS_W;
            { pg8::Gemm g{(const bf16*)(ws + WS_PH), (const bf16*)(wl + W_2), R, D, DFF, 0}; pg8::StaticOrder S; S.init(NB * SEQ, D, (int)gridDim.x, obx(), 1);
              pg8::EpiBf16<0> E{(bf16*)(ws + WS_A1), D};
              PRB(12, (pg8::gemm_phase<pg8::EpiBf16<0>, pg8::StaticOrder, true, true>(lds, g, S, E, otid())));
              pg8::gemm_phase<pg8::EpiBf16<0>, pg8::StaticOrder, true, true>(lds, g, S, E, otid()); }
            if (!last) { __syncthreads();
              pg8::Gemm g{(const bf16*)(ws + WS_PH), (const bf16*)(wl + W_2), 4 * 256, D, DFF / 4, DFF}; pg8::CtxSplitOrder<4, 4> S; S.init(DFF / 4, (int)gridDim.x, obx());
              pg8::EpiSlab E{(bf16*)(ws + WS_SLAB), D, (size_t)1024 * D};
              pg8::gemm_phase<pg8::EpiSlab, pg8::CtxSplitOrder<4, 4>, true, true>(lds, g, S, E, otid());
              tail_convert(wv_, ka_launder(a0), layer + 1, 4, lds, 64); }
            SEAM(pb + 7);
        }
        if (IN(pb + 8)) { rowwise_post(wv_, ka_launder(a0), layer, 1, lds); SEAM(pb + 8); }
    }
#undef IN
#undef SEAM
}

constexpr int N_PHASES = 2 + 9 * DEPTH;
#ifndef MK_ONE_LAUNCH
#define MK_ONE_LAUNCH 1
#endif
extern "C" void kernel_launch(void* const* d_in, const int* in_sizes, int n_in, void* d_out, int out_size, void* d_ws, size_t ws_size, hipStream_t stream) {
    static int grid = 0;
    if (grid == 0) {
        if (n_in != 27 || in_sizes[0] != NB * SEQ * D || out_size != NB * SEQ * D || ws_size < WS_END) { fprintf(stderr, "kernel_launch: unexpected shapes (n_in %d, in0 %d, out %d, ws %zu)\n", n_in, n_in > 0 ? in_sizes[0] : -1, out_size, ws_size); grid = -1; return; }
        int dev = 0, cus = 0;
        if (hipGetDevice(&dev) != hipSuccess || hipDeviceGetAttribute(&cus, hipDeviceAttributeMultiprocessorCount, dev) != hipSuccess) { grid = -1; return; }
        if (hipFuncSetAttribute((const void*)fwd_kernel, hipFuncAttributeMaxDynamicSharedMemorySize, LDS_BYTES) != hipSuccess) { fprintf(stderr, "kernel_launch: hipFuncSetAttribute failed\n"); grid = -1; return; }
        (void)hipGetLastError();
        grid = cus;
    }
    if (grid < 0) return;
    if (hipMemsetAsync((char*)d_ws + WS_CTL, 0, CTL_ZERO_BYTES, stream) != hipSuccess) return;
    Args a{};
    for (int i = 0; i < 27; ++i) a.in[i] = (const float*)d_in[i];
    a.out = (float*)d_out; a.ws = (unsigned char*)d_ws;
#if MK_ONE_LAUNCH
    a.ph_lo = 0; a.ph_hi = N_PHASES;
    hipLaunchKernelGGL(fwd_kernel, dim3(grid), dim3(NTHR), LDS_BYTES, stream, a);
#else
    for (int k = 0; k < N_PHASES; ++k) { a.ph_lo = k; a.ph_hi = k + 1; hipLaunchKernelGGL(fwd_kernel, dim3(grid), dim3(NTHR), LDS_BYTES, stream, a); }
#endif
}
```
